# Optimizing an MI355X kernel written in HIP

```python
import math
import jax, jax.numpy as jnp
from jax import lax
import numpy as np

D_MODEL = 2048
BATCH = 2
SEQ = 16384
DEPTH = 2

GLA_HEADS = 4
GLA_DK = 128
GLA_DV = 256
GLA_KEY_WIDTH = GLA_HEADS * GLA_DK
GLA_VAL_WIDTH = GLA_HEADS * GLA_DV
GLA_GATE_RANK = 16
GLA_GATE_TAU = 16.0
GLA_CHUNK = 64

POOL_WINDOWS = (2, 4, 8, 16)
POOL_GROUPS = 4
POOL_WIDTH = D_MODEL // 2
POOL_GROUP_DIM = POOL_WIDTH // POOL_GROUPS

PROJ_SECTIONS = (GLA_KEY_WIDTH, GLA_KEY_WIDTH, GLA_VAL_WIDTH, GLA_VAL_WIDTH,
                 GLA_GATE_RANK, GLA_GATE_RANK, POOL_WIDTH, D_MODEL, D_MODEL)
D_IN_PROJ = 512 + 512 + 1024 + 1024 + 16 + 16 + 1024 + 2048 + 2048

PEER_HEADS = 8
PEER_NKEYS = 128
PEER_EXPERTS = PEER_NKEYS * PEER_NKEYS
PEER_QDIM = 256
PEER_HALF = PEER_QDIM // 2
PEER_TOPK = 16
PEER_BLOCK = 128

RMS_EPS = 1e-6

kernel_name = "hybrid_gla_pool_peer_encoder"


def rms_norm(x, g):
    xf = x.astype(jnp.float32)
    var = jnp.mean(xf * xf, axis=-1, keepdims=True)
    return (xf * lax.rsqrt(var + RMS_EPS) * g.astype(jnp.float32)).astype(x.dtype)


def split_proj(proj):
    points = []
    acc = 0
    for size in PROJ_SECTIONS[:-1]:
        acc += size
        points.append(acc)
    return jnp.split(proj, points, axis=-1)


def gla_chunked(q, k, v, logg, strict):
    B, S, H, DK = q.shape
    DV = v.shape[-1]
    nc = S // GLA_CHUNK
    q = q.reshape(B, nc, GLA_CHUNK, H, DK)
    k = k.reshape(B, nc, GLA_CHUNK, H, DK)
    v = v.reshape(B, nc, GLA_CHUNK, H, DV)
    b = jnp.cumsum(logg.reshape(B, nc, GLA_CHUNK, H, DK), axis=2)
    qe = q * jnp.exp(b)
    ke = k * jnp.exp(-b)
    attn = jnp.einsum('bnihk,bnjhk->bnhij', qe, ke)
    offset = -1 if strict else 0
    mask = jnp.tril(jnp.ones((GLA_CHUNK, GLA_CHUNK), dtype=bool), k=offset)
    attn = jnp.where(mask, attn, 0.0)
    o_intra = jnp.einsum('bnhij,bnjhv->bnihv', attn, v)
    b_last = b[:, :, -1]
    kd = k * jnp.exp(b_last[:, :, None] - b)
    chunk_kv = jnp.einsum('bnjhk,bnjhv->bnhkv', kd, v)
    decay = jnp.exp(b_last)

    def step(state, xs):
        d, kv = xs
        return d[..., None] * state + kv, state

    init = jnp.zeros((B, H, DK, DV), jnp.float32)
    _, s_prev = lax.scan(step, init, (jnp.moveaxis(decay, 1, 0), jnp.moveaxis(chunk_kv, 1, 0)))
    o_inter = jnp.einsum('bnihk,nbhkv->bnihv', qe, s_prev)
    return (o_intra + o_inter).reshape(B, S, H, DV)


def gla_branch(q, k, v, r, a_f, a_b, wg_f, bg_f, wg_b, bg_b, norm_g):
    B, S, _ = q.shape
    f32 = jnp.float32
    qh = q.astype(f32).reshape(B, S, GLA_HEADS, GLA_DK) * (GLA_DK ** -0.5)
    kh = k.astype(f32).reshape(B, S, GLA_HEADS, GLA_DK)
    vh = v.astype(f32).reshape(B, S, GLA_HEADS, GLA_DV)
    logg_f = (jax.nn.log_sigmoid(a_f.astype(f32) @ wg_f.astype(f32) + bg_f.astype(f32)) / GLA_GATE_TAU
              ).reshape(B, S, GLA_HEADS, GLA_DK)
    logg_b = (jax.nn.log_sigmoid(a_b.astype(f32) @ wg_b.astype(f32) + bg_b.astype(f32)) / GLA_GATE_TAU
              ).reshape(B, S, GLA_HEADS, GLA_DK)
    o_f = gla_chunked(qh, kh, vh, logg_f, strict=False)
    flip = lambda t: jnp.flip(t, axis=1)
    o_b = flip(gla_chunked(flip(qh), flip(kh), flip(vh), flip(logg_b), strict=True))
    o = o_f + o_b
    var = jnp.mean(o * o, axis=-1, keepdims=True)
    o = o * lax.rsqrt(var + RMS_EPS) * norm_g.astype(f32).reshape(GLA_HEADS, GLA_DV)
    o = o.reshape(B, S, GLA_VAL_WIDTH) * jax.nn.silu(r.astype(f32))
    return o.astype(q.dtype)


def multiscale_pool(p, w_grp, scale):
    B, S, _ = p.shape
    f32 = jnp.float32
    pg = p.astype(f32).reshape(B, S, POOL_GROUPS, POOL_GROUP_DIM)
    t = jnp.arange(S)
    outs = []
    for gi, w in enumerate(POOL_WINDOWS):
        xg = pg[:, :, gi]
        cs = jnp.concatenate([jnp.zeros((B, 1, POOL_GROUP_DIM), f32), jnp.cumsum(xg, axis=1)], axis=1)
        lo = jnp.clip(t - w // 2, 0, S)
        hi = jnp.clip(t - w // 2 + w, 0, S)
        win_sum = jnp.take(cs, hi, axis=1) - jnp.take(cs, lo, axis=1)
        cnt = (hi - lo).astype(f32)[None, :, None]
        outs.append(win_sum / cnt - xg)
    pooled = jnp.stack(outs, axis=2)
    mixed = jnp.einsum('bsgc,gcd->bsgd', pooled, w_grp.astype(f32))
    return (mixed.reshape(B, S, POOL_WIDTH) * scale.astype(f32)).astype(p.dtype)


def peer_ffn(x, wq, subkeys, u, v):
    B, S, D = x.shape
    K = PEER_TOPK
    q = (x @ wq).astype(jnp.float32).reshape(B, S, PEER_HEADS, 2, PEER_HALF)
    scores = jnp.einsum('bshpc,hpnc->bshpn', q, subkeys.astype(jnp.float32))
    s_top, i_top = lax.top_k(scores, K)
    cand = (s_top[..., 0, :, None] + s_top[..., 1, None, :]).reshape(B, S, PEER_HEADS, K * K)
    best, flat = lax.top_k(cand, K)
    i1 = jnp.take_along_axis(i_top[..., 0, :], flat // K, axis=-1)
    i2 = jnp.take_along_axis(i_top[..., 1, :], flat % K, axis=-1)
    expert = i1 * PEER_NKEYS + i2
    gate = jax.nn.softmax(best, axis=-1).astype(x.dtype)
    nblk = (B * S) // PEER_BLOCK
    xb = x.reshape(nblk, PEER_BLOCK, D)
    eb = expert.reshape(nblk, PEER_BLOCK, PEER_HEADS, K)
    gb = gate.reshape(nblk, PEER_BLOCK, PEER_HEADS, K)

    def block(args):
        xt, et, gt = args
        ue = jnp.take(u, et, axis=0)
        act = jax.nn.gelu(jnp.einsum('thkd,td->thk', ue, xt), approximate=False)
        ve = jnp.take(v, et, axis=0)
        return jnp.einsum('thk,thkd->td', act * gt, ve)

    out = lax.map(block, (xb, eb, gb))
    return out.reshape(B, S, D)


def setup_inputs(seed: int = 0) -> dict:
    key = jax.random.key(seed)
    ks = jax.random.split(key, 20)
    n = lambda k, shape, s: jax.random.normal(k, shape, jnp.float32) * s
    L, D = DEPTH, D_MODEL
    return {
        "x": n(ks[0], (BATCH, SEQ, D), 1.0),
        "norm_mix_g": 1.0 + n(ks[1], (L, D), 0.02),
        "w_in": n(ks[2], (L, D, D_IN_PROJ), D ** -0.5),
        "gla_gate_w_fwd": n(ks[3], (L, GLA_GATE_RANK, GLA_KEY_WIDTH), GLA_GATE_RANK ** -0.5),
        "gla_gate_b_fwd": n(ks[4], (L, GLA_KEY_WIDTH), 0.1),
        "gla_gate_w_bwd": n(ks[5], (L, GLA_GATE_RANK, GLA_KEY_WIDTH), GLA_GATE_RANK ** -0.5),
        "gla_gate_b_bwd": n(ks[6], (L, GLA_KEY_WIDTH), 0.1),
        "gla_norm_g": 1.0 + n(ks[7], (L, GLA_VAL_WIDTH), 0.02),
        "w_up_gla": n(ks[8], (L, GLA_VAL_WIDTH, D), GLA_VAL_WIDTH ** -0.5),
        "pool_w": n(ks[9], (L, POOL_GROUPS, POOL_GROUP_DIM, POOL_GROUP_DIM), POOL_GROUP_DIM ** -0.5),
        "pool_scale": 1.0 + n(ks[10], (L, POOL_WIDTH), 0.02),
        "w_up_pool": n(ks[11], (L, POOL_WIDTH, D), POOL_WIDTH ** -0.5),
        "w_out": n(ks[12], (L, D, D), D ** -0.5),
        "norm_ffn_g": 1.0 + n(ks[13], (L, D), 0.02),
        "peer_wq": n(ks[14], (L, D, PEER_HEADS * PEER_QDIM), D ** -0.5),
        "peer_subkeys": n(ks[15], (L, PEER_HEADS, 2, PEER_NKEYS, PEER_HALF), PEER_HALF ** -0.5),
        "peer_u": n(ks[16], (L, PEER_EXPERTS, D), D ** -0.5),
        "peer_v": n(ks[17], (L, PEER_EXPERTS, D), PEER_HEADS ** -0.5),
        "norm_final_g": 1.0 + n(ks[18], (D,), 0.02),
    }


def reference(x, norm_mix_g, w_in, gla_gate_w_fwd, gla_gate_b_fwd, gla_gate_w_bwd, gla_gate_b_bwd,
              gla_norm_g, w_up_gla, pool_w, pool_scale, w_up_pool, w_out, norm_ffn_g,
              peer_wq, peer_subkeys, peer_u, peer_v, norm_final_g):
    for l in range(DEPTH):
        h = rms_norm(x, norm_mix_g[l])
        proj = h @ w_in[l]
        q, k, v, r, a_f, a_b, p, g_gla, g_pool = split_proj(proj)
        y_gla = gla_branch(q, k, v, r, a_f, a_b, gla_gate_w_fwd[l], gla_gate_b_fwd[l],
                           gla_gate_w_bwd[l], gla_gate_b_bwd[l], gla_norm_g[l]) @ w_up_gla[l]
        y_pool = multiscale_pool(p, pool_w[l], pool_scale[l]) @ w_up_pool[l]
        merged = jax.nn.sigmoid(g_gla) * y_gla + jax.nn.sigmoid(g_pool) * y_pool
        x = x + merged @ w_out[l]
        h = rms_norm(x, norm_ffn_g[l])
        x = x + peer_ffn(h, peer_wq[l], peer_subkeys[l], peer_u[l], peer_v[l])
    return rms_norm(x, norm_final_g)
```

```cpp
#include <hip/hip_runtime.h>
#include <cstdio>
#include <cstdint>
namespace pg8 {
#define PG8_LAS __attribute__((address_space(3)))
typedef unsigned short bf16_t;
typedef short bf16x8 __attribute__((ext_vector_type(8)));
typedef float f32x4 __attribute__((ext_vector_type(4)));
typedef unsigned u32x4 __attribute__((ext_vector_type(4)));
constexpr int BM = 256, BK = 64, HALF = 128, HTB = HALF * BK * 2  , STAGE_BYTES = 8 * HTB, NXCD = 8, WGM = 8;

__host__ __device__ __forceinline__ int lds_byte(int r, int c) { const int st = (r >> 4) * 2 + (c >> 5), rr = r & 15, cc = c & 31, ob = rr * 64 + cc * 2; return st * 1024 + (ob ^ (((ob >> 9) & 1) << 5)); }
__host__ __device__ __forceinline__ void stage_rc(int b, int& R, int& C) { const int st = b / 1024, sb = b % 1024, swz = sb ^ (((sb >> 9) & 1) << 5); R = (st >> 1) * 16 + swz / 64; C = (st & 1) * 32 + (swz % 64) / 2; }
__host__ __device__ __forceinline__ int perm32(int rho) { const int n = rho >> 4, i = rho & 15; return 8 * (i >> 2) + 4 * n + (i & 3); }

struct Unit { int pm, pn; };
struct Gemm { const bf16_t* A; const bf16_t* Bt; int M, N, K, lda, ldb, a_pn_step; };

struct StaticOrder {
    int nM, nN, nwg, G, c;
    __host__ __device__ void init(int M, int N, int G_, int c_) { nM = M / BM; nN = N / BM; nwg = nM * nN; G = G_; c = c_; }
    __host__ __device__ bool next(int i, Unit& u) const {
        const long L = (long)i * G + c; if (L >= nwg) return false;
        int wgid = (int)L; { const int q = nwg / NXCD, r = nwg % NXCD, xcd = wgid % NXCD, off = wgid / NXCD; wgid = (xcd < r ? xcd * (q + 1) : r * (q + 1) + (xcd - r) * q) + off; }
        const int nig = WGM * nN, gid = wgid / nig, fm = gid * WGM, gsz = (nM - fm) < WGM ? (nM - fm) : WGM;
        u.pm = fm + ((wgid % nig) % gsz); u.pn = (wgid % nig) / gsz; return true;
    }
    __device__ __forceinline__ void a_ready(const Unit&) const {}
    __device__ __forceinline__ void done(const Unit&) const {}
};

typedef float f32x2 __attribute__((ext_vector_type(2)));
typedef __bf16 bf16x2_t __attribute__((ext_vector_type(2)));
__device__ __forceinline__ unsigned pkbf(float lo, float hi) { f32x2 v = {lo, hi}; bf16x2_t b = __builtin_convertvector(v, bf16x2_t); return __builtin_bit_cast(unsigned, b); }
__device__ __forceinline__ float bflo(unsigned w) { return __builtin_bit_cast(float, w << 16); }
__device__ __forceinline__ float bfhi(unsigned w) { return __builtin_bit_cast(float, w & 0xffff0000u); }
__device__ __forceinline__ float fast_sigmoid(float x) { return __builtin_amdgcn_rcpf(1.f + __expf(-x)); }

struct EpiProj {
    static constexpr bool PERM = true, AFTER_DRAIN = false;
    bf16_t *QK, *R, *P, *G; float* AFB;
    __device__ __forceinline__ void operator()(const f32x4 (&acc)[2][2][4][2], const Unit& u, int wr, int wc, int fr, int fq) const {
        const int row0 = u.pm * BM + wr * 64 + fr; const int pn = u.pn;
        if (pn == 28) {
            if (wc == 0) {
#pragma unroll
                for (int ai = 0; ai < 2; ++ai)
#pragma unroll
                    for (int m = 0; m < 4; ++m) { float* rp = AFB + (size_t)(row0 + ai * HALF + m * 16) * 32 + 8 * fq; *(f32x4*)rp = acc[ai][0][m][0]; *(f32x4*)(rp + 4) = acc[ai][0][m][1]; }
            }
            return;
        }
        bf16_t* base; int ldc, colt, mode;
        if (pn < 4) { base = QK; ldc = 1024; colt = pn * 256; mode = (pn < 2) ? 1 : 0; }
        else if (pn < 8) { base = R; ldc = 1024; colt = (pn - 4) * 256; mode = 2; }
        else if (pn < 12) { base = P; ldc = 1024; colt = (pn - 8) * 256; mode = 0; }
        else { base = G; ldc = 4096; colt = (pn - 12) * 256; mode = 3; }
        const int col0 = colt + wc * 32 + 8 * fq;
#pragma unroll
        for (int ai = 0; ai < 2; ++ai)
#pragma unroll
            for (int m = 0; m < 4; ++m) { bf16_t* rowp = base + (size_t)(row0 + ai * HALF + m * 16) * ldc + col0;
#pragma unroll
                for (int bj = 0; bj < 2; ++bj) { f32x4 v0 = acc[ai][bj][m][0], v1 = acc[ai][bj][m][1];
                    if (mode == 1) { v0 = v0 * 0.08838834764831845f; v1 = v1 * 0.08838834764831845f; }
                    else if (mode == 2) {
#pragma unroll
                        for (int e = 0; e < 4; ++e) { v0[e] = v0[e] * fast_sigmoid(v0[e]); v1[e] = v1[e] * fast_sigmoid(v1[e]); } }
                    else if (mode == 3) {
#pragma unroll
                        for (int e = 0; e < 4; ++e) { v0[e] = fast_sigmoid(v0[e]); v1[e] = fast_sigmoid(v1[e]); } }
                    u32x4 w; w.x = pkbf(v0[0], v0[1]); w.y = pkbf(v0[2], v0[3]); w.z = pkbf(v1[0], v1[1]); w.w = pkbf(v1[2], v1[3]);
                    *(u32x4*)(rowp + bj * HALF) = w; } asm volatile("" ::: "memory"); }
    }
};
struct EpiVT {
    static constexpr bool PERM = true, AFTER_DRAIN = false;
    bf16_t* VT;
    __device__ __forceinline__ void operator()(const f32x4 (&acc)[2][2][4][2], const Unit& u, int wr, int wc, int fr, int fq) const {
        const int dv0 = u.pm * BM + wr * 64 + fr, tok0 = u.pn * BM + wc * 32 + 8 * fq;
#pragma unroll
        for (int ai = 0; ai < 2; ++ai)
#pragma unroll
            for (int m = 0; m < 4; ++m) { const int dv = dv0 + ai * HALF + m * 16;
#pragma unroll
                for (int bj = 0; bj < 2; ++bj) { const int tok = tok0 + bj * HALF; const int bc = tok >> 6, tin = tok & 63;
                    const f32x4 v0 = acc[ai][bj][m][0], v1 = acc[ai][bj][m][1];
                    u32x4 w; w.x = pkbf(v0[0], v0[1]); w.y = pkbf(v0[2], v0[3]); w.z = pkbf(v1[0], v1[1]); w.w = pkbf(v1[2], v1[3]);
                    *(u32x4*)(VT + ((size_t)bc * 1024 + dv) * 64 + tin) = w; } }
    }
};
struct EpiScale {
    static constexpr bool PERM = true, AFTER_DRAIN = false;
    bf16_t* O; int ldc; const float* scale;
    __device__ __forceinline__ void operator()(const f32x4 (&acc)[2][2][4][2], const Unit& u, int wr, int wc, int fr, int fq) const {
        const int row0 = u.pm * BM + wr * 64 + fr, col0 = u.pn * BM + wc * 32 + 8 * fq;
        f32x4 sv[2][2];
#pragma unroll
        for (int bj = 0; bj < 2; ++bj)
#pragma unroll
            for (int n = 0; n < 2; ++n) sv[bj][n] = scale ? *(const f32x4*)(scale + col0 + bj * HALF + 4 * n) : (f32x4){1.f, 1.f, 1.f, 1.f};
#pragma unroll
        for (int ai = 0; ai < 2; ++ai)
#pragma unroll
            for (int m = 0; m < 4; ++m) { bf16_t* rowp = O + (size_t)(row0 + ai * HALF + m * 16) * ldc + col0;
#pragma unroll
                for (int bj = 0; bj < 2; ++bj) { const f32x4 v0 = acc[ai][bj][m][0] * sv[bj][0], v1 = acc[ai][bj][m][1] * sv[bj][1];
                    u32x4 w; w.x = pkbf(v0[0], v0[1]); w.y = pkbf(v0[2], v0[3]); w.z = pkbf(v1[0], v1[1]); w.w = pkbf(v1[2], v1[3]);
                    *(u32x4*)(rowp + bj * HALF) = w; } }
    }
};
template <bool ACCUM> struct EpiGate {
    static constexpr bool PERM = true, AFTER_DRAIN = false;
    bf16_t* O; const bf16_t* Gt;
    __device__ __forceinline__ void operator()(const f32x4 (&acc)[2][2][4][2], const Unit& u, int wr, int wc, int fr, int fq) const {
        const int row0 = u.pm * BM + wr * 64 + fr, col0 = u.pn * BM + wc * 32 + 8 * fq;
#pragma unroll
        for (int ai = 0; ai < 2; ++ai)
#pragma unroll
            for (int m = 0; m < 4; ++m) { const size_t row = (size_t)(row0 + ai * HALF + m * 16);
#pragma unroll
                for (int bj = 0; bj < 2; ++bj) { const u32x4 gw = *(const u32x4*)(Gt + row * 4096 + col0 + bj * HALF);
                    f32x4 v0 = acc[ai][bj][m][0], v1 = acc[ai][bj][m][1];
                    v0[0] *= bflo(gw.x); v0[1] *= bfhi(gw.x); v0[2] *= bflo(gw.y); v0[3] *= bfhi(gw.y); v1[0] *= bflo(gw.z); v1[1] *= bfhi(gw.z); v1[2] *= bflo(gw.w); v1[3] *= bfhi(gw.w);
                    bf16_t* op = O + row * 2048 + col0 + bj * HALF;
                    if (ACCUM) { const u32x4 ow = *(const u32x4*)op;
                        v0[0] += bflo(ow.x); v0[1] += bfhi(ow.x); v0[2] += bflo(ow.y); v0[3] += bfhi(ow.y); v1[0] += bflo(ow.z); v1[1] += bfhi(ow.z); v1[2] += bflo(ow.w); v1[3] += bfhi(ow.w); }
                    u32x4 w; w.x = pkbf(v0[0], v0[1]); w.y = pkbf(v0[2], v0[3]); w.z = pkbf(v1[0], v1[1]); w.w = pkbf(v1[2], v1[3]);
                    *(u32x4*)op = w; } asm volatile("" ::: "memory"); }
    }
};
struct EpiResid {
    static constexpr bool PERM = true, AFTER_DRAIN = false;
    const float* xin; float* out;
    __device__ __forceinline__ void operator()(const f32x4 (&acc)[2][2][4][2], const Unit& u, int wr, int wc, int fr, int fq) const {
        const int row0 = u.pm * BM + wr * 64 + fr, col0 = u.pn * BM + wc * 32 + 8 * fq;
#pragma unroll
        for (int ai = 0; ai < 2; ++ai)
#pragma unroll
            for (int m = 0; m < 4; ++m) { const size_t rb = (size_t)(row0 + ai * HALF + m * 16) * 2048 + col0;
#pragma unroll
                for (int bj = 0; bj < 2; ++bj) { const size_t p = rb + bj * HALF;
                    const f32x4 x0 = *(const f32x4*)(xin + p), x1 = *(const f32x4*)(xin + p + 4);
                    *(f32x4*)(out + p) = x0 + acc[ai][bj][m][0]; *(f32x4*)(out + p + 4) = x1 + acc[ai][bj][m][1]; } asm volatile("" ::: "memory"); }
    }
};

template <class Epi, class Sched, bool ALIGN_EPI = false, bool SP2 = false>
__device__ __forceinline__ void gemm_phase(PG8_LAS unsigned char* lds, const Gemm g, const Sched& S, const Epi& E) {
    int tid_o = threadIdx.x; asm volatile("" : "+v"(tid_o));
    const int tid = tid_o, wid = __builtin_amdgcn_readfirstlane(tid >> 6), lane = tid & 63, wr = wid >> 2, wc = wid & 3, fr = lane & 15, fq = lane >> 4;
    const int K = g.K, nt = K / BK;
    unsigned voffA[2], voffB[2];
#pragma unroll
    for (int i = 0; i < 2; ++i) { int R, C; stage_rc(tid * 16 + i * 8192, R, C); const int Rb = Epi::PERM ? ((R & ~31) + perm32(R & 31)) : R;
        voffA[i] = (unsigned)(R * g.lda + C) * 2u; voffB[i] = (unsigned)(Rb * g.ldb + C) * 2u; }
    const size_t kstep = (size_t)(BK * 2);
    const size_t hstepA = (size_t)HALF * g.lda * 2, hstepB = (size_t)HALF * g.ldb * 2;
    const size_t tstepA = 2 * hstepA, tstepB = 2 * hstepB;
    const unsigned ldsw = (unsigned)wid * 1024u;
    const int aoff = lds_byte(wr * 64 + fr, fq * 8), boff = lds_byte(wc * 32 + fr, fq * 8);
#define PG8_SA(b, h) (((b) * 2 + (h)) * HTB)
#define PG8_SB(b, h) ((4 + (b) * 2 + (h)) * HTB)
#define PG8_STAGE(bufoff, gbase, voff) do { _Pragma("unroll") for (int _i = 0; _i < 2; ++_i) \
        __builtin_amdgcn_global_load_lds((const unsigned*)((const char*)(gbase) + (voff)[_i]), (PG8_LAS unsigned*)(lds + (bufoff) + ldsw + _i * 8192), 16, 0, 0); } while (0)
#define PG8_LDA(dst, b, h) do { _Pragma("unroll") for (int m = 0; m < 4; ++m) _Pragma("unroll") for (int k = 0; k < 2; ++k) dst[m][k] = *(const PG8_LAS bf16x8*)(lds + PG8_SA(b, h) + aoff + m * 2048 + k * 1024); } while (0)
#define PG8_LDB(dst, b, h) do { _Pragma("unroll") for (int n = 0; n < 2; ++n) _Pragma("unroll") for (int k = 0; k < 2; ++k) dst[n][k] = *(const PG8_LAS bf16x8*)(lds + PG8_SB(b, h) + boff + n * 2048 + k * 1024); } while (0)
#define PG8_MMA(ai, bj, At, Bt) do { __builtin_amdgcn_s_setprio(1); _Pragma("unroll") for (int m = 0; m < 4; ++m) _Pragma("unroll") for (int n = 0; n < 2; ++n) _Pragma("unroll") for (int k = 0; k < 2; ++k) \
        acc[ai][bj][m][n] = __builtin_amdgcn_mfma_f32_16x16x32_bf16(Bt[n][k], At[m][k], acc[ai][bj][m][n], 0, 0, 0); __builtin_amdgcn_s_setprio(0); } while (0)
#define PG8_WAIT_V(n) asm volatile("s_waitcnt vmcnt(" #n ")" ::: "memory")
#define PG8_WAIT_L(n) asm volatile("s_waitcnt lgkmcnt(" #n ")" ::: "memory")
#define PG8_BAR __builtin_amdgcn_s_barrier()
#define PG8_SCHED __builtin_amdgcn_sched_barrier(0)
    Unit cur, nxt; int ui = 0;
    if (!S.next(0, cur)) return;
    f32x4 acc[2][2][4][2];
#pragma unroll
    for (int a = 0; a < 2; ++a)
#pragma unroll
        for (int b = 0; b < 2; ++b)
#pragma unroll
            for (int m = 0; m < 4; ++m)
#pragma unroll
                for (int n = 0; n < 2; ++n) acc[a][b][m][n] = (f32x4){0.f, 0.f, 0.f, 0.f};
    bf16x8 At[4][2], B0[2][2], B1[2][2];
    const char* cA = (const char*)g.A + (size_t)cur.pm * tstepA + (size_t)cur.pn * g.a_pn_step; const char* cB = (const char*)g.Bt + (size_t)cur.pn * tstepB;
    S.a_ready(cur);
    if constexpr (SP2) {
        PG8_STAGE(PG8_SB(0, 0), cB, voffB); PG8_STAGE(PG8_SB(0, 1), cB + hstepB, voffB); PG8_STAGE(PG8_SA(0, 0), cA, voffA); PG8_STAGE(PG8_SA(0, 1), cA + hstepA, voffA);
        if (wr == 1) PG8_BAR;
        PG8_WAIT_V(2); PG8_BAR;
        PG8_STAGE(PG8_SB(1, 0), cB + kstep, voffB); PG8_STAGE(PG8_SA(1, 0), cA + kstep, voffA); PG8_STAGE(PG8_SB(1, 1), cB + hstepB + kstep, voffB);
        PG8_WAIT_V(6); PG8_BAR;
    } else {
        PG8_STAGE(PG8_SB(0, 0), cB, voffB); PG8_STAGE(PG8_SA(0, 0), cA, voffA); PG8_STAGE(PG8_SB(0, 1), cB + hstepB, voffB); PG8_STAGE(PG8_SA(0, 1), cA + hstepA, voffA);
        if (wr == 1) PG8_BAR;
        PG8_WAIT_V(4); PG8_BAR;
        PG8_STAGE(PG8_SB(1, 0), cB + kstep, voffB); PG8_STAGE(PG8_SA(1, 0), cA + kstep, voffA); PG8_STAGE(PG8_SB(1, 1), cB + hstepB + kstep, voffB);
        PG8_WAIT_V(6); PG8_BAR;
    }
    for (;;) {
        const bool has_next = S.next(ui + 1, nxt);
        const char* nA = has_next ? (const char*)g.A + (size_t)nxt.pm * tstepA + (size_t)nxt.pn * g.a_pn_step : cA; const char* nB = has_next ? (const char*)g.Bt + (size_t)nxt.pn * tstepB : cB;
        for (int t = 0; t < nt; t += 2) {
            const bool last = (t == nt - 2);
            const char* a1 = cA + (size_t)(t + 1) * kstep;
            const char* a2 = last ? nA : cA + (size_t)(t + 2) * kstep; const char* b2 = last ? nB : cB + (size_t)(t + 2) * kstep;
            const char* a3 = a2 + kstep; const char* b3 = b2 + kstep;
            if (last && has_next) S.a_ready(nxt);
            if constexpr (SP2) {
            PG8_LDB(B0, 0, 0); PG8_LDB(B1, 0, 1); PG8_SCHED; PG8_LDA(At, 0, 0); PG8_STAGE(PG8_SA(1, 1), a1 + hstepA, voffA);
            PG8_WAIT_V(8); PG8_WAIT_L(0); PG8_BAR; PG8_MMA(0, 0, At, B0); PG8_MMA(0, 1, At, B1); PG8_BAR; PG8_SCHED;
            PG8_LDA(At, 0, 1); PG8_STAGE(PG8_SB(0, 0), b2, voffB); PG8_STAGE(PG8_SB(0, 1), b2 + hstepB, voffB); PG8_STAGE(PG8_SA(0, 0), a2, voffA);
            PG8_WAIT_V(8); PG8_WAIT_L(0); PG8_BAR; PG8_MMA(1, 0, At, B0); PG8_MMA(1, 1, At, B1); PG8_BAR; PG8_SCHED;
            PG8_LDB(B0, 1, 0); PG8_LDB(B1, 1, 1); PG8_SCHED; PG8_LDA(At, 1, 0); PG8_STAGE(PG8_SA(0, 1), a2 + hstepA, voffA);
            PG8_WAIT_V(8); PG8_WAIT_L(0); PG8_BAR; PG8_MMA(0, 0, At, B0); PG8_MMA(0, 1, At, B1); PG8_BAR; PG8_SCHED;
            PG8_LDA(At, 1, 1); PG8_STAGE(PG8_SB(1, 0), b3, voffB); PG8_STAGE(PG8_SB(1, 1), b3 + hstepB, voffB); PG8_STAGE(PG8_SA(1, 0), a3, voffA);
            PG8_WAIT_V(8); PG8_WAIT_L(0); PG8_BAR; PG8_MMA(1, 0, At, B0); PG8_MMA(1, 1, At, B1); PG8_BAR; PG8_SCHED;
            } else {
            PG8_LDB(B0, 0, 0); PG8_SCHED; PG8_LDA(At, 0, 0); PG8_STAGE(PG8_SA(1, 1), a1 + hstepA, voffA);
            PG8_WAIT_L(8); PG8_BAR; PG8_WAIT_L(0); PG8_MMA(0, 0, At, B0); PG8_BAR; PG8_SCHED;
            PG8_LDB(B1, 0, 1); PG8_STAGE(PG8_SB(0, 0), b2, voffB);
            PG8_BAR; PG8_WAIT_L(0); PG8_MMA(0, 1, At, B1); PG8_BAR;
            PG8_LDA(At, 0, 1); PG8_STAGE(PG8_SA(0, 0), a2, voffA);
            PG8_BAR; PG8_WAIT_L(0); PG8_MMA(1, 0, At, B0); PG8_BAR; PG8_SCHED;
            PG8_STAGE(PG8_SB(0, 1), b2 + hstepB, voffB);
            PG8_WAIT_V(6); PG8_BAR; PG8_MMA(1, 1, At, B1); PG8_BAR;
            PG8_LDB(B0, 1, 0); PG8_SCHED; PG8_LDA(At, 1, 0); PG8_STAGE(PG8_SA(0, 1), a2 + hstepA, voffA);
            PG8_WAIT_L(8); PG8_BAR; PG8_WAIT_L(0); PG8_MMA(0, 0, At, B0); PG8_BAR; PG8_SCHED;
            PG8_LDB(B1, 1, 1); PG8_STAGE(PG8_SB(1, 0), b3, voffB);
            PG8_BAR; PG8_WAIT_L(0); PG8_MMA(0, 1, At, B1); PG8_BAR;
            PG8_LDA(At, 1, 1); PG8_STAGE(PG8_SA(1, 0), a3, voffA);
            PG8_BAR; PG8_WAIT_L(0); PG8_MMA(1, 0, At, B0); PG8_BAR; PG8_SCHED;
            PG8_STAGE(PG8_SB(1, 1), b3 + hstepB, voffB);
            PG8_WAIT_V(6); PG8_BAR; PG8_MMA(1, 1, At, B1); PG8_BAR;
            }
        }
        if constexpr (ALIGN_EPI) { if (wr == 0) PG8_BAR; }
        if constexpr (!Epi::AFTER_DRAIN) { E(acc, cur, wr, wc, fr, fq); S.done(cur); }
        if (!has_next) break;
#pragma unroll
        for (int a = 0; a < 2; ++a)
#pragma unroll
            for (int b = 0; b < 2; ++b)
#pragma unroll
                for (int m = 0; m < 4; ++m)
#pragma unroll
                    for (int n = 0; n < 2; ++n) acc[a][b][m][n] = (f32x4){0.f, 0.f, 0.f, 0.f};
        cur = nxt; cA = nA; cB = nB; ++ui;
        if constexpr (ALIGN_EPI) { if (wr == 1) PG8_BAR; }
    }
    PG8_WAIT_V(0);
    if constexpr (!ALIGN_EPI) { if (wr == 0) PG8_BAR; }
    PG8_BAR;
    if constexpr (Epi::AFTER_DRAIN) { E.fused(acc, cur, wr, wc, fr, fq, lds, wid, lane); S.done(cur); }
#undef PG8_SA
#undef PG8_SB
#undef PG8_STAGE
#undef PG8_LDA
#undef PG8_LDB
#undef PG8_MMA
#undef PG8_WAIT_V
#undef PG8_WAIT_L
#undef PG8_BAR
#undef PG8_SCHED
}
}

#define GAS __attribute__((address_space(1)))
#define LAS __attribute__((address_space(3)))
typedef unsigned short bf16;
typedef unsigned v4u __attribute__((ext_vector_type(4)));
typedef float f32x4 __attribute__((ext_vector_type(4)));
typedef short bf16x8 __attribute__((ext_vector_type(8)));
typedef GAS unsigned gu32;
typedef GAS unsigned long long gu64;
#define RLX_AGENT __ATOMIC_RELAXED, __HIP_MEMORY_SCOPE_AGENT
#define LDS_WAIT() asm volatile("s_waitcnt lgkmcnt(0)" ::: "memory")
#define VM_WAIT() asm volatile("s_waitcnt vmcnt(0)" ::: "memory")
__device__ __forceinline__ unsigned long long rt() { return __builtin_amdgcn_s_memrealtime(); }
__device__ __forceinline__ unsigned f2bf(float f) { unsigned u = __builtin_bit_cast(unsigned, f); return (u + 0x7fffu + ((u >> 16) & 1u)) >> 16; }
__device__ __forceinline__ unsigned pk2(float lo, float hi) { return f2bf(lo) | (f2bf(hi) << 16); }

#define XB_TMO      128
#define XB_XCNT(j)  (256  + 64 * (j))
#define XB_XSUB(j)  (1280 + 64 * (j))
#define XB_XGEN(j)  (2304 + 64 * (j))
#define XB_TOP      3328
#define XB_TOPGEN   3392
#define XCD_BAR_WORDS 3456
#define XB_SPIN_CAP (1u << 18)

__device__ __forceinline__ unsigned xb_ld(unsigned* p)              { return __hip_atomic_load(p, __ATOMIC_RELAXED, __HIP_MEMORY_SCOPE_AGENT); }
__device__ __forceinline__ unsigned xb_add(unsigned* p, unsigned v) { return __hip_atomic_fetch_add(p, v, __ATOMIC_RELAXED, __HIP_MEMORY_SCOPE_AGENT); }
__device__ __forceinline__ unsigned xb_xcc_id() { return (unsigned)__builtin_amdgcn_s_getreg((3 << 11) | 20) & 0xFu; }
#define XB_SPIN(cond, bar) do { unsigned _sp = 0; while (cond) { __builtin_amdgcn_s_sleep(1); \
    if ((++_sp & 255u) == 0u) { if (xb_ld(&(bar)[XB_TMO])) break; if (_sp > XB_SPIN_CAP) { atomicAdd(&(bar)[XB_TMO], 1u); break; } } } } while (0)

struct XcdBarrier {
    unsigned* bar; unsigned x;
    volatile LAS unsigned* st;
};

__device__ __forceinline__ XcdBarrier xcd_barrier_post(unsigned* bar, volatile LAS unsigned* st) {
    XcdBarrier b; b.bar = bar; b.x = xb_xcc_id(); b.st = st;
    if (threadIdx.x == 0) (void)xb_add(&bar[XB_XCNT(b.x)], 1u);
    return b;
}
__device__ __forceinline__ void xcd_barrier_complete(unsigned* bar, unsigned x, unsigned& nloc, unsigned& nx) {
    const unsigned G = gridDim.x * gridDim.y * gridDim.z;
    unsigned sum, cnt, mine, sp = 0u;
    for (;;) {
        sum = 0u; cnt = 0u; mine = 0u;
#pragma unroll
        for (unsigned j = 0; j < 16; ++j) { const unsigned c = xb_ld(&bar[XB_XCNT(j)]); sum += c; cnt += (c > 0u) ? 1u : 0u; mine = (j == x) ? c : mine; }
        if (sum == G) break;
        __builtin_amdgcn_s_sleep(1);
        if ((++sp & 255u) == 0u) { if (xb_ld(&bar[XB_TMO])) break; if (sp > XB_SPIN_CAP) { atomicAdd(&bar[XB_TMO], 1u); break; } }
    }
    nloc = mine > 0u ? mine : 1u; nx = cnt > 0u ? cnt : 1u;
}

__device__ __forceinline__ void xcd_barrier(const XcdBarrier& b) {
    asm volatile("s_waitcnt vmcnt(0)" ::: "memory");
    __syncthreads();
    if (threadIdx.x == 0) {
        unsigned* bar = b.bar;
        __builtin_amdgcn_s_waitcnt(0);
        unsigned nloc = b.st[0], nx = b.st[1];
        if (nloc == 0u) { xcd_barrier_complete(bar, b.x, nloc, nx); b.st[0] = nloc; b.st[1] = nx; }
        const unsigned old = xb_add(&bar[XB_XSUB(b.x)], 1u);
        const unsigned gen = old / nloc;
        if (old + 1u == (gen + 1u) * nloc) {
            __builtin_amdgcn_fence(__ATOMIC_RELEASE, "agent");
            asm volatile("s_waitcnt vmcnt(0)" ::: "memory");
            const unsigned og = xb_add(&bar[XB_TOP], 1u);
            const unsigned tg = og / nx;
            if (og + 1u == (tg + 1u) * nx) xb_add(&bar[XB_TOPGEN], 1u);
            else XB_SPIN(xb_ld(&bar[XB_TOPGEN]) == tg, bar);
            __builtin_amdgcn_fence(__ATOMIC_ACQUIRE, "agent");
            xb_add(&bar[XB_XGEN(b.x)], 1u);
            asm volatile("s_waitcnt vmcnt(0)" ::: "memory");
        } else {
            XB_SPIN(xb_ld(&bar[XB_XGEN(b.x)]) == gen, bar);
            __builtin_amdgcn_fence(__ATOMIC_ACQUIRE, "agent");
            asm volatile("s_waitcnt vmcnt(0)" ::: "memory");
        }
    }
    __syncthreads();
}

constexpr int D = 2048, SEQ = 16384, M = 32768, DEPTH = 2;
constexpr int NCH = 256;
constexpr int NSEG = 16, CPS = NCH / NSEG;
constexpr int DIN = 8224;
constexpr float RMS_EPS = 1e-6f;
constexpr int NWAVES = 8;
constexpr int NPH = 13;

constexpr size_t MiB = 1u << 20;
constexpr size_t WS_CTL = 0, CTL_ZERO_BYTES = 1 * MiB;
constexpr size_t WS_WIN = 1 * MiB;
constexpr size_t WS_WUPG = 34 * MiB;
constexpr size_t WS_WUPP = 38 * MiB;
constexpr size_t WS_WOUT = 42 * MiB;
constexpr size_t WS_WQ = 50 * MiB;
constexpr size_t WS_POOLW = 58 * MiB;
constexpr size_t WS_SUBK = 58 * MiB + 512 * 1024;
constexpr size_t WS_USC = 59 * MiB, WS_VSC = 59 * MiB + 512 * 1024;
constexpr size_t WS_UTAB = 60 * MiB, WS_VTAB = 124 * MiB;
constexpr size_t WS_H = 188 * MiB;
constexpr size_t WS_POOLED = WS_H, WS_POOLMIX = WS_H + 64 * MiB, WS_SEGL = WS_H + 64 * MiB, WS_SIN = WS_H + 96 * MiB;
constexpr size_t WS_QK = 316 * MiB;
constexpr size_t WS_P = 380 * MiB;
constexpr size_t WS_VT = 444 * MiB;
constexpr size_t WS_R = 508 * MiB;
constexpr size_t WS_MERGED = WS_VT;
constexpr size_t WS_G = 572 * MiB;
constexpr size_t WS_PQ = WS_G, WS_IDX = 700 * MiB, WS_GATE = 716 * MiB;
constexpr size_t WS_AFB = 828 * MiB;
constexpr size_t WS_QE = 832 * MiB;
constexpr size_t WS_GLAOUT = WS_QE;
constexpr size_t WS_KDT = 896 * MiB;
constexpr size_t WS_ATTN = 960 * MiB;
constexpr size_t WS_DEC = 992 * MiB;
constexpr size_t WS_END = 994 * MiB;
constexpr int CW_BAR = 4096;

constexpr int RING_BYTES = 131072;
constexpr int LDSCTL_OFF = RING_BYTES, MISC_OFF = LDSCTL_OFF + 320;
constexpr int LDS_BYTES = 147456;

typedef unsigned v2u __attribute__((ext_vector_type(2)));
typedef float f32x2 __attribute__((ext_vector_type(2)));
typedef float f32x16 __attribute__((ext_vector_type(16)));
using pg8::pkbf; using pg8::bflo; using pg8::bfhi;
__device__ __forceinline__ float bf2f(bf16 h) { return __builtin_bit_cast(float, (unsigned)h << 16); }
__device__ __forceinline__ bf16 f2bf1(float f) { return (bf16)(pkbf(f, 0.f) & 0xffffu); }
__device__ __forceinline__ float wave_sum(float v) {
#pragma unroll
    for (int o = 1; o < 64; o <<= 1) v += __shfl_xor(v, o);
    return v;
}
__device__ __forceinline__ float wave_max(float v) {
#pragma unroll
    for (int o = 1; o < 64; o <<= 1) v = fmaxf(v, __shfl_xor(v, o));
    return v;
}
__device__ __forceinline__ f32x16 mfma32(bf16x8 a, bf16x8 b, f32x16 c) { return __builtin_amdgcn_mfma_f32_32x32x16_bf16(a, b, c, 0, 0, 0); }
__device__ __forceinline__ bf16x8 mk8(unsigned a, unsigned b, unsigned c, unsigned d) { v4u t = {a, b, c, d}; return __builtin_bit_cast(bf16x8, t); }

__device__ __forceinline__ void transpose_item(const float* __restrict__ W, int N, bf16* WT, int ldt, int dst_row0, int k0, int n0, LAS float* scr, int lane) {
#pragma unroll 8
    for (int i = 0; i < 32; ++i) { const int kk = 2 * i + (lane >> 5); scr[kk * 33 + (lane & 31)] = W[(size_t)(k0 + kk) * N + n0 + (lane & 31)]; }
    LDS_WAIT(); asm volatile("" ::: "memory");
    const int c = lane & 7;
#pragma unroll
    for (int j = 0; j < 4; ++j) { const int n = (lane >> 3) + 8 * j; const LAS float* s = scr + (8 * c) * 33 + n;
        v4u o; o.x = pkbf(s[0 * 33], s[1 * 33]); o.y = pkbf(s[2 * 33], s[3 * 33]); o.z = pkbf(s[4 * 33], s[5 * 33]); o.w = pkbf(s[6 * 33], s[7 * 33]);
        *(GAS v4u*)(WT + (size_t)(dst_row0 + n) * ldt + k0 + 8 * c) = o; }
    LDS_WAIT(); asm volatile("" ::: "memory");
}
__device__ __forceinline__ void transpose_matrix(const float* W, int K, int N, bf16* WT, LAS float* scr, int lane, int gw, int NGW) {
    const int nblk = N / 32, items = (K / 64) * nblk;
    for (int it = gw; it < items; it += NGW) { const int kb = it / nblk, nb = it % nblk; transpose_item(W, N, WT, K, nb * 32, kb * 64, nb * 32, scr, lane); }
}
__device__ __forceinline__ void table_row_fp8(const float* __restrict__ T, unsigned* __restrict__ O, float* __restrict__ inv, int row, int lane) {
    const f32x4* src = (const f32x4*)(T + (size_t)row * 2048) + lane;
    f32x4 v[8]; float am = 0.f;
#pragma unroll
    for (int j = 0; j < 8; ++j) { v[j] = src[64 * j]; am = fmaxf(am, fmaxf(fmaxf(fabsf(v[j].x), fabsf(v[j].y)), fmaxf(fabsf(v[j].z), fabsf(v[j].w)))); }
    am = wave_max(am);
    float e = (am > 1e-30f) ? floorf(__log2f(224.f / am)) : 0.f; e = fminf(fmaxf(e, -60.f), 60.f);
    const float sc = exp2f(e);
    unsigned* dst = O + (size_t)row * 512 + lane;
#pragma unroll
    for (int j = 0; j < 8; ++j) { int w = 0; w = __builtin_amdgcn_cvt_pk_fp8_f32(v[j].x * sc, v[j].y * sc, w, false); w = __builtin_amdgcn_cvt_pk_fp8_f32(v[j].z * sc, v[j].w * sc, w, true); dst[64 * j] = (unsigned)w; }
    if (lane == 0) inv[row] = exp2f(-e);
}
__device__ __forceinline__ void rmsnorm_row(const float* xrow, const float* __restrict__ g, bf16* orow, int lane) {
    const f32x4* xr = (const f32x4*)xrow + lane; const f32x4* gr = (const f32x4*)g + lane;
    f32x4 v[8]; float s = 0.f;
#pragma unroll
    for (int j = 0; j < 8; ++j) { v[j] = xr[64 * j]; s += (v[j].x * v[j].x + v[j].y * v[j].y) + (v[j].z * v[j].z + v[j].w * v[j].w); }
    const float rs = rsqrtf(wave_sum(s) * (1.f / 2048.f) + RMS_EPS);
    v2u* o8 = (v2u*)orow + lane;
#pragma unroll
    for (int j = 0; j < 8; ++j) { const f32x4 gg = gr[64 * j]; v2u o; o.x = pkbf(v[j].x * rs * gg.x, v[j].y * rs * gg.y); o.y = pkbf(v[j].z * rs * gg.z, v[j].w * rs * gg.w); o8[64 * j] = o; }
}

constexpr int PA_A = 0, PA_QT = 4096, PA_Q = 6144, PA_K = PA_Q + 17408, PA_KE = PA_K + 17408;
__device__ __forceinline__ void gla_prep_unit(int uid, unsigned char* lds, const bf16* __restrict__ QK, const float* __restrict__ AFB, const float* __restrict__ Wgf, const float* __restrict__ Bgf,
                                              const float* __restrict__ Wgb, const float* __restrict__ Bgb, bf16* QE, bf16* KDT, bf16* ATTN, float* DEC, int tid, int wave, int lane) {
    const int dir = uid & 1, h = (uid >> 1) & 3, bn = uid >> 3;
    const size_t row0 = (size_t)bn * 64;
    float* aS = (float*)(lds + PA_A); float* qtot = (float*)(lds + PA_QT);
    bf16* qS = (bf16*)(lds + PA_Q); bf16* kS = (bf16*)(lds + PA_K); bf16* keS = (bf16*)(lds + PA_KE);
    const float* Wg = dir ? Wgb : Wgf; const float* Bg = dir ? Bgb : Bgf;
    __syncthreads();
    if (tid < 256) { const int t = tid >> 2, q4 = tid & 3; *(f32x4*)(aS + t * 16 + 4 * q4) = *(const f32x4*)(AFB + (row0 + t) * 32 + dir * 16 + 4 * q4); }
#pragma unroll
    for (int pp = 0; pp < 2; ++pp) { const int p = tid + 512 * pp, t = p >> 4, cp = p & 15;
        const bf16* src = QK + (row0 + t) * 1024 + h * 128 + cp * 8;
        *(v4u*)(qS + t * 136 + cp * 8) = *(const v4u*)src; *(v4u*)(kS + t * 136 + cp * 8) = *(const v4u*)(src + 512); }
    const int c = tid & 127, tq = tid >> 7;
    float wg[16];
#pragma unroll
    for (int r = 0; r < 16; ++r) wg[r] = Wg[r * 512 + h * 128 + c];
    const float bias = Bg[h * 128 + c];
    __syncthreads();
    float cum[16]; float run = 0.f;
#pragma unroll
    for (int ii = 0; ii < 16; ++ii) { const int t = tq * 16 + (dir ? 15 - ii : ii);
        const f32x4 a0 = *(const f32x4*)(aS + t * 16), a1 = *(const f32x4*)(aS + t * 16 + 4), a2 = *(const f32x4*)(aS + t * 16 + 8), a3 = *(const f32x4*)(aS + t * 16 + 12);
        float z = bias;
        z += a0.x * wg[0] + a0.y * wg[1] + a0.z * wg[2] + a0.w * wg[3]; z += a1.x * wg[4] + a1.y * wg[5] + a1.z * wg[6] + a1.w * wg[7];
        z += a2.x * wg[8] + a2.y * wg[9] + a2.z * wg[10] + a2.w * wg[11]; z += a3.x * wg[12] + a3.y * wg[13] + a3.z * wg[14] + a3.w * wg[15];
        const float lg = (fminf(z, 0.f) - __logf(1.f + __expf(-fabsf(z)))) * (1.f / 16.f);
        run += lg; cum[ii] = run; }
    qtot[tq * 128 + c] = run;
    __syncthreads();
    const float q0 = qtot[c], q1 = qtot[128 + c], q2 = qtot[256 + c], q3 = qtot[384 + c];
    const float btot = (q0 + q1) + (q2 + q3);
    float off;
    if (dir == 0) off = (tq > 0 ? q0 : 0.f) + (tq > 1 ? q1 : 0.f) + (tq > 2 ? q2 : 0.f);
    else          off = (tq < 3 ? q3 : 0.f) + (tq < 2 ? q2 : 0.f) + (tq < 1 ? q1 : 0.f);
    if (tq == 0) DEC[(size_t)uid * 128 + c] = __expf(btot);
#pragma unroll
    for (int ii = 0; ii < 16; ++ii) { const int t = tq * 16 + (dir ? 15 - ii : ii); const float b = cum[ii] + off;
        const float qv = bf2f(qS[t * 136 + c]), kv = bf2f(kS[t * 136 + c]);
        qS[t * 136 + c] = f2bf1(qv * __expf(b)); keS[t * 136 + c] = f2bf1(kv * __expf(-b)); kS[t * 136 + c] = f2bf1(kv * __expf(btot - b)); }
    __syncthreads();
    const int r = lane & 31, hh = lane >> 5;
    if (wave < 4) {
        const int jt = wave >> 1, it = wave & 1;
        f32x16 acc;
#pragma unroll
        for (int e = 0; e < 16; ++e) acc[e] = 0.f;
#pragma unroll
        for (int s = 0; s < 8; ++s) { const bf16x8 A = *(const bf16x8*)(keS + (32 * jt + r) * 136 + 16 * s + 8 * hh); const bf16x8 B = *(const bf16x8*)(qS + (32 * it + r) * 136 + 16 * s + 8 * hh); acc = mfma32(A, B, acc); }
        const int i = 32 * it + r; float v[16];
#pragma unroll
        for (int e = 0; e < 16; ++e) { const int j = 32 * jt + (e & 3) + 8 * (e >> 2) + 4 * hh; const bool keep = dir ? (j > i) : (j <= i); v[e] = keep ? acc[e] : 0.f; }
#pragma unroll
        for (int s2 = 0; s2 < 2; ++s2) { v4u o; o.x = pkbf(v[8 * s2 + 0], v[8 * s2 + 1]); o.y = pkbf(v[8 * s2 + 2], v[8 * s2 + 3]); o.z = pkbf(v[8 * s2 + 4], v[8 * s2 + 5]); o.w = pkbf(v[8 * s2 + 6], v[8 * s2 + 7]);
            *(v4u*)(ATTN + (size_t)uid * 4096 + (size_t)((it * 4 + 2 * jt + s2) * 64 + lane) * 8) = o; }
    }
#pragma unroll
    for (int e = 0; e < 2; ++e) { const int f = wave * 2 + e;
        {
            const int it = f >> 3, ks = f & 7, dt = ks >> 1, s2 = ks & 1;
            const bf16* base = qS + (32 * it + r) * 136 + 32 * dt + 16 * s2 + 4 * hh;
            const v2u lo = *(const v2u*)base, hi = *(const v2u*)(base + 8);
            v4u o = {lo.x, lo.y, hi.x, hi.y};
            *(v4u*)(QE + (size_t)uid * 8192 + (size_t)(f * 64 + lane) * 8) = o; }
        {
            const int dt = f >> 2, ks = f & 3, dim = 32 * dt + r;
            unsigned w[4];
#pragma unroll
            for (int p2 = 0; p2 < 4; ++p2) { const int j0 = 2 * p2, j1 = 2 * p2 + 1;
                const int t0 = 16 * ks + 8 * (j0 >> 2) + 4 * hh + (j0 & 3), t1 = 16 * ks + 8 * (j1 >> 2) + 4 * hh + (j1 & 3);
                w[p2] = (unsigned)kS[t0 * 136 + dim] | ((unsigned)kS[t1 * 136 + dim] << 16); }
            v4u o = {w[0], w[1], w[2], w[3]};
            *(v4u*)(KDT + (size_t)uid * 8192 + (size_t)(f * 64 + lane) * 8) = o; }
    }
}

__device__ __forceinline__ void pool_item(int item, const bf16* __restrict__ P, bf16* __restrict__ PO) {
    const int oct = item & 127, run = item >> 7; const int m0 = run * 32, b = m0 >> 14, t0 = m0 & (SEQ - 1);
    const int g = oct >> 5, hw = 1 << g;
    const bf16* Pb = P + (size_t)b * SEQ * 1024 + oct * 8; bf16* Ob = PO + (size_t)b * SEQ * 1024 + oct * 8;
    float s[8];
#pragma unroll
    for (int e = 0; e < 8; ++e) s[e] = 0.f;
    const int lo0 = (t0 - hw > 0) ? t0 - hw : 0, hi0 = (t0 + hw < SEQ) ? t0 + hw : SEQ;
    for (int u = lo0; u < hi0; ++u) { const v4u w = *(const v4u*)(Pb + (size_t)u * 1024);
        s[0] += bflo(w.x); s[1] += bfhi(w.x); s[2] += bflo(w.y); s[3] += bfhi(w.y); s[4] += bflo(w.z); s[5] += bfhi(w.z); s[6] += bflo(w.w); s[7] += bfhi(w.w); }
    for (int t = t0; t < t0 + 32; ++t) {
        const int lo = (t - hw > 0) ? t - hw : 0, hi = (t + hw < SEQ) ? t + hw : SEQ; const float ic = 1.f / (float)(hi - lo);
        const v4u w = *(const v4u*)(Pb + (size_t)t * 1024);
        v4u o; o.x = pkbf(s[0] * ic - bflo(w.x), s[1] * ic - bfhi(w.x)); o.y = pkbf(s[2] * ic - bflo(w.y), s[3] * ic - bfhi(w.y));
        o.z = pkbf(s[4] * ic - bflo(w.z), s[5] * ic - bfhi(w.z)); o.w = pkbf(s[6] * ic - bflo(w.w), s[7] * ic - bfhi(w.w));
        *(v4u*)(Ob + (size_t)t * 1024) = o;
        if (t - hw >= 0) { const v4u x = *(const v4u*)(Pb + (size_t)(t - hw) * 1024);
            s[0] -= bflo(x.x); s[1] -= bfhi(x.x); s[2] -= bflo(x.y); s[3] -= bfhi(x.y); s[4] -= bflo(x.z); s[5] -= bfhi(x.z); s[6] -= bflo(x.w); s[7] -= bfhi(x.w); }
        if (t + hw < SEQ) { const v4u x = *(const v4u*)(Pb + (size_t)(t + hw) * 1024);
            s[0] += bflo(x.x); s[1] += bfhi(x.x); s[2] += bflo(x.y); s[3] += bfhi(x.y); s[4] += bflo(x.z); s[5] += bfhi(x.z); s[6] += bflo(x.w); s[7] += bfhi(x.w); }
    }
}

constexpr int SB_QE = 0, SB_AT = 16384, SB_KD = 24576, SB_DEC = 40960, SB_BYTES = 41472;
template <bool FULL> __device__ __forceinline__ void gla_scan_block(int su, unsigned char* lds, const bf16* __restrict__ QE, const bf16* __restrict__ ATTN, const bf16* __restrict__ KDT,
                                                                    const float* __restrict__ DEC, const bf16* __restrict__ VT, float* SEGL, const float* __restrict__ SIN, bf16* OF, bf16* OB,
                                                                    int tid, int wave, int lane) {
    const int bhd = su / NSEG, seg = su % NSEG, dir = bhd & 1, h = (bhd >> 1) & 3, b = bhd >> 3;
    const int r = lane & 31, hh = lane >> 5, w = wave;
    f32x16 st[4];
    if (FULL) {
#pragma unroll
        for (int dt = 0; dt < 4; ++dt)
#pragma unroll
            for (int e = 0; e < 16; ++e) st[dt][e] = SIN[((size_t)((su * 8 + w) * 4 + dt) * 16 + e) * 64 + lane];
    } else {
#pragma unroll
        for (int dt = 0; dt < 4; ++dt)
#pragma unroll
            for (int e = 0; e < 16; ++e) st[dt][e] = 0.f;
    }
    v4u sg[5]; v4u sdec; v2u vn[8]; bf16x8 vc[4];
#define SCAN_UID(i_) ({ const int sp_ = seg * CPS + (i_); const int n_ = dir ? (NCH - 1 - sp_) : sp_; (((b * NCH + n_) * 4 + h) * 2 + dir); })
#define SCAN_LOAD(i_) do { const int uid_ = SCAN_UID(i_); \
        if (FULL) { sg[0] = *(const v4u*)(QE + (size_t)uid_ * 8192 + (size_t)tid * 8); sg[1] = *(const v4u*)(QE + (size_t)uid_ * 8192 + (size_t)(tid + 512) * 8); \
                    sg[2] = *(const v4u*)(ATTN + (size_t)uid_ * 4096 + (size_t)tid * 8); } \
        sg[3] = *(const v4u*)(KDT + (size_t)uid_ * 8192 + (size_t)tid * 8); sg[4] = *(const v4u*)(KDT + (size_t)uid_ * 8192 + (size_t)(tid + 512) * 8); \
        if (tid < 32) sdec = *(const v4u*)(DEC + (size_t)uid_ * 128 + tid * 4); \
        const bf16* vb_ = VT + ((size_t)(uid_ >> 3) * 1024 + h * 256 + 32 * w + r) * 64 + 4 * hh; \
        _Pragma("unroll") for (int ks_ = 0; ks_ < 4; ++ks_) { vn[2 * ks_] = *(const v2u*)(vb_ + 16 * ks_); vn[2 * ks_ + 1] = *(const v2u*)(vb_ + 16 * ks_ + 8); } } while (0)
#define SCAN_STORE(buf_) do { unsigned char* B_ = lds + (buf_) * SB_BYTES; \
        if (FULL) { *(v4u*)(B_ + SB_QE + tid * 16) = sg[0]; *(v4u*)(B_ + SB_QE + (tid + 512) * 16) = sg[1]; *(v4u*)(B_ + SB_AT + tid * 16) = sg[2]; } \
        *(v4u*)(B_ + SB_KD + tid * 16) = sg[3]; *(v4u*)(B_ + SB_KD + (tid + 512) * 16) = sg[4]; \
        if (tid < 32) *(v4u*)(B_ + SB_DEC + tid * 16) = sdec; \
        _Pragma("unroll") for (int ks_ = 0; ks_ < 4; ++ks_) vc[ks_] = mk8(vn[2 * ks_].x, vn[2 * ks_].y, vn[2 * ks_ + 1].x, vn[2 * ks_ + 1].y); } while (0)
    __syncthreads();
    SCAN_LOAD(0); SCAN_STORE(0);
    __syncthreads();
    for (int i = 0; i < CPS; ++i) {
        const bool more = (i + 1 < CPS);
        if (more) SCAN_LOAD(i + 1);
        const unsigned char* B = lds + (i & 1) * SB_BYTES;
        if (FULL) {
            f32x16 o0, o1;
#pragma unroll
            for (int e = 0; e < 16; ++e) { o0[e] = 0.f; o1[e] = 0.f; }
#pragma unroll
            for (int dt = 0; dt < 4; ++dt)
#pragma unroll
                for (int s2 = 0; s2 < 2; ++s2) { const int ks = 2 * dt + s2;
                    const bf16x8 sf = mk8(pkbf(st[dt][8 * s2 + 0], st[dt][8 * s2 + 1]), pkbf(st[dt][8 * s2 + 2], st[dt][8 * s2 + 3]), pkbf(st[dt][8 * s2 + 4], st[dt][8 * s2 + 5]), pkbf(st[dt][8 * s2 + 6], st[dt][8 * s2 + 7]));
                    const bf16x8 a0 = *(const bf16x8*)(B + SB_QE + ((0 * 8 + ks) * 64 + lane) * 16); const bf16x8 a1 = *(const bf16x8*)(B + SB_QE + ((1 * 8 + ks) * 64 + lane) * 16);
                    o0 = mfma32(a0, sf, o0); o1 = mfma32(a1, sf, o1); }
#pragma unroll
            for (int ks = 0; ks < 4; ++ks) { const bf16x8 a0 = *(const bf16x8*)(B + SB_AT + ((0 * 4 + ks) * 64 + lane) * 16); const bf16x8 a1 = *(const bf16x8*)(B + SB_AT + ((1 * 4 + ks) * 64 + lane) * 16);
                o0 = mfma32(a0, vc[ks], o0); o1 = mfma32(a1, vc[ks], o1); }
            const int uid = SCAN_UID(i);
            bf16* Ob = (dir ? OB : OF) + (size_t)(uid >> 3) * 64 * 1024 + h * 256 + 32 * w + r;
#pragma unroll
            for (int e = 0; e < 16; ++e) { const int tk = (e & 3) + 8 * (e >> 2) + 4 * hh; Ob[(size_t)tk * 1024] = f2bf1(o0[e]); Ob[(size_t)(32 + tk) * 1024] = f2bf1(o1[e]); }
        }
#pragma unroll
        for (int dt = 0; dt < 4; ++dt) {
#pragma unroll
            for (int q = 0; q < 4; ++q) { const f32x4 d4 = *(const f32x4*)(B + SB_DEC + (32 * dt + 8 * q + 4 * hh) * 4);
                st[dt][4 * q + 0] *= d4.x; st[dt][4 * q + 1] *= d4.y; st[dt][4 * q + 2] *= d4.z; st[dt][4 * q + 3] *= d4.w; }
#pragma unroll
            for (int ks = 0; ks < 4; ++ks) { const bf16x8 a = *(const bf16x8*)(B + SB_KD + ((dt * 4 + ks) * 64 + lane) * 16); st[dt] = mfma32(a, vc[ks], st[dt]); }
        }
        if (more) SCAN_STORE((i + 1) & 1);
        __syncthreads();
    }
    if (!FULL) {
#pragma unroll
        for (int dt = 0; dt < 4; ++dt)
#pragma unroll
            for (int e = 0; e < 16; ++e) SEGL[((size_t)((su * 8 + w) * 4 + dt) * 16 + e) * 64 + lane] = st[dt][e];
    }
#undef SCAN_UID
#undef SCAN_LOAD
#undef SCAN_STORE
}
__device__ __forceinline__ void gla_carry_item(int item, const float* __restrict__ SEGL, float* SIN, const float* __restrict__ DEC, int lane) {
    const int bhd = item >> 5, w = (item >> 2) & 7, dt = item & 3, dir = bhd & 1, h = (bhd >> 1) & 3, b = bhd >> 3, hh = lane >> 5;
    float S[16];
#pragma unroll
    for (int e = 0; e < 16; ++e) S[e] = 0.f;
    for (int seg = 0; seg < NSEG; ++seg) { const int su = bhd * NSEG + seg; const size_t i0 = (size_t)((su * 8 + w) * 4 + dt) * 16;
#pragma unroll
        for (int e = 0; e < 16; ++e) SIN[(i0 + e) * 64 + lane] = S[e];
        float Dg[16];
#pragma unroll
        for (int e = 0; e < 16; ++e) Dg[e] = 1.f;
        for (int i = 0; i < CPS; ++i) { const int sp = seg * CPS + i, n = dir ? (NCH - 1 - sp) : sp; const int uid = ((b * NCH + n) * 4 + h) * 2 + dir;
#pragma unroll
            for (int q = 0; q < 4; ++q) { const f32x4 d4 = *(const f32x4*)(DEC + (size_t)uid * 128 + 32 * dt + 8 * q + 4 * hh); Dg[4 * q] *= d4.x; Dg[4 * q + 1] *= d4.y; Dg[4 * q + 2] *= d4.z; Dg[4 * q + 3] *= d4.w; } }
#pragma unroll
        for (int e = 0; e < 16; ++e) S[e] = Dg[e] * S[e] + SEGL[(i0 + e) * 64 + lane];
    }
}
__device__ __forceinline__ void gla_fin_row(int m, const bf16* __restrict__ OF, const bf16* __restrict__ OB, const bf16* __restrict__ R, const float* __restrict__ g, bf16* GO, int lane) {
    const size_t p = (size_t)m * 1024 + 16 * lane;
    const v4u f0 = *(const v4u*)(OF + p), f1 = *(const v4u*)(OF + p + 8), b0 = *(const v4u*)(OB + p), b1 = *(const v4u*)(OB + p + 8), r0 = *(const v4u*)(R + p), r1 = *(const v4u*)(R + p + 8);
    float o[16], rr[16];
#define UNP(dst, w0, w1) do { dst[0] = bflo(w0.x); dst[1] = bfhi(w0.x); dst[2] = bflo(w0.y); dst[3] = bfhi(w0.y); dst[4] = bflo(w0.z); dst[5] = bfhi(w0.z); dst[6] = bflo(w0.w); dst[7] = bfhi(w0.w); \
        dst[8] = bflo(w1.x); dst[9] = bfhi(w1.x); dst[10] = bflo(w1.y); dst[11] = bfhi(w1.y); dst[12] = bflo(w1.z); dst[13] = bfhi(w1.z); dst[14] = bflo(w1.w); dst[15] = bfhi(w1.w); } while (0)
    float t[16]; UNP(o, f0, f1); UNP(t, b0, b1); UNP(rr, r0, r1);
#undef UNP
    float ss = 0.f;
#pragma unroll
    for (int e = 0; e < 16; ++e) { o[e] += t[e]; ss += o[e] * o[e]; }
    ss += __shfl_xor(ss, 1); ss += __shfl_xor(ss, 2); ss += __shfl_xor(ss, 4); ss += __shfl_xor(ss, 8);
    const float rs = rsqrtf(ss * (1.f / 256.f) + RMS_EPS);
    const f32x4* gp = (const f32x4*)(g + 16 * lane);
    float gg[16];
#pragma unroll
    for (int q = 0; q < 4; ++q) { const f32x4 x = gp[q]; gg[4 * q] = x.x; gg[4 * q + 1] = x.y; gg[4 * q + 2] = x.z; gg[4 * q + 3] = x.w; }
    unsigned w[8];
#pragma unroll
    for (int e = 0; e < 8; ++e) w[e] = pkbf(o[2 * e] * rs * gg[2 * e] * rr[2 * e], o[2 * e + 1] * rs * gg[2 * e + 1] * rr[2 * e + 1]);
    v4u o0 = {w[0], w[1], w[2], w[3]}, o1 = {w[4], w[5], w[6], w[7]};
    *(v4u*)(GO + p) = o0; *(v4u*)(GO + p + 8) = o1;
}

__device__ __forceinline__ unsigned sortable(float f) { const unsigned b = __builtin_bit_cast(unsigned, f); return b ^ ((unsigned)((int)b >> 31) | 0x80000000u); }
__device__ __forceinline__ float unsortable(unsigned u) { const unsigned b = (u & 0x80000000u) ? (u ^ 0x80000000u) : ~u; return __builtin_bit_cast(float, b); }
__device__ __forceinline__ unsigned umax3(unsigned a, unsigned b, unsigned c) { return max(max(a, b), c); }
__device__ __forceinline__ void peer_half_topk(int p, int h, const unsigned char* sk, const bf16* __restrict__ PQ, size_t tok, int lane, unsigned (&Lp)[16]) {
    const int hh = lane >> 5;
    const bf16* qp = PQ + tok * 2048 + h * 256 + p * 128 + 8 * hh;
    bf16x8 bq[8];
#pragma unroll
    for (int s = 0; s < 8; ++s) bq[s] = *(const bf16x8*)(qp + 16 * s);
    unsigned key[64];
#pragma unroll
    for (int nt = 0; nt < 4; ++nt) { f32x16 sc;
#pragma unroll
        for (int e = 0; e < 16; ++e) sc[e] = 0.f;
#pragma unroll
        for (int s = 0; s < 8; ++s) { const bf16x8 a = *(const bf16x8*)(sk + (size_t)(((p * 4 + nt) * 8 + s) * 64 + lane) * 16); sc = mfma32(a, bq[s], sc); }
#pragma unroll
        for (int e = 0; e < 16; ++e) { const int n = 32 * nt + (e & 3) + 8 * (e >> 2) + 4 * hh; key[nt * 16 + e] = (sortable(sc[e]) & ~127u) | (unsigned)(127 - n); } }
#pragma unroll
    for (int rd = 0; rd < 16; ++rd) { unsigned mx = 0u;
#pragma unroll
        for (int e = 0; e < 64; e += 2) mx = umax3(mx, key[e], key[e + 1]);
        const unsigned wv = max(mx, (unsigned)__shfl_xor((int)mx, 32));
        Lp[rd] = wv;
#pragma unroll
        for (int e = 0; e < 64; ++e) key[e] = (key[e] == wv) ? 0u : key[e]; }
}
__device__ __forceinline__ void peer_topk_item(int tile, int h, const unsigned char* sk  , const bf16* __restrict__ PQ, unsigned short* IDX, float* GATE, int lane) {
    const int r = lane & 31, hh = lane >> 5; const size_t tok = (size_t)tile * 32 + r;
    unsigned L[2][16];
    peer_half_topk(0, h, sk, PQ, tok, lane, L[0]);
    __builtin_amdgcn_sched_barrier(0);
#pragma unroll
    for (int a = 0; a < 16; ++a) asm volatile("" : "+v"(L[0][a]));
    peer_half_topk(1, h, sk, PQ, tok, lane, L[1]);
    __builtin_amdgcn_sched_barrier(0);
#pragma unroll
    for (int a = 0; a < 16; ++a) asm volatile("" : "+v"(L[1][a]));
    float v0[16], v1[16];
#pragma unroll
    for (int a = 0; a < 16; ++a) { v0[a] = unsortable(L[0][a] & ~127u); v1[a] = unsortable(L[1][a] & ~127u); }
    unsigned ck[50];
    {
        int c = 0;
#pragma unroll
        for (int a = 0; a < 16; ++a)
#pragma unroll
            for (int b2 = 0; b2 < 16; ++b2) if ((a + 1) * (b2 + 1) <= 16) { ck[c] = (sortable(v0[a] + v1[b2]) & ~255u) | (unsigned)(255 - (a * 16 + b2)); ++c; }
    }
    unsigned bk[16];
#pragma unroll
    for (int rd = 0; rd < 16; ++rd) { unsigned mx = 0u;
#pragma unroll
        for (int e = 0; e < 50; e += 2) mx = umax3(mx, ck[e], ck[e + 1]);
        bk[rd] = mx;
#pragma unroll
        for (int e = 0; e < 50; ++e) ck[e] = (ck[e] == mx) ? 0u : ck[e]; }
    float gs[16]; unsigned ex[16]; float Z = 0.f; const float s0 = unsortable(bk[0] & ~255u);
#pragma unroll
    for (int k = 0; k < 16; ++k) { const unsigned flat = 255u - (bk[k] & 255u), a = flat >> 4, b2 = flat & 15u;
        unsigned k1 = 0u, k2 = 0u;
#pragma unroll
        for (int a2 = 0; a2 < 16; ++a2) { k1 = (a == (unsigned)a2) ? L[0][a2] : k1; k2 = (b2 == (unsigned)a2) ? L[1][a2] : k2; }
        ex[k] = (127u - (k1 & 127u)) * 128u + (127u - (k2 & 127u));
        gs[k] = __expf(unsortable(bk[k] & ~255u) - s0); Z += gs[k]; }
    const float iz = 1.f / Z;
    if (hh == 0) {
        unsigned short* ip = IDX + (tok * 8 + h) * 16; float* gp = GATE + (tok * 8 + h) * 16;
        v4u i0 = {ex[0] | (ex[1] << 16), ex[2] | (ex[3] << 16), ex[4] | (ex[5] << 16), ex[6] | (ex[7] << 16)}, i1 = {ex[8] | (ex[9] << 16), ex[10] | (ex[11] << 16), ex[12] | (ex[13] << 16), ex[14] | (ex[15] << 16)};
        *(v4u*)ip = i0; *(v4u*)(ip + 8) = i1;
#pragma unroll
        for (int q = 0; q < 4; ++q) { f32x4 o = {gs[4 * q] * iz, gs[4 * q + 1] * iz, gs[4 * q + 2] * iz, gs[4 * q + 3] * iz}; *(f32x4*)(gp + 4 * q) = o; }
    }
}

__device__ __forceinline__ f32x2 dot16_fp8(const v4u w, const f32x2* hv2, f32x2 s) {
#pragma unroll
    for (int d = 0; d < 4; ++d) { const f32x2 lo = __builtin_amdgcn_cvt_pk_f32_fp8((int)w[d], false), hi = __builtin_amdgcn_cvt_pk_f32_fp8((int)w[d], true);
        s = __builtin_elementwise_fma(lo, hv2[2 * d], s); s = __builtin_elementwise_fma(hi, hv2[2 * d + 1], s); }
    return s;
}
__device__ __forceinline__ void axpy16_fp8(const v4u w, const f32x2 a2, f32x2* acc2) {
#pragma unroll
    for (int d = 0; d < 4; ++d) { const f32x2 lo = __builtin_amdgcn_cvt_pk_f32_fp8((int)w[d], false), hi = __builtin_amdgcn_cvt_pk_f32_fp8((int)w[d], true);
        acc2[2 * d] = __builtin_elementwise_fma(lo, a2, acc2[2 * d]); acc2[2 * d + 1] = __builtin_elementwise_fma(hi, a2, acc2[2 * d + 1]); }
}
__device__ __forceinline__ float gelu_erf(float x) { return 0.5f * x * (1.f + erff(x * 0.70710678118654752f)); }
__device__ __forceinline__ void peer_token(size_t tok, const bf16* __restrict__ H2, const unsigned short* __restrict__ IDX, const float* __restrict__ GATE, const unsigned char* __restrict__ U8, const unsigned char* __restrict__ V8,
                                           const float* __restrict__ USC, const float* __restrict__ VSC, float* xio, bf16* Hn, const float* __restrict__ gn, int last, int lane) {
    const int i0 = IDX[tok * 128 + lane], i1 = IDX[tok * 128 + 64 + lane];
    const float g0 = GATE[tok * 128 + lane], g1 = GATE[tok * 128 + 64 + lane];
    f32x2 hv2[16];
    { const bf16* hp = H2 + tok * 2048 + 16 * lane; const v4u a = *(const v4u*)hp, b = *(const v4u*)(hp + 8), c = *(const v4u*)(hp + 1024), d = *(const v4u*)(hp + 1032);
#define UNP8(o_, w_) do { hv2[o_] = (f32x2){bflo(w_.x), bfhi(w_.x)}; hv2[o_ + 1] = (f32x2){bflo(w_.y), bfhi(w_.y)}; hv2[o_ + 2] = (f32x2){bflo(w_.z), bfhi(w_.z)}; hv2[o_ + 3] = (f32x2){bflo(w_.w), bfhi(w_.w)}; } while (0)
      UNP8(0, a); UNP8(4, b); UNP8(8, c); UNP8(12, d);
#undef UNP8
    }
    float dots[2];
#pragma unroll
    for (int grp = 0; grp < 2; ++grp) { const int iv = grp ? i1 : i0; float dres = 0.f;
#pragma nounroll
        for (int pb = 0; pb < 64; pb += 8) {
            v4u wa[8], wb[8];
#pragma unroll
            for (int j = 0; j < 8; ++j) { const int e = __builtin_amdgcn_readlane(iv, pb + j); const unsigned char* row = U8 + (size_t)e * 2048 + 16 * lane; wa[j] = *(const v4u*)row; wb[j] = *(const v4u*)(row + 1024); }
            float pt[8];
#pragma unroll
            for (int j = 0; j < 8; ++j) { f32x2 s2 = {0.f, 0.f}; s2 = dot16_fp8(wa[j], hv2, s2); s2 = dot16_fp8(wb[j], hv2 + 8, s2); pt[j] = s2.x + s2.y; }
#pragma unroll
            for (int j = 0; j < 4; ++j) { const float send = (lane & 4) ? pt[j] : pt[j + 4], keep = (lane & 4) ? pt[j + 4] : pt[j]; pt[j] = keep + __shfl_xor(send, 4); }
#pragma unroll
            for (int j = 0; j < 2; ++j) { const float send = (lane & 2) ? pt[j] : pt[j + 2], keep = (lane & 2) ? pt[j + 2] : pt[j]; pt[j] = keep + __shfl_xor(send, 2); }
            { const float send = (lane & 1) ? pt[0] : pt[1], keep = (lane & 1) ? pt[1] : pt[0]; pt[0] = keep + __shfl_xor(send, 1); }
            float tsum = pt[0];
            tsum += __shfl_xor(tsum, 8); tsum += __shfl_xor(tsum, 16); tsum += __shfl_xor(tsum, 32);
            if ((lane >> 3) == (pb >> 3)) dres = tsum;
        }
        dots[grp] = dres; }
    const float a0 = gelu_erf(dots[0] * USC[i0]) * g0 * VSC[i0], a1 = gelu_erf(dots[1] * USC[i1]) * g1 * VSC[i1];
    asm volatile("" ::: "memory");
    f32x2 acc2[16];
#pragma unroll
    for (int e = 0; e < 16; ++e) acc2[e] = (f32x2){0.f, 0.f};
#pragma unroll
    for (int grp = 0; grp < 2; ++grp) { const int iv = grp ? i1 : i0; const int av = __builtin_bit_cast(int, grp ? a1 : a0);
#pragma nounroll
        for (int pb = 0; pb < 64; pb += 8) {
            v4u wa[8], wb[8];
#pragma unroll
            for (int j = 0; j < 8; ++j) { const int e = __builtin_amdgcn_readlane(iv, pb + j); const unsigned char* row = V8 + (size_t)e * 2048 + 16 * lane; wa[j] = *(const v4u*)row; wb[j] = *(const v4u*)(row + 1024); }
#pragma unroll
            for (int j = 0; j < 8; ++j) { const float a = __builtin_bit_cast(float, __builtin_amdgcn_readlane(av, pb + j)); const f32x2 a2 = {a, a}; axpy16_fp8(wa[j], a2, acc2); axpy16_fp8(wb[j], a2, acc2 + 8); }
        } }
    asm volatile("" ::: "memory");
    float acc[32];
#pragma unroll
    for (int e = 0; e < 16; ++e) { acc[2 * e] = acc2[e].x; acc[2 * e + 1] = acc2[e].y; }
    float* xp = xio + tok * 2048 + 16 * lane; float ss = 0.f;
#pragma unroll
    for (int q = 0; q < 4; ++q) { const f32x4 x = *(const f32x4*)(xp + 4 * q), y = *(const f32x4*)(xp + 1024 + 4 * q);
        acc[4 * q] += x.x; acc[4 * q + 1] += x.y; acc[4 * q + 2] += x.z; acc[4 * q + 3] += x.w; acc[16 + 4 * q] += y.x; acc[16 + 4 * q + 1] += y.y; acc[16 + 4 * q + 2] += y.z; acc[16 + 4 * q + 3] += y.w; }
#pragma unroll
    for (int e = 0; e < 32; ++e) ss += acc[e] * acc[e];
    const float rs = rsqrtf(wave_sum(ss) * (1.f / 2048.f) + RMS_EPS);
    const float* gp = gn + 16 * lane;
    if (last) {
#pragma unroll
        for (int q = 0; q < 4; ++q) { const f32x4 ga = *(const f32x4*)(gp + 4 * q), gb = *(const f32x4*)(gp + 1024 + 4 * q);
            f32x4 oa = {acc[4 * q] * rs * ga.x, acc[4 * q + 1] * rs * ga.y, acc[4 * q + 2] * rs * ga.z, acc[4 * q + 3] * rs * ga.w};
            f32x4 ob = {acc[16 + 4 * q] * rs * gb.x, acc[16 + 4 * q + 1] * rs * gb.y, acc[16 + 4 * q + 2] * rs * gb.z, acc[16 + 4 * q + 3] * rs * gb.w};
            *(f32x4*)(xp + 4 * q) = oa; *(f32x4*)(xp + 1024 + 4 * q) = ob; }
    } else {
        unsigned wa[8], wb[8];
#pragma unroll
        for (int q = 0; q < 4; ++q) { const f32x4 ga = *(const f32x4*)(gp + 4 * q), gb = *(const f32x4*)(gp + 1024 + 4 * q);
            f32x4 oa = {acc[4 * q], acc[4 * q + 1], acc[4 * q + 2], acc[4 * q + 3]}, ob = {acc[16 + 4 * q], acc[16 + 4 * q + 1], acc[16 + 4 * q + 2], acc[16 + 4 * q + 3]};
            *(f32x4*)(xp + 4 * q) = oa; *(f32x4*)(xp + 1024 + 4 * q) = ob;
            wa[2 * q] = pkbf(oa.x * rs * ga.x, oa.y * rs * ga.y); wa[2 * q + 1] = pkbf(oa.z * rs * ga.z, oa.w * rs * ga.w);
            wb[2 * q] = pkbf(ob.x * rs * gb.x, ob.y * rs * gb.y); wb[2 * q + 1] = pkbf(ob.z * rs * gb.z, ob.w * rs * gb.w); }
        bf16* hp = Hn + tok * 2048 + 16 * lane;
        v4u h0 = {wa[0], wa[1], wa[2], wa[3]}, h1 = {wa[4], wa[5], wa[6], wa[7]}, h2 = {wb[0], wb[1], wb[2], wb[3]}, h3 = {wb[4], wb[5], wb[6], wb[7]};
        *(v4u*)hp = h0; *(v4u*)(hp + 8) = h1; *(v4u*)(hp + 1024) = h2; *(v4u*)(hp + 1032) = h3;
    }
}

#ifndef MK_MULTI
#define MK_MULTI 0
#endif
struct Args { const float* in[19]; float* out; unsigned char* ws; int ph_lo, ph_hi, l_lo, l_hi; };
__global__ void __launch_bounds__(NWAVES * 64, 2) fwd_kernel(Args args) {
    extern __shared__ __attribute__((aligned(16))) unsigned char lds[];
    LAS unsigned char* ldsL = (LAS unsigned char*)lds;
    volatile LAS unsigned* MISC = (volatile LAS unsigned*)(ldsL + MISC_OFF);
    const int tid0 = threadIdx.x, wave = __builtin_amdgcn_readfirstlane(tid0 >> 6);
#define PHASE_IDS() int tid = threadIdx.x; asm volatile("" : "+v"(tid)); const int lane = tid & 63; (void)lane
    const int G = gridDim.x; const int bx = blockIdx.x; const int vcu = (G % 8 == 0) ? (bx % 8) * (G / 8) + bx / 8 : bx;
    const int gw = vcu * NWAVES + wave, NGW = G * NWAVES;
    unsigned char* ws = args.ws;
    gu32* ctl = (gu32*)(ws + WS_CTL);
    for (int u = tid0; u < (LDS_BYTES - LDSCTL_OFF) / 4; u += NWAVES * 64) ((LAS unsigned*)(ldsL + LDSCTL_OFF))[u] = 0u;
    __syncthreads();
    XcdBarrier bar; bar.bar = (unsigned*)(ctl + CW_BAR); bar.x = 0; bar.st = nullptr;
    if (!MK_MULTI) bar = xcd_barrier_post((unsigned*)(ctl + CW_BAR), MISC + 8);
#define GRID_BAR() do { if (!MK_MULTI) xcd_barrier(bar); } while (0)
    const int lo = args.ph_lo, hi = args.ph_hi;
#ifdef PH_ONLY
#define IN(k) ((k) == PH_ONLY && lo <= (k) && (k) < hi)
#else
#define IN(k) (lo <= (k) && (k) < hi)
#endif
#define BOTH(k) (IN(k) && IN((k) + 1))

    bf16* WIN = (bf16*)(ws + WS_WIN); bf16* WUPG = (bf16*)(ws + WS_WUPG); bf16* WUPP = (bf16*)(ws + WS_WUPP); bf16* WOUT = (bf16*)(ws + WS_WOUT); bf16* WQ = (bf16*)(ws + WS_WQ);
    bf16* POOLW = (bf16*)(ws + WS_POOLW); bf16* SUBK = (bf16*)(ws + WS_SUBK); float* USC = (float*)(ws + WS_USC); float* VSC = (float*)(ws + WS_VSC);
    unsigned char* UTAB = ws + WS_UTAB; unsigned char* VTAB = ws + WS_VTAB;
    bf16* Hb = (bf16*)(ws + WS_H); bf16* POOLED = (bf16*)(ws + WS_POOLED); bf16* POOLMIX = (bf16*)(ws + WS_POOLMIX); float* SEGL = (float*)(ws + WS_SEGL); float* SIN = (float*)(ws + WS_SIN);
    bf16* QK = (bf16*)(ws + WS_QK); bf16* Pb = (bf16*)(ws + WS_P); bf16* OFb = (bf16*)(ws + WS_QK); bf16* OBb = (bf16*)(ws + WS_P);
    bf16* VT = (bf16*)(ws + WS_VT); bf16* Rb = (bf16*)(ws + WS_R); bf16* MERGED = (bf16*)(ws + WS_MERGED); bf16* Gb = (bf16*)(ws + WS_G); bf16* PQ = (bf16*)(ws + WS_PQ);
    unsigned short* IDX = (unsigned short*)(ws + WS_IDX); float* GATE = (float*)(ws + WS_GATE); float* AFB = (float*)(ws + WS_AFB);
    bf16* QE = (bf16*)(ws + WS_QE); bf16* GLAOUT = (bf16*)(ws + WS_GLAOUT); bf16* KDT = (bf16*)(ws + WS_KDT); bf16* ATTN = (bf16*)(ws + WS_ATTN); float* DEC = (float*)(ws + WS_DEC);
    float* out = args.out;

    for (int l = args.l_lo; l < args.l_hi; ++l) {
        const float* x_in = (l == 0) ? args.in[0] : (const float*)out;
        const float* w_in = args.in[2] + (size_t)l * D * DIN;
        if (IN(0)) { PHASE_IDS();
            LAS float* scr = (LAS float*)(ldsL + wave * 16384);
            for (int it = gw; it < 32 * 257; it += NGW) { const int kb = it / 257, nb = it % 257, n0 = nb * 32;
                int d; if (n0 < 1024) d = n0; else if (n0 < 2048) d = n0 + 6400; else if (n0 < 3072) d = n0 - 1024; else if (n0 == 3072) d = 7168; else d = n0 - 1056;
                transpose_item(w_in, DIN, WIN, 2048, d, kb * 64, n0, scr, lane); }
            for (int i = gw * 64 + lane; i < 224 * 2048 / 8; i += NGW * 64) { v4u z = {0u, 0u, 0u, 0u}; *(v4u*)(WIN + (size_t)7200 * 2048 + (size_t)i * 8) = z; }
            transpose_matrix(args.in[8] + (size_t)l * 1024 * 2048, 1024, 2048, WUPG, scr, lane, gw, NGW);
            transpose_matrix(args.in[11] + (size_t)l * 1024 * 2048, 1024, 2048, WUPP, scr, lane, gw, NGW);
            transpose_matrix(args.in[12] + (size_t)l * 2048 * 2048, 2048, 2048, WOUT, scr, lane, gw, NGW);
            transpose_matrix(args.in[14] + (size_t)l * 2048 * 2048, 2048, 2048, WQ, scr, lane, gw, NGW);
            for (int g = 0; g < 4; ++g) transpose_matrix(args.in[9] + ((size_t)l * 4 + g) * 65536, 256, 256, POOLW + (size_t)g * 65536, scr, lane, gw, NGW);
            { const float* sk = args.in[15] + (size_t)l * 262144;
              for (int f = gw; f < 512; f += NGW) { const int hp = f >> 5, nt = (f >> 3) & 3, s = f & 7, r = lane & 31, hh = lane >> 5;
                  const float* src = sk + ((size_t)hp * 128 + 32 * nt + r) * 128 + 16 * s + 8 * hh; const f32x4 a = *(const f32x4*)src, b = *(const f32x4*)(src + 4);
                  v4u o = {pkbf(a.x, a.y), pkbf(a.z, a.w), pkbf(b.x, b.y), pkbf(b.z, b.w)}; *(v4u*)(SUBK + ((size_t)f * 64 + lane) * 8) = o; } }
            { const float* ut = args.in[16] + (size_t)l * 16384 * 2048; const float* vt = args.in[17] + (size_t)l * 16384 * 2048;
              for (int row = gw; row < 32768; row += NGW) { if (row < 16384) table_row_fp8(ut, (unsigned*)UTAB, USC, row, lane); else table_row_fp8(vt, (unsigned*)VTAB, VSC, row - 16384, lane); } }
            if (l == 0) for (int m = gw; m < M; m += NGW) rmsnorm_row(x_in + (size_t)m * D, args.in[1], Hb + (size_t)m * D, lane);
            if (BOTH(0)) GRID_BAR();
        }
        if (IN(1)) { PHASE_IDS();
            { pg8::Gemm g{Hb, WIN, M, 7424, 2048, 2048, 2048, 0}; pg8::StaticOrder S; S.init(M, 7424, G, bx);
              pg8::EpiProj E{QK, Rb, Pb, Gb, AFB};
              pg8::gemm_phase<pg8::EpiProj, pg8::StaticOrder, true, true>(ldsL, g, S, E); }
            { pg8::Gemm g{WIN + (size_t)7424 * 2048, Hb, 1024, M, 2048, 2048, 2048, 0}; pg8::StaticOrder S; S.init(1024, M, G, bx);
              pg8::EpiVT E{VT};
              pg8::gemm_phase<pg8::EpiVT, pg8::StaticOrder, true, true>(ldsL, g, S, E); }
            if (BOTH(1)) GRID_BAR();
        }
        if (IN(2)) { PHASE_IDS();
            for (int uid = vcu; uid < 4096; uid += G)
                gla_prep_unit(uid, lds, QK, AFB, args.in[3] + (size_t)l * 8192, args.in[4] + (size_t)l * 512, args.in[5] + (size_t)l * 8192, args.in[6] + (size_t)l * 512, QE, KDT, ATTN, DEC, tid, wave, lane);
            for (int item = vcu * 512 + tid; item < (M / 32) * 128; item += G * 512) pool_item(item, Pb, POOLED);
            if (BOTH(2)) GRID_BAR();
        }
        if (IN(3)) { PHASE_IDS();
            for (int su = vcu; su < 16 * NSEG; su += G) gla_scan_block<false>(su, lds, QE, ATTN, KDT, DEC, VT, SEGL, SIN, OFb, OBb, tid, wave, lane);
            if (BOTH(3)) GRID_BAR();
        }
        if (IN(4)) { PHASE_IDS();
            for (int item = gw; item < 512; item += NGW) gla_carry_item(item, SEGL, SIN, DEC, lane);
            if (BOTH(4)) GRID_BAR();
        }
        if (IN(5)) { PHASE_IDS();
            for (int su = vcu; su < 16 * NSEG; su += G) gla_scan_block<true>(su, lds, QE, ATTN, KDT, DEC, VT, SEGL, SIN, OFb, OBb, tid, wave, lane);
            if (BOTH(5)) GRID_BAR();
        }
        if (IN(6)) { PHASE_IDS();
            for (int m = gw; m < M; m += NGW) gla_fin_row(m, OFb, OBb, Rb, args.in[7] + (size_t)l * 1024, GLAOUT, lane);
            { pg8::Gemm g{POOLED, POOLW, M, 1024, 256, 1024, 256, 512}; pg8::StaticOrder S; S.init(M, 1024, G, bx);
              pg8::EpiScale E{POOLMIX, 1024, args.in[10] + (size_t)l * 1024};
              pg8::gemm_phase<pg8::EpiScale, pg8::StaticOrder, true, true>(ldsL, g, S, E); }
            if (BOTH(6)) GRID_BAR();
        }
        if (IN(7)) { PHASE_IDS();
            { pg8::Gemm g{GLAOUT, WUPG, M, 2048, 1024, 1024, 1024, 0}; pg8::StaticOrder S; S.init(M, 2048, G, bx);
              pg8::EpiGate<false> E{MERGED, Gb};
              pg8::gemm_phase<pg8::EpiGate<false>, pg8::StaticOrder, true, true>(ldsL, g, S, E); }
            { pg8::Gemm g{POOLMIX, WUPP, M, 2048, 1024, 1024, 1024, 0}; pg8::StaticOrder S; S.init(M, 2048, G, bx);
              pg8::EpiGate<true> E{MERGED, Gb + 2048};
              pg8::gemm_phase<pg8::EpiGate<true>, pg8::StaticOrder, true, true>(ldsL, g, S, E); }
            if (BOTH(7)) GRID_BAR();
        }
        if (IN(8)) { PHASE_IDS();
            { pg8::Gemm g{MERGED, WOUT, M, 2048, 2048, 2048, 2048, 0}; pg8::StaticOrder S; S.init(M, 2048, G, bx);
              pg8::EpiResid E{x_in, out};
              pg8::gemm_phase<pg8::EpiResid, pg8::StaticOrder, true, true>(ldsL, g, S, E); }
            if (BOTH(8)) GRID_BAR();
        }
        if (IN(9)) { PHASE_IDS();
            for (int m = gw; m < M; m += NGW) rmsnorm_row(out + (size_t)m * D, args.in[13] + (size_t)l * D, Hb + (size_t)m * D, lane);
            if (BOTH(9)) GRID_BAR();
        }
        if (IN(10)) { PHASE_IDS();
            { pg8::Gemm g{Hb, WQ, M, 2048, 2048, 2048, 2048, 0}; pg8::StaticOrder S; S.init(M, 2048, G, bx);
              pg8::EpiScale E{PQ, 2048, nullptr};
              pg8::gemm_phase<pg8::EpiScale, pg8::StaticOrder, true, true>(ldsL, g, S, E); }
            if (BOTH(10)) GRID_BAR();
        }
        if (IN(11)) { PHASE_IDS();
            for (int j = 0; j < 4; ++j) {
                __syncthreads();
                for (int i = tid; i < 8192; i += 512) *(v4u*)(lds + (size_t)i * 16) = *(const v4u*)((const unsigned char*)SUBK + (size_t)j * 131072 + (size_t)i * 16);
                __syncthreads();
                const int hsel = wave >> 2, h = 2 * j + hsel;
                for (int tile = vcu * 4 + (wave & 3); tile < M / 32; tile += G * 4) peer_topk_item(tile, h, lds + hsel * 65536, PQ, IDX, GATE, lane);
            }
            if (BOTH(11)) GRID_BAR();
        }
        if (IN(12)) { PHASE_IDS();
            const int last = (l == DEPTH - 1);
            const float* gn = last ? args.in[18] : args.in[1] + (size_t)(l + 1) * D;
            for (int tok = gw; tok < M; tok += NGW) peer_token((size_t)tok, Hb, IDX, GATE, UTAB, VTAB, USC, VSC, out, Hb, gn, last, lane);
            if (lo == 0 && hi == NPH && l + 1 < args.l_hi) GRID_BAR();
        }
    }
#undef IN
#undef BOTH
#undef GRID_BAR
}

extern "C" void kernel_launch(void* const* d_in, const int* in_sizes, int n_in, void* d_out, int out_size, void* d_ws, size_t ws_size, hipStream_t stream) {
    static int grid = 0;
    if (grid == 0) {
        if (n_in != 19 || in_sizes[0] != M * D || out_size != M * D || ws_size < WS_END) { fprintf(stderr, "kernel_launch: unexpected shapes / workspace (n_in %d, ws %zu, need %zu); nothing launched\n", n_in, ws_size, (size_t)WS_END); grid = -1; return; }
        int dev = 0, cus = 0, per_cu = 0;
        if (hipGetDevice(&dev) != hipSuccess || hipDeviceGetAttribute(&cus, hipDeviceAttributeMultiprocessorCount, dev) != hipSuccess) { grid = -1; return; }
        if (hipFuncSetAttribute((const void*)fwd_kernel, hipFuncAttributeMaxDynamicSharedMemorySize, LDS_BYTES) != hipSuccess) { fprintf(stderr, "kernel_launch: hipFuncSetAttribute failed\n"); grid = -1; return; }
        if (hipOccupancyMaxActiveBlocksPerMultiprocessor(&per_cu, (const void*)fwd_kernel, NWAVES * 64, LDS_BYTES) != hipSuccess || per_cu < 1) { fprintf(stderr, "kernel_launch: occupancy query reports %d blocks per CU\n", per_cu); }
        (void)hipGetLastError();
        grid = cus;
    }
    if (grid < 0) return;
    if (hipMemsetAsync((char*)d_ws + WS_CTL, 0, CTL_ZERO_BYTES, stream) != hipSuccess) return;
    Args a{};
    for (int i = 0; i < 19; ++i) a.in[i] = (const float*)d_in[i];
    a.out = (float*)d_out; a.ws = (unsigned char*)d_ws;
#if MK_MULTI
    for (int l = 0; l < DEPTH; ++l)
        for (int ph = 0; ph < NPH; ++ph) { a.ph_lo = ph; a.ph_hi = ph + 1; a.l_lo = l; a.l_hi = l + 1;
            hipLaunchKernelGGL(fwd_kernel, dim3(grid), dim3(NWAVES * 64), LDS_BYTES, stream, a); }
#else
    a.ph_lo = 0; a.ph_hi = NPH; a.l_lo = 0; a.l_hi = DEPTH;
    hipLaunchKernelGGL(fwd_kernel, dim3(grid), dim3(NWAVES * 64), LDS_BYTES, stream, a);
#endif
}
```

```cpp
#include <hip/hip_runtime.h>
#include <cstdio>
#include <cstdint>
namespace pg8 {
#define PG8_LAS __attribute__((address_space(3)))
typedef unsigned short bf16_t;
typedef short bf16x8 __attribute__((ext_vector_type(8)));
typedef float f32x4 __attribute__((ext_vector_type(4)));
typedef unsigned u32x4 __attribute__((ext_vector_type(4)));
typedef unsigned u32x2 __attribute__((ext_vector_type(2)));
constexpr int BM = 256, BK = 64, HALF = 128, HTB = HALF * BK * 2  , STAGE_BYTES = 8 * HTB, NXCD = 8, WGM = 8;

__host__ __device__ __forceinline__ int lds_byte(int r, int c) { const int st = (r >> 4) * 2 + (c >> 5), rr = r & 15, cc = c & 31, ob = rr * 64 + cc * 2; return st * 1024 + (ob ^ (((ob >> 9) & 1) << 5)); }
__host__ __device__ __forceinline__ void stage_rc(int b, int& R, int& C) { const int st = b / 1024, sb = b % 1024, swz = sb ^ (((sb >> 9) & 1) << 5); R = (st >> 1) * 16 + swz / 64; C = (st & 1) * 32 + (swz % 64) / 2; }
__host__ __device__ __forceinline__ int perm32(int rho) { const int n = rho >> 4, i = rho & 15; return 8 * (i >> 2) + 4 * n + (i & 3); }

struct Unit { int pm, pn, sub; };
struct Gemm { const bf16_t* A; const bf16_t* Bt; int M, N, K, lda, ldb, a_pn_step; const bf16_t* A2; const bf16_t* Bt2; };

struct StaticOrder {
    int nM, nN, nwg, G, c;
    __host__ __device__ void init(int M, int N, int G_, int c_) { nM = M / BM; nN = N / BM; nwg = nM * nN; G = G_; c = c_; }
    __host__ __device__ bool next(int i, Unit& u) const {
        const long L = (long)i * G + c; if (L >= nwg) return false;
        int wgid = (int)L; { const int q = nwg / NXCD, r = nwg % NXCD, xcd = wgid % NXCD, off = wgid / NXCD; wgid = (xcd < r ? xcd * (q + 1) : r * (q + 1) + (xcd - r) * q) + off; }
        const int nig = WGM * nN, gid = wgid / nig, fm = gid * WGM, gsz = (nM - fm) < WGM ? (nM - fm) : WGM;
        u.pm = fm + ((wgid % nig) % gsz); u.pn = (wgid % nig) / gsz; u.sub = 0; return true;
    }
    __device__ __forceinline__ void a_ready(const Unit&) const {}
    __device__ __forceinline__ void done(const Unit&) const {}
};

struct TwoPartOrder : StaticOrder {
    __host__ __device__ bool next(int i, Unit& u) const { if (!StaticOrder::next(i >> 1, u)) return false; u.sub = i & 1; return true; }
};
typedef float f32x2 __attribute__((ext_vector_type(2)));
typedef __bf16 bf16x2_t __attribute__((ext_vector_type(2)));
__device__ __forceinline__ unsigned pkbf(float lo, float hi) { f32x2 v = {lo, hi}; bf16x2_t b = __builtin_convertvector(v, bf16x2_t); return __builtin_bit_cast(unsigned, b); }
__device__ __forceinline__ float bflo(unsigned w) { return __builtin_bit_cast(float, w << 16); }
__device__ __forceinline__ float bfhi(unsigned w) { return __builtin_bit_cast(float, w & 0xffff0000u); }
__device__ __forceinline__ float fast_sigmoid(float x) { return __builtin_amdgcn_rcpf(1.f + __expf(-x)); }
template <int NP> __device__ __forceinline__ float row_rs(const float* ssp, int row) {
    const f32x4* p = (const f32x4*)(ssp + (size_t)row * NP); f32x4 a = p[0];
#pragma unroll
    for (int k = 1; k < NP / 4; ++k) a = a + p[k];
    return rsqrtf(((a.x + a.y) + (a.z + a.w)) * (1.f / 2048.f) + 1e-6f);
}

template <int NP> __device__ __forceinline__ float row_rs_fq(const float* ssp, int row, int fq) {
    const f32x4* p = (const f32x4*)(ssp + (size_t)row * NP + fq * (NP / 4)); f32x4 a = p[0];
    if (NP == 32) a = a + p[1];
    float t = (a.x + a.y) + (a.z + a.w);
    t += __shfl_xor(t, 16); t += __shfl_xor(t, 32);
    return rsqrtf(t * (1.f / 2048.f) + 1e-6f);
}
template <int NP> __device__ __forceinline__ void row_rs_fq8(const float* ssp, int row0, int fq, float (&rsc)[2][4]) {
    f32x4 a[2][4], b[2][4];
#pragma unroll
    for (int ai = 0; ai < 2; ++ai)
#pragma unroll
        for (int m = 0; m < 4; ++m) { const f32x4* p = (const f32x4*)(ssp + (size_t)(row0 + ai * HALF + m * 16) * NP + fq * (NP / 4)); a[ai][m] = p[0]; if (NP == 32) b[ai][m] = p[1]; }
#pragma unroll
    for (int ai = 0; ai < 2; ++ai)
#pragma unroll
        for (int m = 0; m < 4; ++m) { f32x4 v = a[ai][m]; if (NP == 32) v = v + b[ai][m];
            float t = (v.x + v.y) + (v.z + v.w); t += __shfl_xor(t, 16); t += __shfl_xor(t, 32);
            rsc[ai][m] = rsqrtf(t * (1.f / 2048.f) + 1e-6f); }
}
struct EpiProj {
    static constexpr bool PERM = true, AFTER_DRAIN = false; __device__ static bool keep(const Unit&) { return false; }
    bf16_t *QK, *R, *P, *G; float* AFB; const float* ss;
    __device__ __forceinline__ void operator()(const f32x4 (&acc)[2][2][4][2], const Unit& u, int wr, int wc, int fr, int fq) const {
        const int row0 = u.pm * BM + wr * 64 + fr; const int pn = u.pn;
        float rsc[2][4];
        if (ss) row_rs_fq8<16>(ss, row0, fq, rsc);
        else {
#pragma unroll
            for (int ai = 0; ai < 2; ++ai)
#pragma unroll
                for (int m = 0; m < 4; ++m) rsc[ai][m] = 1.f; }
        bf16_t* base; int ldc, colt, mode;
        if (pn < 4) { base = QK; ldc = 1024; colt = pn * 256; mode = (pn < 2) ? 1 : 0; }
        else if (pn < 8) { base = R; ldc = 1024; colt = (pn - 4) * 256; mode = 2; }
        else if (pn < 12) { base = P; ldc = 1024; colt = (pn - 8) * 256; mode = 0; }
        else { base = G; ldc = 4096; colt = (pn - 12) * 256; mode = 3; }
        const int col0 = colt + wc * 32 + 8 * fq;
#pragma unroll
        for (int ai = 0; ai < 2; ++ai)
#pragma unroll
            for (int m = 0; m < 4; ++m) { bf16_t* rowp = base + (size_t)(row0 + ai * HALF + m * 16) * ldc + col0;
#pragma unroll
                for (int bj = 0; bj < 2; ++bj) { f32x4 v0 = acc[ai][bj][m][0] * rsc[ai][m], v1 = acc[ai][bj][m][1] * rsc[ai][m];
                    if (mode == 1) { v0 = v0 * 0.08838834764831845f; v1 = v1 * 0.08838834764831845f; }
                    else if (mode == 2) {
#pragma unroll
                        for (int e = 0; e < 4; ++e) { v0[e] = v0[e] * fast_sigmoid(v0[e]); v1[e] = v1[e] * fast_sigmoid(v1[e]); } }
                    else if (mode == 3) {
#pragma unroll
                        for (int e = 0; e < 4; ++e) { v0[e] = fast_sigmoid(v0[e]); v1[e] = fast_sigmoid(v1[e]); } }
                    if (mode == 3) { unsigned w0 = 0u, w1 = 0u;
#pragma unroll
                        for (int e = 0; e < 4; ++e) { w0 = __builtin_amdgcn_cvt_pk_u8_f32(__builtin_rintf(v0[e] * 255.f), e, w0); w1 = __builtin_amdgcn_cvt_pk_u8_f32(__builtin_rintf(v1[e] * 255.f), e, w1); }
                        u32x2 w = {w0, w1}; *(u32x2*)((unsigned char*)G + (size_t)(row0 + ai * HALF + m * 16) * 4096 + col0 + bj * HALF) = w; }
                    else {
                    u32x4 w; w.x = pkbf(v0[0], v0[1]); w.y = pkbf(v0[2], v0[3]); w.z = pkbf(v1[0], v1[1]); w.w = pkbf(v1[2], v1[3]);
                    *(u32x4*)(rowp + bj * HALF) = w; } } asm volatile("" ::: "memory"); }
    }
};
struct EpiVT {
    static constexpr bool PERM = true, AFTER_DRAIN = false; __device__ static bool keep(const Unit&) { return false; }
    bf16_t* VT; const float* ss;
    __device__ __forceinline__ void operator()(const f32x4 (&acc)[2][2][4][2], const Unit& u, int wr, int wc, int fr, int fq) const {
        const int dv0 = u.pm * BM + wr * 64 + fr, tok0 = u.pn * BM + wc * 32 + 8 * fq;
        f32x4 cs[2][2];
#pragma unroll
        for (int bj = 0; bj < 2; ++bj)
#pragma unroll
            for (int n = 0; n < 2; ++n) cs[bj][n] = (f32x4){1.f, 1.f, 1.f, 1.f};
        if (ss) { const float mine = row_rs<16>(ss, tok0 + (fr >> 3) * HALF + (fr & 7));
#pragma unroll
            for (int bj = 0; bj < 2; ++bj)
#pragma unroll
                for (int n = 0; n < 2; ++n)
#pragma unroll
                    for (int k = 0; k < 4; ++k) cs[bj][n][k] = __shfl(mine, fq * 16 + bj * 8 + 4 * n + k); }
#pragma unroll
        for (int ai = 0; ai < 2; ++ai)
#pragma unroll
            for (int m = 0; m < 4; ++m) { const int dv = dv0 + ai * HALF + m * 16;
#pragma unroll
                for (int bj = 0; bj < 2; ++bj) { const int tok = tok0 + bj * HALF; const int bc = tok >> 6, tin = tok & 63;
                    const f32x4 v0 = acc[ai][bj][m][0] * cs[bj][0], v1 = acc[ai][bj][m][1] * cs[bj][1];
                    u32x4 w; w.x = pkbf(v0[0], v0[1]); w.y = pkbf(v0[2], v0[3]); w.z = pkbf(v1[0], v1[1]); w.w = pkbf(v1[2], v1[3]);
                    *(u32x4*)(VT + ((size_t)bc * 1024 + dv) * 64 + tin) = w; } }
    }
};
template <bool ROWS> struct EpiScale {
    static constexpr bool PERM = true, AFTER_DRAIN = false; __device__ static bool keep(const Unit&) { return false; }
    bf16_t* O; int ldc; const float* scale; const float* ss;
    __device__ __forceinline__ void operator()(const f32x4 (&acc)[2][2][4][2], const Unit& u, int wr, int wc, int fr, int fq) const {
        const int row0 = u.pm * BM + wr * 64 + fr, col0 = u.pn * BM + wc * 32 + 8 * fq;
        f32x4 sv[2][2];
#pragma unroll
        for (int bj = 0; bj < 2; ++bj)
#pragma unroll
            for (int n = 0; n < 2; ++n) sv[bj][n] = scale ? *(const f32x4*)(scale + col0 + bj * HALF + 4 * n) : (f32x4){1.f, 1.f, 1.f, 1.f};
        float rsc[2][4];
        if (ROWS) row_rs_fq8<32>(ss, row0, fq, rsc);
#pragma unroll
        for (int ai = 0; ai < 2; ++ai)
#pragma unroll
            for (int m = 0; m < 4; ++m) { bf16_t* rowp = O + (size_t)(row0 + ai * HALF + m * 16) * ldc + col0; const float rr = ROWS ? rsc[ai][m] : 1.f;
#pragma unroll
                for (int bj = 0; bj < 2; ++bj) { const f32x4 v0 = acc[ai][bj][m][0] * sv[bj][0] * rr, v1 = acc[ai][bj][m][1] * sv[bj][1] * rr;
                    u32x4 w; w.x = pkbf(v0[0], v0[1]); w.y = pkbf(v0[2], v0[3]); w.z = pkbf(v1[0], v1[1]); w.w = pkbf(v1[2], v1[3]);
                    *(u32x4*)(rowp + bj * HALF) = w; } }
    }
};
template <bool ACCUM> struct EpiGate {
    static constexpr bool PERM = true, AFTER_DRAIN = false; __device__ static bool keep(const Unit&) { return false; }
    bf16_t* O; const bf16_t* Gt;
    __device__ __forceinline__ void operator()(const f32x4 (&acc)[2][2][4][2], const Unit& u, int wr, int wc, int fr, int fq) const {
        const int row0 = u.pm * BM + wr * 64 + fr, col0 = u.pn * BM + wc * 32 + 8 * fq;
#pragma unroll
        for (int ai = 0; ai < 2; ++ai) {
            u32x4 gwv[4][2], owv[4][2];
#pragma unroll
            for (int m = 0; m < 4; ++m)
#pragma unroll
                for (int bj = 0; bj < 2; ++bj) { const size_t row = (size_t)(row0 + ai * HALF + m * 16);
                    gwv[m][bj] = *(const u32x4*)(Gt + row * 4096 + col0 + bj * HALF);
                    if (ACCUM) owv[m][bj] = *(const u32x4*)(O + row * 2048 + col0 + bj * HALF); }
            asm volatile("" ::: "memory");
#pragma unroll
            for (int m = 0; m < 4; ++m) { const size_t row = (size_t)(row0 + ai * HALF + m * 16);
#pragma unroll
                for (int bj = 0; bj < 2; ++bj) { const u32x4 gw = gwv[m][bj];
                    f32x4 v0 = acc[ai][bj][m][0], v1 = acc[ai][bj][m][1];
                    v0[0] *= bflo(gw.x); v0[1] *= bfhi(gw.x); v0[2] *= bflo(gw.y); v0[3] *= bfhi(gw.y); v1[0] *= bflo(gw.z); v1[1] *= bfhi(gw.z); v1[2] *= bflo(gw.w); v1[3] *= bfhi(gw.w);
                    if (ACCUM) { const u32x4 ow = owv[m][bj];
                        v0[0] += bflo(ow.x); v0[1] += bfhi(ow.x); v0[2] += bflo(ow.y); v0[3] += bfhi(ow.y); v1[0] += bflo(ow.z); v1[1] += bfhi(ow.z); v1[2] += bflo(ow.w); v1[3] += bfhi(ow.w); }
                    u32x4 w; w.x = pkbf(v0[0], v0[1]); w.y = pkbf(v0[2], v0[3]); w.z = pkbf(v1[0], v1[1]); w.w = pkbf(v1[2], v1[3]);
                    *(u32x4*)(O + row * 2048 + col0 + bj * HALF) = w; } }
            asm volatile("" ::: "memory");
        }
    }
};
struct EpiMerge {
    static constexpr bool PERM = true, AFTER_DRAIN = false; __device__ static bool keep(const Unit& u) { return u.sub == 0; }
    bf16_t* O; const unsigned char* Gt;
    __device__ __forceinline__ void operator()(f32x4 (&acc)[2][2][4][2], const Unit& u, int wr, int wc, int fr, int fq) const {
        const int row0 = u.pm * BM + wr * 64 + fr, col0 = u.pn * BM + wc * 32 + 8 * fq;
#pragma unroll
        for (int ai = 0; ai < 2; ++ai) {
            u32x2 g1[4][2], g2[4][2];
#pragma unroll
            for (int m = 0; m < 4; ++m)
#pragma unroll
                for (int bj = 0; bj < 2; ++bj) { const size_t p = (size_t)(row0 + ai * HALF + m * 16) * 4096 + col0 + bj * HALF;
                    g2[m][bj] = *(const u32x2*)(Gt + p + 2048); if (u.sub == 0) g1[m][bj] = *(const u32x2*)(Gt + p); }
            asm volatile("" ::: "memory");
#pragma unroll
            for (int m = 0; m < 4; ++m)
#pragma unroll
                for (int bj = 0; bj < 2; ++bj) { const u32x2 b = g2[m][bj];
                    float s2[8];
#pragma unroll
                    for (int e = 0; e < 4; ++e) { s2[e] = (float)((b.x >> (8 * e)) & 255u) * (1.f / 255.f); s2[4 + e] = (float)((b.y >> (8 * e)) & 255u) * (1.f / 255.f); }
#pragma unroll
                    for (int e = 0; e < 8; ++e) s2[e] = fmaxf(s2[e], 8.6736174e-19f);
                    f32x4 v0 = acc[ai][bj][m][0], v1 = acc[ai][bj][m][1];
                    if (u.sub == 0) { const u32x2 a = g1[m][bj];
                        float s1[8];
#pragma unroll
                        for (int e = 0; e < 4; ++e) { s1[e] = (float)((a.x >> (8 * e)) & 255u) * (1.f / 255.f); s1[4 + e] = (float)((a.y >> (8 * e)) & 255u) * (1.f / 255.f); }
#pragma unroll
                        for (int e = 0; e < 4; ++e) { v0[e] *= s1[e] * __builtin_amdgcn_rcpf(s2[e]); v1[e] *= s1[4 + e] * __builtin_amdgcn_rcpf(s2[4 + e]); }
                        acc[ai][bj][m][0] = v0; acc[ai][bj][m][1] = v1;
                    } else {
#pragma unroll
                        for (int e = 0; e < 4; ++e) { v0[e] *= s2[e]; v1[e] *= s2[4 + e]; }
                        u32x4 w; w.x = pkbf(v0[0], v0[1]); w.y = pkbf(v0[2], v0[3]); w.z = pkbf(v1[0], v1[1]); w.w = pkbf(v1[2], v1[3]);
                        *(u32x4*)(O + (size_t)(row0 + ai * HALF + m * 16) * 2048 + col0 + bj * HALF) = w; } }
            asm volatile("" ::: "memory");
        }
    }
};
struct EpiResid {
    static constexpr bool PERM = true, AFTER_DRAIN = false; __device__ static bool keep(const Unit&) { return false; }
    const float* xin; bf16_t* XB; float* ss;
    __device__ __forceinline__ void operator()(const f32x4 (&acc)[2][2][4][2], const Unit& u, int wr, int wc, int fr, int fq) const {
        const int row0 = u.pm * BM + wr * 64 + fr, col0 = u.pn * BM + wc * 32 + 8 * fq;
        f32x4 xv[2][2][2][2];
#define ER_LOAD(h4_) do { const int ai_ = (h4_) >> 1, mb_ = ((h4_) & 1) * 2; _Pragma("unroll") for (int mm = 0; mm < 2; ++mm) _Pragma("unroll") for (int bj = 0; bj < 2; ++bj) { \
            const size_t p = (size_t)(row0 + ai_ * HALF + (mb_ + mm) * 16) * 2048 + col0 + bj * HALF; xv[(h4_) & 1][mm][bj][0] = *(const f32x4*)(xin + p); xv[(h4_) & 1][mm][bj][1] = *(const f32x4*)(xin + p + 4); } } while (0)
        ER_LOAD(0);
#pragma unroll
        for (int h4 = 0; h4 < 4; ++h4) { const int ai = h4 >> 1, mb = (h4 & 1) * 2;
            if (h4 + 1 < 4) ER_LOAD(h4 + 1);
            asm volatile("" ::: "memory");
#pragma unroll
            for (int mm = 0; mm < 2; ++mm) { const int m = mb + mm; const int row = row0 + ai * HALF + m * 16; const size_t rb = (size_t)row * 2048 + col0; float sq = 0.f;
#pragma unroll
                for (int bj = 0; bj < 2; ++bj) { const size_t p = rb + bj * HALF;
                    const f32x4 x0 = xv[h4 & 1][mm][bj][0] + acc[ai][bj][m][0], x1 = xv[h4 & 1][mm][bj][1] + acc[ai][bj][m][1];
                    sq += (x0.x * x0.x + x0.y * x0.y) + (x0.z * x0.z + x0.w * x0.w) + (x1.x * x1.x + x1.y * x1.y) + (x1.z * x1.z + x1.w * x1.w);
                    u32x4 w; w.x = pkbf(x0[0], x0[1]); w.y = pkbf(x0[2], x0[3]); w.z = pkbf(x1[0], x1[1]); w.w = pkbf(x1[2], x1[3]);
                    *(u32x4*)(XB + p) = w; }
                sq += __shfl_xor(sq, 16); sq += __shfl_xor(sq, 32);
                if (fq == 0) ss[(size_t)row * 32 + u.pn * 4 + wc] = sq; }
            asm volatile("" ::: "memory");
        }
#undef ER_LOAD
    }
};

template <class Epi, class Sched, bool ALIGN_EPI = false, bool SP2 = false>
__device__ __forceinline__ void gemm_phase(PG8_LAS unsigned char* lds, const Gemm g, const Sched& S, const Epi& E) {
    int tid_o = threadIdx.x; asm volatile("" : "+v"(tid_o));
    const int tid = tid_o, wid = __builtin_amdgcn_readfirstlane(tid >> 6), lane = tid & 63, wr = wid >> 2, wc = wid & 3, fr = lane & 15, fq = lane >> 4;
    int K_o = g.K; asm volatile("" : "+s"(K_o));
    const int K = K_o, nt = K / BK;
    unsigned voffA[2], voffB[2];
#pragma unroll
    for (int i = 0; i < 2; ++i) { int R, C; stage_rc(tid * 16 + i * 8192, R, C); const int Rb = Epi::PERM ? ((R & ~31) + perm32(R & 31)) : R;
        voffA[i] = (unsigned)(R * g.lda + C) * 2u; voffB[i] = (unsigned)(Rb * g.ldb + C) * 2u; }
    const size_t kstep = (size_t)(BK * 2);
    const size_t hstepA = (size_t)HALF * g.lda * 2, hstepB = (size_t)HALF * g.ldb * 2;
    const size_t tstepA = 2 * hstepA, tstepB = 2 * hstepB;
    const unsigned ldsw = (unsigned)wid * 1024u;
    const int aoff = lds_byte(wr * 64 + fr, fq * 8), boff = lds_byte(wc * 32 + fr, fq * 8);
#define PG8_SA(b, h) (((b) * 2 + (h)) * HTB)
#define PG8_SB(b, h) ((4 + (b) * 2 + (h)) * HTB)
#define PG8_STAGE(bufoff, gbase, voff) do { _Pragma("unroll") for (int _i = 0; _i < 2; ++_i) \
        __builtin_amdgcn_global_load_lds((const unsigned*)((const char*)(gbase) + (voff)[_i]), (PG8_LAS unsigned*)(lds + (bufoff) + ldsw + _i * 8192), 16, 0, 0); } while (0)
#define PG8_LDA(dst, b, h) do { _Pragma("unroll") for (int m = 0; m < 4; ++m) _Pragma("unroll") for (int k = 0; k < 2; ++k) dst[m][k] = *(const PG8_LAS bf16x8*)(lds + PG8_SA(b, h) + aoff + m * 2048 + k * 1024); } while (0)
#define PG8_LDB(dst, b, h) do { _Pragma("unroll") for (int n = 0; n < 2; ++n) _Pragma("unroll") for (int k = 0; k < 2; ++k) dst[n][k] = *(const PG8_LAS bf16x8*)(lds + PG8_SB(b, h) + boff + n * 2048 + k * 1024); } while (0)
#define PG8_MMA(ai, bj, At, Bt) do { __builtin_amdgcn_s_setprio(1); _Pragma("unroll") for (int m = 0; m < 4; ++m) _Pragma("unroll") for (int n = 0; n < 2; ++n) _Pragma("unroll") for (int k = 0; k < 2; ++k) \
        acc[ai][bj][m][n] = __builtin_amdgcn_mfma_f32_16x16x32_bf16(Bt[n][k], At[m][k], acc[ai][bj][m][n], 0, 0, 0); __builtin_amdgcn_s_setprio(0); } while (0)
#define PG8_WAIT_V(n) asm volatile("s_waitcnt vmcnt(" #n ")" ::: "memory")
#define PG8_WAIT_L(n) asm volatile("s_waitcnt lgkmcnt(" #n ")" ::: "memory")
#define PG8_BAR __builtin_amdgcn_s_barrier()
#define PG8_SCHED __builtin_amdgcn_sched_barrier(0)
    Unit cur, nxt; int ui = 0;
    if (!S.next(0, cur)) return;
    f32x4 acc[2][2][4][2];
    float zf = 0.f; asm volatile("" : "+v"(zf));
#pragma unroll
    for (int a = 0; a < 2; ++a)
#pragma unroll
        for (int b = 0; b < 2; ++b)
#pragma unroll
            for (int m = 0; m < 4; ++m)
#pragma unroll
                for (int n = 0; n < 2; ++n) acc[a][b][m][n] = (f32x4){zf, zf, zf, zf};
    bf16x8 At[4][2], B0[2][2], B1[2][2];
    const char* cA = (const char*)(cur.sub ? g.A2 : g.A) + (size_t)cur.pm * tstepA + (size_t)cur.pn * g.a_pn_step; const char* cB = (const char*)(cur.sub ? g.Bt2 : g.Bt) + (size_t)cur.pn * tstepB;
    S.a_ready(cur);
    if constexpr (SP2) {
        PG8_STAGE(PG8_SB(0, 0), cB, voffB); PG8_STAGE(PG8_SB(0, 1), cB + hstepB, voffB); PG8_STAGE(PG8_SA(0, 0), cA, voffA); PG8_STAGE(PG8_SA(0, 1), cA + hstepA, voffA);
        if (wr == 1) PG8_BAR;
        PG8_WAIT_V(2); PG8_BAR;
        PG8_STAGE(PG8_SB(1, 0), cB + kstep, voffB); PG8_STAGE(PG8_SA(1, 0), cA + kstep, voffA); PG8_STAGE(PG8_SB(1, 1), cB + hstepB + kstep, voffB);
        PG8_WAIT_V(6); PG8_BAR;
    } else {
        PG8_STAGE(PG8_SB(0, 0), cB, voffB); PG8_STAGE(PG8_SA(0, 0), cA, voffA); PG8_STAGE(PG8_SB(0, 1), cB + hstepB, voffB); PG8_STAGE(PG8_SA(0, 1), cA + hstepA, voffA);
        if (wr == 1) PG8_BAR;
        PG8_WAIT_V(4); PG8_BAR;
        PG8_STAGE(PG8_SB(1, 0), cB + kstep, voffB); PG8_STAGE(PG8_SA(1, 0), cA + kstep, voffA); PG8_STAGE(PG8_SB(1, 1), cB + hstepB + kstep, voffB);
        PG8_WAIT_V(6); PG8_BAR;
    }
    for (;;) {
        const bool has_next = S.next(ui + 1, nxt);
        const char* nA = has_next ? (const char*)(nxt.sub ? g.A2 : g.A) + (size_t)nxt.pm * tstepA + (size_t)nxt.pn * g.a_pn_step : cA; const char* nB = has_next ? (const char*)(nxt.sub ? g.Bt2 : g.Bt) + (size_t)nxt.pn * tstepB : cB;
        for (int t = 0; t < nt; t += 2) {
            const bool last = (t == nt - 2);
            const char* a1 = cA + (size_t)(t + 1) * kstep;
            const char* a2 = last ? nA : cA + (size_t)(t + 2) * kstep; const char* b2 = last ? nB : cB + (size_t)(t + 2) * kstep;
            const char* a3 = a2 + kstep; const char* b3 = b2 + kstep;
            if (last && has_next) S.a_ready(nxt);
            if constexpr (SP2) {
            PG8_LDB(B0, 0, 0); PG8_LDB(B1, 0, 1); PG8_SCHED; PG8_LDA(At, 0, 0); PG8_STAGE(PG8_SA(1, 1), a1 + hstepA, voffA);
            PG8_WAIT_V(8); PG8_WAIT_L(0); PG8_BAR; PG8_MMA(0, 0, At, B0); PG8_MMA(0, 1, At, B1); PG8_BAR; PG8_SCHED;
            PG8_LDA(At, 0, 1); PG8_STAGE(PG8_SB(0, 0), b2, voffB); PG8_STAGE(PG8_SB(0, 1), b2 + hstepB, voffB); PG8_STAGE(PG8_SA(0, 0), a2, voffA);
            PG8_WAIT_V(8); PG8_WAIT_L(0); PG8_BAR; PG8_MMA(1, 0, At, B0); PG8_MMA(1, 1, At, B1); PG8_BAR; PG8_SCHED;
            PG8_LDB(B0, 1, 0); PG8_LDB(B1, 1, 1); PG8_SCHED; PG8_LDA(At, 1, 0); PG8_STAGE(PG8_SA(0, 1), a2 + hstepA, voffA);
            PG8_WAIT_V(8); PG8_WAIT_L(0); PG8_BAR; PG8_MMA(0, 0, At, B0); PG8_MMA(0, 1, At, B1); PG8_BAR; PG8_SCHED;
            PG8_LDA(At, 1, 1); PG8_STAGE(PG8_SB(1, 0), b3, voffB); PG8_STAGE(PG8_SB(1, 1), b3 + hstepB, voffB); PG8_STAGE(PG8_SA(1, 0), a3, voffA);
            PG8_WAIT_V(8); PG8_WAIT_L(0); PG8_BAR; PG8_MMA(1, 0, At, B0); PG8_MMA(1, 1, At, B1); PG8_BAR; PG8_SCHED;
            } else {
            PG8_LDB(B0, 0, 0); PG8_SCHED; PG8_LDA(At, 0, 0); PG8_STAGE(PG8_SA(1, 1), a1 + hstepA, voffA);
            PG8_WAIT_L(8); PG8_BAR; PG8_WAIT_L(0); PG8_MMA(0, 0, At, B0); PG8_BAR; PG8_SCHED;
            PG8_LDB(B1, 0, 1); PG8_STAGE(PG8_SB(0, 0), b2, voffB);
            PG8_BAR; PG8_WAIT_L(0); PG8_MMA(0, 1, At, B1); PG8_BAR;
            PG8_LDA(At, 0, 1); PG8_STAGE(PG8_SA(0, 0), a2, voffA);
            PG8_BAR; PG8_WAIT_L(0); PG8_MMA(1, 0, At, B0); PG8_BAR; PG8_SCHED;
            PG8_STAGE(PG8_SB(0, 1), b2 + hstepB, voffB);
            PG8_WAIT_V(6); PG8_BAR; PG8_MMA(1, 1, At, B1); PG8_BAR;
            PG8_LDB(B0, 1, 0); PG8_SCHED; PG8_LDA(At, 1, 0); PG8_STAGE(PG8_SA(0, 1), a2 + hstepA, voffA);
            PG8_WAIT_L(8); PG8_BAR; PG8_WAIT_L(0); PG8_MMA(0, 0, At, B0); PG8_BAR; PG8_SCHED;
            PG8_LDB(B1, 1, 1); PG8_STAGE(PG8_SB(1, 0), b3, voffB);
            PG8_BAR; PG8_WAIT_L(0); PG8_MMA(0, 1, At, B1); PG8_BAR;
            PG8_LDA(At, 1, 1); PG8_STAGE(PG8_SA(1, 0), a3, voffA);
            PG8_BAR; PG8_WAIT_L(0); PG8_MMA(1, 0, At, B0); PG8_BAR; PG8_SCHED;
            PG8_STAGE(PG8_SB(1, 1), b3 + hstepB, voffB);
            PG8_WAIT_V(6); PG8_BAR; PG8_MMA(1, 1, At, B1); PG8_BAR;
            }
        }
        if constexpr (ALIGN_EPI) { if (wr == 0) PG8_BAR; }
        if constexpr (!Epi::AFTER_DRAIN) { E(acc, cur, wr, wc, fr, fq); S.done(cur); }
        if (!has_next) break;
        if (!Epi::keep(cur)) {
        float zf2 = 0.f; asm volatile("" : "+v"(zf2));
#pragma unroll
        for (int a = 0; a < 2; ++a)
#pragma unroll
            for (int b = 0; b < 2; ++b)
#pragma unroll
                for (int m = 0; m < 4; ++m)
#pragma unroll
                    for (int n = 0; n < 2; ++n) acc[a][b][m][n] = (f32x4){zf2, zf2, zf2, zf2};
        }
        cur = nxt; cA = nA; cB = nB; ++ui;
        if constexpr (ALIGN_EPI) { if (wr == 1) PG8_BAR; }
    }
    PG8_WAIT_V(0);
    if constexpr (!ALIGN_EPI) { if (wr == 0) PG8_BAR; }
    PG8_BAR;
    if constexpr (Epi::AFTER_DRAIN) { E.fused(acc, cur, wr, wc, fr, fq, lds, wid, lane); S.done(cur); }
#undef PG8_SA
#undef PG8_SB
#undef PG8_STAGE
#undef PG8_LDA
#undef PG8_LDB
#undef PG8_MMA
#undef PG8_WAIT_V
#undef PG8_WAIT_L
#undef PG8_BAR
#undef PG8_SCHED
}
}

#define GAS __attribute__((address_space(1)))
#define LAS __attribute__((address_space(3)))
typedef unsigned short bf16;
typedef unsigned v4u __attribute__((ext_vector_type(4)));
typedef float f32x4 __attribute__((ext_vector_type(4)));
typedef short bf16x8 __attribute__((ext_vector_type(8)));
typedef GAS unsigned gu32;
typedef GAS unsigned long long gu64;
#define RLX_AGENT __ATOMIC_RELAXED, __HIP_MEMORY_SCOPE_AGENT
#define LDS_WAIT() asm volatile("s_waitcnt lgkmcnt(0)" ::: "memory")
#define VM_WAIT() asm volatile("s_waitcnt vmcnt(0)" ::: "memory")
__device__ __forceinline__ unsigned long long rt() { return __builtin_amdgcn_s_memrealtime(); }
__device__ __forceinline__ unsigned f2bf(float f) { unsigned u = __builtin_bit_cast(unsigned, f); return (u + 0x7fffu + ((u >> 16) & 1u)) >> 16; }
__device__ __forceinline__ unsigned pk2(float lo, float hi) { return f2bf(lo) | (f2bf(hi) << 16); }

#define XB_TMO      128
#define XB_XCNT(j)  (256  + 64 * (j))
#define XB_XSUB(j)  (1280 + 64 * (j))
#define XB_XGEN(j)  (2304 + 64 * (j))
#define XB_TOP      3328
#define XB_TOPGEN   3392
#define XCD_BAR_WORDS 3456
#define XB_SPIN_CAP (1u << 18)

__device__ __forceinline__ unsigned xb_ld(unsigned* p)              { return __hip_atomic_load(p, __ATOMIC_RELAXED, __HIP_MEMORY_SCOPE_AGENT); }
__device__ __forceinline__ unsigned xb_add(unsigned* p, unsigned v) { return __hip_atomic_fetch_add(p, v, __ATOMIC_RELAXED, __HIP_MEMORY_SCOPE_AGENT); }
__device__ __forceinline__ unsigned xb_xcc_id() { return (unsigned)__builtin_amdgcn_s_getreg((3 << 11) | 20) & 0xFu; }
#define XB_SPIN(cond, bar) do { unsigned _sp = 0; while (cond) { __builtin_amdgcn_s_sleep(1); \
    if ((++_sp & 255u) == 0u) { if (xb_ld(&(bar)[XB_TMO])) break; if (_sp > XB_SPIN_CAP) { atomicAdd(&(bar)[XB_TMO], 1u); break; } } } } while (0)

struct XcdBarrier {
    unsigned* bar; unsigned x;
    volatile LAS unsigned* st;
};

__device__ __forceinline__ XcdBarrier xcd_barrier_post(unsigned* bar, volatile LAS unsigned* st) {
    XcdBarrier b; b.bar = bar; b.x = xb_xcc_id(); b.st = st;
    if (threadIdx.x == 0) (void)xb_add(&bar[XB_XCNT(b.x)], 1u);
    return b;
}
__device__ __forceinline__ void xcd_barrier_complete(unsigned* bar, unsigned x, unsigned& nloc, unsigned& nx) {
    const unsigned G = gridDim.x * gridDim.y * gridDim.z;
    unsigned sum, cnt, mine, sp = 0u;
    for (;;) {
        sum = 0u; cnt = 0u; mine = 0u;
#pragma unroll
        for (unsigned j = 0; j < 16; ++j) { const unsigned c = xb_ld(&bar[XB_XCNT(j)]); sum += c; cnt += (c > 0u) ? 1u : 0u; mine = (j == x) ? c : mine; }
        if (sum == G) break;
        __builtin_amdgcn_s_sleep(1);
        if ((++sp & 255u) == 0u) { if (xb_ld(&bar[XB_TMO])) break; if (sp > XB_SPIN_CAP) { atomicAdd(&bar[XB_TMO], 1u); break; } }
    }
    nloc = mine > 0u ? mine : 1u; nx = cnt > 0u ? cnt : 1u;
}

__device__ __forceinline__ void xcd_barrier(const XcdBarrier& b) {
    asm volatile("s_waitcnt vmcnt(0)" ::: "memory");
    __syncthreads();
    if (threadIdx.x == 0) {
        unsigned* bar = b.bar;
        __builtin_amdgcn_s_waitcnt(0);
        unsigned nloc = b.st[0], nx = b.st[1];
        if (nloc == 0u) { xcd_barrier_complete(bar, b.x, nloc, nx); b.st[0] = nloc; b.st[1] = nx; }
        const unsigned old = xb_add(&bar[XB_XSUB(b.x)], 1u);
        const unsigned gen = old / nloc;
        if (old + 1u == (gen + 1u) * nloc) {
            __builtin_amdgcn_fence(__ATOMIC_RELEASE, "agent");
            asm volatile("s_waitcnt vmcnt(0)" ::: "memory");
            const unsigned og = xb_add(&bar[XB_TOP], 1u);
            const unsigned tg = og / nx;
            if (og + 1u == (tg + 1u) * nx) xb_add(&bar[XB_TOPGEN], 1u);
            else XB_SPIN(xb_ld(&bar[XB_TOPGEN]) == tg, bar);
            __builtin_amdgcn_fence(__ATOMIC_ACQUIRE, "agent");
            xb_add(&bar[XB_XGEN(b.x)], 1u);
            asm volatile("s_waitcnt vmcnt(0)" ::: "memory");
        } else {
            XB_SPIN(xb_ld(&bar[XB_XGEN(b.x)]) == gen, bar);
            __builtin_amdgcn_fence(__ATOMIC_ACQUIRE, "agent");
            asm volatile("s_waitcnt vmcnt(0)" ::: "memory");
        }
    }
    __syncthreads();
}

constexpr int D = 2048, SEQ = 16384, M = 32768, DEPTH = 2;
constexpr int NCH = 256;
constexpr int NSEG = 16, CPS = NCH / NSEG;
constexpr int DIN = 8224;
constexpr float RMS_EPS = 1e-6f;
constexpr int NWAVES = 8;
constexpr int NPH = 15;

constexpr size_t MiB = 1u << 20;
constexpr size_t WS_CTL = 0, CTL_ZERO_BYTES = 1 * MiB;
constexpr size_t WS_WIN = 1 * MiB;
constexpr size_t WS_WUPG = 34 * MiB;
constexpr size_t WS_WUPP = 38 * MiB;
constexpr size_t WS_WOUT = 42 * MiB;
constexpr size_t WS_WQ = 50 * MiB;
constexpr size_t WS_POOLW = 58 * MiB;
constexpr size_t WS_SUBK = 58 * MiB + 512 * 1024;
constexpr size_t WS_USC = 59 * MiB, WS_VSC = 59 * MiB + 512 * 1024;
constexpr size_t WS_UTAB = 60 * MiB, WS_VTAB = 124 * MiB;
constexpr size_t WS_H = 188 * MiB;
constexpr size_t WS_POOLED = WS_H, WS_POOLMIX = WS_H + 64 * MiB, WS_SEGL = WS_H + 64 * MiB, WS_SIN = WS_H + 96 * MiB;
constexpr size_t WS_QK = 316 * MiB;
constexpr size_t WS_P = 380 * MiB;
constexpr size_t WS_VT = 444 * MiB;
constexpr size_t WS_R = 508 * MiB;
constexpr size_t WS_MERGED = WS_VT;
constexpr size_t WS_G = 572 * MiB;
constexpr size_t WS_PQ = WS_G, WS_IDX = 700 * MiB, WS_GATE = 716 * MiB;
constexpr size_t WS_AFB = 828 * MiB;
constexpr size_t WS_QE = 832 * MiB;
constexpr size_t WS_GLAOUT = WS_QE;
constexpr size_t WS_KDT = 896 * MiB;
constexpr size_t WS_ATTN = 960 * MiB;
constexpr size_t WS_DEC = 992 * MiB;
constexpr size_t WS_SSP1 = 994 * MiB, WS_SSP2 = 998 * MiB;
constexpr size_t WS_END = 1000 * MiB;
constexpr int CW_BAR = 4096;

constexpr int RING_BYTES = 131072;
constexpr int LDSCTL_OFF = RING_BYTES, MISC_OFF = LDSCTL_OFF + 320;
constexpr int LDS_BYTES = 147456;

typedef unsigned v2u __attribute__((ext_vector_type(2)));
typedef float f32x2 __attribute__((ext_vector_type(2)));
typedef float f32x16 __attribute__((ext_vector_type(16)));
using pg8::pkbf; using pg8::bflo; using pg8::bfhi;
__device__ __forceinline__ float bf2f(bf16 h) { return __builtin_bit_cast(float, (unsigned)h << 16); }
__device__ __forceinline__ bf16 f2bf1(float f) { return (bf16)(pkbf(f, 0.f) & 0xffffu); }
__device__ __forceinline__ float wave_sum(float v) {
#pragma unroll
    for (int o = 1; o < 64; o <<= 1) v += __shfl_xor(v, o);
    return v;
}
__device__ __forceinline__ float wave_max(float v) {
#pragma unroll
    for (int o = 1; o < 64; o <<= 1) v = fmaxf(v, __shfl_xor(v, o));
    return v;
}
__device__ __forceinline__ f32x16 mfma32(bf16x8 a, bf16x8 b, f32x16 c) { return __builtin_amdgcn_mfma_f32_32x32x16_bf16(a, b, c, 0, 0, 0); }
__device__ __forceinline__ bf16x8 mk8(unsigned a, unsigned b, unsigned c, unsigned d) { v4u t = {a, b, c, d}; return __builtin_bit_cast(bf16x8, t); }

#define LDS_BAR() do { asm volatile("s_waitcnt lgkmcnt(0)" ::: "memory"); __builtin_amdgcn_s_barrier(); asm volatile("" ::: "memory"); } while (0)
__device__ __forceinline__ void transpose_item(const float* __restrict__ W, int N, bf16* WT, int ldt, int dst_row0, int k0, int n0, LAS float* scr, int lane, const float* __restrict__ gk = nullptr) {
#pragma unroll
    for (int i = 0; i < 8; ++i) { const int kk = 8 * i + (lane >> 3), c4 = 4 * (lane & 7); f32x4 v = *(const f32x4*)(W + (size_t)(k0 + kk) * N + n0 + c4);
        if (gk) v = v * gk[k0 + kk];
        LAS float* d = scr + kk * 33 + c4; d[0] = v.x; d[1] = v.y; d[2] = v.z; d[3] = v.w; }
    LDS_WAIT(); asm volatile("" ::: "memory");
    const int c = lane & 7;
#pragma unroll
    for (int j = 0; j < 4; ++j) { const int n = (lane >> 3) + 8 * j; const LAS float* s = scr + (8 * c) * 33 + n;
        v4u o; o.x = pkbf(s[0 * 33], s[1 * 33]); o.y = pkbf(s[2 * 33], s[3 * 33]); o.z = pkbf(s[4 * 33], s[5 * 33]); o.w = pkbf(s[6 * 33], s[7 * 33]);
        *(GAS v4u*)(WT + (size_t)(dst_row0 + n) * ldt + k0 + 8 * c) = o; }
    LDS_WAIT(); asm volatile("" ::: "memory");
}
__device__ __forceinline__ void transpose_matrix(const float* W, int K, int N, bf16* WT, LAS float* scr, int lane, int gw, int NGW) {
    const int nblk = N / 32, items = (K / 64) * nblk;
    for (int it = gw; it < items; it += NGW) { const int kb = it / nblk, nb = it % nblk; transpose_item(W, N, WT, K, nb * 32, kb * 64, nb * 32, scr, lane); }
}
__device__ __forceinline__ void table_rows_fp8(const float* __restrict__ T, unsigned* __restrict__ O, float* __restrict__ inv, int rowA, int rowB, int lane, const float* __restrict__ gc = nullptr) {
    const f32x4* sa = (const f32x4*)(T + (size_t)rowA * 2048) + lane; const f32x4* sb = (const f32x4*)(T + (size_t)rowB * 2048) + lane;
    f32x4 va[8], vb[8]; float ama = 0.f, amb = 0.f;
#pragma unroll
    for (int j = 0; j < 8; ++j) { va[j] = sa[64 * j]; vb[j] = sb[64 * j]; }
    if (gc) {
#pragma unroll
        for (int j = 0; j < 8; ++j) { const f32x4 gq = ((const f32x4*)gc)[64 * j + lane]; va[j] = va[j] * gq; vb[j] = vb[j] * gq; } }
#pragma unroll
    for (int j = 0; j < 8; ++j) { ama = fmaxf(ama, fmaxf(fmaxf(fabsf(va[j].x), fabsf(va[j].y)), fmaxf(fabsf(va[j].z), fabsf(va[j].w)))); amb = fmaxf(amb, fmaxf(fmaxf(fabsf(vb[j].x), fabsf(vb[j].y)), fmaxf(fabsf(vb[j].z), fabsf(vb[j].w)))); }
#pragma unroll
    for (int o = 1; o < 64; o <<= 1) { ama = fmaxf(ama, __shfl_xor(ama, o)); amb = fmaxf(amb, __shfl_xor(amb, o)); }
    float ea = (ama > 1e-30f) ? floorf(__log2f(224.f / ama)) : 0.f; ea = fminf(fmaxf(ea, -60.f), 60.f);
    float eb = (amb > 1e-30f) ? floorf(__log2f(224.f / amb)) : 0.f; eb = fminf(fmaxf(eb, -60.f), 60.f);
    const float sca = exp2f(ea), scb = exp2f(eb);
#pragma unroll
    for (int j = 0; j < 8; ++j) { const int dw = 64 * j + lane; int w = 0;
        w = __builtin_amdgcn_cvt_pk_fp8_f32(va[j].x * sca, va[j].y * sca, w, false); w = __builtin_amdgcn_cvt_pk_fp8_f32(va[j].z * sca, va[j].w * sca, w, true);
        O[((size_t)(dw >> 5) * 16384 + rowA) * 32 + (dw & 31)] = (unsigned)w; w = 0;
        w = __builtin_amdgcn_cvt_pk_fp8_f32(vb[j].x * scb, vb[j].y * scb, w, false); w = __builtin_amdgcn_cvt_pk_fp8_f32(vb[j].z * scb, vb[j].w * scb, w, true);
        O[((size_t)(dw >> 5) * 16384 + rowB) * 32 + (dw & 31)] = (unsigned)w; }
    if (lane == 0) { inv[rowA] = exp2f(-ea); inv[rowB] = exp2f(-eb); }
}
__device__ __forceinline__ void rmsnorm_row(const float* xrow, const float* __restrict__ g, bf16* orow, int lane) {
    const f32x4* xr = (const f32x4*)xrow + lane; const f32x4* gr = (const f32x4*)g + lane;
    f32x4 v[8]; float s = 0.f;
#pragma unroll
    for (int j = 0; j < 8; ++j) { v[j] = xr[64 * j]; s += (v[j].x * v[j].x + v[j].y * v[j].y) + (v[j].z * v[j].z + v[j].w * v[j].w); }
    const float rs = rsqrtf(wave_sum(s) * (1.f / 2048.f) + RMS_EPS);
    v2u* o8 = (v2u*)orow + lane;
#pragma unroll
    for (int j = 0; j < 8; ++j) { const f32x4 gg = gr[64 * j]; v2u o; o.x = pkbf(v[j].x * rs * gg.x, v[j].y * rs * gg.y); o.y = pkbf(v[j].z * rs * gg.z, v[j].w * rs * gg.w); o8[64 * j] = o; }
}

constexpr int PA_A = 0, PA_QT = 4096, PA_Q = 8192, PA_K = PA_Q + 17408, PA_KE = PA_K + 17408, PA_BYTES = PA_KE + 17408;
static_assert(2 * PA_BYTES <= RING_BYTES, "prep LDS");
struct PrepIn { f32x4 a; unsigned q[8], k[8]; float wg[2][16]; float bias[2]; };
__device__ __forceinline__ void gla_prep_load(PrepIn& in, int uid, const bf16* __restrict__ QK, const float* __restrict__ AFB, const float* __restrict__ Wgf, const float* __restrict__ Bgf,
                                              const float* __restrict__ Wgb, const float* __restrict__ Bgb, int tid) {
    const int dir = uid & 1, h = (uid >> 1) & 3, bn = uid >> 3; const size_t row0 = (size_t)bn * 64;
    const float* Wg = dir ? Wgb : Wgf; const float* Bg = dir ? Bgb : Bgf;
    { const int t = (tid & 255) >> 2, q4 = tid & 3; in.a = *(const f32x4*)(AFB + (row0 + t) * 32 + dir * 16 + 4 * q4); }
    const int c2 = tid & 63, tq = tid >> 6;
#pragma unroll
    for (int j = 0; j < 8; ++j) { const bf16* src = QK + (row0 + tq * 8 + j) * 1024 + h * 128 + 2 * c2; in.q[j] = *(const unsigned*)src; in.k[j] = *(const unsigned*)(src + 512); }
#pragma unroll
    for (int r = 0; r < 16; ++r) { const f32x2 w2 = *(const f32x2*)(Wg + r * 512 + h * 128 + 2 * c2); in.wg[0][r] = w2.x; in.wg[1][r] = w2.y; }
    { const f32x2 b2 = *(const f32x2*)(Bg + h * 128 + 2 * c2); in.bias[0] = b2.x; in.bias[1] = b2.y; }
}
__device__ __forceinline__ void gla_prep_unit(int uid, int uid_next, PrepIn& in, LAS unsigned char* lds, const bf16* __restrict__ QK, const float* __restrict__ AFB, const float* __restrict__ Wgf, const float* __restrict__ Bgf,
                                              const float* __restrict__ Wgb, const float* __restrict__ Bgb, bf16* QE, bf16* KDT, bf16* ATTN, float* DEC, int tid, int wave, int lane) {
    const int dir = uid & 1;
    LAS float* aS = (LAS float*)(lds + PA_A); LAS float* qtot = (LAS float*)(lds + PA_QT);
    LAS bf16* qS = (LAS bf16*)(lds + PA_Q); LAS bf16* kS = (LAS bf16*)(lds + PA_K); LAS bf16* keS = (LAS bf16*)(lds + PA_KE);
    if (tid < 256) { const int t = tid >> 2, q4 = tid & 3; *(LAS f32x4*)(aS + t * 16 + 4 * q4) = in.a; }
    const int c2 = tid & 63, tq = tid >> 6;
    unsigned qv[8], kv[8]; float wg0[16], wg1[16];
#pragma unroll
    for (int j = 0; j < 8; ++j) { qv[j] = in.q[j]; kv[j] = in.k[j]; }
#pragma unroll
    for (int r = 0; r < 16; ++r) { wg0[r] = in.wg[0][r]; wg1[r] = in.wg[1][r]; }
    const float bias0 = in.bias[0], bias1 = in.bias[1];
    gla_prep_load(in, uid_next, QK, AFB, Wgf, Bgf, Wgb, Bgb, tid);
    LDS_BAR();
    float lg0[8], lg1[8], P0[8], P1[8]; float run0 = 0.f, run1 = 0.f;
#pragma unroll
    for (int j = 0; j < 8; ++j) { const int t = tq * 8 + j;
        const f32x4 a0 = *(const LAS f32x4*)(aS + t * 16), a1 = *(const LAS f32x4*)(aS + t * 16 + 4), a2 = *(const LAS f32x4*)(aS + t * 16 + 8), a3 = *(const LAS f32x4*)(aS + t * 16 + 12);
        f32x2 z2 = {bias0, bias1};
        const float av[16] = {a0.x, a0.y, a0.z, a0.w, a1.x, a1.y, a1.z, a1.w, a2.x, a2.y, a2.z, a2.w, a3.x, a3.y, a3.z, a3.w};
#pragma unroll
        for (int r2 = 0; r2 < 16; ++r2) z2 = __builtin_elementwise_fma((f32x2){av[r2], av[r2]}, (f32x2){wg0[r2], wg1[r2]}, z2);
        const float z0 = z2.x, z1 = z2.y;
        lg0[j] = (fminf(z0, 0.f) - __logf(1.f + __expf(-fabsf(z0)))) * (1.f / 16.f); lg1[j] = (fminf(z1, 0.f) - __logf(1.f + __expf(-fabsf(z1)))) * (1.f / 16.f);
        run0 += lg0[j]; run1 += lg1[j]; P0[j] = run0; P1[j] = run1; }
    *(LAS f32x2*)(qtot + tq * 128 + 2 * c2) = (f32x2){run0, run1};
    LDS_BAR();
    float btot0 = 0.f, btot1 = 0.f, off0 = 0.f, off1 = 0.f;
#pragma unroll
    for (int g8 = 0; g8 < 8; ++g8) { const f32x2 v = *(const LAS f32x2*)(qtot + g8 * 128 + 2 * c2); btot0 += v.x; btot1 += v.y;
        const bool before = dir ? (g8 > tq) : (g8 < tq); off0 += before ? v.x : 0.f; off1 += before ? v.y : 0.f; }
    const float dt0 = __expf(btot0), dt1 = __expf(btot1);
    if (tq == 0) *(f32x2*)(DEC + (size_t)uid * 128 + 2 * c2) = (f32x2){dt0, dt1};
#pragma unroll
    for (int j = 0; j < 8; ++j) { const int t = tq * 8 + j;
        const float b0 = (dir ? (run0 - P0[j] + lg0[j]) : P0[j]) + off0, b1 = (dir ? (run1 - P1[j] + lg1[j]) : P1[j]) + off1;
        const float q0 = bflo(qv[j]), q1 = bfhi(qv[j]), k0 = bflo(kv[j]), k1 = bfhi(kv[j]);
        const float e0 = __expf(b0), e1 = __expf(b1), i0 = __builtin_amdgcn_rcpf(e0), i1 = __builtin_amdgcn_rcpf(e1);
        *(LAS unsigned*)(qS + t * 136 + 2 * c2) = pkbf(q0 * e0, q1 * e1);
        *(LAS unsigned*)(keS + t * 136 + 2 * c2) = pkbf(k0 * i0, k1 * i1);
        *(LAS unsigned*)(kS + t * 136 + 2 * c2) = pkbf(k0 * (dt0 * i0), k1 * (dt1 * i1)); }
    LDS_BAR();
    const int r = lane & 31, hh = lane >> 5;
    if (wave < 4) {
        const int jt = wave >> 1, it = wave & 1;
        f32x16 acc;
#pragma unroll
        for (int e = 0; e < 16; ++e) acc[e] = 0.f;
#pragma unroll
        for (int s = 0; s < 8; ++s) { const bf16x8 A = *(const LAS bf16x8*)(keS + (32 * jt + r) * 136 + 16 * s + 8 * hh); const bf16x8 B = *(const LAS bf16x8*)(qS + (32 * it + r) * 136 + 16 * s + 8 * hh); acc = mfma32(A, B, acc); }
        const int i = 32 * it + r; float v[16];
#pragma unroll
        for (int e = 0; e < 16; ++e) { const int j = 32 * jt + (e & 3) + 8 * (e >> 2) + 4 * hh; const bool keep = dir ? (j > i) : (j <= i); v[e] = keep ? acc[e] : 0.f; }
#pragma unroll
        for (int s2 = 0; s2 < 2; ++s2) { v4u o; o.x = pkbf(v[8 * s2 + 0], v[8 * s2 + 1]); o.y = pkbf(v[8 * s2 + 2], v[8 * s2 + 3]); o.z = pkbf(v[8 * s2 + 4], v[8 * s2 + 5]); o.w = pkbf(v[8 * s2 + 6], v[8 * s2 + 7]);
            *(v4u*)(ATTN + (size_t)uid * 4096 + (size_t)((it * 4 + 2 * jt + s2) * 64 + lane) * 8) = o; }
    }
#pragma unroll
    for (int e = 0; e < 2; ++e) { const int f = wave * 2 + e;
        {
            const int it = f >> 3, ks = f & 7, dt = ks >> 1, s2 = ks & 1;
            const LAS bf16* base = qS + (32 * it + r) * 136 + 32 * dt + 16 * s2 + 4 * hh;
            const v2u lo = *(const LAS v2u*)base, hi = *(const LAS v2u*)(base + 8);
            v4u o = {lo.x, lo.y, hi.x, hi.y};
            *(v4u*)(QE + (size_t)uid * 8192 + (size_t)(f * 64 + lane) * 8) = o; }
        {
            const int dt = f >> 2, ks = f & 3, dim = 32 * dt + r;
            unsigned w[4];
#pragma unroll
            for (int p2 = 0; p2 < 4; ++p2) { const int j0 = 2 * p2, j1 = 2 * p2 + 1;
                const int t0 = 16 * ks + 8 * (j0 >> 2) + 4 * hh + (j0 & 3), t1 = 16 * ks + 8 * (j1 >> 2) + 4 * hh + (j1 & 3);
                w[p2] = (unsigned)kS[t0 * 136 + dim] | ((unsigned)kS[t1 * 136 + dim] << 16); }
            v4u o = {w[0], w[1], w[2], w[3]};
            *(v4u*)(KDT + (size_t)uid * 8192 + (size_t)(f * 64 + lane) * 8) = o; }
    }
}

__device__ __forceinline__ void pool_item(int item, const bf16* __restrict__ P, bf16* __restrict__ PO) {
    const int oct = item & 127, run = item >> 7; const int m0 = run * 32, b = m0 >> 14, t0 = m0 & (SEQ - 1);
    const int g = oct >> 5, hw = 1 << g;
    const bf16* Pb = P + (size_t)b * SEQ * 1024 + oct * 8; bf16* Ob = PO + (size_t)b * SEQ * 1024 + oct * 8;
    float s[8];
#pragma unroll
    for (int e = 0; e < 8; ++e) s[e] = 0.f;
    const int lo0 = (t0 - hw > 0) ? t0 - hw : 0, hi0 = (t0 + hw < SEQ) ? t0 + hw : SEQ;
    for (int u = lo0; u < hi0; ++u) { const v4u w = *(const v4u*)(Pb + (size_t)u * 1024);
        s[0] += bflo(w.x); s[1] += bfhi(w.x); s[2] += bflo(w.y); s[3] += bfhi(w.y); s[4] += bflo(w.z); s[5] += bfhi(w.z); s[6] += bflo(w.w); s[7] += bfhi(w.w); }
    for (int t = t0; t < t0 + 32; ++t) {
        const int lo = (t - hw > 0) ? t - hw : 0, hi = (t + hw < SEQ) ? t + hw : SEQ; const float ic = 1.f / (float)(hi - lo);
        const v4u w = *(const v4u*)(Pb + (size_t)t * 1024);
        v4u o; o.x = pkbf(s[0] * ic - bflo(w.x), s[1] * ic - bfhi(w.x)); o.y = pkbf(s[2] * ic - bflo(w.y), s[3] * ic - bfhi(w.y));
        o.z = pkbf(s[4] * ic - bflo(w.z), s[5] * ic - bfhi(w.z)); o.w = pkbf(s[6] * ic - bflo(w.w), s[7] * ic - bfhi(w.w));
        *(v4u*)(Ob + (size_t)t * 1024) = o;
        if (t - hw >= 0) { const v4u x = *(const v4u*)(Pb + (size_t)(t - hw) * 1024);
            s[0] -= bflo(x.x); s[1] -= bfhi(x.x); s[2] -= bflo(x.y); s[3] -= bfhi(x.y); s[4] -= bflo(x.z); s[5] -= bfhi(x.z); s[6] -= bflo(x.w); s[7] -= bfhi(x.w); }
        if (t + hw < SEQ) { const v4u x = *(const v4u*)(Pb + (size_t)(t + hw) * 1024);
            s[0] += bflo(x.x); s[1] += bfhi(x.x); s[2] += bflo(x.y); s[3] += bfhi(x.y); s[4] += bflo(x.z); s[5] += bfhi(x.z); s[6] += bflo(x.w); s[7] += bfhi(x.w); }
    }
}

constexpr int SB_QE = 0, SB_AT = 16384, SB_KD = 24576, SB_DEC = 40960, SB_BYTES = 41472;
template <bool FULL> __device__ __forceinline__ void gla_scan_block(int su, LAS unsigned char* lds, const bf16* __restrict__ QE, const bf16* __restrict__ ATTN, const bf16* __restrict__ KDT,
                                                                    const float* __restrict__ DEC, const bf16* __restrict__ VT, float* SEGL, float* SEGD, bf16* OF, bf16* OB,
                                                                    int tid, int wave, int lane) {
    const int bhd = su / NSEG, seg = su % NSEG, dir = bhd & 1, h = (bhd >> 1) & 3, b = bhd >> 3;
    const int r = lane & 31, hh = lane >> 5, w = wave;
    f32x16 st[4];
    if (FULL) {
#pragma unroll
        for (int dt = 0; dt < 4; ++dt)
#pragma unroll
            for (int e = 0; e < 16; ++e) st[dt][e] = 0.f;
        for (int sp = 0; sp < seg; ++sp) { const int su2 = bhd * NSEG + sp;
#pragma unroll
            for (int dt = 0; dt < 4; ++dt) {
#pragma unroll
                for (int q = 0; q < 4; ++q) { const f32x4 d4 = *(const f32x4*)(SEGD + (size_t)su2 * 128 + 32 * dt + 8 * q + 4 * hh);
                    const size_t i0 = ((size_t)((su2 * 8 + w) * 4 + dt) * 16 + 4 * q) * 64 + lane;
                    st[dt][4 * q + 0] = d4.x * st[dt][4 * q + 0] + SEGL[i0]; st[dt][4 * q + 1] = d4.y * st[dt][4 * q + 1] + SEGL[i0 + 64];
                    st[dt][4 * q + 2] = d4.z * st[dt][4 * q + 2] + SEGL[i0 + 128]; st[dt][4 * q + 3] = d4.w * st[dt][4 * q + 3] + SEGL[i0 + 192]; } } }
    } else {
#pragma unroll
        for (int dt = 0; dt < 4; ++dt)
#pragma unroll
            for (int e = 0; e < 16; ++e) st[dt][e] = 0.f;
    }
    v4u sg[5]; v4u sdec; v2u vn[8]; bf16x8 vc[4];
#define SCAN_UID(i_) ({ const int sp_ = seg * CPS + (i_); const int n_ = dir ? (NCH - 1 - sp_) : sp_; (((b * NCH + n_) * 4 + h) * 2 + dir); })
#define SCAN_LOAD(i_) do { const int uid_ = SCAN_UID(i_); \
        if (FULL) { sg[0] = *(const v4u*)(QE + (size_t)uid_ * 8192 + (size_t)tid * 8); sg[1] = *(const v4u*)(QE + (size_t)uid_ * 8192 + (size_t)(tid + 512) * 8); \
                    sg[2] = *(const v4u*)(ATTN + (size_t)uid_ * 4096 + (size_t)tid * 8); } \
        sg[3] = *(const v4u*)(KDT + (size_t)uid_ * 8192 + (size_t)tid * 8); sg[4] = *(const v4u*)(KDT + (size_t)uid_ * 8192 + (size_t)(tid + 512) * 8); \
        if (tid < 32) sdec = *(const v4u*)(DEC + (size_t)uid_ * 128 + tid * 4); \
        const bf16* vb_ = VT + ((size_t)(uid_ >> 3) * 1024 + h * 256 + 32 * w + r) * 64 + 4 * hh; \
        _Pragma("unroll") for (int ks_ = 0; ks_ < 4; ++ks_) { vn[2 * ks_] = *(const v2u*)(vb_ + 16 * ks_); vn[2 * ks_ + 1] = *(const v2u*)(vb_ + 16 * ks_ + 8); } } while (0)
#define SCAN_STORE(buf_) do { LAS unsigned char* B_ = lds + (buf_) * SB_BYTES; \
        if (FULL) { *(LAS v4u*)(B_ + SB_QE + tid * 16) = sg[0]; *(LAS v4u*)(B_ + SB_QE + (tid + 512) * 16) = sg[1]; *(LAS v4u*)(B_ + SB_AT + tid * 16) = sg[2]; } \
        *(LAS v4u*)(B_ + SB_KD + tid * 16) = sg[3]; *(LAS v4u*)(B_ + SB_KD + (tid + 512) * 16) = sg[4]; \
        if (tid < 32) *(LAS v4u*)(B_ + SB_DEC + tid * 16) = sdec; \
        _Pragma("unroll") for (int ks_ = 0; ks_ < 4; ++ks_) vc[ks_] = mk8(vn[2 * ks_].x, vn[2 * ks_].y, vn[2 * ks_ + 1].x, vn[2 * ks_ + 1].y); } while (0)
    float dprod = 1.f;
    LDS_BAR();
    SCAN_LOAD(0); SCAN_STORE(0);
    LDS_BAR();
    for (int i = 0; i < CPS; ++i) {
        const bool more = (i + 1 < CPS);
        if (more) SCAN_LOAD(i + 1);
        const LAS unsigned char* B = lds + (i & 1) * SB_BYTES;
        if (FULL) {
            f32x16 o0, o1;
#pragma unroll
            for (int e = 0; e < 16; ++e) { o0[e] = 0.f; o1[e] = 0.f; }
#pragma unroll
            for (int dt = 0; dt < 4; ++dt)
#pragma unroll
                for (int s2 = 0; s2 < 2; ++s2) { const int ks = 2 * dt + s2;
                    const bf16x8 sf = mk8(pkbf(st[dt][8 * s2 + 0], st[dt][8 * s2 + 1]), pkbf(st[dt][8 * s2 + 2], st[dt][8 * s2 + 3]), pkbf(st[dt][8 * s2 + 4], st[dt][8 * s2 + 5]), pkbf(st[dt][8 * s2 + 6], st[dt][8 * s2 + 7]));
                    const bf16x8 a0 = *(const LAS bf16x8*)(B + SB_QE + ((0 * 8 + ks) * 64 + lane) * 16); const bf16x8 a1 = *(const LAS bf16x8*)(B + SB_QE + ((1 * 8 + ks) * 64 + lane) * 16);
                    o0 = mfma32(a0, sf, o0); o1 = mfma32(a1, sf, o1); }
#pragma unroll
            for (int ks = 0; ks < 4; ++ks) { const bf16x8 a0 = *(const LAS bf16x8*)(B + SB_AT + ((0 * 4 + ks) * 64 + lane) * 16); const bf16x8 a1 = *(const LAS bf16x8*)(B + SB_AT + ((1 * 4 + ks) * 64 + lane) * 16);
                o0 = mfma32(a0, vc[ks], o0); o1 = mfma32(a1, vc[ks], o1); }
            const int uid = SCAN_UID(i);
            bf16* Ob = (dir ? OB : OF) + (size_t)(uid >> 3) * 64 * 1024 + h * 256 + 32 * w + r;
#pragma unroll
            for (int e = 0; e < 16; ++e) { const int tk = (e & 3) + 8 * (e >> 2) + 4 * hh; Ob[(size_t)tk * 1024] = f2bf1(o0[e]); Ob[(size_t)(32 + tk) * 1024] = f2bf1(o1[e]); }
        }
#pragma unroll
        for (int dt = 0; dt < 4; ++dt) {
#pragma unroll
            for (int q = 0; q < 4; ++q) { const f32x4 d4 = *(const LAS f32x4*)(B + SB_DEC + (32 * dt + 8 * q + 4 * hh) * 4);
                st[dt][4 * q + 0] *= d4.x; st[dt][4 * q + 1] *= d4.y; st[dt][4 * q + 2] *= d4.z; st[dt][4 * q + 3] *= d4.w; }
#pragma unroll
            for (int ks = 0; ks < 4; ++ks) { const bf16x8 a = *(const LAS bf16x8*)(B + SB_KD + ((dt * 4 + ks) * 64 + lane) * 16); st[dt] = mfma32(a, vc[ks], st[dt]); }
        }
        if (!FULL && tid < 128) dprod *= *(const LAS float*)(B + SB_DEC + tid * 4);
        if (more) SCAN_STORE((i + 1) & 1);
        LDS_BAR();
    }
    if (!FULL) {
#pragma unroll
        for (int dt = 0; dt < 4; ++dt)
#pragma unroll
            for (int e = 0; e < 16; ++e) SEGL[((size_t)((su * 8 + w) * 4 + dt) * 16 + e) * 64 + lane] = st[dt][e];
        if (tid < 128) SEGD[(size_t)su * 128 + tid] = dprod;
    }
#undef SCAN_UID
#undef SCAN_LOAD
#undef SCAN_STORE
}
struct FinIn { v4u f0, f1, b0, b1, r0, r1; };
__device__ __forceinline__ void gla_fin_load(FinIn& in, int m, const bf16* __restrict__ OF, const bf16* __restrict__ OB, const bf16* __restrict__ R, int lane) {
    const size_t p = (size_t)m * 1024 + 16 * lane;
    in.f0 = *(const v4u*)(OF + p); in.f1 = *(const v4u*)(OF + p + 8); in.b0 = *(const v4u*)(OB + p); in.b1 = *(const v4u*)(OB + p + 8); in.r0 = *(const v4u*)(R + p); in.r1 = *(const v4u*)(R + p + 8);
}
__device__ __forceinline__ void gla_fin_row(const FinIn& in, int m, const float (&gg)[16], bf16* GO, int lane) {
    const size_t p = (size_t)m * 1024 + 16 * lane;
    const v4u f0 = in.f0, f1 = in.f1, b0 = in.b0, b1 = in.b1, r0 = in.r0, r1 = in.r1;
    float o[16], rr[16];
#define UNP(dst, w0, w1) do { dst[0] = bflo(w0.x); dst[1] = bfhi(w0.x); dst[2] = bflo(w0.y); dst[3] = bfhi(w0.y); dst[4] = bflo(w0.z); dst[5] = bfhi(w0.z); dst[6] = bflo(w0.w); dst[7] = bfhi(w0.w); \
        dst[8] = bflo(w1.x); dst[9] = bfhi(w1.x); dst[10] = bflo(w1.y); dst[11] = bfhi(w1.y); dst[12] = bflo(w1.z); dst[13] = bfhi(w1.z); dst[14] = bflo(w1.w); dst[15] = bfhi(w1.w); } while (0)
    float t[16]; UNP(o, f0, f1); UNP(t, b0, b1); UNP(rr, r0, r1);
#undef UNP
    float ss = 0.f;
#pragma unroll
    for (int e = 0; e < 16; ++e) { o[e] += t[e]; ss += o[e] * o[e]; }
    ss += __shfl_xor(ss, 1); ss += __shfl_xor(ss, 2); ss += __shfl_xor(ss, 4); ss += __shfl_xor(ss, 8);
    const float rs = rsqrtf(ss * (1.f / 256.f) + RMS_EPS);
    unsigned w[8];
#pragma unroll
    for (int e = 0; e < 8; ++e) w[e] = pkbf(o[2 * e] * rs * gg[2 * e] * rr[2 * e], o[2 * e + 1] * rs * gg[2 * e + 1] * rr[2 * e + 1]);
    v4u o0 = {w[0], w[1], w[2], w[3]}, o1 = {w[4], w[5], w[6], w[7]};
    *(v4u*)(GO + p) = o0; *(v4u*)(GO + p + 8) = o1;
}
__device__ __forceinline__ unsigned sortable(float f) { const unsigned b = __builtin_bit_cast(unsigned, f); return b ^ ((unsigned)((int)b >> 31) | 0x80000000u); }
__device__ __forceinline__ float unsortable(unsigned u) { const unsigned b = (u & 0x80000000u) ? (u ^ 0x80000000u) : ~u; return __builtin_bit_cast(float, b); }
__device__ __forceinline__ unsigned umax3(unsigned a, unsigned b, unsigned c) { return max(max(a, b), c); }
__device__ __forceinline__ void ce_desc(unsigned& a, unsigned& b) { const unsigned hi = max(a, b), lo = min(a, b); a = hi; b = lo; }
__device__ __forceinline__ void bitonic_sort16_desc(unsigned (&x)[16]) {
#pragma unroll
    for (int k = 2; k <= 16; k <<= 1)
#pragma unroll
        for (int j = k >> 1; j > 0; j >>= 1)
#pragma unroll
            for (int i = 0; i < 16; ++i) { const int l = i ^ j; if (l > i) { if ((i & k) == 0) ce_desc(x[i], x[l]); else ce_desc(x[l], x[i]); } }
}
__device__ __forceinline__ void bitonic_merge16_desc(unsigned (&x)[16]) {
#pragma unroll
    for (int j = 8; j > 0; j >>= 1)
#pragma unroll
        for (int i = 0; i < 16; ++i) { const int l = i ^ j; if (l > i) ce_desc(x[i], x[l]); }
}
__device__ __forceinline__ void topmerge16(unsigned (&a)[16], const unsigned (&b)[16]) {
#pragma unroll
    for (int i = 0; i < 16; ++i) a[i] = max(a[i], b[15 - i]);
    bitonic_merge16_desc(a);
}
__device__ __forceinline__ void peer_half_topk(int p, int h, const LAS unsigned char* sk, const bf16* __restrict__ PQ, size_t tok, int lane, unsigned (&Lp)[16]) {
    const int hh = lane >> 5;
    const bf16* qp = PQ + tok * 2048 + h * 256 + p * 128 + 8 * hh;
    bf16x8 bq[8];
#pragma unroll
    for (int s = 0; s < 8; ++s) bq[s] = *(const bf16x8*)(qp + 16 * s);
    unsigned key[64];
#pragma unroll
    for (int nt = 0; nt < 4; ++nt) { f32x16 sc;
#pragma unroll
        for (int e = 0; e < 16; ++e) sc[e] = 0.f;
#pragma unroll
        for (int s = 0; s < 8; ++s) { const bf16x8 a = *(const LAS bf16x8*)(sk + (((p * 4 + nt) * 8 + s) * 64 + lane) * 16); sc = mfma32(a, bq[s], sc); }
#pragma unroll
        for (int e = 0; e < 16; ++e) { const int n = 32 * nt + (e & 3) + 8 * (e >> 2) + 4 * hh; key[nt * 16 + e] = (sortable(sc[e]) & ~127u) | (unsigned)(127 - n); } }
    unsigned g0[16], g1[16], g2[16], g3[16];
#pragma unroll
    for (int e = 0; e < 16; ++e) { g0[e] = key[e]; g1[e] = key[16 + e]; g2[e] = key[32 + e]; g3[e] = key[48 + e]; }
    bitonic_sort16_desc(g0); bitonic_sort16_desc(g1); bitonic_sort16_desc(g2); bitonic_sort16_desc(g3);
    topmerge16(g0, g1); topmerge16(g2, g3); topmerge16(g0, g2);
#pragma unroll
    for (int e = 0; e < 16; ++e) g1[e] = (unsigned)__shfl_xor((int)g0[e], 32);
    topmerge16(g0, g1);
#pragma unroll
    for (int e = 0; e < 16; ++e) Lp[e] = g0[e];
}
__device__ __forceinline__ void peer_topk_item(int tile, int h, const LAS unsigned char* sk  , const bf16* __restrict__ PQ, unsigned short* IDX, float* GATE, int lane) {
    const int r = lane & 31, hh = lane >> 5; const size_t tok = (size_t)tile * 32 + r;
    unsigned L[2][16];
    peer_half_topk(0, h, sk, PQ, tok, lane, L[0]);
    __builtin_amdgcn_sched_barrier(0);
#pragma unroll
    for (int a = 0; a < 16; ++a) asm volatile("" : "+v"(L[0][a]));
    peer_half_topk(1, h, sk, PQ, tok, lane, L[1]);
    __builtin_amdgcn_sched_barrier(0);
#pragma unroll
    for (int a = 0; a < 16; ++a) asm volatile("" : "+v"(L[1][a]));
    float v0[16], v1[16];
#pragma unroll
    for (int a = 0; a < 16; ++a) { v0[a] = unsortable(L[0][a] & ~127u); v1[a] = unsortable(L[1][a] & ~127u); }
#define CKEY(a_, b_) ((sortable(v0[a_] + v1[b_]) & ~255u) | (unsigned)(255 - ((a_) * 16 + (b_))))
    unsigned R[16], T[16];
#pragma unroll
    for (int b2 = 0; b2 < 16; ++b2) R[b2] = CKEY(0, b2);
#define ROWMERGE(a_, n_) do { _Pragma("unroll") for (int b2 = 0; b2 < 16; ++b2) T[b2] = (b2 < (n_)) ? CKEY(a_, (b2 < (n_) ? b2 : 0)) : 0u; topmerge16(R, T); } while (0)
    ROWMERGE(1, 8); ROWMERGE(2, 5); ROWMERGE(3, 4); ROWMERGE(4, 3); ROWMERGE(5, 2); ROWMERGE(6, 2); ROWMERGE(7, 2);
#pragma unroll
    for (int b2 = 0; b2 < 16; ++b2) T[b2] = (b2 < 8) ? CKEY((b2 < 8 ? 8 + b2 : 8), 0) : 0u;
    topmerge16(R, T);
#undef ROWMERGE
#undef CKEY
    unsigned bk[16];
#pragma unroll
    for (int rd = 0; rd < 16; ++rd) bk[rd] = R[rd];
    float gs[16]; unsigned ex[16]; float Z = 0.f; const float s0 = unsortable(bk[0] & ~255u);
#pragma unroll
    for (int k = 0; k < 16; ++k) { const unsigned flat = 255u - (bk[k] & 255u), a = flat >> 4, b2 = flat & 15u;
        unsigned k1 = 0u, k2 = 0u;
#pragma unroll
        for (int a2 = 0; a2 < 16; ++a2) { k1 = (a == (unsigned)a2) ? L[0][a2] : k1; k2 = (b2 == (unsigned)a2) ? L[1][a2] : k2; }
        ex[k] = (127u - (k1 & 127u)) * 128u + (127u - (k2 & 127u));
        gs[k] = __expf(unsortable(bk[k] & ~255u) - s0); Z += gs[k]; }
    const float iz = 1.f / Z;
    if (hh == 0) {
        unsigned short* ip = IDX + (tok * 8 + h) * 16; float* gp = GATE + (tok * 8 + h) * 16;
        v4u i0 = {ex[0] | (ex[1] << 16), ex[2] | (ex[3] << 16), ex[4] | (ex[5] << 16), ex[6] | (ex[7] << 16)}, i1 = {ex[8] | (ex[9] << 16), ex[10] | (ex[11] << 16), ex[12] | (ex[13] << 16), ex[14] | (ex[15] << 16)};
        *(v4u*)ip = i0; *(v4u*)(ip + 8) = i1;
#pragma unroll
        for (int q = 0; q < 4; ++q) { f32x4 o = {gs[4 * q] * iz, gs[4 * q + 1] * iz, gs[4 * q + 2] * iz, gs[4 * q + 3] * iz}; *(f32x4*)(gp + 4 * q) = o; }
    }
}

__device__ __forceinline__ f32x2 dot16_fp8(const v4u w, const f32x2* hv2, f32x2 s) {
#pragma unroll
    for (int d = 0; d < 4; ++d) { const f32x2 lo = __builtin_amdgcn_cvt_pk_f32_fp8((int)w[d], false), hi = __builtin_amdgcn_cvt_pk_f32_fp8((int)w[d], true);
        s = __builtin_elementwise_fma(lo, hv2[2 * d], s); s = __builtin_elementwise_fma(hi, hv2[2 * d + 1], s); }
    return s;
}
__device__ __forceinline__ void axpy16_fp8(const v4u w, const f32x2 a2, f32x2* acc2) {
#pragma unroll
    for (int d = 0; d < 4; ++d) { const f32x2 lo = __builtin_amdgcn_cvt_pk_f32_fp8((int)w[d], false), hi = __builtin_amdgcn_cvt_pk_f32_fp8((int)w[d], true);
        acc2[2 * d] = __builtin_elementwise_fma(lo, a2, acc2[2 * d]); acc2[2 * d + 1] = __builtin_elementwise_fma(hi, a2, acc2[2 * d + 1]); }
}
__device__ __forceinline__ float gelu_erf(float x) { return 0.5f * x * (1.f + erff(x * 0.70710678118654752f)); }
template <int CTRL> __device__ __forceinline__ float dppf(float v) { return __builtin_bit_cast(float, __builtin_amdgcn_update_dpp(0, __builtin_bit_cast(int, v), CTRL, 0xF, 0xF, true)); }
__device__ __forceinline__ float sum8(float v) { v += dppf<0xB1>(v); v += dppf<0x4E>(v); v += dppf<0x141>(v); return v; }
struct PMeta { v4u ia, ib, o0, o1, o2, o3; f32x2 x1; };
__device__ __forceinline__ void peer_meta(PMeta& m, size_t tok, const unsigned short* __restrict__ IDX, int g) {
    m.ia = *(const v4u*)(IDX + tok * 128 + g * 16); m.ib = *(const v4u*)(IDX + tok * 128 + g * 16 + 8);
}
template <bool VP> __device__ __forceinline__ void peer_issue(PMeta& m, v4u (&w)[16], const unsigned char* __restrict__ tb, size_t tok, int sl, const bf16* __restrict__ XB, const float* __restrict__ ACT, const float* X, int g, int i, int c) {
    const unsigned iw[8] = {m.ia.x, m.ia.y, m.ia.z, m.ia.w, m.ib.x, m.ib.y, m.ib.z, m.ib.w};
#pragma unroll
    for (int q = 0; q < 16; ++q) { const unsigned e = (iw[q >> 1] >> (16 * (q & 1))) & 0xffffu; w[q] = *(const v4u*)(tb + (size_t)e * 128); }
    if (VP) { const v4u* ap = (const v4u*)(ACT + tok * 128 + g * 16); m.o0 = ap[0]; m.o1 = ap[1]; m.o2 = ap[2]; m.o3 = ap[3]; m.x1 = *(const f32x2*)(X + tok * 2048 + c); }
    else { const bf16* hp = XB + tok * 2048 + sl * 128 + 16 * i; m.o0 = *(const v4u*)hp; m.o1 = *(const v4u*)(hp + 8); }
}
__device__ __forceinline__ void peer_u_compute(const PMeta& m, const v4u (&w)[16], size_t tok, int label, int sub, float* PART, int g, int i) {
    const v4u h0 = m.o0, h1 = m.o1;
    const f32x2 hv2[8] = {{bflo(h0.x), bfhi(h0.x)}, {bflo(h0.y), bfhi(h0.y)}, {bflo(h0.z), bfhi(h0.z)}, {bflo(h0.w), bfhi(h0.w)}, {bflo(h1.x), bfhi(h1.x)}, {bflo(h1.y), bfhi(h1.y)}, {bflo(h1.z), bfhi(h1.z)}, {bflo(h1.w), bfhi(h1.w)}};
    float d[16];
#pragma unroll
    for (int q = 0; q < 16; ++q) { f32x2 s2 = {0.f, 0.f}; s2 = dot16_fp8(w[q], hv2, s2); d[q] = sum8(s2.x + s2.y); }
    { unsigned pv = pkbf(d[0], d[1]);
#pragma unroll
      for (int e = 1; e < 8; ++e) { const unsigned c2 = pkbf(d[2 * e], d[2 * e + 1]); pv = (i == e) ? c2 : pv; }
      *(unsigned*)((bf16*)PART + ((size_t)(2 * label + sub) * M + tok) * 128 + g * 16 + 2 * i) = pv; }
}
template <bool VP> __device__ __forceinline__ void peer_slice_loop(int sl, int label, int sub, int tok0, int tstep, const bf16* __restrict__ XB, const float* __restrict__ ACT, const unsigned short* __restrict__ IDX,
                                                                   const unsigned char* __restrict__ TAB, float* PART, float* X, bf16* XBn, const float* __restrict__ gn, float* ssn, int lane) {
    const int g = lane >> 3, i = lane & 7;
    const int j = ((lane >> 5) & 1) * 4 + ((lane >> 4) & 1) * 2 + ((lane >> 3) & 1), c = sl * 128 + 16 * i + 2 * j;
    const unsigned char* tb = TAB + (size_t)sl * (16384 * 128) + 16 * i;
    f32x2 gg = {0.f, 0.f}; if (VP) gg = *(const f32x2*)(gn + c);
    if (tok0 >= M) return;
    const int NT = (M - tok0 + tstep - 1) / tstep;
#define PS_TOK(k_) ((size_t)(tok0 + ((k_) < NT ? (k_) : NT - 1) * tstep))
    PMeta mA, mB, mN; v4u wA[16], wB[16];
    peer_meta(mA, PS_TOK(0), IDX, g); peer_meta(mB, PS_TOK(1), IDX, g);
    asm volatile("" : "+v"(mB.ia), "+v"(mB.ib));
    peer_issue<VP>(mA, wA, tb, PS_TOK(0), sl, XB, ACT, X, g, i, c);
    int k = 0;
    for (; k + 1 < NT; k += 2) {
        peer_meta(mN, PS_TOK(k + 2), IDX, g);
        asm volatile("" ::: "memory");
        peer_issue<VP>(mB, wB, tb, PS_TOK(k + 1), sl, XB, ACT, X, g, i, c);
        asm volatile("" ::: "memory");
        peer_u_compute(mA, wA, PS_TOK(k), label, sub, PART, g, i);
        asm volatile("" ::: "memory");
        mA.ia = mN.ia; mA.ib = mN.ib;
        peer_meta(mN, PS_TOK(k + 3), IDX, g);
        asm volatile("" ::: "memory");
        peer_issue<VP>(mA, wA, tb, PS_TOK(k + 2), sl, XB, ACT, X, g, i, c);
        asm volatile("" ::: "memory");
        peer_u_compute(mB, wB, PS_TOK(k + 1), label, sub, PART, g, i);
        asm volatile("" ::: "memory");
        mB.ia = mN.ia; mB.ib = mN.ib;
    }
    if (k < NT) { peer_u_compute(mA, wA, PS_TOK(k), label, sub, PART, g, i); }
#undef PS_TOK
}
__device__ __forceinline__ void peer_combine_row(size_t tok, const float* __restrict__ PART, const unsigned short* __restrict__ IDX, const float* __restrict__ GATE, const float* __restrict__ USC, const float* __restrict__ VSC,
                                                 const float* __restrict__ ss, float* ACT, int lane) {
    float sv = ss[(tok + (lane >> 5)) * 32 + (lane & 31)];
    sv += __shfl_xor(sv, 1); sv += __shfl_xor(sv, 2); sv += __shfl_xor(sv, 4); sv += __shfl_xor(sv, 8); sv += __shfl_xor(sv, 16);
    const float rsv = rsqrtf(sv * (1.f / 2048.f) + RMS_EPS);
    const float rs[2] = {__shfl(rsv, 0), __shfl(rsv, 32)};
    f32x2 sum[2]; unsigned ew[2]; f32x2 gt[2]; unsigned pv[2][16];
#pragma unroll
    for (int t = 0; t < 2; ++t) { const size_t p = (tok + t) * 128 + 2 * lane;
        ew[t] = *(const unsigned*)(IDX + p); gt[t] = *(const f32x2*)(GATE + p);
#pragma unroll
        for (int lab = 0; lab < 16; ++lab) pv[t][lab] = *(const unsigned*)((const bf16*)PART + (size_t)lab * M * 128 + p); }
#pragma unroll
    for (int t = 0; t < 2; ++t) { sum[t] = (f32x2){0.f, 0.f};
#pragma unroll
        for (int lab = 0; lab < 16; ++lab) sum[t] = sum[t] + (f32x2){bflo(pv[t][lab]), bfhi(pv[t][lab])}; }
#pragma unroll
    for (int t = 0; t < 2; ++t) { const size_t p = (tok + t) * 128 + 2 * lane; const int e0 = ew[t] & 0xffff, e1 = ew[t] >> 16;
        *(unsigned*)((bf16*)ACT + p) = pkbf(gelu_erf(sum[t].x * rs[t] * USC[e0]) * gt[t].x * VSC[e0], gelu_erf(sum[t].y * rs[t] * USC[e1]) * gt[t].y * VSC[e1]); }
}
struct VMeta { v4u ia, ib; v4u a0, a1; f32x2 x1; };
__device__ __forceinline__ void peer_v_idx(VMeta& m, size_t tok, const unsigned short* __restrict__ IDX, int g) { m.ia = *(const v4u*)(IDX + tok * 128 + g * 16); m.ib = *(const v4u*)(IDX + tok * 128 + g * 16 + 8); }
__device__ __forceinline__ void peer_v_issue(VMeta& m, v4u (&w)[16], const unsigned char* __restrict__ vb, size_t tok, const float* __restrict__ ACT, const bf16* XB1, int g, int c) {
    const unsigned iw[8] = {m.ia.x, m.ia.y, m.ia.z, m.ia.w, m.ib.x, m.ib.y, m.ib.z, m.ib.w};
#pragma unroll
    for (int q = 0; q < 16; ++q) { const unsigned e = (iw[q >> 1] >> (16 * (q & 1))) & 0xffffu; w[q] = *(const v4u*)(vb + (size_t)e * 128); }
    const v4u* ap = (const v4u*)((const bf16*)ACT + tok * 128 + g * 16); m.a0 = ap[0]; m.a1 = ap[1];
    { const unsigned xw = *(const unsigned*)(XB1 + tok * 2048 + c); m.x1 = (f32x2){bflo(xw), bfhi(xw)}; }
}
template <bool WB> __device__ __forceinline__ void peer_v_fin(const VMeta& m, const v4u (&w)[16], size_t tok, int sl, float* X, bf16* XBn, const f32x2 gg, float* ssn, int lane, int c) {
    const v4u a0 = m.a0, a1 = m.a1;
    const float av[16] = {bflo(a0.x), bfhi(a0.x), bflo(a0.y), bfhi(a0.y), bflo(a0.z), bfhi(a0.z), bflo(a0.w), bfhi(a0.w), bflo(a1.x), bfhi(a1.x), bflo(a1.y), bfhi(a1.y), bflo(a1.z), bfhi(a1.z), bflo(a1.w), bfhi(a1.w)};
    f32x2 acc2[8];
#pragma unroll
    for (int k = 0; k < 8; ++k) acc2[k] = (f32x2){0.f, 0.f};
#pragma unroll
    for (int q = 0; q < 16; ++q) { const f32x2 a2v = {av[q], av[q]}; axpy16_fp8(w[q], a2v, acc2); }
#pragma unroll
    for (int k = 0; k < 4; ++k) { const bool up = (lane & 32) != 0; const f32x2 send = up ? acc2[k] : acc2[k + 4], keep = up ? acc2[k + 4] : acc2[k];
        acc2[k] = (f32x2){keep.x + __shfl_xor(send.x, 32), keep.y + __shfl_xor(send.y, 32)}; }
#pragma unroll
    for (int k = 0; k < 2; ++k) { const bool up = (lane & 16) != 0; const f32x2 send = up ? acc2[k] : acc2[k + 2], keep = up ? acc2[k + 2] : acc2[k];
        acc2[k] = (f32x2){keep.x + __shfl_xor(send.x, 16), keep.y + __shfl_xor(send.y, 16)}; }
    { const bool up = (lane & 8) != 0; const f32x2 send = up ? acc2[0] : acc2[1], keep = up ? acc2[1] : acc2[0];
        acc2[0] = (f32x2){keep.x + __shfl_xor(send.x, 8), keep.y + __shfl_xor(send.y, 8)}; }
    const f32x2 x2 = {m.x1.x + acc2[0].x, m.x1.y + acc2[0].y};
    *(f32x2*)(X + tok * 2048 + c) = x2;
    if (WB) *(unsigned*)(XBn + tok * 2048 + c) = pkbf(x2.x * gg.x, x2.y * gg.y);
    const float sq = wave_sum(x2.x * x2.x + x2.y * x2.y);
    ssn[tok * 16 + sl] = sq;
}
template <bool WB> __device__ __forceinline__ void peer_v_loop(int sl, int tok0, int tstep, const float* __restrict__ ACT, const unsigned short* __restrict__ IDX, const unsigned char* __restrict__ V8, float* X, bf16* XBn, const float* __restrict__ gn, float* ssn, int lane) {
    const int g = lane >> 3, i = lane & 7;
    const int j = ((lane >> 5) & 1) * 4 + ((lane >> 4) & 1) * 2 + ((lane >> 3) & 1), c = sl * 128 + 16 * i + 2 * j;
    const unsigned char* vb = V8 + (size_t)sl * (16384 * 128) + 16 * i;
    const f32x2 gg = *(const f32x2*)(gn + c);
    if (tok0 >= M) return;
    const int NT = (M - tok0 + tstep - 1) / tstep;
#define PS_TOK(k_) ((size_t)(tok0 + ((k_) < NT ? (k_) : NT - 1) * tstep))
    VMeta mA, mB, mN; v4u wA[16], wB[16];
    peer_v_idx(mA, PS_TOK(0), IDX, g); peer_v_idx(mB, PS_TOK(1), IDX, g);
    asm volatile("" : "+v"(mB.ia), "+v"(mB.ib));
    peer_v_issue(mA, wA, vb, PS_TOK(0), ACT, XBn, g, c);
    int k = 0;
    for (; k + 1 < NT; k += 2) {
        peer_v_idx(mN, PS_TOK(k + 2), IDX, g);
        asm volatile("" ::: "memory");
        peer_v_issue(mB, wB, vb, PS_TOK(k + 1), ACT, XBn, g, c);
        asm volatile("" ::: "memory");
        peer_v_fin<WB>(mA, wA, PS_TOK(k), sl, X, XBn, gg, ssn, lane, c);
        asm volatile("" ::: "memory");
        mA.ia = mN.ia; mA.ib = mN.ib;
        peer_v_idx(mN, PS_TOK(k + 3), IDX, g);
        asm volatile("" ::: "memory");
        peer_v_issue(mA, wA, vb, PS_TOK(k + 2), ACT, XBn, g, c);
        asm volatile("" ::: "memory");
        peer_v_fin<WB>(mB, wB, PS_TOK(k + 1), sl, X, XBn, gg, ssn, lane, c);
        asm volatile("" ::: "memory");
        mB.ia = mN.ia; mB.ib = mN.ib;
    }
    if (k < NT) peer_v_fin<WB>(mA, wA, PS_TOK(k), sl, X, XBn, gg, ssn, lane, c);
#undef PS_TOK
}
__device__ __forceinline__ void final_norm_row(float* xrow, const float* __restrict__ g, const float* __restrict__ ssp, int lane) {
    const float rs = rsqrtf(wave_sum(lane < 16 ? ssp[lane] : 0.f) * (1.f / 2048.f) + RMS_EPS);
    f32x4* xr = (f32x4*)xrow + lane; const f32x4* gr = (const f32x4*)g + lane;
    f32x4 v[8], gg[8];
#pragma unroll
    for (int jj = 0; jj < 8; ++jj) { v[jj] = xr[64 * jj]; gg[jj] = gr[64 * jj]; }
#pragma unroll
    for (int jj = 0; jj < 8; ++jj) xr[64 * jj] = (f32x4){v[jj].x * rs * gg[jj].x, v[jj].y * rs * gg[jj].y, v[jj].z * rs * gg[jj].z, v[jj].w * rs * gg[jj].w};
}

__device__ __forceinline__ void afb_unit(int unit, const bf16* __restrict__ H, const bf16* __restrict__ Waf, float* AFBo, const float* __restrict__ ss, int lane) {
    const int fr = lane & 15, kq = lane >> 4, row0 = unit * 16;
    const bf16* ap = H + (size_t)(row0 + fr) * 2048 + 8 * kq; const bf16* bp = Waf + (size_t)fr * 2048 + 8 * kq;
    f32x4 c0 = {0.f, 0.f, 0.f, 0.f}, c1 = {0.f, 0.f, 0.f, 0.f};
#pragma unroll 1
    for (int s0 = 0; s0 < 64; s0 += 8) {
        bf16x8 Av[8], Bv[8], Cv[8];
#pragma unroll
        for (int q = 0; q < 8; ++q) { Av[q] = *(const bf16x8*)(ap + 32 * (s0 + q)); Bv[q] = *(const bf16x8*)(bp + 32 * (s0 + q)); Cv[q] = *(const bf16x8*)(bp + 16 * 2048 + 32 * (s0 + q)); }
        asm volatile("" : "+v"(Av[0]), "+v"(Bv[0]), "+v"(Cv[0]), "+v"(Av[7]), "+v"(Bv[7]), "+v"(Cv[7]));
#pragma unroll
        for (int q = 0; q < 8; ++q) { c0 = __builtin_amdgcn_mfma_f32_16x16x32_bf16(Av[q], Bv[q], c0, 0, 0, 0); c1 = __builtin_amdgcn_mfma_f32_16x16x32_bf16(Av[q], Cv[q], c1, 0, 0, 0); }
    }
    const float mine = ss ? pg8::row_rs<16>(ss, row0 + fr) : 1.f;
#pragma unroll
    for (int e = 0; e < 4; ++e) { const int rr = 4 * kq + e; const float sc = __shfl(mine, rr); float* o = AFBo + (size_t)(row0 + rr) * 32 + fr; o[0] = c0[e] * sc; o[16] = c1[e] * sc; }
}
__device__ __forceinline__ const float* gin(const float* p) { const GAS float* g = (const GAS float*)p; asm volatile("" : "+s"(g)); return (const float*)g; }
#ifndef MK_MULTI
#define MK_MULTI 0
#endif
struct Args { const float* in[19]; float* out; unsigned char* ws; int ph_lo, ph_hi, l_lo, l_hi; };
__global__ void __launch_bounds__(NWAVES * 64, 2) fwd_kernel(Args args) {
    extern __shared__ __attribute__((aligned(16))) unsigned char lds[];
    LAS unsigned char* ldsL = (LAS unsigned char*)lds;
    volatile LAS unsigned* MISC = (volatile LAS unsigned*)(ldsL + MISC_OFF);
    const int tid0 = threadIdx.x, wave = __builtin_amdgcn_readfirstlane(tid0 >> 6);
#define PHASE_IDS() int tid = threadIdx.x; asm volatile("" : "+v"(tid)); const int lane = tid & 63; (void)lane; GAS unsigned char* wsp0 = (GAS unsigned char*)args.ws; asm volatile("" : "+s"(wsp0)); unsigned char* wsp = (unsigned char*)wsp0; GAS float* outp0 = (GAS float*)args.out; asm volatile("" : "+s"(outp0)); float* outp = (float*)outp0; int lp = l; asm volatile("" : "+s"(lp)); (void)wsp; (void)outp; (void)lp
    const int G = gridDim.x; const int bx = blockIdx.x; const int vcu = (G % 8 == 0) ? (bx % 8) * (G / 8) + bx / 8 : bx;
    const int gw = vcu * NWAVES + wave, NGW = G * NWAVES;
    unsigned char* ws = args.ws;
    gu32* ctl = (gu32*)(ws + WS_CTL);
    for (int u = tid0; u < (LDS_BYTES - LDSCTL_OFF) / 4; u += NWAVES * 64) ((LAS unsigned*)(ldsL + LDSCTL_OFF))[u] = 0u;
    __syncthreads();
    XcdBarrier bar; bar.bar = (unsigned*)(ctl + CW_BAR); bar.x = 0; bar.st = nullptr;
    if (!MK_MULTI) bar = xcd_barrier_post((unsigned*)(ctl + CW_BAR), MISC + 8);
#define GRID_BAR() do { if (!MK_MULTI) xcd_barrier(bar); } while (0)
    const int lo = args.ph_lo, hi = args.ph_hi;
#ifdef PH_ONLY
#define IN(k) ((k) == PH_ONLY && lo <= (k) && (k) < hi)
#else
#define IN(k) (lo <= (k) && (k) < hi)
#endif
#define BOTH(k) (IN(k) && IN((k) + 1))
#ifndef DUP_MASK
#define DUP_MASK 0
#endif
#define NREP(k) ((((DUP_MASK) >> (k)) & 1) && l == 0 ? 2 : 1)

#define WIN ((bf16*)(wsp + WS_WIN))
#define WUPG ((bf16*)(wsp + WS_WUPG))
#define WUPP ((bf16*)(wsp + WS_WUPP))
#define WOUT ((bf16*)(wsp + WS_WOUT))
#define WQ ((bf16*)(wsp + WS_WQ))
#define POOLW ((bf16*)(wsp + WS_POOLW))
#define SUBK ((bf16*)(wsp + WS_SUBK))
#define Hb ((bf16*)(wsp + WS_H))
#define POOLED ((bf16*)(wsp + WS_POOLED))
#define POOLMIX ((bf16*)(wsp + WS_POOLMIX))
#define QK ((bf16*)(wsp + WS_QK))
#define Pb ((bf16*)(wsp + WS_P))
#define OFb ((bf16*)(wsp + WS_QK))
#define OBb ((bf16*)(wsp + WS_P))
#define VT ((bf16*)(wsp + WS_VT))
#define Rb ((bf16*)(wsp + WS_R))
#define MERGED ((bf16*)(wsp + WS_MERGED))
#define Gb ((bf16*)(wsp + WS_G))
#define PQ ((bf16*)(wsp + WS_PQ))
#define QE ((bf16*)(wsp + WS_QE))
#define GLAOUT ((bf16*)(wsp + WS_GLAOUT))
#define KDT ((bf16*)(wsp + WS_KDT))
#define ATTN ((bf16*)(wsp + WS_ATTN))
#define USC ((float*)(wsp + WS_USC))
#define VSC ((float*)(wsp + WS_VSC))
#define UTAB (wsp + WS_UTAB)
#define VTAB (wsp + WS_VTAB)
#define SEGL ((float*)(wsp + WS_SEGL))
#define SIN ((float*)(wsp + WS_SIN))
#define IDX ((unsigned short*)(wsp + WS_IDX))
#define GATE ((float*)(wsp + WS_GATE))
#define AFB ((float*)(wsp + WS_AFB))
#define DEC ((float*)(wsp + WS_DEC))
#define SSP1 ((float*)(wsp + WS_SSP1))
#define SSP2 ((float*)(wsp + WS_SSP2))
#define PART ((float*)(wsp + WS_QK))
#define ACT ((float*)(wsp + WS_QE))
#define GIN(k_) gin(args.in[k_])
#define x_in ((lp == 0) ? GIN(0) : (const float*)outp)
#define w_in (GIN(2) + (size_t)lp * D * DIN)
#define ssin ((lp == 0) ? (const float*)nullptr : (const float*)SSP2)
#define ss1 SSP1
#define ss2 SSP2
    for (int l = args.l_lo; l < args.l_hi; ++l) {
        if (IN(0)) { PHASE_IDS(); for (int rep = 0; rep < NREP(0); ++rep) {
            LAS float* scr = (LAS float*)(ldsL + wave * 16384);
            { const float* sk = GIN(15) + (size_t)lp * 262144;
              const float* w_upg = GIN(8) + (size_t)lp * 1024 * 2048; const float* w_upp = GIN(11) + (size_t)lp * 1024 * 2048; const float* w_o = GIN(12) + (size_t)lp * 2048 * 2048; const float* w_q = GIN(14) + (size_t)lp * 2048 * 2048;
              const float* w_pool = GIN(9) + (size_t)lp * 4 * 65536;
              constexpr int I_IN = 32 * 257, I_UP = 16 * 64, I_SQ = 32 * 64, I_PL = 4 * 32, I_SK = 512;
              constexpr int E_IN = I_IN, E_UPG = E_IN + I_UP, E_UPP = E_UPG + I_UP, E_O = E_UPP + I_SQ, E_Q = E_O + I_SQ, E_PL = E_Q + I_PL, E_ALL = E_PL + I_SK;
              for (int it0 = gw; it0 < E_ALL; it0 += NGW) { int it = it0;
                if (it < E_IN) { const int kb = it / 257, nb = it % 257, n0 = nb * 32;
                    int d; if (n0 < 1024) d = n0; else if (n0 < 2048) d = n0 + 6400; else if (n0 < 3072) d = n0 - 1024; else if (n0 == 3072) d = 7168; else d = n0 - 1056;
                    transpose_item(w_in, DIN, WIN, 2048, d, kb * 64, n0, scr, lane); }
                else if (it < E_UPG) { it -= E_IN;  transpose_item(w_upg, 2048, WUPG, 1024, (it % 64) * 32, (it / 64) * 64, (it % 64) * 32, scr, lane); }
                else if (it < E_UPP) { it -= E_UPG; transpose_item(w_upp, 2048, WUPP, 1024, (it % 64) * 32, (it / 64) * 64, (it % 64) * 32, scr, lane); }
                else if (it < E_O)   { it -= E_UPP; transpose_item(w_o, 2048, WOUT, 2048, (it % 64) * 32, (it / 64) * 64, (it % 64) * 32, scr, lane); }
                else if (it < E_Q)   { it -= E_O;   transpose_item(w_q, 2048, WQ, 2048, (it % 64) * 32, (it / 64) * 64, (it % 64) * 32, scr, lane, GIN(13) + (size_t)lp * D); }
                else if (it < E_PL)  { it -= E_Q; const int g = it >> 5, r5 = it & 31; transpose_item(w_pool + (size_t)g * 65536, 256, POOLW + (size_t)g * 65536, 256, (r5 % 8) * 32, (r5 / 8) * 64, (r5 % 8) * 32, scr, lane); }
                else { const int f = it - E_PL; const int hp = f >> 5, nt = (f >> 3) & 3, s5 = f & 7, r = lane & 31, hh = lane >> 5;
                    const float* src = sk + ((size_t)hp * 128 + 32 * nt + r) * 128 + 16 * s5 + 8 * hh; const f32x4 a = *(const f32x4*)src, b = *(const f32x4*)(src + 4);
                    v4u o = {pkbf(a.x, a.y), pkbf(a.z, a.w), pkbf(b.x, b.y), pkbf(b.z, b.w)}; *(v4u*)(SUBK + ((size_t)f * 64 + lane) * 8) = o; } } }
            { const float* ut = GIN(16) + (size_t)lp * 16384 * 2048; const float* vt = GIN(17) + (size_t)lp * 16384 * 2048;
              for (int row = gw; row < 16384; row += NGW) { if (row < 8192)
                table_rows_fp8(ut, (unsigned*)UTAB, USC, row, row + 8192, lane, GIN(13) + (size_t)lp * D); else table_rows_fp8(vt, (unsigned*)VTAB, VSC, row - 8192, row, lane); } }
            if (lp == 0) for (int m = gw; m < M; m += NGW) rmsnorm_row(x_in + (size_t)m * D, GIN(1), Hb + (size_t)m * D, lane);
            if (rep + 1 < NREP(0)) GRID_BAR(); }
            if (BOTH(0)) GRID_BAR();
        }
        if (IN(1)) { PHASE_IDS(); for (int rep = 0; rep < NREP(1); ++rep) {
            { pg8::Gemm g{Hb, WIN, M, 7168, 2048, 2048, 2048, 0, nullptr, nullptr}; pg8::StaticOrder S; S.init(M, 7168, G, bx);
              pg8::EpiProj E{QK, Rb, Pb, Gb, AFB, ssin};
              pg8::gemm_phase<pg8::EpiProj, pg8::StaticOrder, true, true>(ldsL, g, S, E); }
            { pg8::Gemm g{WIN + (size_t)7424 * 2048, Hb, 1024, M, 2048, 2048, 2048, 0, nullptr, nullptr}; pg8::StaticOrder S; S.init(1024, M, G, bx);
              pg8::EpiVT E{VT, ssin};
              pg8::gemm_phase<pg8::EpiVT, pg8::StaticOrder, true, true>(ldsL, g, S, E); }
            for (int unit = gw; unit < M / 16; unit += NGW) afb_unit(unit, Hb, WIN + (size_t)7168 * 2048, AFB, ssin, lane);
            if (rep + 1 < NREP(1)) GRID_BAR(); }
            if (BOTH(1)) GRID_BAR();
        }
        if (IN(2)) { PHASE_IDS(); for (int rep = 0; rep < NREP(2); ++rep) {
            if (vcu < 4096) { PrepIn pin; gla_prep_load(pin, vcu, QK, AFB, GIN(3) + (size_t)lp * 8192, GIN(4) + (size_t)lp * 512, GIN(5) + (size_t)lp * 8192, GIN(6) + (size_t)lp * 512, tid);
                __syncthreads();
                int pb = 0;
                for (int uid = vcu; uid < 4096; uid += G, pb ^= 1)
                    gla_prep_unit(uid, (uid + G < 4096) ? uid + G : uid, pin, ldsL + pb * PA_BYTES, QK, AFB, GIN(3) + (size_t)lp * 8192, GIN(4) + (size_t)lp * 512, GIN(5) + (size_t)lp * 8192, GIN(6) + (size_t)lp * 512, QE, KDT, ATTN, DEC, tid, wave, lane);
                __syncthreads(); }
            for (int item = vcu * 512 + tid; item < (M / 32) * 128; item += G * 512) pool_item(item, Pb, POOLED);
            if (rep + 1 < NREP(2)) GRID_BAR(); }
            if (BOTH(2)) GRID_BAR();
        }
        if (IN(3)) { PHASE_IDS(); for (int rep = 0; rep < NREP(3); ++rep) {
            for (int su = vcu; su < 16 * NSEG; su += G) gla_scan_block<false>(su, ldsL, QE, ATTN, KDT, DEC, VT, SEGL, SIN, OFb, OBb, tid, wave, lane);
            if (rep + 1 < NREP(3)) GRID_BAR(); }
            if (BOTH(3)) GRID_BAR();
        }
        if (IN(5)) { PHASE_IDS(); for (int rep = 0; rep < NREP(5); ++rep) {
            for (int su = vcu; su < 16 * NSEG; su += G) gla_scan_block<true>(su, ldsL, QE, ATTN, KDT, DEC, VT, SEGL, SIN, OFb, OBb, tid, wave, lane);
            if (rep + 1 < NREP(5)) GRID_BAR(); }
            if (BOTH(5)) GRID_BAR();
        }
        if (IN(6)) { PHASE_IDS(); for (int rep = 0; rep < NREP(6); ++rep) {
            { float gg[16]; { const f32x4* gp = (const f32x4*)(GIN(7) + (size_t)lp * 1024 + 16 * lane);
#pragma unroll
                for (int q = 0; q < 4; ++q) { const f32x4 x = gp[q]; gg[4 * q] = x.x; gg[4 * q + 1] = x.y; gg[4 * q + 2] = x.z; gg[4 * q + 3] = x.w; } }
              for (int m = gw; m < M; m += 2 * NGW) { const int m2 = (m + NGW < M) ? m + NGW : m;
                  FinIn ia, ib; gla_fin_load(ia, m, OFb, OBb, Rb, lane); gla_fin_load(ib, m2, OFb, OBb, Rb, lane);
                  gla_fin_row(ia, m, gg, GLAOUT, lane); if (m2 != m) gla_fin_row(ib, m2, gg, GLAOUT, lane); } }
            { pg8::Gemm g{POOLED, POOLW, M, 1024, 256, 1024, 256, 512, nullptr, nullptr}; pg8::StaticOrder S; S.init(M, 1024, G, bx);
              pg8::EpiScale<false> E{POOLMIX, 1024, GIN(10) + (size_t)lp * 1024, nullptr};
              pg8::gemm_phase<pg8::EpiScale<false>, pg8::StaticOrder, true, true>(ldsL, g, S, E); }
            if (rep + 1 < NREP(6)) GRID_BAR(); }
            if (BOTH(6)) GRID_BAR();
        }
        if (IN(7)) { PHASE_IDS(); for (int rep = 0; rep < NREP(7); ++rep) {
            { pg8::Gemm g{GLAOUT, WUPG, M, 2048, 1024, 1024, 1024, 0, POOLMIX, WUPP}; pg8::TwoPartOrder S; S.init(M, 2048, G, bx);
              pg8::EpiMerge E{MERGED, (const unsigned char*)Gb};
              pg8::gemm_phase<pg8::EpiMerge, pg8::TwoPartOrder, true, true>(ldsL, g, S, E); }
            if (rep + 1 < NREP(7)) GRID_BAR(); }
            if (BOTH(7)) GRID_BAR();
        }
        if (IN(8)) { PHASE_IDS(); for (int rep = 0; rep < NREP(8); ++rep) {
            { pg8::Gemm g{MERGED, WOUT, M, 2048, 2048, 2048, 2048, 0, nullptr, nullptr}; pg8::StaticOrder S; S.init(M, 2048, G, bx);
              pg8::EpiResid E{x_in, Hb, ss1};
              pg8::gemm_phase<pg8::EpiResid, pg8::StaticOrder, true, true>(ldsL, g, S, E); }
            if (rep + 1 < NREP(8)) GRID_BAR(); }
            if (BOTH(8)) GRID_BAR();
        }
        if (IN(9)) { PHASE_IDS(); for (int rep = 0; rep < NREP(9); ++rep) {
            { pg8::Gemm g{Hb, WQ, M, 2048, 2048, 2048, 2048, 0, nullptr, nullptr}; pg8::StaticOrder S; S.init(M, 2048, G, bx);
              pg8::EpiScale<true> E{PQ, 2048, nullptr, ss1};
              pg8::gemm_phase<pg8::EpiScale<true>, pg8::StaticOrder, true, true>(ldsL, g, S, E); }
            if (rep + 1 < NREP(9)) GRID_BAR(); }
            if (BOTH(9)) GRID_BAR();
        }
        if (IN(10)) { PHASE_IDS(); for (int rep = 0; rep < NREP(10); ++rep) {
            for (int j = 0; j < 4; ++j) {
                __syncthreads();
                for (int i = tid; i < 8192; i += 512) *(LAS v4u*)(ldsL + i * 16) = *(const v4u*)((const unsigned char*)SUBK + (size_t)j * 131072 + (size_t)i * 16);
                __syncthreads();
                const int hsel = wave >> 2, h = 2 * j + hsel;
                for (int tile = vcu * 4 + (wave & 3); tile < M / 32; tile += G * 4) peer_topk_item(tile, h, ldsL + hsel * 65536, PQ, IDX, GATE, lane);
            }
            if (rep + 1 < NREP(10)) GRID_BAR(); }
            if (BOTH(10)) GRID_BAR();
        }
        if (IN(11)) { PHASE_IDS(); for (int rep = 0; rep < NREP(11); ++rep) {
            const int label = bx & 7, rank = bx >> 3, nrank = (G - label + 7) >> 3;
            for (int sub = 0; sub < 2; ++sub)
                peer_slice_loop<false>(2 * label + sub, label, sub, rank * NWAVES + wave, nrank * NWAVES, Hb, ACT, IDX, UTAB, PART, outp, Hb, nullptr, nullptr, lane);
            if (rep + 1 < NREP(11)) GRID_BAR(); }
            if (BOTH(11)) GRID_BAR();
        }
        if (IN(12)) { PHASE_IDS(); for (int rep = 0; rep < NREP(12); ++rep) {
            for (int tok = 2 * gw; tok < M; tok += 2 * NGW) peer_combine_row((size_t)tok, PART, IDX, GATE, USC, VSC, ss1, ACT, lane);
            if (rep + 1 < NREP(12)) GRID_BAR(); }
            if (BOTH(12)) GRID_BAR();
        }
        if (IN(13)) { PHASE_IDS();
            const int last = (lp == DEPTH - 1);
            const float* gn = last ? GIN(18) : GIN(1) + (size_t)(lp + 1) * D;
            const int label = bx & 7, rank = bx >> 3, nrank = (G - label + 7) >> 3;
            for (int sub = 0; sub < 2; ++sub)
                if (last) peer_v_loop<false>(2 * label + sub, rank * NWAVES + wave, nrank * NWAVES, ACT, IDX, VTAB, outp, Hb, gn, ss2, lane);
                else      peer_v_loop<true>(2 * label + sub, rank * NWAVES + wave, nrank * NWAVES, ACT, IDX, VTAB, outp, Hb, gn, ss2, lane);
            if ((BOTH(13) && last) || (lo == 0 && hi == NPH && l + 1 < args.l_hi)) GRID_BAR();
        }
        if (IN(14) && l == DEPTH - 1) { PHASE_IDS();
            for (int m = gw; m < M; m += NGW) final_norm_row(outp + (size_t)m * D, GIN(18), ss2 + (size_t)m * 16, lane);
        }
    }
#undef IN
#undef BOTH
#undef GRID_BAR
}

#undef WIN
#undef WUPG
#undef WUPP
#undef WOUT
#undef WQ
#undef POOLW
#undef SUBK
#undef Hb
#undef POOLED
#undef POOLMIX
#undef QK
#undef Pb
#undef OFb
#undef OBb
#undef VT
#undef Rb
#undef MERGED
#undef Gb
#undef PQ
#undef QE
#undef GLAOUT
#undef KDT
#undef ATTN
#undef USC
#undef VSC
#undef UTAB
#undef VTAB
#undef SEGL
#undef SIN
#undef IDX
#undef GATE
#undef AFB
#undef DEC
#undef SSP1
#undef SSP2
#undef PART
#undef ACT
#undef GIN
#undef x_in
#undef w_in
#undef ssin
#undef ss1
#undef ss2
extern "C" void kernel_launch(void* const* d_in, const int* in_sizes, int n_in, void* d_out, int out_size, void* d_ws, size_t ws_size, hipStream_t stream) {
    static int grid = 0;
    if (grid == 0) {
        if (n_in != 19 || in_sizes[0] != M * D || out_size != M * D || ws_size < WS_END) { fprintf(stderr, "kernel_launch: unexpected shapes / workspace (n_in %d, ws %zu, need %zu); nothing launched\n", n_in, ws_size, (size_t)WS_END); grid = -1; return; }
        int dev = 0, cus = 0, per_cu = 0;
        if (hipGetDevice(&dev) != hipSuccess || hipDeviceGetAttribute(&cus, hipDeviceAttributeMultiprocessorCount, dev) != hipSuccess) { grid = -1; return; }
        if (hipFuncSetAttribute((const void*)fwd_kernel, hipFuncAttributeMaxDynamicSharedMemorySize, LDS_BYTES) != hipSuccess) { fprintf(stderr, "kernel_launch: hipFuncSetAttribute failed\n"); grid = -1; return; }
        if (hipOccupancyMaxActiveBlocksPerMultiprocessor(&per_cu, (const void*)fwd_kernel, NWAVES * 64, LDS_BYTES) != hipSuccess || per_cu < 1) { fprintf(stderr, "kernel_launch: occupancy query reports %d blocks per CU\n", per_cu); }
        (void)hipGetLastError();
        grid = cus;
    }
    if (grid < 0) return;
    if (hipMemsetAsync((char*)d_ws + WS_CTL, 0, CTL_ZERO_BYTES, stream) != hipSuccess) return;
    Args a{};
    for (int i = 0; i < 19; ++i) a.in[i] = (const float*)d_in[i];
    a.out = (float*)d_out; a.ws = (unsigned char*)d_ws;
#if MK_MULTI
    for (int l = 0; l < DEPTH; ++l)
        for (int ph = 0; ph < NPH; ++ph) { a.ph_lo = ph; a.ph_hi = ph + 1; a.l_lo = l; a.l_hi = l + 1;
            hipLaunchKernelGGL(fwd_kernel, dim3(grid), dim3(NWAVES * 64), LDS_BYTES, stream, a); }
#else
    a.ph_lo = 0; a.ph_hi = NPH; a.l_lo = 0; a.l_hi = DEPTH;
    hipLaunchKernelGGL(fwd_kernel, dim3(grid), dim3(NWAVES * 64), LDS_BYTES, stream, a);
#endif
}
```

```cpp
#include <hip/hip_runtime.h>
#include <cstdio>
#include <cstdint>
namespace pg8 {
#define PG8_LAS __attribute__((address_space(3)))
typedef unsigned short bf16_t;
typedef short bf16x8 __attribute__((ext_vector_type(8)));
typedef float f32x4 __attribute__((ext_vector_type(4)));
typedef unsigned u32x4 __attribute__((ext_vector_type(4)));
typedef unsigned u32x2 __attribute__((ext_vector_type(2)));
constexpr int BM = 256, BK = 64, HALF = 128, HTB = HALF * BK * 2  , STAGE_BYTES = 8 * HTB, NXCD = 8, WGM = 8;

__host__ __device__ __forceinline__ int lds_byte(int r, int c) { const int st = (r >> 4) * 2 + (c >> 5), rr = r & 15, cc = c & 31, ob = rr * 64 + cc * 2; return st * 1024 + (ob ^ (((ob >> 9) & 1) << 5)); }
__host__ __device__ __forceinline__ void stage_rc(int b, int& R, int& C) { const int st = b / 1024, sb = b % 1024, swz = sb ^ (((sb >> 9) & 1) << 5); R = (st >> 1) * 16 + swz / 64; C = (st & 1) * 32 + (swz % 64) / 2; }
__host__ __device__ __forceinline__ int perm32(int rho) { const int n = rho >> 4, i = rho & 15; return 8 * (i >> 2) + 4 * n + (i & 3); }

struct Unit { int pm, pn, sub; };
struct Gemm { const bf16_t* A; const bf16_t* Bt; int M, N, K, lda, ldb, a_pn_step; const bf16_t* A2; const bf16_t* Bt2; };

struct StaticOrder {
    int nM, nN, nwg, G, c;
    __host__ __device__ void init(int M, int N, int G_, int c_) { nM = M / BM; nN = N / BM; nwg = nM * nN; G = G_; c = c_; }
    __host__ __device__ bool next(int i, Unit& u) const {
        const long L = (long)i * G + c; if (L >= nwg) return false;
        int wgid = (int)L; { const int q = nwg / NXCD, r = nwg % NXCD, xcd = wgid % NXCD, off = wgid / NXCD; wgid = (xcd < r ? xcd * (q + 1) : r * (q + 1) + (xcd - r) * q) + off; }
        const int nig = WGM * nN, gid = wgid / nig, fm = gid * WGM, gsz = (nM - fm) < WGM ? (nM - fm) : WGM;
        u.pm = fm + ((wgid % nig) % gsz); u.pn = (wgid % nig) / gsz; u.sub = 0; return true;
    }
    __device__ __forceinline__ void a_ready(const Unit&) const {}
    __device__ __forceinline__ void done(const Unit&) const {}
};

struct TwoPartOrder : StaticOrder {
    __host__ __device__ bool next(int i, Unit& u) const { if (!StaticOrder::next(i >> 1, u)) return false; u.sub = i & 1; return true; }
};
typedef float f32x2 __attribute__((ext_vector_type(2)));
typedef __bf16 bf16x2_t __attribute__((ext_vector_type(2)));
__device__ __forceinline__ unsigned pkbf(float lo, float hi) { f32x2 v = {lo, hi}; bf16x2_t b = __builtin_convertvector(v, bf16x2_t); return __builtin_bit_cast(unsigned, b); }
__device__ __forceinline__ float bflo(unsigned w) { return __builtin_bit_cast(float, w << 16); }
__device__ __forceinline__ float bfhi(unsigned w) { return __builtin_bit_cast(float, w & 0xffff0000u); }
__device__ __forceinline__ float fast_sigmoid(float x) { return __builtin_amdgcn_rcpf(1.f + __expf(-x)); }
template <int NP> __device__ __forceinline__ float row_rs(const float* ssp, int row) {
    const f32x4* p = (const f32x4*)(ssp + (size_t)row * NP); f32x4 a = p[0];
#pragma unroll
    for (int k = 1; k < NP / 4; ++k) a = a + p[k];
    return rsqrtf(((a.x + a.y) + (a.z + a.w)) * (1.f / 2048.f) + 1e-6f);
}

template <int NP> __device__ __forceinline__ float row_rs_fq(const float* ssp, int row, int fq) {
    const f32x4* p = (const f32x4*)(ssp + (size_t)row * NP + fq * (NP / 4)); f32x4 a = p[0];
    if (NP == 32) a = a + p[1];
    float t = (a.x + a.y) + (a.z + a.w);
    t += __shfl_xor(t, 16); t += __shfl_xor(t, 32);
    return rsqrtf(t * (1.f / 2048.f) + 1e-6f);
}
template <int NP> __device__ __forceinline__ void row_rs_fq8(const float* ssp, int row0, int fq, float (&rsc)[2][4]) {
#pragma unroll
    for (int ai = 0; ai < 2; ++ai) {
        f32x4 a[4], b[4];
#pragma unroll
        for (int m = 0; m < 4; ++m) { const f32x4* p = (const f32x4*)(ssp + (size_t)(row0 + ai * HALF + m * 16) * NP + fq * (NP / 4)); a[m] = p[0]; if (NP == 32) b[m] = p[1]; }
#pragma unroll
        for (int m = 0; m < 4; ++m) { f32x4 v = a[m]; if (NP == 32) v = v + b[m];
            float t = (v.x + v.y) + (v.z + v.w); t += __shfl_xor(t, 16); t += __shfl_xor(t, 32);
            rsc[ai][m] = rsqrtf(t * (1.f / 2048.f) + 1e-6f); }
    }
}
struct EpiProj {
    static constexpr bool PERM = true, AFTER_DRAIN = false; __device__ static bool keep(const Unit&) { return false; }
    bf16_t *QK, *R, *P, *G; float* AFB; const float* ss;
    __device__ __forceinline__ void operator()(const f32x4 (&acc)[2][2][4][2], const Unit& u, int wr, int wc, int fr, int fq) const {
        const int row0 = u.pm * BM + wr * 64 + fr; const int pn = u.pn;
        float rsc[2][4];
        if (ss) row_rs_fq8<16>(ss, row0, fq, rsc);
        else {
#pragma unroll
            for (int ai = 0; ai < 2; ++ai)
#pragma unroll
                for (int m = 0; m < 4; ++m) rsc[ai][m] = 1.f; }
        bf16_t* base; int ldc, colt, mode;
        if (pn < 4) { base = QK; ldc = 1024; colt = pn * 256; mode = (pn < 2) ? 1 : 0; }
        else if (pn < 8) { base = R; ldc = 1024; colt = (pn - 4) * 256; mode = 2; }
        else if (pn < 12) { base = P; ldc = 1024; colt = (pn - 8) * 256; mode = 0; }
        else { base = G; ldc = 4096; colt = (pn - 12) * 256; mode = 3; }
        const int col0 = colt + wc * 32 + 8 * fq;
#pragma unroll
        for (int ai = 0; ai < 2; ++ai)
#pragma unroll
            for (int m = 0; m < 4; ++m) { bf16_t* rowp = base + (size_t)(row0 + ai * HALF + m * 16) * ldc + col0;
#pragma unroll
                for (int bj = 0; bj < 2; ++bj) { f32x4 v0 = acc[ai][bj][m][0] * rsc[ai][m], v1 = acc[ai][bj][m][1] * rsc[ai][m];
                    if (mode == 1) { v0 = v0 * 0.08838834764831845f; v1 = v1 * 0.08838834764831845f; }
                    else if (mode == 2) {
#pragma unroll
                        for (int e = 0; e < 4; ++e) { v0[e] = v0[e] * fast_sigmoid(v0[e]); v1[e] = v1[e] * fast_sigmoid(v1[e]); } }
                    else if (mode == 3) {
#pragma unroll
                        for (int e = 0; e < 4; ++e) { v0[e] = fast_sigmoid(v0[e]); v1[e] = fast_sigmoid(v1[e]); } }
                    if (mode == 3) { unsigned w0 = 0u, w1 = 0u;
#pragma unroll
                        for (int e = 0; e < 4; ++e) { w0 = __builtin_amdgcn_cvt_pk_u8_f32(__builtin_rintf(v0[e] * 255.f), e, w0); w1 = __builtin_amdgcn_cvt_pk_u8_f32(__builtin_rintf(v1[e] * 255.f), e, w1); }
                        u32x2 w = {w0, w1}; *(u32x2*)((unsigned char*)G + (size_t)(row0 + ai * HALF + m * 16) * 4096 + col0 + bj * HALF) = w; }
                    else {
                    u32x4 w; w.x = pkbf(v0[0], v0[1]); w.y = pkbf(v0[2], v0[3]); w.z = pkbf(v1[0], v1[1]); w.w = pkbf(v1[2], v1[3]);
                    *(u32x4*)(rowp + bj * HALF) = w; } } asm volatile("" ::: "memory"); }
    }
};
struct EpiVT {
    static constexpr bool PERM = true, AFTER_DRAIN = false; __device__ static bool keep(const Unit&) { return false; }
    bf16_t* VT; const float* ss;
    __device__ __forceinline__ void operator()(const f32x4 (&acc)[2][2][4][2], const Unit& u, int wr, int wc, int fr, int fq) const {
        const int dv0 = u.pm * BM + wr * 64 + fr, tok0 = u.pn * BM + wc * 32 + 8 * fq;
        f32x4 cs[2][2];
#pragma unroll
        for (int bj = 0; bj < 2; ++bj)
#pragma unroll
            for (int n = 0; n < 2; ++n) cs[bj][n] = (f32x4){1.f, 1.f, 1.f, 1.f};
        if (ss) { const float mine = row_rs<16>(ss, tok0 + (fr >> 3) * HALF + (fr & 7));
#pragma unroll
            for (int bj = 0; bj < 2; ++bj)
#pragma unroll
                for (int n = 0; n < 2; ++n)
#pragma unroll
                    for (int k = 0; k < 4; ++k) cs[bj][n][k] = __shfl(mine, fq * 16 + bj * 8 + 4 * n + k); }
#pragma unroll
        for (int ai = 0; ai < 2; ++ai)
#pragma unroll
            for (int m = 0; m < 4; ++m) { const int dv = dv0 + ai * HALF + m * 16;
#pragma unroll
                for (int bj = 0; bj < 2; ++bj) { const int tok = tok0 + bj * HALF; const int bc = tok >> 6, tin = tok & 63;
                    const f32x4 v0 = acc[ai][bj][m][0] * cs[bj][0], v1 = acc[ai][bj][m][1] * cs[bj][1];
                    u32x4 w; w.x = pkbf(v0[0], v0[1]); w.y = pkbf(v0[2], v0[3]); w.z = pkbf(v1[0], v1[1]); w.w = pkbf(v1[2], v1[3]);
                    *(u32x4*)(VT + ((size_t)bc * 1024 + dv) * 64 + tin) = w; } }
    }
};
template <bool ROWS> struct EpiScale {
    static constexpr bool PERM = true, AFTER_DRAIN = false; __device__ static bool keep(const Unit&) { return false; }
    bf16_t* O; int ldc; const float* scale; const float* ss;
    __device__ __forceinline__ void operator()(const f32x4 (&acc)[2][2][4][2], const Unit& u, int wr, int wc, int fr, int fq) const {
        const int row0 = u.pm * BM + wr * 64 + fr, col0 = u.pn * BM + wc * 32 + 8 * fq;
        f32x4 sv[2][2];
#pragma unroll
        for (int bj = 0; bj < 2; ++bj)
#pragma unroll
            for (int n = 0; n < 2; ++n) sv[bj][n] = scale ? *(const f32x4*)(scale + col0 + bj * HALF + 4 * n) : (f32x4){1.f, 1.f, 1.f, 1.f};
        float rsc[2][4];
        if (ROWS) row_rs_fq8<32>(ss, row0, fq, rsc);
#pragma unroll
        for (int ai = 0; ai < 2; ++ai)
#pragma unroll
            for (int m = 0; m < 4; ++m) { bf16_t* rowp = O + (size_t)(row0 + ai * HALF + m * 16) * ldc + col0; const float rr = ROWS ? rsc[ai][m] : 1.f;
#pragma unroll
                for (int bj = 0; bj < 2; ++bj) { const f32x4 v0 = acc[ai][bj][m][0] * sv[bj][0] * rr, v1 = acc[ai][bj][m][1] * sv[bj][1] * rr;
                    u32x4 w; w.x = pkbf(v0[0], v0[1]); w.y = pkbf(v0[2], v0[3]); w.z = pkbf(v1[0], v1[1]); w.w = pkbf(v1[2], v1[3]);
                    *(u32x4*)(rowp + bj * HALF) = w; } }
    }
};
template <bool ACCUM> struct EpiGate {
    static constexpr bool PERM = true, AFTER_DRAIN = false; __device__ static bool keep(const Unit&) { return false; }
    bf16_t* O; const bf16_t* Gt;
    __device__ __forceinline__ void operator()(const f32x4 (&acc)[2][2][4][2], const Unit& u, int wr, int wc, int fr, int fq) const {
        const int row0 = u.pm * BM + wr * 64 + fr, col0 = u.pn * BM + wc * 32 + 8 * fq;
#pragma unroll
        for (int ai = 0; ai < 2; ++ai) {
            u32x4 gwv[4][2], owv[4][2];
#pragma unroll
            for (int m = 0; m < 4; ++m)
#pragma unroll
                for (int bj = 0; bj < 2; ++bj) { const size_t row = (size_t)(row0 + ai * HALF + m * 16);
                    gwv[m][bj] = *(const u32x4*)(Gt + row * 4096 + col0 + bj * HALF);
                    if (ACCUM) owv[m][bj] = *(const u32x4*)(O + row * 2048 + col0 + bj * HALF); }
            asm volatile("" ::: "memory");
#pragma unroll
            for (int m = 0; m < 4; ++m) { const size_t row = (size_t)(row0 + ai * HALF + m * 16);
#pragma unroll
                for (int bj = 0; bj < 2; ++bj) { const u32x4 gw = gwv[m][bj];
                    f32x4 v0 = acc[ai][bj][m][0], v1 = acc[ai][bj][m][1];
                    v0[0] *= bflo(gw.x); v0[1] *= bfhi(gw.x); v0[2] *= bflo(gw.y); v0[3] *= bfhi(gw.y); v1[0] *= bflo(gw.z); v1[1] *= bfhi(gw.z); v1[2] *= bflo(gw.w); v1[3] *= bfhi(gw.w);
                    if (ACCUM) { const u32x4 ow = owv[m][bj];
                        v0[0] += bflo(ow.x); v0[1] += bfhi(ow.x); v0[2] += bflo(ow.y); v0[3] += bfhi(ow.y); v1[0] += bflo(ow.z); v1[1] += bfhi(ow.z); v1[2] += bflo(ow.w); v1[3] += bfhi(ow.w); }
                    u32x4 w; w.x = pkbf(v0[0], v0[1]); w.y = pkbf(v0[2], v0[3]); w.z = pkbf(v1[0], v1[1]); w.w = pkbf(v1[2], v1[3]);
                    *(u32x4*)(O + row * 2048 + col0 + bj * HALF) = w; } }
            asm volatile("" ::: "memory");
        }
    }
};
struct EpiMerge {
    static constexpr bool PERM = true, AFTER_DRAIN = false; __device__ static bool keep(const Unit& u) { return u.sub == 0; }
    bf16_t* O; const unsigned char* Gt;
    __device__ __forceinline__ void operator()(f32x4 (&acc)[2][2][4][2], const Unit& u, int wr, int wc, int fr, int fq) const {
        const int row0 = u.pm * BM + wr * 64 + fr, col0 = u.pn * BM + wc * 32 + 8 * fq;
#pragma unroll
        for (int ai = 0; ai < 2; ++ai) {
            u32x2 g1[4][2], g2[4][2];
#pragma unroll
            for (int m = 0; m < 4; ++m)
#pragma unroll
                for (int bj = 0; bj < 2; ++bj) { const size_t p = (size_t)(row0 + ai * HALF + m * 16) * 4096 + col0 + bj * HALF;
                    g2[m][bj] = *(const u32x2*)(Gt + p + 2048); if (u.sub == 0) g1[m][bj] = *(const u32x2*)(Gt + p); }
            asm volatile("" ::: "memory");
#pragma unroll
            for (int m = 0; m < 4; ++m)
#pragma unroll
                for (int bj = 0; bj < 2; ++bj) { const u32x2 b = g2[m][bj];
                    float s2[8];
#pragma unroll
                    for (int e = 0; e < 4; ++e) { s2[e] = (float)((b.x >> (8 * e)) & 255u) * (1.f / 255.f); s2[4 + e] = (float)((b.y >> (8 * e)) & 255u) * (1.f / 255.f); }
#pragma unroll
                    for (int e = 0; e < 8; ++e) s2[e] = fmaxf(s2[e], 8.6736174e-19f);
                    f32x4 v0 = acc[ai][bj][m][0], v1 = acc[ai][bj][m][1];
                    if (u.sub == 0) { const u32x2 a = g1[m][bj];
                        float s1[8];
#pragma unroll
                        for (int e = 0; e < 4; ++e) { s1[e] = (float)((a.x >> (8 * e)) & 255u) * (1.f / 255.f); s1[4 + e] = (float)((a.y >> (8 * e)) & 255u) * (1.f / 255.f); }
#pragma unroll
                        for (int e = 0; e < 4; ++e) { v0[e] *= s1[e] * __builtin_amdgcn_rcpf(s2[e]); v1[e] *= s1[4 + e] * __builtin_amdgcn_rcpf(s2[4 + e]); }
                        acc[ai][bj][m][0] = v0; acc[ai][bj][m][1] = v1;
                    } else {
#pragma unroll
                        for (int e = 0; e < 4; ++e) { v0[e] *= s2[e]; v1[e] *= s2[4 + e]; }
                        u32x4 w; w.x = pkbf(v0[0], v0[1]); w.y = pkbf(v0[2], v0[3]); w.z = pkbf(v1[0], v1[1]); w.w = pkbf(v1[2], v1[3]);
                        *(u32x4*)(O + (size_t)(row0 + ai * HALF + m * 16) * 2048 + col0 + bj * HALF) = w; } }
            asm volatile("" ::: "memory");
        }
    }
};
struct EpiResid {
    static constexpr bool PERM = true, AFTER_DRAIN = false; __device__ static bool keep(const Unit&) { return false; }
    const float* xin; bf16_t* XB; float* ss;
    __device__ __forceinline__ void operator()(const f32x4 (&acc)[2][2][4][2], const Unit& u, int wr, int wc, int fr, int fq) const {
        const int row0 = u.pm * BM + wr * 64 + fr, col0 = u.pn * BM + wc * 32 + 8 * fq;
#pragma unroll
        for (int h4 = 0; h4 < 4; ++h4) { const int ai = h4 >> 1, mb = (h4 & 1) * 2;
            f32x4 xv[2][2][2];
#pragma unroll
            for (int mm = 0; mm < 2; ++mm)
#pragma unroll
                for (int bj = 0; bj < 2; ++bj) { const size_t p = (size_t)(row0 + ai * HALF + (mb + mm) * 16) * 2048 + col0 + bj * HALF; xv[mm][bj][0] = *(const f32x4*)(xin + p); xv[mm][bj][1] = *(const f32x4*)(xin + p + 4); }
            asm volatile("" ::: "memory");
#pragma unroll
            for (int mm = 0; mm < 2; ++mm) { const int m = mb + mm; const int row = row0 + ai * HALF + m * 16; const size_t rb = (size_t)row * 2048 + col0; float sq = 0.f;
#pragma unroll
                for (int bj = 0; bj < 2; ++bj) { const size_t p = rb + bj * HALF;
                    const f32x4 x0 = xv[mm][bj][0] + acc[ai][bj][m][0], x1 = xv[mm][bj][1] + acc[ai][bj][m][1];
                    sq += (x0.x * x0.x + x0.y * x0.y) + (x0.z * x0.z + x0.w * x0.w) + (x1.x * x1.x + x1.y * x1.y) + (x1.z * x1.z + x1.w * x1.w);
                    u32x4 w; w.x = pkbf(x0[0], x0[1]); w.y = pkbf(x0[2], x0[3]); w.z = pkbf(x1[0], x1[1]); w.w = pkbf(x1[2], x1[3]);
                    *(u32x4*)(XB + p) = w; }
                sq += __shfl_xor(sq, 16); sq += __shfl_xor(sq, 32);
                if (fq == 0) ss[(size_t)row * 32 + u.pn * 4 + wc] = sq; }
            asm volatile("" ::: "memory");
        }
    }
};

template <class Epi, class Sched, bool ALIGN_EPI = false, bool SP2 = false>
__device__ __forceinline__ void gemm_phase(PG8_LAS unsigned char* lds, const Gemm g, const Sched& S, const Epi& E) {
    int tid_o = threadIdx.x; asm volatile("" : "+v"(tid_o));
    const int tid = tid_o, wid = __builtin_amdgcn_readfirstlane(tid >> 6), lane = tid & 63, wr = wid >> 2, wc = wid & 3, fr = lane & 15, fq = lane >> 4;
    int K_o = g.K; asm volatile("" : "+s"(K_o));
    const int K = K_o, nt = K / BK;
    unsigned voffA[2], voffB[2];
#pragma unroll
    for (int i = 0; i < 2; ++i) { int R, C; stage_rc(tid * 16 + i * 8192, R, C); const int Rb = Epi::PERM ? ((R & ~31) + perm32(R & 31)) : R;
        voffA[i] = (unsigned)(R * g.lda + C) * 2u; voffB[i] = (unsigned)(Rb * g.ldb + C) * 2u; }
    const size_t kstep = (size_t)(BK * 2);
    const size_t hstepA = (size_t)HALF * g.lda * 2, hstepB = (size_t)HALF * g.ldb * 2;
    const size_t tstepA = 2 * hstepA, tstepB = 2 * hstepB;
    const unsigned ldsw = (unsigned)wid * 1024u;
    const int aoff = lds_byte(wr * 64 + fr, fq * 8), boff = lds_byte(wc * 32 + fr, fq * 8);
#define PG8_SA(b, h) (((b) * 2 + (h)) * HTB)
#define PG8_SB(b, h) ((4 + (b) * 2 + (h)) * HTB)
#define PG8_STAGE(bufoff, gbase, voff) do { _Pragma("unroll") for (int _i = 0; _i < 2; ++_i) \
        __builtin_amdgcn_global_load_lds((const unsigned*)((const char*)(gbase) + (voff)[_i]), (PG8_LAS unsigned*)(lds + (bufoff) + ldsw + _i * 8192), 16, 0, 0); } while (0)
#define PG8_LDA(dst, b, h) do { _Pragma("unroll") for (int m = 0; m < 4; ++m) _Pragma("unroll") for (int k = 0; k < 2; ++k) dst[m][k] = *(const PG8_LAS bf16x8*)(lds + PG8_SA(b, h) + aoff + m * 2048 + k * 1024); } while (0)
#define PG8_LDB(dst, b, h) do { _Pragma("unroll") for (int n = 0; n < 2; ++n) _Pragma("unroll") for (int k = 0; k < 2; ++k) dst[n][k] = *(const PG8_LAS bf16x8*)(lds + PG8_SB(b, h) + boff + n * 2048 + k * 1024); } while (0)
#define PG8_MMA(ai, bj, At, Bt) do { __builtin_amdgcn_s_setprio(1); _Pragma("unroll") for (int m = 0; m < 4; ++m) _Pragma("unroll") for (int n = 0; n < 2; ++n) _Pragma("unroll") for (int k = 0; k < 2; ++k) \
        acc[ai][bj][m][n] = __builtin_amdgcn_mfma_f32_16x16x32_bf16(Bt[n][k], At[m][k], acc[ai][bj][m][n], 0, 0, 0); __builtin_amdgcn_s_setprio(0); } while (0)
#define PG8_WAIT_V(n) asm volatile("s_waitcnt vmcnt(" #n ")" ::: "memory")
#define PG8_WAIT_L(n) asm volatile("s_waitcnt lgkmcnt(" #n ")" ::: "memory")
#define PG8_BAR __builtin_amdgcn_s_barrier()
#define PG8_SCHED __builtin_amdgcn_sched_barrier(0)
    Unit cur, nxt; int ui = 0;
    if (!S.next(0, cur)) return;
    f32x4 acc[2][2][4][2];
    float zf = 0.f; asm volatile("" : "+v"(zf));
#pragma unroll
    for (int a = 0; a < 2; ++a)
#pragma unroll
        for (int b = 0; b < 2; ++b)
#pragma unroll
            for (int m = 0; m < 4; ++m)
#pragma unroll
                for (int n = 0; n < 2; ++n) acc[a][b][m][n] = (f32x4){zf, zf, zf, zf};
    bf16x8 At[4][2], B0[2][2], B1[2][2];
    const char* cA = (const char*)(cur.sub ? g.A2 : g.A) + (size_t)cur.pm * tstepA + (size_t)cur.pn * g.a_pn_step; const char* cB = (const char*)(cur.sub ? g.Bt2 : g.Bt) + (size_t)cur.pn * tstepB;
    S.a_ready(cur);
    if constexpr (SP2) {
        PG8_STAGE(PG8_SB(0, 0), cB, voffB); PG8_STAGE(PG8_SB(0, 1), cB + hstepB, voffB); PG8_STAGE(PG8_SA(0, 0), cA, voffA); PG8_STAGE(PG8_SA(0, 1), cA + hstepA, voffA);
        if (wr == 1) PG8_BAR;
        PG8_WAIT_V(2); PG8_BAR;
        PG8_STAGE(PG8_SB(1, 0), cB + kstep, voffB); PG8_STAGE(PG8_SA(1, 0), cA + kstep, voffA); PG8_STAGE(PG8_SB(1, 1), cB + hstepB + kstep, voffB);
        PG8_WAIT_V(6); PG8_BAR;
    } else {
        PG8_STAGE(PG8_SB(0, 0), cB, voffB); PG8_STAGE(PG8_SA(0, 0), cA, voffA); PG8_STAGE(PG8_SB(0, 1), cB + hstepB, voffB); PG8_STAGE(PG8_SA(0, 1), cA + hstepA, voffA);
        if (wr == 1) PG8_BAR;
        PG8_WAIT_V(4); PG8_BAR;
        PG8_STAGE(PG8_SB(1, 0), cB + kstep, voffB); PG8_STAGE(PG8_SA(1, 0), cA + kstep, voffA); PG8_STAGE(PG8_SB(1, 1), cB + hstepB + kstep, voffB);
        PG8_WAIT_V(6); PG8_BAR;
    }
    for (;;) {
        const bool has_next = S.next(ui + 1, nxt);
        const char* nA = has_next ? (const char*)(nxt.sub ? g.A2 : g.A) + (size_t)nxt.pm * tstepA + (size_t)nxt.pn * g.a_pn_step : cA; const char* nB = has_next ? (const char*)(nxt.sub ? g.Bt2 : g.Bt) + (size_t)nxt.pn * tstepB : cB;
        for (int t = 0; t < nt; t += 2) {
            const bool last = (t == nt - 2);
            const char* a1 = cA + (size_t)(t + 1) * kstep;
            const char* a2 = last ? nA : cA + (size_t)(t + 2) * kstep; const char* b2 = last ? nB : cB + (size_t)(t + 2) * kstep;
            const char* a3 = a2 + kstep; const char* b3 = b2 + kstep;
            if (last && has_next) S.a_ready(nxt);
            if constexpr (SP2) {
            PG8_LDB(B0, 0, 0); PG8_LDB(B1, 0, 1); PG8_SCHED; PG8_LDA(At, 0, 0); PG8_STAGE(PG8_SA(1, 1), a1 + hstepA, voffA);
            PG8_WAIT_V(8); PG8_WAIT_L(0); PG8_BAR; PG8_MMA(0, 0, At, B0); PG8_MMA(0, 1, At, B1); PG8_BAR; PG8_SCHED;
            PG8_LDA(At, 0, 1); PG8_STAGE(PG8_SB(0, 0), b2, voffB); PG8_STAGE(PG8_SB(0, 1), b2 + hstepB, voffB); PG8_STAGE(PG8_SA(0, 0), a2, voffA);
            PG8_WAIT_V(8); PG8_WAIT_L(0); PG8_BAR; PG8_MMA(1, 0, At, B0); PG8_MMA(1, 1, At, B1); PG8_BAR; PG8_SCHED;
            PG8_LDB(B0, 1, 0); PG8_LDB(B1, 1, 1); PG8_SCHED; PG8_LDA(At, 1, 0); PG8_STAGE(PG8_SA(0, 1), a2 + hstepA, voffA);
            PG8_WAIT_V(8); PG8_WAIT_L(0); PG8_BAR; PG8_MMA(0, 0, At, B0); PG8_MMA(0, 1, At, B1); PG8_BAR; PG8_SCHED;
            PG8_LDA(At, 1, 1); PG8_STAGE(PG8_SB(1, 0), b3, voffB); PG8_STAGE(PG8_SB(1, 1), b3 + hstepB, voffB); PG8_STAGE(PG8_SA(1, 0), a3, voffA);
            PG8_WAIT_V(8); PG8_WAIT_L(0); PG8_BAR; PG8_MMA(1, 0, At, B0); PG8_MMA(1, 1, At, B1); PG8_BAR; PG8_SCHED;
            } else {
            PG8_LDB(B0, 0, 0); PG8_SCHED; PG8_LDA(At, 0, 0); PG8_STAGE(PG8_SA(1, 1), a1 + hstepA, voffA);
            PG8_WAIT_L(8); PG8_BAR; PG8_WAIT_L(0); PG8_MMA(0, 0, At, B0); PG8_BAR; PG8_SCHED;
            PG8_LDB(B1, 0, 1); PG8_STAGE(PG8_SB(0, 0), b2, voffB);
            PG8_BAR; PG8_WAIT_L(0); PG8_MMA(0, 1, At, B1); PG8_BAR;
            PG8_LDA(At, 0, 1); PG8_STAGE(PG8_SA(0, 0), a2, voffA);
            PG8_BAR; PG8_WAIT_L(0); PG8_MMA(1, 0, At, B0); PG8_BAR; PG8_SCHED;
            PG8_STAGE(PG8_SB(0, 1), b2 + hstepB, voffB);
            PG8_WAIT_V(6); PG8_BAR; PG8_MMA(1, 1, At, B1); PG8_BAR;
            PG8_LDB(B0, 1, 0); PG8_SCHED; PG8_LDA(At, 1, 0); PG8_STAGE(PG8_SA(0, 1), a2 + hstepA, voffA);
            PG8_WAIT_L(8); PG8_BAR; PG8_WAIT_L(0); PG8_MMA(0, 0, At, B0); PG8_BAR; PG8_SCHED;
            PG8_LDB(B1, 1, 1); PG8_STAGE(PG8_SB(1, 0), b3, voffB);
            PG8_BAR; PG8_WAIT_L(0); PG8_MMA(0, 1, At, B1); PG8_BAR;
            PG8_LDA(At, 1, 1); PG8_STAGE(PG8_SA(1, 0), a3, voffA);
            PG8_BAR; PG8_WAIT_L(0); PG8_MMA(1, 0, At, B0); PG8_BAR; PG8_SCHED;
            PG8_STAGE(PG8_SB(1, 1), b3 + hstepB, voffB);
            PG8_WAIT_V(6); PG8_BAR; PG8_MMA(1, 1, At, B1); PG8_BAR;
            }
        }
        if constexpr (ALIGN_EPI) { if (wr == 0) PG8_BAR; }
        if constexpr (!Epi::AFTER_DRAIN) { E(acc, cur, wr, wc, fr, fq); S.done(cur); }
        if (!has_next) break;
        if (!Epi::keep(cur)) {
        float zf2 = 0.f; asm volatile("" : "+v"(zf2));
#pragma unroll
        for (int a = 0; a < 2; ++a)
#pragma unroll
            for (int b = 0; b < 2; ++b)
#pragma unroll
                for (int m = 0; m < 4; ++m)
#pragma unroll
                    for (int n = 0; n < 2; ++n) acc[a][b][m][n] = (f32x4){zf2, zf2, zf2, zf2};
        }
        cur = nxt; cA = nA; cB = nB; ++ui;
        if constexpr (ALIGN_EPI) { if (wr == 1) PG8_BAR; }
    }
    PG8_WAIT_V(0);
    if constexpr (!ALIGN_EPI) { if (wr == 0) PG8_BAR; }
    PG8_BAR;
    if constexpr (Epi::AFTER_DRAIN) { E.fused(acc, cur, wr, wc, fr, fq, lds, wid, lane); S.done(cur); }
#undef PG8_SA
#undef PG8_SB
#undef PG8_STAGE
#undef PG8_LDA
#undef PG8_LDB
#undef PG8_MMA
#undef PG8_WAIT_V
#undef PG8_WAIT_L
#undef PG8_BAR
#undef PG8_SCHED
}
}

#define GAS __attribute__((address_space(1)))
#define LAS __attribute__((address_space(3)))
typedef unsigned short bf16;
typedef unsigned v4u __attribute__((ext_vector_type(4)));
typedef float f32x4 __attribute__((ext_vector_type(4)));
typedef short bf16x8 __attribute__((ext_vector_type(8)));
typedef GAS unsigned gu32;
typedef GAS unsigned long long gu64;
#define RLX_AGENT __ATOMIC_RELAXED, __HIP_MEMORY_SCOPE_AGENT
#define LDS_WAIT() asm volatile("s_waitcnt lgkmcnt(0)" ::: "memory")
#define VM_WAIT() asm volatile("s_waitcnt vmcnt(0)" ::: "memory")
__device__ __forceinline__ unsigned long long rt() { return __builtin_amdgcn_s_memrealtime(); }
__device__ __forceinline__ unsigned f2bf(float f) { unsigned u = __builtin_bit_cast(unsigned, f); return (u + 0x7fffu + ((u >> 16) & 1u)) >> 16; }
__device__ __forceinline__ unsigned pk2(float lo, float hi) { return f2bf(lo) | (f2bf(hi) << 16); }

#define XB_TMO      128
#define XB_XCNT(j)  (256  + 64 * (j))
#define XB_XSUB(j)  (1280 + 64 * (j))
#define XB_XGEN(j)  (2304 + 64 * (j))
#define XB_TOP      3328
#define XB_TOPGEN   3392
#define XCD_BAR_WORDS 3456
#define XB_SPIN_CAP (1u << 18)

__device__ __forceinline__ unsigned xb_ld(unsigned* p)              { return __hip_atomic_load(p, __ATOMIC_RELAXED, __HIP_MEMORY_SCOPE_AGENT); }
__device__ __forceinline__ unsigned xb_add(unsigned* p, unsigned v) { return __hip_atomic_fetch_add(p, v, __ATOMIC_RELAXED, __HIP_MEMORY_SCOPE_AGENT); }
__device__ __forceinline__ unsigned xb_xcc_id() { return (unsigned)__builtin_amdgcn_s_getreg((3 << 11) | 20) & 0xFu; }
#define XB_SPIN(cond, bar) do { unsigned _sp = 0; while (cond) { __builtin_amdgcn_s_sleep(1); \
    if ((++_sp & 255u) == 0u) { if (xb_ld(&(bar)[XB_TMO])) break; if (_sp > XB_SPIN_CAP) { atomicAdd(&(bar)[XB_TMO], 1u); break; } } } } while (0)

struct XcdBarrier {
    unsigned* bar; unsigned x;
    volatile LAS unsigned* st;
};

__device__ __forceinline__ XcdBarrier xcd_barrier_post(unsigned* bar, volatile LAS unsigned* st) {
    XcdBarrier b; b.bar = bar; b.x = xb_xcc_id(); b.st = st;
    if (threadIdx.x == 0) (void)xb_add(&bar[XB_XCNT(b.x)], 1u);
    return b;
}
__device__ __forceinline__ void xcd_barrier_complete(unsigned* bar, unsigned x, unsigned& nloc, unsigned& nx) {
    const unsigned G = gridDim.x * gridDim.y * gridDim.z;
    unsigned sum, cnt, mine, sp = 0u;
    for (;;) {
        sum = 0u; cnt = 0u; mine = 0u;
#pragma unroll
        for (unsigned j = 0; j < 16; ++j) { const unsigned c = xb_ld(&bar[XB_XCNT(j)]); sum += c; cnt += (c > 0u) ? 1u : 0u; mine = (j == x) ? c : mine; }
        if (sum == G) break;
        __builtin_amdgcn_s_sleep(1);
        if ((++sp & 255u) == 0u) { if (xb_ld(&bar[XB_TMO])) break; if (sp > XB_SPIN_CAP) { atomicAdd(&bar[XB_TMO], 1u); break; } }
    }
    nloc = mine > 0u ? mine : 1u; nx = cnt > 0u ? cnt : 1u;
}

__device__ __forceinline__ void xcd_barrier(const XcdBarrier& b) {
    asm volatile("s_waitcnt vmcnt(0)" ::: "memory");
    __syncthreads();
    if (threadIdx.x == 0) {
        unsigned* bar = b.bar;
        __builtin_amdgcn_s_waitcnt(0);
        unsigned nloc = b.st[0], nx = b.st[1];
        if (nloc == 0u) { xcd_barrier_complete(bar, b.x, nloc, nx); b.st[0] = nloc; b.st[1] = nx; }
        const unsigned old = xb_add(&bar[XB_XSUB(b.x)], 1u);
        const unsigned gen = old / nloc;
        if (old + 1u == (gen + 1u) * nloc) {
            __builtin_amdgcn_fence(__ATOMIC_RELEASE, "agent");
            asm volatile("s_waitcnt vmcnt(0)" ::: "memory");
            const unsigned og = xb_add(&bar[XB_TOP], 1u);
            const unsigned tg = og / nx;
            if (og + 1u == (tg + 1u) * nx) xb_add(&bar[XB_TOPGEN], 1u);
            else XB_SPIN(xb_ld(&bar[XB_TOPGEN]) == tg, bar);
            __builtin_amdgcn_fence(__ATOMIC_ACQUIRE, "agent");
            xb_add(&bar[XB_XGEN(b.x)], 1u);
            asm volatile("s_waitcnt vmcnt(0)" ::: "memory");
        } else {
            XB_SPIN(xb_ld(&bar[XB_XGEN(b.x)]) == gen, bar);
            __builtin_amdgcn_fence(__ATOMIC_ACQUIRE, "agent");
            asm volatile("s_waitcnt vmcnt(0)" ::: "memory");
        }
    }
    __syncthreads();
}

constexpr int D = 2048, SEQ = 16384, M = 32768, DEPTH = 2;
constexpr int NCH = 256;
constexpr int NSEG = 16, CPS = NCH / NSEG;
constexpr int DIN = 8224;
constexpr float RMS_EPS = 1e-6f;
constexpr int NWAVES = 8;
constexpr int NPH = 15;

constexpr size_t MiB = 1u << 20;
constexpr size_t WS_CTL = 0, CTL_ZERO_BYTES = 1 * MiB;
constexpr size_t WS_WIN = 1 * MiB;
constexpr size_t WS_WUPG = 34 * MiB;
constexpr size_t WS_WUPP = 38 * MiB;
constexpr size_t WS_WOUT = 42 * MiB;
constexpr size_t WS_WQ = 50 * MiB;
constexpr size_t WS_POOLW = 58 * MiB;
constexpr size_t WS_SUBK = 58 * MiB + 512 * 1024;
constexpr size_t WS_USC = 59 * MiB, WS_VSC = 59 * MiB + 512 * 1024;
constexpr size_t WS_UTAB = 60 * MiB, WS_VTAB = 124 * MiB;
constexpr size_t WS_H = 188 * MiB;
constexpr size_t WS_POOLED = WS_H, WS_POOLMIX = WS_H + 64 * MiB, WS_SEGL = WS_H + 64 * MiB, WS_SIN = WS_H + 96 * MiB;
constexpr size_t WS_QK = 316 * MiB;
constexpr size_t WS_P = 380 * MiB;
constexpr size_t WS_VT = 444 * MiB;
constexpr size_t WS_R = 508 * MiB;
constexpr size_t WS_MERGED = WS_VT;
constexpr size_t WS_G = 572 * MiB;
constexpr size_t WS_PQ = WS_G, WS_IDX = 700 * MiB, WS_GATE = 716 * MiB;
constexpr size_t WS_AFB = 828 * MiB;
constexpr size_t WS_QE = 832 * MiB;
constexpr size_t WS_GLAOUT = WS_QE;
constexpr size_t WS_KDT = 896 * MiB;
constexpr size_t WS_ATTN = 960 * MiB;
constexpr size_t WS_DEC = 992 * MiB;
constexpr size_t WS_SSP1 = 994 * MiB, WS_SSP2 = 998 * MiB;
constexpr size_t WS_END = 1000 * MiB;
constexpr int CW_BAR = 4096;

constexpr int RING_BYTES = 131072;
constexpr int LDSCTL_OFF = RING_BYTES, MISC_OFF = LDSCTL_OFF + 320;
constexpr int LDS_BYTES = 147456;

typedef unsigned v2u __attribute__((ext_vector_type(2)));
typedef float f32x2 __attribute__((ext_vector_type(2)));
typedef float f32x16 __attribute__((ext_vector_type(16)));
using pg8::pkbf; using pg8::bflo; using pg8::bfhi;
__device__ __forceinline__ float bf2f(bf16 h) { return __builtin_bit_cast(float, (unsigned)h << 16); }
__device__ __forceinline__ bf16 f2bf1(float f) { return (bf16)(pkbf(f, 0.f) & 0xffffu); }
__device__ __forceinline__ float wave_sum(float v) {
#pragma unroll
    for (int o = 1; o < 64; o <<= 1) v += __shfl_xor(v, o);
    return v;
}
__device__ __forceinline__ float wave_max(float v) {
#pragma unroll
    for (int o = 1; o < 64; o <<= 1) v = fmaxf(v, __shfl_xor(v, o));
    return v;
}
__device__ __forceinline__ f32x16 mfma32(bf16x8 a, bf16x8 b, f32x16 c) { return __builtin_amdgcn_mfma_f32_32x32x16_bf16(a, b, c, 0, 0, 0); }
__device__ __forceinline__ bf16x8 mk8(unsigned a, unsigned b, unsigned c, unsigned d) { v4u t = {a, b, c, d}; return __builtin_bit_cast(bf16x8, t); }

#define LDS_BAR() do { asm volatile("s_waitcnt lgkmcnt(0)" ::: "memory"); __builtin_amdgcn_s_barrier(); asm volatile("" ::: "memory"); } while (0)
__device__ __forceinline__ void transpose_item(const float* __restrict__ W, int N, bf16* WT, int ldt, int dst_row0, int k0, int n0, LAS float* scr, int lane, const float* __restrict__ gk = nullptr) {
#pragma unroll
    for (int i = 0; i < 8; ++i) { const int kk = 8 * i + (lane >> 3), c4 = 4 * (lane & 7); f32x4 v = *(const f32x4*)(W + (size_t)(k0 + kk) * N + n0 + c4);
        if (gk) v = v * gk[k0 + kk];
        LAS float* d = scr + kk * 33 + c4; d[0] = v.x; d[1] = v.y; d[2] = v.z; d[3] = v.w; }
    LDS_WAIT(); asm volatile("" ::: "memory");
    const int c = lane & 7;
#pragma unroll
    for (int j = 0; j < 4; ++j) { const int n = (lane >> 3) + 8 * j; const LAS float* s = scr + (8 * c) * 33 + n;
        v4u o; o.x = pkbf(s[0 * 33], s[1 * 33]); o.y = pkbf(s[2 * 33], s[3 * 33]); o.z = pkbf(s[4 * 33], s[5 * 33]); o.w = pkbf(s[6 * 33], s[7 * 33]);
        *(GAS v4u*)(WT + (size_t)(dst_row0 + n) * ldt + k0 + 8 * c) = o; }
    LDS_WAIT(); asm volatile("" ::: "memory");
}
__device__ __forceinline__ void transpose_matrix(const float* W, int K, int N, bf16* WT, LAS float* scr, int lane, int gw, int NGW) {
    const int nblk = N / 32, items = (K / 64) * nblk;
    for (int it = gw; it < items; it += NGW) { const int kb = it / nblk, nb = it % nblk; transpose_item(W, N, WT, K, nb * 32, kb * 64, nb * 32, scr, lane); }
}
__device__ __forceinline__ void table_rows_fp8(const float* __restrict__ T, unsigned* __restrict__ O, float* __restrict__ inv, int rowA, int rowB, int lane, const float* __restrict__ gc = nullptr) {
    const f32x4* sa = (const f32x4*)(T + (size_t)rowA * 2048) + lane; const f32x4* sb = (const f32x4*)(T + (size_t)rowB * 2048) + lane;
    f32x4 va[8], vb[8]; float ama = 0.f, amb = 0.f;
#pragma unroll
    for (int j = 0; j < 8; ++j) { va[j] = sa[64 * j]; vb[j] = sb[64 * j]; }
    if (gc) {
#pragma unroll
        for (int j = 0; j < 8; ++j) { const f32x4 gq = ((const f32x4*)gc)[64 * j + lane]; va[j] = va[j] * gq; vb[j] = vb[j] * gq; } }
#pragma unroll
    for (int j = 0; j < 8; ++j) { ama = fmaxf(ama, fmaxf(fmaxf(fabsf(va[j].x), fabsf(va[j].y)), fmaxf(fabsf(va[j].z), fabsf(va[j].w)))); amb = fmaxf(amb, fmaxf(fmaxf(fabsf(vb[j].x), fabsf(vb[j].y)), fmaxf(fabsf(vb[j].z), fabsf(vb[j].w)))); }
#pragma unroll
    for (int o = 1; o < 64; o <<= 1) { ama = fmaxf(ama, __shfl_xor(ama, o)); amb = fmaxf(amb, __shfl_xor(amb, o)); }
    float ea = (ama > 1e-30f) ? floorf(__log2f(224.f / ama)) : 0.f; ea = fminf(fmaxf(ea, -60.f), 60.f);
    float eb = (amb > 1e-30f) ? floorf(__log2f(224.f / amb)) : 0.f; eb = fminf(fmaxf(eb, -60.f), 60.f);
    const float sca = exp2f(ea), scb = exp2f(eb);
#pragma unroll
    for (int j = 0; j < 8; ++j) { const int dw = 64 * j + lane; int w = 0;
        w = __builtin_amdgcn_cvt_pk_fp8_f32(va[j].x * sca, va[j].y * sca, w, false); w = __builtin_amdgcn_cvt_pk_fp8_f32(va[j].z * sca, va[j].w * sca, w, true);
        O[((size_t)(dw >> 5) * 16384 + rowA) * 32 + (dw & 31)] = (unsigned)w; w = 0;
        w = __builtin_amdgcn_cvt_pk_fp8_f32(vb[j].x * scb, vb[j].y * scb, w, false); w = __builtin_amdgcn_cvt_pk_fp8_f32(vb[j].z * scb, vb[j].w * scb, w, true);
        O[((size_t)(dw >> 5) * 16384 + rowB) * 32 + (dw & 31)] = (unsigned)w; }
    if (lane == 0) { inv[rowA] = exp2f(-ea); inv[rowB] = exp2f(-eb); }
}
__device__ __forceinline__ void rmsnorm_row(const float* xrow, const float* __restrict__ g, bf16* orow, int lane) {
    const f32x4* xr = (const f32x4*)xrow + lane; const f32x4* gr = (const f32x4*)g + lane;
    f32x4 v[8]; float s = 0.f;
#pragma unroll
    for (int j = 0; j < 8; ++j) { v[j] = xr[64 * j]; s += (v[j].x * v[j].x + v[j].y * v[j].y) + (v[j].z * v[j].z + v[j].w * v[j].w); }
    const float rs = rsqrtf(wave_sum(s) * (1.f / 2048.f) + RMS_EPS);
    v2u* o8 = (v2u*)orow + lane;
#pragma unroll
    for (int j = 0; j < 8; ++j) { const f32x4 gg = gr[64 * j]; v2u o; o.x = pkbf(v[j].x * rs * gg.x, v[j].y * rs * gg.y); o.y = pkbf(v[j].z * rs * gg.z, v[j].w * rs * gg.w); o8[64 * j] = o; }
}

constexpr int PA_A = 0, PA_QT = 4096, PA_Q = 8192, PA_K = PA_Q + 17408, PA_KE = PA_K + 17408, PA_BYTES = PA_KE + 17408;
static_assert(2 * PA_BYTES <= RING_BYTES, "prep LDS");
struct PrepIn { f32x4 a; unsigned q[8], k[8]; float wg[2][16]; float bias[2]; };
__device__ __forceinline__ void gla_prep_load(PrepIn& in, int uid, const bf16* __restrict__ QK, const float* __restrict__ AFB, const float* __restrict__ Wgf, const float* __restrict__ Bgf,
                                              const float* __restrict__ Wgb, const float* __restrict__ Bgb, int tid) {
    const int dir = uid & 1, h = (uid >> 1) & 3, bn = uid >> 3; const size_t row0 = (size_t)bn * 64;
    const float* Wg = dir ? Wgb : Wgf; const float* Bg = dir ? Bgb : Bgf;
    { const int t = (tid & 255) >> 2, q4 = tid & 3; in.a = *(const f32x4*)(AFB + (row0 + t) * 32 + dir * 16 + 4 * q4); }
    const int c2 = tid & 63, tq = tid >> 6;
#pragma unroll
    for (int j = 0; j < 8; ++j) { const bf16* src = QK + (row0 + tq * 8 + j) * 1024 + h * 128 + 2 * c2; in.q[j] = *(const unsigned*)src; in.k[j] = *(const unsigned*)(src + 512); }
#pragma unroll
    for (int r = 0; r < 16; ++r) { const f32x2 w2 = *(const f32x2*)(Wg + r * 512 + h * 128 + 2 * c2); in.wg[0][r] = w2.x; in.wg[1][r] = w2.y; }
    { const f32x2 b2 = *(const f32x2*)(Bg + h * 128 + 2 * c2); in.bias[0] = b2.x; in.bias[1] = b2.y; }
}
__device__ __forceinline__ void gla_prep_unit(int uid, int uid_next, PrepIn& in, LAS unsigned char* lds, const bf16* __restrict__ QK, const float* __restrict__ AFB, const float* __restrict__ Wgf, const float* __restrict__ Bgf,
                                              const float* __restrict__ Wgb, const float* __restrict__ Bgb, bf16* QE, bf16* KDT, bf16* ATTN, float* DEC, int tid, int wave, int lane) {
    const int dir = uid & 1;
    LAS float* aS = (LAS float*)(lds + PA_A); LAS float* qtot = (LAS float*)(lds + PA_QT);
    LAS bf16* qS = (LAS bf16*)(lds + PA_Q); LAS bf16* kS = (LAS bf16*)(lds + PA_K); LAS bf16* keS = (LAS bf16*)(lds + PA_KE);
    if (tid < 256) { const int t = tid >> 2, q4 = tid & 3; *(LAS f32x4*)(aS + t * 16 + 4 * q4) = in.a; }
    const int c2 = tid & 63, tq = tid >> 6;
    unsigned qv[8], kv[8]; float wg0[16], wg1[16];
#pragma unroll
    for (int j = 0; j < 8; ++j) { qv[j] = in.q[j]; kv[j] = in.k[j]; }
#pragma unroll
    for (int r = 0; r < 16; ++r) { wg0[r] = in.wg[0][r]; wg1[r] = in.wg[1][r]; }
    const float bias0 = in.bias[0], bias1 = in.bias[1];
    gla_prep_load(in, uid_next, QK, AFB, Wgf, Bgf, Wgb, Bgb, tid);
    LDS_BAR();
    float lg0[8], lg1[8], P0[8], P1[8]; float run0 = 0.f, run1 = 0.f;
#pragma unroll
    for (int j = 0; j < 8; ++j) { const int t = tq * 8 + j;
        const f32x4 a0 = *(const LAS f32x4*)(aS + t * 16), a1 = *(const LAS f32x4*)(aS + t * 16 + 4), a2 = *(const LAS f32x4*)(aS + t * 16 + 8), a3 = *(const LAS f32x4*)(aS + t * 16 + 12);
        f32x2 z2 = {bias0, bias1};
        const float av[16] = {a0.x, a0.y, a0.z, a0.w, a1.x, a1.y, a1.z, a1.w, a2.x, a2.y, a2.z, a2.w, a3.x, a3.y, a3.z, a3.w};
#pragma unroll
        for (int r2 = 0; r2 < 16; ++r2) z2 = __builtin_elementwise_fma((f32x2){av[r2], av[r2]}, (f32x2){wg0[r2], wg1[r2]}, z2);
        const float z0 = z2.x, z1 = z2.y;
        lg0[j] = (fminf(z0, 0.f) - __logf(1.f + __expf(-fabsf(z0)))) * (1.f / 16.f); lg1[j] = (fminf(z1, 0.f) - __logf(1.f + __expf(-fabsf(z1)))) * (1.f / 16.f);
        run0 += lg0[j]; run1 += lg1[j]; P0[j] = run0; P1[j] = run1; }
    *(LAS f32x2*)(qtot + tq * 128 + 2 * c2) = (f32x2){run0, run1};
    LDS_BAR();
    float btot0 = 0.f, btot1 = 0.f, off0 = 0.f, off1 = 0.f;
#pragma unroll
    for (int g8 = 0; g8 < 8; ++g8) { const f32x2 v = *(const LAS f32x2*)(qtot + g8 * 128 + 2 * c2); btot0 += v.x; btot1 += v.y;
        const bool before = dir ? (g8 > tq) : (g8 < tq); off0 += before ? v.x : 0.f; off1 += before ? v.y : 0.f; }
    const float dt0 = __expf(btot0), dt1 = __expf(btot1);
    if (tq == 0) *(f32x2*)(DEC + (size_t)uid * 128 + 2 * c2) = (f32x2){dt0, dt1};
#pragma unroll
    for (int j = 0; j < 8; ++j) { const int t = tq * 8 + j;
        const float b0 = (dir ? (run0 - P0[j] + lg0[j]) : P0[j]) + off0, b1 = (dir ? (run1 - P1[j] + lg1[j]) : P1[j]) + off1;
        const float q0 = bflo(qv[j]), q1 = bfhi(qv[j]), k0 = bflo(kv[j]), k1 = bfhi(kv[j]);
        const float e0 = __expf(b0), e1 = __expf(b1), i0 = __builtin_amdgcn_rcpf(e0), i1 = __builtin_amdgcn_rcpf(e1);
        *(LAS unsigned*)(qS + t * 136 + 2 * c2) = pkbf(q0 * e0, q1 * e1);
        *(LAS unsigned*)(keS + t * 136 + 2 * c2) = pkbf(k0 * i0, k1 * i1);
        *(LAS unsigned*)(kS + t * 136 + 2 * c2) = pkbf(k0 * (dt0 * i0), k1 * (dt1 * i1)); }
    LDS_BAR();
    const int r = lane & 31, hh = lane >> 5;
    if (wave < 4) {
        const int jt = wave >> 1, it = wave & 1;
        f32x16 acc;
#pragma unroll
        for (int e = 0; e < 16; ++e) acc[e] = 0.f;
#pragma unroll
        for (int s = 0; s < 8; ++s) { const bf16x8 A = *(const LAS bf16x8*)(keS + (32 * jt + r) * 136 + 16 * s + 8 * hh); const bf16x8 B = *(const LAS bf16x8*)(qS + (32 * it + r) * 136 + 16 * s + 8 * hh); acc = mfma32(A, B, acc); }
        const int i = 32 * it + r; float v[16];
#pragma unroll
        for (int e = 0; e < 16; ++e) { const int j = 32 * jt + (e & 3) + 8 * (e >> 2) + 4 * hh; const bool keep = dir ? (j > i) : (j <= i); v[e] = keep ? acc[e] : 0.f; }
#pragma unroll
        for (int s2 = 0; s2 < 2; ++s2) { v4u o; o.x = pkbf(v[8 * s2 + 0], v[8 * s2 + 1]); o.y = pkbf(v[8 * s2 + 2], v[8 * s2 + 3]); o.z = pkbf(v[8 * s2 + 4], v[8 * s2 + 5]); o.w = pkbf(v[8 * s2 + 6], v[8 * s2 + 7]);
            *(v4u*)(ATTN + (size_t)uid * 4096 + (size_t)((it * 4 + 2 * jt + s2) * 64 + lane) * 8) = o; }
    }
#pragma unroll
    for (int e = 0; e < 2; ++e) { const int f = wave * 2 + e;
        {
            const int it = f >> 3, ks = f & 7, dt = ks >> 1, s2 = ks & 1;
            const LAS bf16* base = qS + (32 * it + r) * 136 + 32 * dt + 16 * s2 + 4 * hh;
            const v2u lo = *(const LAS v2u*)base, hi = *(const LAS v2u*)(base + 8);
            v4u o = {lo.x, lo.y, hi.x, hi.y};
            *(v4u*)(QE + (size_t)uid * 8192 + (size_t)(f * 64 + lane) * 8) = o; }
        {
            const int dt = f >> 2, ks = f & 3, dim = 32 * dt + r;
            unsigned w[4];
#pragma unroll
            for (int p2 = 0; p2 < 4; ++p2) { const int j0 = 2 * p2, j1 = 2 * p2 + 1;
                const int t0 = 16 * ks + 8 * (j0 >> 2) + 4 * hh + (j0 & 3), t1 = 16 * ks + 8 * (j1 >> 2) + 4 * hh + (j1 & 3);
                w[p2] = (unsigned)kS[t0 * 136 + dim] | ((unsigned)kS[t1 * 136 + dim] << 16); }
            v4u o = {w[0], w[1], w[2], w[3]};
            *(v4u*)(KDT + (size_t)uid * 8192 + (size_t)(f * 64 + lane) * 8) = o; }
    }
}

__device__ __forceinline__ void pool_item(int item, const bf16* __restrict__ P, bf16* __restrict__ PO) {
    const int oct = item & 127, run = item >> 7; const int m0 = run * 32, b = m0 >> 14, t0 = m0 & (SEQ - 1);
    const int g = oct >> 5, hw = 1 << g;
    const bf16* Pb = P + (size_t)b * SEQ * 1024 + oct * 8; bf16* Ob = PO + (size_t)b * SEQ * 1024 + oct * 8;
    float s[8];
#pragma unroll
    for (int e = 0; e < 8; ++e) s[e] = 0.f;
    const int lo0 = (t0 - hw > 0) ? t0 - hw : 0, hi0 = (t0 + hw < SEQ) ? t0 + hw : SEQ;
    for (int u = lo0; u < hi0; ++u) { const v4u w = *(const v4u*)(Pb + (size_t)u * 1024);
        s[0] += bflo(w.x); s[1] += bfhi(w.x); s[2] += bflo(w.y); s[3] += bfhi(w.y); s[4] += bflo(w.z); s[5] += bfhi(w.z); s[6] += bflo(w.w); s[7] += bfhi(w.w); }
    for (int t = t0; t < t0 + 32; ++t) {
        const int lo = (t - hw > 0) ? t - hw : 0, hi = (t + hw < SEQ) ? t + hw : SEQ; const float ic = 1.f / (float)(hi - lo);
        const v4u w = *(const v4u*)(Pb + (size_t)t * 1024);
        v4u o; o.x = pkbf(s[0] * ic - bflo(w.x), s[1] * ic - bfhi(w.x)); o.y = pkbf(s[2] * ic - bflo(w.y), s[3] * ic - bfhi(w.y));
        o.z = pkbf(s[4] * ic - bflo(w.z), s[5] * ic - bfhi(w.z)); o.w = pkbf(s[6] * ic - bflo(w.w), s[7] * ic - bfhi(w.w));
        *(v4u*)(Ob + (size_t)t * 1024) = o;
        if (t - hw >= 0) { const v4u x = *(const v4u*)(Pb + (size_t)(t - hw) * 1024);
            s[0] -= bflo(x.x); s[1] -= bfhi(x.x); s[2] -= bflo(x.y); s[3] -= bfhi(x.y); s[4] -= bflo(x.z); s[5] -= bfhi(x.z); s[6] -= bflo(x.w); s[7] -= bfhi(x.w); }
        if (t + hw < SEQ) { const v4u x = *(const v4u*)(Pb + (size_t)(t + hw) * 1024);
            s[0] += bflo(x.x); s[1] += bfhi(x.x); s[2] += bflo(x.y); s[3] += bfhi(x.y); s[4] += bflo(x.z); s[5] += bfhi(x.z); s[6] += bflo(x.w); s[7] += bfhi(x.w); }
    }
}

constexpr int SB_QE = 0, SB_AT = 16384, SB_KD = 24576, SB_DEC = 40960, SB_BYTES = 41472;
template <bool FULL> __device__ __forceinline__ void gla_scan_block(int su, LAS unsigned char* lds, const bf16* __restrict__ QE, const bf16* __restrict__ ATTN, const bf16* __restrict__ KDT,
                                                                    const float* __restrict__ DEC, const bf16* __restrict__ VT, float* SEGL, float* SEGD, bf16* OF, bf16* OB,
                                                                    int tid, int wave, int lane) {
    const int bhd = su / NSEG, seg = su % NSEG, dir = bhd & 1, h = (bhd >> 1) & 3, b = bhd >> 3;
    const int r = lane & 31, hh = lane >> 5, w = wave;
    f32x16 st[4];
    if (FULL) {
#pragma unroll
        for (int dt = 0; dt < 4; ++dt)
#pragma unroll
            for (int e = 0; e < 16; ++e) st[dt][e] = 0.f;
        for (int sp = 0; sp < seg; ++sp) { const int su2 = bhd * NSEG + sp;
#pragma unroll
            for (int dt = 0; dt < 4; ++dt) {
#pragma unroll
                for (int q = 0; q < 4; ++q) { const f32x4 d4 = *(const f32x4*)(SEGD + (size_t)su2 * 128 + 32 * dt + 8 * q + 4 * hh);
                    const size_t i0 = ((size_t)((su2 * 8 + w) * 4 + dt) * 16 + 4 * q) * 64 + lane;
                    st[dt][4 * q + 0] = d4.x * st[dt][4 * q + 0] + SEGL[i0]; st[dt][4 * q + 1] = d4.y * st[dt][4 * q + 1] + SEGL[i0 + 64];
                    st[dt][4 * q + 2] = d4.z * st[dt][4 * q + 2] + SEGL[i0 + 128]; st[dt][4 * q + 3] = d4.w * st[dt][4 * q + 3] + SEGL[i0 + 192]; } } }
    } else {
#pragma unroll
        for (int dt = 0; dt < 4; ++dt)
#pragma unroll
            for (int e = 0; e < 16; ++e) st[dt][e] = 0.f;
    }
    v4u sg[5]; v4u sdec; v2u vn[8]; bf16x8 vc[4];
#define SCAN_UID(i_) ({ const int sp_ = seg * CPS + (i_); const int n_ = dir ? (NCH - 1 - sp_) : sp_; (((b * NCH + n_) * 4 + h) * 2 + dir); })
#define SCAN_LOAD(i_) do { const int uid_ = SCAN_UID(i_); \
        if (FULL) { sg[0] = *(const v4u*)(QE + (size_t)uid_ * 8192 + (size_t)tid * 8); sg[1] = *(const v4u*)(QE + (size_t)uid_ * 8192 + (size_t)(tid + 512) * 8); \
                    sg[2] = *(const v4u*)(ATTN + (size_t)uid_ * 4096 + (size_t)tid * 8); } \
        sg[3] = *(const v4u*)(KDT + (size_t)uid_ * 8192 + (size_t)tid * 8); sg[4] = *(const v4u*)(KDT + (size_t)uid_ * 8192 + (size_t)(tid + 512) * 8); \
        if (tid < 32) sdec = *(const v4u*)(DEC + (size_t)uid_ * 128 + tid * 4); \
        const bf16* vb_ = VT + ((size_t)(uid_ >> 3) * 1024 + h * 256 + 32 * w + r) * 64 + 4 * hh; \
        _Pragma("unroll") for (int ks_ = 0; ks_ < 4; ++ks_) { vn[2 * ks_] = *(const v2u*)(vb_ + 16 * ks_); vn[2 * ks_ + 1] = *(const v2u*)(vb_ + 16 * ks_ + 8); } } while (0)
#define SCAN_STORE(buf_) do { LAS unsigned char* B_ = lds + (buf_) * SB_BYTES; \
        if (FULL) { *(LAS v4u*)(B_ + SB_QE + tid * 16) = sg[0]; *(LAS v4u*)(B_ + SB_QE + (tid + 512) * 16) = sg[1]; *(LAS v4u*)(B_ + SB_AT + tid * 16) = sg[2]; } \
        *(LAS v4u*)(B_ + SB_KD + tid * 16) = sg[3]; *(LAS v4u*)(B_ + SB_KD + (tid + 512) * 16) = sg[4]; \
        if (tid < 32) *(LAS v4u*)(B_ + SB_DEC + tid * 16) = sdec; \
        _Pragma("unroll") for (int ks_ = 0; ks_ < 4; ++ks_) vc[ks_] = mk8(vn[2 * ks_].x, vn[2 * ks_].y, vn[2 * ks_ + 1].x, vn[2 * ks_ + 1].y); } while (0)
    float dprod = 1.f;
    LDS_BAR();
    SCAN_LOAD(0); SCAN_STORE(0);
    LDS_BAR();
    for (int i = 0; i < CPS; ++i) {
        const bool more = (i + 1 < CPS);
        if (more) SCAN_LOAD(i + 1);
        const LAS unsigned char* B = lds + (i & 1) * SB_BYTES;
        if (FULL) {
            f32x16 o0, o1;
#pragma unroll
            for (int e = 0; e < 16; ++e) { o0[e] = 0.f; o1[e] = 0.f; }
#pragma unroll
            for (int dt = 0; dt < 4; ++dt)
#pragma unroll
                for (int s2 = 0; s2 < 2; ++s2) { const int ks = 2 * dt + s2;
                    const bf16x8 sf = mk8(pkbf(st[dt][8 * s2 + 0], st[dt][8 * s2 + 1]), pkbf(st[dt][8 * s2 + 2], st[dt][8 * s2 + 3]), pkbf(st[dt][8 * s2 + 4], st[dt][8 * s2 + 5]), pkbf(st[dt][8 * s2 + 6], st[dt][8 * s2 + 7]));
                    const bf16x8 a0 = *(const LAS bf16x8*)(B + SB_QE + ((0 * 8 + ks) * 64 + lane) * 16); const bf16x8 a1 = *(const LAS bf16x8*)(B + SB_QE + ((1 * 8 + ks) * 64 + lane) * 16);
                    o0 = mfma32(a0, sf, o0); o1 = mfma32(a1, sf, o1); }
#pragma unroll
            for (int ks = 0; ks < 4; ++ks) { const bf16x8 a0 = *(const LAS bf16x8*)(B + SB_AT + ((0 * 4 + ks) * 64 + lane) * 16); const bf16x8 a1 = *(const LAS bf16x8*)(B + SB_AT + ((1 * 4 + ks) * 64 + lane) * 16);
                o0 = mfma32(a0, vc[ks], o0); o1 = mfma32(a1, vc[ks], o1); }
            const int uid = SCAN_UID(i);
            bf16* Ob = (dir ? OB : OF) + (size_t)(uid >> 3) * 64 * 1024 + h * 256 + 32 * w + r;
#pragma unroll
            for (int e = 0; e < 16; ++e) { const int tk = (e & 3) + 8 * (e >> 2) + 4 * hh; Ob[(size_t)tk * 1024] = f2bf1(o0[e]); Ob[(size_t)(32 + tk) * 1024] = f2bf1(o1[e]); }
        }
#pragma unroll
        for (int dt = 0; dt < 4; ++dt) {
#pragma unroll
            for (int q = 0; q < 4; ++q) { const f32x4 d4 = *(const LAS f32x4*)(B + SB_DEC + (32 * dt + 8 * q + 4 * hh) * 4);
                st[dt][4 * q + 0] *= d4.x; st[dt][4 * q + 1] *= d4.y; st[dt][4 * q + 2] *= d4.z; st[dt][4 * q + 3] *= d4.w; }
#pragma unroll
            for (int ks = 0; ks < 4; ++ks) { const bf16x8 a = *(const LAS bf16x8*)(B + SB_KD + ((dt * 4 + ks) * 64 + lane) * 16); st[dt] = mfma32(a, vc[ks], st[dt]); }
        }
        if (!FULL && tid < 128) dprod *= *(const LAS float*)(B + SB_DEC + tid * 4);
        if (more) SCAN_STORE((i + 1) & 1);
        LDS_BAR();
    }
    if (!FULL) {
#pragma unroll
        for (int dt = 0; dt < 4; ++dt)
#pragma unroll
            for (int e = 0; e < 16; ++e) SEGL[((size_t)((su * 8 + w) * 4 + dt) * 16 + e) * 64 + lane] = st[dt][e];
        if (tid < 128) SEGD[(size_t)su * 128 + tid] = dprod;
    }
#undef SCAN_UID
#undef SCAN_LOAD
#undef SCAN_STORE
}
struct FinIn { v4u f0, f1, b0, b1, r0, r1; };
__device__ __forceinline__ void gla_fin_load(FinIn& in, int m, const bf16* __restrict__ OF, const bf16* __restrict__ OB, const bf16* __restrict__ R, int lane) {
    const size_t p = (size_t)m * 1024 + 16 * lane;
    in.f0 = *(const v4u*)(OF + p); in.f1 = *(const v4u*)(OF + p + 8); in.b0 = *(const v4u*)(OB + p); in.b1 = *(const v4u*)(OB + p + 8); in.r0 = *(const v4u*)(R + p); in.r1 = *(const v4u*)(R + p + 8);
}
__device__ __forceinline__ void gla_fin_row(const FinIn& in, int m, const float (&gg)[16], bf16* GO, int lane) {
    const size_t p = (size_t)m * 1024 + 16 * lane;
    const v4u f0 = in.f0, f1 = in.f1, b0 = in.b0, b1 = in.b1, r0 = in.r0, r1 = in.r1;
    float o[16], rr[16];
#define UNP(dst, w0, w1) do { dst[0] = bflo(w0.x); dst[1] = bfhi(w0.x); dst[2] = bflo(w0.y); dst[3] = bfhi(w0.y); dst[4] = bflo(w0.z); dst[5] = bfhi(w0.z); dst[6] = bflo(w0.w); dst[7] = bfhi(w0.w); \
        dst[8] = bflo(w1.x); dst[9] = bfhi(w1.x); dst[10] = bflo(w1.y); dst[11] = bfhi(w1.y); dst[12] = bflo(w1.z); dst[13] = bfhi(w1.z); dst[14] = bflo(w1.w); dst[15] = bfhi(w1.w); } while (0)
    float t[16]; UNP(o, f0, f1); UNP(t, b0, b1); UNP(rr, r0, r1);
#undef UNP
    float ss = 0.f;
#pragma unroll
    for (int e = 0; e < 16; ++e) { o[e] += t[e]; ss += o[e] * o[e]; }
    ss += __shfl_xor(ss, 1); ss += __shfl_xor(ss, 2); ss += __shfl_xor(ss, 4); ss += __shfl_xor(ss, 8);
    const float rs = rsqrtf(ss * (1.f / 256.f) + RMS_EPS);
    unsigned w[8];
#pragma unroll
    for (int e = 0; e < 8; ++e) w[e] = pkbf(o[2 * e] * rs * gg[2 * e] * rr[2 * e], o[2 * e + 1] * rs * gg[2 * e + 1] * rr[2 * e + 1]);
    v4u o0 = {w[0], w[1], w[2], w[3]}, o1 = {w[4], w[5], w[6], w[7]};
    *(v4u*)(GO + p) = o0; *(v4u*)(GO + p + 8) = o1;
}
__device__ __forceinline__ unsigned sortable(float f) { const unsigned b = __builtin_bit_cast(unsigned, f); return b ^ ((unsigned)((int)b >> 31) | 0x80000000u); }
__device__ __forceinline__ float unsortable(unsigned u) { const unsigned b = (u & 0x80000000u) ? (u ^ 0x80000000u) : ~u; return __builtin_bit_cast(float, b); }
__device__ __forceinline__ unsigned umax3(unsigned a, unsigned b, unsigned c) { return max(max(a, b), c); }
__device__ __forceinline__ void ce_desc(unsigned& a, unsigned& b) { const unsigned hi = max(a, b), lo = min(a, b); a = hi; b = lo; }
__device__ __forceinline__ void bitonic_sort16_desc(unsigned (&x)[16]) {
#pragma unroll
    for (int k = 2; k <= 16; k <<= 1)
#pragma unroll
        for (int j = k >> 1; j > 0; j >>= 1)
#pragma unroll
            for (int i = 0; i < 16; ++i) { const int l = i ^ j; if (l > i) { if ((i & k) == 0) ce_desc(x[i], x[l]); else ce_desc(x[l], x[i]); } }
}
__device__ __forceinline__ void bitonic_merge16_desc(unsigned (&x)[16]) {
#pragma unroll
    for (int j = 8; j > 0; j >>= 1)
#pragma unroll
        for (int i = 0; i < 16; ++i) { const int l = i ^ j; if (l > i) ce_desc(x[i], x[l]); }
}
__device__ __forceinline__ void topmerge16(unsigned (&a)[16], const unsigned (&b)[16]) {
#pragma unroll
    for (int i = 0; i < 16; ++i) a[i] = max(a[i], b[15 - i]);
    bitonic_merge16_desc(a);
}
__device__ __forceinline__ void peer_half_topk(int p, int h, const LAS unsigned char* sk, const bf16* __restrict__ PQ, size_t tok, int lane, unsigned (&Lp)[16]) {
    const int hh = lane >> 5;
    const bf16* qp = PQ + tok * 2048 + h * 256 + p * 128 + 8 * hh;
    bf16x8 bq[8];
#pragma unroll
    for (int s = 0; s < 8; ++s) bq[s] = *(const bf16x8*)(qp + 16 * s);
    unsigned key[64];
#pragma unroll
    for (int nt = 0; nt < 4; ++nt) { f32x16 sc;
#pragma unroll
        for (int e = 0; e < 16; ++e) sc[e] = 0.f;
#pragma unroll
        for (int s = 0; s < 8; ++s) { const bf16x8 a = *(const LAS bf16x8*)(sk + (((p * 4 + nt) * 8 + s) * 64 + lane) * 16); sc = mfma32(a, bq[s], sc); }
#pragma unroll
        for (int e = 0; e < 16; ++e) { const int n = 32 * nt + (e & 3) + 8 * (e >> 2) + 4 * hh; key[nt * 16 + e] = (sortable(sc[e]) & ~127u) | (unsigned)(127 - n); } }
    unsigned g0[16], g1[16], g2[16], g3[16];
#pragma unroll
    for (int e = 0; e < 16; ++e) { g0[e] = key[e]; g1[e] = key[16 + e]; g2[e] = key[32 + e]; g3[e] = key[48 + e]; }
    bitonic_sort16_desc(g0); bitonic_sort16_desc(g1); bitonic_sort16_desc(g2); bitonic_sort16_desc(g3);
    topmerge16(g0, g1); topmerge16(g2, g3); topmerge16(g0, g2);
#pragma unroll
    for (int e = 0; e < 16; ++e) g1[e] = (unsigned)__shfl_xor((int)g0[e], 32);
    topmerge16(g0, g1);
#pragma unroll
    for (int e = 0; e < 16; ++e) Lp[e] = g0[e];
}
__device__ __forceinline__ void peer_topk_item(int tile, int h, const LAS unsigned char* sk  , const bf16* __restrict__ PQ, unsigned short* IDX, float* GATE, int lane) {
    const int r = lane & 31, hh = lane >> 5; const size_t tok = (size_t)tile * 32 + r;
    unsigned L[2][16];
    peer_half_topk(0, h, sk, PQ, tok, lane, L[0]);
    __builtin_amdgcn_sched_barrier(0);
#pragma unroll
    for (int a = 0; a < 16; ++a) asm volatile("" : "+v"(L[0][a]));
    peer_half_topk(1, h, sk, PQ, tok, lane, L[1]);
    __builtin_amdgcn_sched_barrier(0);
#pragma unroll
    for (int a = 0; a < 16; ++a) asm volatile("" : "+v"(L[1][a]));
    float v0[16], v1[16];
#pragma unroll
    for (int a = 0; a < 16; ++a) { v0[a] = unsortable(L[0][a] & ~127u); v1[a] = unsortable(L[1][a] & ~127u); }
#define CKEY(a_, b_) ((sortable(v0[a_] + v1[b_]) & ~255u) | (unsigned)(255 - ((a_) * 16 + (b_))))
    unsigned R[16], T[16];
#pragma unroll
    for (int b2 = 0; b2 < 16; ++b2) R[b2] = CKEY(0, b2);
#define ROWMERGE(a_, n_) do { _Pragma("unroll") for (int b2 = 0; b2 < 16; ++b2) T[b2] = (b2 < (n_)) ? CKEY(a_, (b2 < (n_) ? b2 : 0)) : 0u; topmerge16(R, T); } while (0)
    ROWMERGE(1, 8); ROWMERGE(2, 5); ROWMERGE(3, 4); ROWMERGE(4, 3); ROWMERGE(5, 2); ROWMERGE(6, 2); ROWMERGE(7, 2);
#pragma unroll
    for (int b2 = 0; b2 < 16; ++b2) T[b2] = (b2 < 8) ? CKEY((b2 < 8 ? 8 + b2 : 8), 0) : 0u;
    topmerge16(R, T);
#undef ROWMERGE
#undef CKEY
    unsigned bk[16];
#pragma unroll
    for (int rd = 0; rd < 16; ++rd) bk[rd] = R[rd];
    float gs[16]; unsigned ex[16]; float Z = 0.f; const float s0 = unsortable(bk[0] & ~255u);
#pragma unroll
    for (int k = 0; k < 16; ++k) { const unsigned flat = 255u - (bk[k] & 255u), a = flat >> 4, b2 = flat & 15u;
        unsigned k1 = 0u, k2 = 0u;
#pragma unroll
        for (int a2 = 0; a2 < 16; ++a2) { k1 = (a == (unsigned)a2) ? L[0][a2] : k1; k2 = (b2 == (unsigned)a2) ? L[1][a2] : k2; }
        ex[k] = (127u - (k1 & 127u)) * 128u + (127u - (k2 & 127u));
        gs[k] = __expf(unsortable(bk[k] & ~255u) - s0); Z += gs[k]; }
    const float iz = 1.f / Z;
    if (hh == 0) {
        unsigned short* ip = IDX + (tok * 8 + h) * 16; float* gp = GATE + (tok * 8 + h) * 16;
        v4u i0 = {ex[0] | (ex[1] << 16), ex[2] | (ex[3] << 16), ex[4] | (ex[5] << 16), ex[6] | (ex[7] << 16)}, i1 = {ex[8] | (ex[9] << 16), ex[10] | (ex[11] << 16), ex[12] | (ex[13] << 16), ex[14] | (ex[15] << 16)};
        *(v4u*)ip = i0; *(v4u*)(ip + 8) = i1;
#pragma unroll
        for (int q = 0; q < 4; ++q) { f32x4 o = {gs[4 * q] * iz, gs[4 * q + 1] * iz, gs[4 * q + 2] * iz, gs[4 * q + 3] * iz}; *(f32x4*)(gp + 4 * q) = o; }
    }
}

__device__ __forceinline__ f32x2 dot16_fp8(const v4u w, const f32x2* hv2, f32x2 s) {
#pragma unroll
    for (int d = 0; d < 4; ++d) { const f32x2 lo = __builtin_amdgcn_cvt_pk_f32_fp8((int)w[d], false), hi = __builtin_amdgcn_cvt_pk_f32_fp8((int)w[d], true);
        s = __builtin_elementwise_fma(lo, hv2[2 * d], s); s = __builtin_elementwise_fma(hi, hv2[2 * d + 1], s); }
    return s;
}
__device__ __forceinline__ void axpy16_fp8(const v4u w, const f32x2 a2, f32x2* acc2) {
#pragma unroll
    for (int d = 0; d < 4; ++d) { const f32x2 lo = __builtin_amdgcn_cvt_pk_f32_fp8((int)w[d], false), hi = __builtin_amdgcn_cvt_pk_f32_fp8((int)w[d], true);
        acc2[2 * d] = __builtin_elementwise_fma(lo, a2, acc2[2 * d]); acc2[2 * d + 1] = __builtin_elementwise_fma(hi, a2, acc2[2 * d + 1]); }
}
__device__ __forceinline__ float gelu_erf(float x) { return 0.5f * x * (1.f + erff(x * 0.70710678118654752f)); }
template <int CTRL> __device__ __forceinline__ float dppf(float v) { return __builtin_bit_cast(float, __builtin_amdgcn_update_dpp(0, __builtin_bit_cast(int, v), CTRL, 0xF, 0xF, true)); }
__device__ __forceinline__ float sum8(float v) { v += dppf<0xB1>(v); v += dppf<0x4E>(v); v += dppf<0x141>(v); return v; }
struct PMeta { v4u ia, ib, o0, o1, o2, o3; f32x2 x1; };
__device__ __forceinline__ void peer_meta(PMeta& m, size_t tok, const unsigned short* __restrict__ IDX, int g) {
    m.ia = *(const v4u*)(IDX + tok * 128 + g * 16); m.ib = *(const v4u*)(IDX + tok * 128 + g * 16 + 8);
}
template <bool VP> __device__ __forceinline__ void peer_issue(PMeta& m, v4u (&w)[16], const unsigned char* __restrict__ tb, size_t tok, int sl, const bf16* __restrict__ XB, const float* __restrict__ ACT, const float* X, int g, int i, int c) {
    const unsigned iw[8] = {m.ia.x, m.ia.y, m.ia.z, m.ia.w, m.ib.x, m.ib.y, m.ib.z, m.ib.w};
#pragma unroll
    for (int q = 0; q < 16; ++q) { const unsigned e = (iw[q >> 1] >> (16 * (q & 1))) & 0xffffu; w[q] = *(const v4u*)(tb + (size_t)e * 128); }
    if (VP) { const v4u* ap = (const v4u*)(ACT + tok * 128 + g * 16); m.o0 = ap[0]; m.o1 = ap[1]; m.o2 = ap[2]; m.o3 = ap[3]; m.x1 = *(const f32x2*)(X + tok * 2048 + c); }
    else { const bf16* hp = XB + tok * 2048 + sl * 128 + 16 * i; m.o0 = *(const v4u*)hp; m.o1 = *(const v4u*)(hp + 8); }
}
__device__ __forceinline__ void peer_u_compute(const PMeta& m, const v4u (&w)[16], size_t tok, int label, int sub, float* PART, int g, int i) {
    const v4u h0 = m.o0, h1 = m.o1;
    const f32x2 hv2[8] = {{bflo(h0.x), bfhi(h0.x)}, {bflo(h0.y), bfhi(h0.y)}, {bflo(h0.z), bfhi(h0.z)}, {bflo(h0.w), bfhi(h0.w)}, {bflo(h1.x), bfhi(h1.x)}, {bflo(h1.y), bfhi(h1.y)}, {bflo(h1.z), bfhi(h1.z)}, {bflo(h1.w), bfhi(h1.w)}};
    float v[16];
#pragma unroll
    for (int q = 0; q < 16; ++q) { f32x2 s2 = {0.f, 0.f}; s2 = dot16_fp8(w[q], hv2, s2); v[q] = s2.x + s2.y; }
    const bool up1 = (i & 4) != 0, up2 = (i & 2) != 0, up3 = (i & 1) != 0;
    float a[8], b[4], c[2];
#pragma unroll
    for (int k = 0; k < 8; ++k) { const float send = up1 ? v[k] : v[k + 8], keep = up1 ? v[k + 8] : v[k]; a[k] = keep + dppf<0x141>(send); }
#pragma unroll
    for (int k = 0; k < 4; ++k) { const float send = up2 ? a[k] : a[k + 4], keep = up2 ? a[k + 4] : a[k]; b[k] = keep + dppf<0x4E>(send); }
#pragma unroll
    for (int k = 0; k < 2; ++k) { const float send = up3 ? b[k] : b[k + 2], keep = up3 ? b[k + 2] : b[k]; c[k] = keep + dppf<0xB1>(send); }
    *(unsigned*)((bf16*)PART + ((size_t)(2 * label + sub) * M + tok) * 128 + g * 16 + 2 * i) = pkbf(c[0], c[1]);
}
template <bool VP> __device__ __forceinline__ void peer_slice_loop(int sl, int label, int sub, int tok0, int tstep, const bf16* __restrict__ XB, const float* __restrict__ ACT, const unsigned short* __restrict__ IDX,
                                                                   const unsigned char* __restrict__ TAB, float* PART, float* X, bf16* XBn, const float* __restrict__ gn, float* ssn, int lane) {
    const int g = lane >> 3, i = lane & 7;
    const int j = ((lane >> 5) & 1) * 4 + ((lane >> 4) & 1) * 2 + ((lane >> 3) & 1), c = sl * 128 + 16 * i + 2 * j;
    const unsigned char* tb = TAB + (size_t)sl * (16384 * 128) + 16 * i;
    f32x2 gg = {0.f, 0.f}; if (VP) gg = *(const f32x2*)(gn + c);
    if (tok0 >= M) return;
    const int NT = (M - tok0 + tstep - 1) / tstep;
#define PS_TOK(k_) ((size_t)(tok0 + ((k_) < NT ? (k_) : NT - 1) * tstep))
    PMeta mA, mB, mN; v4u wA[16], wB[16];
    peer_meta(mA, PS_TOK(0), IDX, g); peer_meta(mB, PS_TOK(1), IDX, g);
    asm volatile("" : "+v"(mB.ia), "+v"(mB.ib));
    peer_issue<VP>(mA, wA, tb, PS_TOK(0), sl, XB, ACT, X, g, i, c);
    int k = 0;
    for (; k + 1 < NT; k += 2) {
        peer_meta(mN, PS_TOK(k + 2), IDX, g);
        asm volatile("" ::: "memory");
        peer_issue<VP>(mB, wB, tb, PS_TOK(k + 1), sl, XB, ACT, X, g, i, c);
        asm volatile("" ::: "memory");
        peer_u_compute(mA, wA, PS_TOK(k), label, sub, PART, g, i);
        asm volatile("" ::: "memory");
        mA.ia = mN.ia; mA.ib = mN.ib;
        peer_meta(mN, PS_TOK(k + 3), IDX, g);
        asm volatile("" ::: "memory");
        peer_issue<VP>(mA, wA, tb, PS_TOK(k + 2), sl, XB, ACT, X, g, i, c);
        asm volatile("" ::: "memory");
        peer_u_compute(mB, wB, PS_TOK(k + 1), label, sub, PART, g, i);
        asm volatile("" ::: "memory");
        mB.ia = mN.ia; mB.ib = mN.ib;
    }
    if (k < NT) { peer_u_compute(mA, wA, PS_TOK(k), label, sub, PART, g, i); }
#undef PS_TOK
}
__device__ __forceinline__ void peer_combine_row(size_t tok, const float* __restrict__ PART, const unsigned short* __restrict__ IDX, const float* __restrict__ GATE, const float* __restrict__ USC, const float* __restrict__ VSC,
                                                 const float* __restrict__ ss, float* ACT, int lane) {
    float sv = ss[(tok + (lane >> 5)) * 32 + (lane & 31)];
    sv += __shfl_xor(sv, 1); sv += __shfl_xor(sv, 2); sv += __shfl_xor(sv, 4); sv += __shfl_xor(sv, 8); sv += __shfl_xor(sv, 16);
    const float rsv = rsqrtf(sv * (1.f / 2048.f) + RMS_EPS);
    const float rs[2] = {__shfl(rsv, 0), __shfl(rsv, 32)};
    f32x2 sum[2]; unsigned ew[2]; f32x2 gt[2]; unsigned pv[2][16];
#pragma unroll
    for (int t = 0; t < 2; ++t) { const size_t p = (tok + t) * 128 + 2 * lane;
        ew[t] = *(const unsigned*)(IDX + p); gt[t] = *(const f32x2*)(GATE + p);
#pragma unroll
        for (int lab = 0; lab < 16; ++lab) pv[t][lab] = *(const unsigned*)((const bf16*)PART + (size_t)lab * M * 128 + p); }
#pragma unroll
    for (int t = 0; t < 2; ++t) { sum[t] = (f32x2){0.f, 0.f};
#pragma unroll
        for (int lab = 0; lab < 16; ++lab) sum[t] = sum[t] + (f32x2){bflo(pv[t][lab]), bfhi(pv[t][lab])}; }
#pragma unroll
    for (int t = 0; t < 2; ++t) { const size_t p = (tok + t) * 128 + 2 * lane; const int e0 = ew[t] & 0xffff, e1 = ew[t] >> 16;
        *(unsigned*)((bf16*)ACT + p) = pkbf(gelu_erf(sum[t].x * rs[t] * USC[e0]) * gt[t].x * VSC[e0], gelu_erf(sum[t].y * rs[t] * USC[e1]) * gt[t].y * VSC[e1]); }
}
struct VMeta { v4u ia, ib; v4u a0, a1; f32x2 x1; };
__device__ __forceinline__ void peer_v_idx(VMeta& m, size_t tok, const unsigned short* __restrict__ IDX, int g) { m.ia = *(const v4u*)(IDX + tok * 128 + g * 16); m.ib = *(const v4u*)(IDX + tok * 128 + g * 16 + 8); }
__device__ __forceinline__ void peer_v_issue(VMeta& m, v4u (&w)[16], const unsigned char* __restrict__ vb, size_t tok, const float* __restrict__ ACT, const bf16* XB1, int g, int c) {
    const unsigned iw[8] = {m.ia.x, m.ia.y, m.ia.z, m.ia.w, m.ib.x, m.ib.y, m.ib.z, m.ib.w};
#pragma unroll
    for (int q = 0; q < 16; ++q) { const unsigned e = (iw[q >> 1] >> (16 * (q & 1))) & 0xffffu; w[q] = *(const v4u*)(vb + (size_t)e * 128); }
    const v4u* ap = (const v4u*)((const bf16*)ACT + tok * 128 + g * 16); m.a0 = ap[0]; m.a1 = ap[1];
    { const unsigned xw = *(const unsigned*)(XB1 + tok * 2048 + c); m.x1 = (f32x2){bflo(xw), bfhi(xw)}; }
}
template <bool WB> __device__ __forceinline__ void peer_v_fin(const VMeta& m, const v4u (&w)[16], size_t tok, int sl, float* X, bf16* XBn, const f32x2 gg, float* ssn, int lane, int c) {
    const v4u a0 = m.a0, a1 = m.a1;
    const float av[16] = {bflo(a0.x), bfhi(a0.x), bflo(a0.y), bfhi(a0.y), bflo(a0.z), bfhi(a0.z), bflo(a0.w), bfhi(a0.w), bflo(a1.x), bfhi(a1.x), bflo(a1.y), bfhi(a1.y), bflo(a1.z), bfhi(a1.z), bflo(a1.w), bfhi(a1.w)};
    f32x2 acc2[8];
#pragma unroll
    for (int k = 0; k < 8; ++k) acc2[k] = (f32x2){0.f, 0.f};
#pragma unroll
    for (int q = 0; q < 16; ++q) { const f32x2 a2v = {av[q], av[q]}; axpy16_fp8(w[q], a2v, acc2); }
#pragma unroll
    for (int k = 0; k < 4; ++k) { const bool up = (lane & 32) != 0; const f32x2 send = up ? acc2[k] : acc2[k + 4], keep = up ? acc2[k + 4] : acc2[k];
        acc2[k] = (f32x2){keep.x + __shfl_xor(send.x, 32), keep.y + __shfl_xor(send.y, 32)}; }
#pragma unroll
    for (int k = 0; k < 2; ++k) { const bool up = (lane & 16) != 0; const f32x2 send = up ? acc2[k] : acc2[k + 2], keep = up ? acc2[k + 2] : acc2[k];
        acc2[k] = (f32x2){keep.x + __shfl_xor(send.x, 16), keep.y + __shfl_xor(send.y, 16)}; }
    { const bool up = (lane & 8) != 0; const f32x2 send = up ? acc2[0] : acc2[1], keep = up ? acc2[1] : acc2[0];
        acc2[0] = (f32x2){keep.x + __shfl_xor(send.x, 8), keep.y + __shfl_xor(send.y, 8)}; }
    const f32x2 x2 = {m.x1.x + acc2[0].x, m.x1.y + acc2[0].y};
    *(f32x2*)(X + tok * 2048 + c) = x2;
    if (WB) *(unsigned*)(XBn + tok * 2048 + c) = pkbf(x2.x * gg.x, x2.y * gg.y);
    const float sq = wave_sum(x2.x * x2.x + x2.y * x2.y);
    ssn[tok * 16 + sl] = sq;
}
template <bool WB> __device__ __forceinline__ void peer_v_loop(int sl, int tok0, int tstep, const float* __restrict__ ACT, const unsigned short* __restrict__ IDX, const unsigned char* __restrict__ V8, float* X, bf16* XBn, const float* __restrict__ gn, float* ssn, int lane) {
    const int g = lane >> 3, i = lane & 7;
    const int j = ((lane >> 5) & 1) * 4 + ((lane >> 4) & 1) * 2 + ((lane >> 3) & 1), c = sl * 128 + 16 * i + 2 * j;
    const unsigned char* vb = V8 + (size_t)sl * (16384 * 128) + 16 * i;
    const f32x2 gg = *(const f32x2*)(gn + c);
    if (tok0 >= M) return;
    const int NT = (M - tok0 + tstep - 1) / tstep;
#define PS_TOK(k_) ((size_t)(tok0 + ((k_) < NT ? (k_) : NT - 1) * tstep))
    VMeta mA, mB, mN; v4u wA[16], wB[16];
    peer_v_idx(mA, PS_TOK(0), IDX, g); peer_v_idx(mB, PS_TOK(1), IDX, g);
    asm volatile("" : "+v"(mB.ia), "+v"(mB.ib));
    peer_v_issue(mA, wA, vb, PS_TOK(0), ACT, XBn, g, c);
    int k = 0;
    for (; k + 1 < NT; k += 2) {
        peer_v_idx(mN, PS_TOK(k + 2), IDX, g);
        asm volatile("" ::: "memory");
        peer_v_issue(mB, wB, vb, PS_TOK(k + 1), ACT, XBn, g, c);
        asm volatile("" ::: "memory");
        peer_v_fin<WB>(mA, wA, PS_TOK(k), sl, X, XBn, gg, ssn, lane, c);
        asm volatile("" ::: "memory");
        mA.ia = mN.ia; mA.ib = mN.ib;
        peer_v_idx(mN, PS_TOK(k + 3), IDX, g);
        asm volatile("" ::: "memory");
        peer_v_issue(mA, wA, vb, PS_TOK(k + 2), ACT, XBn, g, c);
        asm volatile("" ::: "memory");
        peer_v_fin<WB>(mB, wB, PS_TOK(k + 1), sl, X, XBn, gg, ssn, lane, c);
        asm volatile("" ::: "memory");
        mB.ia = mN.ia; mB.ib = mN.ib;
    }
    if (k < NT) peer_v_fin<WB>(mA, wA, PS_TOK(k), sl, X, XBn, gg, ssn, lane, c);
#undef PS_TOK
}
__device__ __forceinline__ void final_norm_row(float* xrow, const float* __restrict__ g, const float* __restrict__ ssp, int lane) {
    const float rs = rsqrtf(wave_sum(lane < 16 ? ssp[lane] : 0.f) * (1.f / 2048.f) + RMS_EPS);
    f32x4* xr = (f32x4*)xrow + lane; const f32x4* gr = (const f32x4*)g + lane;
    f32x4 v[8], gg[8];
#pragma unroll
    for (int jj = 0; jj < 8; ++jj) { v[jj] = xr[64 * jj]; gg[jj] = gr[64 * jj]; }
#pragma unroll
    for (int jj = 0; jj < 8; ++jj) xr[64 * jj] = (f32x4){v[jj].x * rs * gg[jj].x, v[jj].y * rs * gg[jj].y, v[jj].z * rs * gg[jj].z, v[jj].w * rs * gg[jj].w};
}

__device__ __forceinline__ void afb_unit(int unit, const bf16* __restrict__ H, const bf16* __restrict__ Waf, float* AFBo, const float* __restrict__ ss, int lane) {
    const int fr = lane & 15, kq = lane >> 4, row0 = unit * 16;
    const bf16* ap = H + (size_t)(row0 + fr) * 2048 + 8 * kq; const bf16* bp = Waf + (size_t)fr * 2048 + 8 * kq;
    f32x4 c0 = {0.f, 0.f, 0.f, 0.f}, c1 = {0.f, 0.f, 0.f, 0.f};
#pragma unroll 1
    for (int s0 = 0; s0 < 64; s0 += 8) {
        bf16x8 Av[8], Bv[8], Cv[8];
#pragma unroll
        for (int q = 0; q < 8; ++q) { Av[q] = *(const bf16x8*)(ap + 32 * (s0 + q)); Bv[q] = *(const bf16x8*)(bp + 32 * (s0 + q)); Cv[q] = *(const bf16x8*)(bp + 16 * 2048 + 32 * (s0 + q)); }
        asm volatile("" : "+v"(Av[0]), "+v"(Bv[0]), "+v"(Cv[0]), "+v"(Av[7]), "+v"(Bv[7]), "+v"(Cv[7]));
#pragma unroll
        for (int q = 0; q < 8; ++q) { c0 = __builtin_amdgcn_mfma_f32_16x16x32_bf16(Av[q], Bv[q], c0, 0, 0, 0); c1 = __builtin_amdgcn_mfma_f32_16x16x32_bf16(Av[q], Cv[q], c1, 0, 0, 0); }
    }
    const float mine = ss ? pg8::row_rs<16>(ss, row0 + fr) : 1.f;
#pragma unroll
    for (int e = 0; e < 4; ++e) { const int rr = 4 * kq + e; const float sc = __shfl(mine, rr); float* o = AFBo + (size_t)(row0 + rr) * 32 + fr; o[0] = c0[e] * sc; o[16] = c1[e] * sc; }
}
__device__ __forceinline__ const float* gin(const float* p) { const GAS float* g = (const GAS float*)p; asm volatile("" : "+s"(g)); return (const float*)g; }
#ifndef MK_MULTI
#define MK_MULTI 0
#endif
struct Args { const float* in[19]; float* out; unsigned char* ws; int ph_lo, ph_hi, l_lo, l_hi; };
__global__ void __launch_bounds__(NWAVES * 64, 2) fwd_kernel(Args args) {
    extern __shared__ __attribute__((aligned(16))) unsigned char lds[];
    LAS unsigned char* ldsL = (LAS unsigned char*)lds;
    volatile LAS unsigned* MISC = (volatile LAS unsigned*)(ldsL + MISC_OFF);
    const int tid0 = threadIdx.x, wave = __builtin_amdgcn_readfirstlane(tid0 >> 6);
#define PHASE_IDS() int tid = threadIdx.x; asm volatile("" : "+v"(tid)); const int lane = tid & 63; (void)lane; GAS unsigned char* wsp0 = (GAS unsigned char*)args.ws; asm volatile("" : "+s"(wsp0)); unsigned char* wsp = (unsigned char*)wsp0; GAS float* outp0 = (GAS float*)args.out; asm volatile("" : "+s"(outp0)); float* outp = (float*)outp0; int lp = l; asm volatile("" : "+s"(lp)); (void)wsp; (void)outp; (void)lp
    const int G = gridDim.x; const int bx = blockIdx.x; const int vcu = (G % 8 == 0) ? (bx % 8) * (G / 8) + bx / 8 : bx;
    const int gw = vcu * NWAVES + wave, NGW = G * NWAVES;
    unsigned char* ws = args.ws;
    gu32* ctl = (gu32*)(ws + WS_CTL);
    for (int u = tid0; u < (LDS_BYTES - LDSCTL_OFF) / 4; u += NWAVES * 64) ((LAS unsigned*)(ldsL + LDSCTL_OFF))[u] = 0u;
    __syncthreads();
    XcdBarrier bar; bar.bar = (unsigned*)(ctl + CW_BAR); bar.x = 0; bar.st = nullptr;
    if (!MK_MULTI) bar = xcd_barrier_post((unsigned*)(ctl + CW_BAR), MISC + 8);
#define GRID_BAR() do { if (!MK_MULTI) xcd_barrier(bar); } while (0)
    const int lo = args.ph_lo, hi = args.ph_hi;
#ifdef PH_ONLY
#define IN(k) ((k) == PH_ONLY && lo <= (k) && (k) < hi)
#else
#define IN(k) (lo <= (k) && (k) < hi)
#endif
#define BOTH(k) (IN(k) && IN((k) + 1))
#ifndef DUP_MASK
#define DUP_MASK 0
#endif
#define NREP(k) ((((DUP_MASK) >> (k)) & 1) && l == 0 ? 2 : 1)

#define WIN ((bf16*)(wsp + WS_WIN))
#define WUPG ((bf16*)(wsp + WS_WUPG))
#define WUPP ((bf16*)(wsp + WS_WUPP))
#define WOUT ((bf16*)(wsp + WS_WOUT))
#define WQ ((bf16*)(wsp + WS_WQ))
#define POOLW ((bf16*)(wsp + WS_POOLW))
#define SUBK ((bf16*)(wsp + WS_SUBK))
#define Hb ((bf16*)(wsp + WS_H))
#define POOLED ((bf16*)(wsp + WS_POOLED))
#define POOLMIX ((bf16*)(wsp + WS_POOLMIX))
#define QK ((bf16*)(wsp + WS_QK))
#define Pb ((bf16*)(wsp + WS_P))
#define OFb ((bf16*)(wsp + WS_QK))
#define OBb ((bf16*)(wsp + WS_P))
#define VT ((bf16*)(wsp + WS_VT))
#define Rb ((bf16*)(wsp + WS_R))
#define MERGED ((bf16*)(wsp + WS_MERGED))
#define Gb ((bf16*)(wsp + WS_G))
#define PQ ((bf16*)(wsp + WS_PQ))
#define QE ((bf16*)(wsp + WS_QE))
#define GLAOUT ((bf16*)(wsp + WS_GLAOUT))
#define KDT ((bf16*)(wsp + WS_KDT))
#define ATTN ((bf16*)(wsp + WS_ATTN))
#define USC ((float*)(wsp + WS_USC))
#define VSC ((float*)(wsp + WS_VSC))
#define UTAB (wsp + WS_UTAB)
#define VTAB (wsp + WS_VTAB)
#define SEGL ((float*)(wsp + WS_SEGL))
#define SIN ((float*)(wsp + WS_SIN))
#define IDX ((unsigned short*)(wsp + WS_IDX))
#define GATE ((float*)(wsp + WS_GATE))
#define AFB ((float*)(wsp + WS_AFB))
#define DEC ((float*)(wsp + WS_DEC))
#define SSP1 ((float*)(wsp + WS_SSP1))
#define SSP2 ((float*)(wsp + WS_SSP2))
#define PART ((float*)(wsp + WS_QK))
#define ACT ((float*)(wsp + WS_QE))
#define GIN(k_) gin(args.in[k_])
#define x_in ((lp == 0) ? GIN(0) : (const float*)outp)
#define w_in (GIN(2) + (size_t)lp * D * DIN)
#define ssin ((lp == 0) ? (const float*)nullptr : (const float*)SSP2)
#define ss1 SSP1
#define ss2 SSP2
    for (int l = args.l_lo; l < args.l_hi; ++l) {
        if (IN(0)) { PHASE_IDS(); for (int rep = 0; rep < NREP(0); ++rep) {
            LAS float* scr = (LAS float*)(ldsL + wave * 16384);
            { const float* sk = GIN(15) + (size_t)lp * 262144;
              const float* w_upg = GIN(8) + (size_t)lp * 1024 * 2048; const float* w_upp = GIN(11) + (size_t)lp * 1024 * 2048; const float* w_o = GIN(12) + (size_t)lp * 2048 * 2048; const float* w_q = GIN(14) + (size_t)lp * 2048 * 2048;
              const float* w_pool = GIN(9) + (size_t)lp * 4 * 65536;
              constexpr int I_IN = 32 * 257, I_UP = 16 * 64, I_SQ = 32 * 64, I_PL = 4 * 32, I_SK = 512;
              constexpr int E_IN = I_IN, E_UPG = E_IN + I_UP, E_UPP = E_UPG + I_UP, E_O = E_UPP + I_SQ, E_Q = E_O + I_SQ, E_PL = E_Q + I_PL, E_ALL = E_PL + I_SK;
              for (int it0 = gw; it0 < E_ALL; it0 += NGW) { int it = it0;
                if (it < E_IN) { const int kb = it / 257, nb = it % 257, n0 = nb * 32;
                    int d; if (n0 < 1024) d = n0; else if (n0 < 2048) d = n0 + 6400; else if (n0 < 3072) d = n0 - 1024; else if (n0 == 3072) d = 7168; else d = n0 - 1056;
                    transpose_item(w_in, DIN, WIN, 2048, d, kb * 64, n0, scr, lane); }
                else if (it < E_UPG) { it -= E_IN;  transpose_item(w_upg, 2048, WUPG, 1024, (it % 64) * 32, (it / 64) * 64, (it % 64) * 32, scr, lane); }
                else if (it < E_UPP) { it -= E_UPG; transpose_item(w_upp, 2048, WUPP, 1024, (it % 64) * 32, (it / 64) * 64, (it % 64) * 32, scr, lane); }
                else if (it < E_O)   { it -= E_UPP; transpose_item(w_o, 2048, WOUT, 2048, (it % 64) * 32, (it / 64) * 64, (it % 64) * 32, scr, lane); }
                else if (it < E_Q)   { it -= E_O;   transpose_item(w_q, 2048, WQ, 2048, (it % 64) * 32, (it / 64) * 64, (it % 64) * 32, scr, lane, GIN(13) + (size_t)lp * D); }
                else if (it < E_PL)  { it -= E_Q; const int g = it >> 5, r5 = it & 31; transpose_item(w_pool + (size_t)g * 65536, 256, POOLW + (size_t)g * 65536, 256, (r5 % 8) * 32, (r5 / 8) * 64, (r5 % 8) * 32, scr, lane); }
                else { const int f = it - E_PL; const int hp = f >> 5, nt = (f >> 3) & 3, s5 = f & 7, r = lane & 31, hh = lane >> 5;
                    const float* src = sk + ((size_t)hp * 128 + 32 * nt + r) * 128 + 16 * s5 + 8 * hh; const f32x4 a = *(const f32x4*)src, b = *(const f32x4*)(src + 4);
                    v4u o = {pkbf(a.x, a.y), pkbf(a.z, a.w), pkbf(b.x, b.y), pkbf(b.z, b.w)}; *(v4u*)(SUBK + ((size_t)f * 64 + lane) * 8) = o; } } }
            { const float* ut = GIN(16) + (size_t)lp * 16384 * 2048; const float* vt = GIN(17) + (size_t)lp * 16384 * 2048;
              for (int row = gw; row < 16384; row += NGW) { if (row < 8192)
                table_rows_fp8(ut, (unsigned*)UTAB, USC, row, row + 8192, lane, GIN(13) + (size_t)lp * D); else table_rows_fp8(vt, (unsigned*)VTAB, VSC, row - 8192, row, lane); } }
            if (lp == 0) for (int m = gw; m < M; m += NGW) rmsnorm_row(x_in + (size_t)m * D, GIN(1), Hb + (size_t)m * D, lane);
            if (rep + 1 < NREP(0)) GRID_BAR(); }
            if (BOTH(0)) GRID_BAR();
        }
        if (IN(1)) { PHASE_IDS(); for (int rep = 0; rep < NREP(1); ++rep) {
            { pg8::Gemm g{Hb, WIN, M, 7168, 2048, 2048, 2048, 0, nullptr, nullptr}; pg8::StaticOrder S; S.init(M, 7168, G, bx);
              pg8::EpiProj E{QK, Rb, Pb, Gb, AFB, ssin};
              pg8::gemm_phase<pg8::EpiProj, pg8::StaticOrder, true, true>(ldsL, g, S, E); }
            { pg8::Gemm g{WIN + (size_t)7424 * 2048, Hb, 1024, M, 2048, 2048, 2048, 0, nullptr, nullptr}; pg8::StaticOrder S; S.init(1024, M, G, bx);
              pg8::EpiVT E{VT, ssin};
              pg8::gemm_phase<pg8::EpiVT, pg8::StaticOrder, true, true>(ldsL, g, S, E); }
            for (int unit = gw; unit < M / 16; unit += NGW) afb_unit(unit, Hb, WIN + (size_t)7168 * 2048, AFB, ssin, lane);
            if (rep + 1 < NREP(1)) GRID_BAR(); }
            if (BOTH(1)) GRID_BAR();
        }
        if (IN(2)) { PHASE_IDS(); for (int rep = 0; rep < NREP(2); ++rep) {
            if (vcu < 4096) { PrepIn pin; gla_prep_load(pin, vcu, QK, AFB, GIN(3) + (size_t)lp * 8192, GIN(4) + (size_t)lp * 512, GIN(5) + (size_t)lp * 8192, GIN(6) + (size_t)lp * 512, tid);
                __syncthreads();
                int pb = 0;
                for (int uid = vcu; uid < 4096; uid += G, pb ^= 1)
                    gla_prep_unit(uid, (uid + G < 4096) ? uid + G : uid, pin, ldsL + pb * PA_BYTES, QK, AFB, GIN(3) + (size_t)lp * 8192, GIN(4) + (size_t)lp * 512, GIN(5) + (size_t)lp * 8192, GIN(6) + (size_t)lp * 512, QE, KDT, ATTN, DEC, tid, wave, lane);
                __syncthreads(); }
            for (int item = vcu * 512 + tid; item < (M / 32) * 128; item += G * 512) pool_item(item, Pb, POOLED);
            if (rep + 1 < NREP(2)) GRID_BAR(); }
            if (BOTH(2)) GRID_BAR();
        }
        if (IN(3)) { PHASE_IDS(); for (int rep = 0; rep < NREP(3); ++rep) {
            for (int su = vcu; su < 16 * NSEG; su += G) gla_scan_block<false>(su, ldsL, QE, ATTN, KDT, DEC, VT, SEGL, SIN, OFb, OBb, tid, wave, lane);
            if (rep + 1 < NREP(3)) GRID_BAR(); }
            if (BOTH(3)) GRID_BAR();
        }
        if (IN(5)) { PHASE_IDS(); for (int rep = 0; rep < NREP(5); ++rep) {
            for (int su = vcu; su < 16 * NSEG; su += G) gla_scan_block<true>(su, ldsL, QE, ATTN, KDT, DEC, VT, SEGL, SIN, OFb, OBb, tid, wave, lane);
            if (rep + 1 < NREP(5)) GRID_BAR(); }
            if (BOTH(5)) GRID_BAR();
        }
        if (IN(6)) { PHASE_IDS(); for (int rep = 0; rep < NREP(6); ++rep) {
            { float gg[16]; { const f32x4* gp = (const f32x4*)(GIN(7) + (size_t)lp * 1024 + 16 * lane);
#pragma unroll
                for (int q = 0; q < 4; ++q) { const f32x4 x = gp[q]; gg[4 * q] = x.x; gg[4 * q + 1] = x.y; gg[4 * q + 2] = x.z; gg[4 * q + 3] = x.w; } }
              for (int m = gw; m < M; m += 2 * NGW) { const int m2 = (m + NGW < M) ? m + NGW : m;
                  FinIn ia, ib; gla_fin_load(ia, m, OFb, OBb, Rb, lane); gla_fin_load(ib, m2, OFb, OBb, Rb, lane);
                  gla_fin_row(ia, m, gg, GLAOUT, lane); if (m2 != m) gla_fin_row(ib, m2, gg, GLAOUT, lane); } }
            { pg8::Gemm g{POOLED, POOLW, M, 1024, 256, 1024, 256, 512, nullptr, nullptr}; pg8::StaticOrder S; S.init(M, 1024, G, bx);
              pg8::EpiScale<false> E{POOLMIX, 1024, GIN(10) + (size_t)lp * 1024, nullptr};
              pg8::gemm_phase<pg8::EpiScale<false>, pg8::StaticOrder, true, true>(ldsL, g, S, E); }
            if (rep + 1 < NREP(6)) GRID_BAR(); }
            if (BOTH(6)) GRID_BAR();
        }
        if (IN(7)) { PHASE_IDS(); for (int rep = 0; rep < NREP(7); ++rep) {
            { pg8::Gemm g{GLAOUT, WUPG, M, 2048, 1024, 1024, 1024, 0, POOLMIX, WUPP}; pg8::TwoPartOrder S; S.init(M, 2048, G, bx);
              pg8::EpiMerge E{MERGED, (const unsigned char*)Gb};
              pg8::gemm_phase<pg8::EpiMerge, pg8::TwoPartOrder, true, true>(ldsL, g, S, E); }
            if (rep + 1 < NREP(7)) GRID_BAR(); }
            if (BOTH(7)) GRID_BAR();
        }
        if (IN(8)) { PHASE_IDS(); for (int rep = 0; rep < NREP(8); ++rep) {
            { pg8::Gemm g{MERGED, WOUT, M, 2048, 2048, 2048, 2048, 0, nullptr, nullptr}; pg8::StaticOrder S; S.init(M, 2048, G, bx);
              pg8::EpiResid E{x_in, Hb, ss1};
              pg8::gemm_phase<pg8::EpiResid, pg8::StaticOrder, true, true>(ldsL, g, S, E); }
            if (rep + 1 < NREP(8)) GRID_BAR(); }
            if (BOTH(8)) GRID_BAR();
        }
        if (IN(9)) { PHASE_IDS(); for (int rep = 0; rep < NREP(9); ++rep) {
            { pg8::Gemm g{Hb, WQ, M, 2048, 2048, 2048, 2048, 0, nullptr, nullptr}; pg8::StaticOrder S; S.init(M, 2048, G, bx);
              pg8::EpiScale<true> E{PQ, 2048, nullptr, ss1};
              pg8::gemm_phase<pg8::EpiScale<true>, pg8::StaticOrder, true, true>(ldsL, g, S, E); }
            if (rep + 1 < NREP(9)) GRID_BAR(); }
            if (BOTH(9)) GRID_BAR();
        }
        if (IN(10)) { PHASE_IDS(); for (int rep = 0; rep < NREP(10); ++rep) {
            for (int j = 0; j < 4; ++j) {
                __syncthreads();
                for (int i = tid; i < 8192; i += 512) *(LAS v4u*)(ldsL + i * 16) = *(const v4u*)((const unsigned char*)SUBK + (size_t)j * 131072 + (size_t)i * 16);
                __syncthreads();
                const int hsel = wave >> 2, h = 2 * j + hsel;
                for (int tile = vcu * 4 + (wave & 3); tile < M / 32; tile += G * 4) peer_topk_item(tile, h, ldsL + hsel * 65536, PQ, IDX, GATE, lane);
            }
            if (rep + 1 < NREP(10)) GRID_BAR(); }
            if (BOTH(10)) GRID_BAR();
        }
        if (IN(11)) { PHASE_IDS(); for (int rep = 0; rep < NREP(11); ++rep) {
            const int label = bx & 7, rank = bx >> 3, nrank = (G - label + 7) >> 3;
            for (int sub = 0; sub < 2; ++sub)
                peer_slice_loop<false>(2 * label + sub, label, sub, rank * NWAVES + wave, nrank * NWAVES, Hb, ACT, IDX, UTAB, PART, outp, Hb, nullptr, nullptr, lane);
            if (rep + 1 < NREP(11)) GRID_BAR(); }
            if (BOTH(11)) GRID_BAR();
        }
        if (IN(12)) { PHASE_IDS(); for (int rep = 0; rep < NREP(12); ++rep) {
            for (int tok = 2 * gw; tok < M; tok += 2 * NGW) peer_combine_row((size_t)tok, PART, IDX, GATE, USC, VSC, ss1, ACT, lane);
            if (rep + 1 < NREP(12)) GRID_BAR(); }
            if (BOTH(12)) GRID_BAR();
        }
        if (IN(13)) { PHASE_IDS();
            const int last = (lp == DEPTH - 1);
            const float* gn = last ? GIN(18) : GIN(1) + (size_t)(lp + 1) * D;
            const int label = bx & 7, rank = bx >> 3, nrank = (G - label + 7) >> 3;
            for (int sub = 0; sub < 2; ++sub)
                if (last) peer_v_loop<false>(2 * label + sub, rank * NWAVES + wave, nrank * NWAVES, ACT, IDX, VTAB, outp, Hb, gn, ss2, lane);
                else      peer_v_loop<true>(2 * label + sub, rank * NWAVES + wave, nrank * NWAVES, ACT, IDX, VTAB, outp, Hb, gn, ss2, lane);
            if ((BOTH(13) && last) || (lo == 0 && hi == NPH && l + 1 < args.l_hi)) GRID_BAR();
        }
        if (IN(14) && l == DEPTH - 1) { PHASE_IDS();
            for (int m = gw; m < M; m += NGW) final_norm_row(outp + (size_t)m * D, GIN(18), ss2 + (size_t)m * 16, lane);
        }
    }
#undef IN
#undef BOTH
#undef GRID_BAR
}

#undef WIN
#undef WUPG
#undef WUPP
#undef WOUT
#undef WQ
#undef POOLW
#undef SUBK
#undef Hb
#undef POOLED
#undef POOLMIX
#undef QK
#undef Pb
#undef OFb
#undef OBb
#undef VT
#undef Rb
#undef MERGED
#undef Gb
#undef PQ
#undef QE
#undef GLAOUT
#undef KDT
#undef ATTN
#undef USC
#undef VSC
#undef UTAB
#undef VTAB
#undef SEGL
#undef SIN
#undef IDX
#undef GATE
#undef AFB
#undef DEC
#undef SSP1
#undef SSP2
#undef PART
#undef ACT
#undef GIN
#undef x_in
#undef w_in
#undef ssin
#undef ss1
#undef ss2
extern "C" void kernel_launch(void* const* d_in, const int* in_sizes, int n_in, void* d_out, int out_size, void* d_ws, size_t ws_size, hipStream_t stream) {
    static int grid = 0;
    if (grid == 0) {
        if (n_in != 19 || in_sizes[0] != M * D || out_size != M * D || ws_size < WS_END) { fprintf(stderr, "kernel_launch: unexpected shapes / workspace (n_in %d, ws %zu, need %zu); nothing launched\n", n_in, ws_size, (size_t)WS_END); grid = -1; return; }
        int dev = 0, cus = 0, per_cu = 0;
        if (hipGetDevice(&dev) != hipSuccess || hipDeviceGetAttribute(&cus, hipDeviceAttributeMultiprocessorCount, dev) != hipSuccess) { grid = -1; return; }
        if (hipFuncSetAttribute((const void*)fwd_kernel, hipFuncAttributeMaxDynamicSharedMemorySize, LDS_BYTES) != hipSuccess) { fprintf(stderr, "kernel_launch: hipFuncSetAttribute failed\n"); grid = -1; return; }
        if (hipOccupancyMaxActiveBlocksPerMultiprocessor(&per_cu, (const void*)fwd_kernel, NWAVES * 64, LDS_BYTES) != hipSuccess || per_cu < 1) { fprintf(stderr, "kernel_launch: occupancy query reports %d blocks per CU\n", per_cu); }
        (void)hipGetLastError();
        grid = cus;
    }
    if (grid < 0) return;
    if (hipMemsetAsync((char*)d_ws + WS_CTL, 0, CTL_ZERO_BYTES, stream) != hipSuccess) return;
    Args a{};
    for (int i = 0; i < 19; ++i) a.in[i] = (const float*)d_in[i];
    a.out = (float*)d_out; a.ws = (unsigned char*)d_ws;
#if MK_MULTI
    for (int l = 0; l < DEPTH; ++l)
        for (int ph = 0; ph < NPH; ++ph) { a.ph_lo = ph; a.ph_hi = ph + 1; a.l_lo = l; a.l_hi = l + 1;
            hipLaunchKernelGGL(fwd_kernel, dim3(grid), dim3(NWAVES * 64), LDS_BYTES, stream, a); }
#else
    a.ph_lo = 0; a.ph_hi = NPH; a.l_lo = 0; a.l_hi = DEPTH;
    hipLaunchKernelGGL(fwd_kernel, dim3(grid), dim3(NWAVES * 64), LDS_BYTES, stream, a);
#endif
}
```

```cpp
#include <hip/hip_runtime.h>
#include <cstdio>
#include <cstdint>
namespace pg8 {
#define PG8_LAS __attribute__((address_space(3)))
typedef unsigned short bf16_t;
typedef short bf16x8 __attribute__((ext_vector_type(8)));
typedef float f32x4 __attribute__((ext_vector_type(4)));
typedef unsigned u32x4 __attribute__((ext_vector_type(4)));
typedef unsigned u32x2 __attribute__((ext_vector_type(2)));
constexpr int BM = 256, BK = 64, HALF = 128, HTB = HALF * BK * 2  , STAGE_BYTES = 8 * HTB, NXCD = 8, WGM = 8;

__host__ __device__ __forceinline__ int lds_byte(int r, int c) { const int st = (r >> 4) * 2 + (c >> 5), rr = r & 15, cc = c & 31, ob = rr * 64 + cc * 2; return st * 1024 + (ob ^ (((ob >> 9) & 1) << 5)); }
__host__ __device__ __forceinline__ void stage_rc(int b, int& R, int& C) { const int st = b / 1024, sb = b % 1024, swz = sb ^ (((sb >> 9) & 1) << 5); R = (st >> 1) * 16 + swz / 64; C = (st & 1) * 32 + (swz % 64) / 2; }
__host__ __device__ __forceinline__ int perm32(int rho) { const int n = rho >> 4, i = rho & 15; return 8 * (i >> 2) + 4 * n + (i & 3); }

struct Unit { int pm, pn, sub; };
struct Gemm { const bf16_t* A; const bf16_t* Bt; int M, N, K, lda, ldb, a_pn_step; const bf16_t* A2; const bf16_t* Bt2; };

struct StaticOrder {
    int nM, nN, nwg, G, c;
    __host__ __device__ void init(int M, int N, int G_, int c_) { nM = M / BM; nN = N / BM; nwg = nM * nN; G = G_; c = c_; }
    __host__ __device__ bool next(int i, Unit& u) const {
        const long L = (long)i * G + c; if (L >= nwg) return false;
        int wgid = (int)L; { const int q = nwg / NXCD, r = nwg % NXCD, xcd = wgid % NXCD, off = wgid / NXCD; wgid = (xcd < r ? xcd * (q + 1) : r * (q + 1) + (xcd - r) * q) + off; }
        const int nig = WGM * nN, gid = wgid / nig, fm = gid * WGM, gsz = (nM - fm) < WGM ? (nM - fm) : WGM;
        u.pm = fm + ((wgid % nig) % gsz); u.pn = (wgid % nig) / gsz; u.sub = 0; return true;
    }
    __device__ __forceinline__ void a_ready(const Unit&) const {}
    __device__ __forceinline__ void done(const Unit&) const {}
};

struct TwoPartOrder : StaticOrder {
    __host__ __device__ bool next(int i, Unit& u) const { if (!StaticOrder::next(i >> 1, u)) return false; u.sub = i & 1; return true; }
};
typedef float f32x2 __attribute__((ext_vector_type(2)));
typedef __bf16 bf16x2_t __attribute__((ext_vector_type(2)));
__device__ __forceinline__ unsigned pkbf(float lo, float hi) { f32x2 v = {lo, hi}; bf16x2_t b = __builtin_convertvector(v, bf16x2_t); return __builtin_bit_cast(unsigned, b); }
__device__ __forceinline__ float bflo(unsigned w) { return __builtin_bit_cast(float, w << 16); }
__device__ __forceinline__ float bfhi(unsigned w) { return __builtin_bit_cast(float, w & 0xffff0000u); }
__device__ __forceinline__ float fast_sigmoid(float x) { return __builtin_amdgcn_rcpf(1.f + __expf(-x)); }
template <int NP> __device__ __forceinline__ float row_rs(const float* ssp, int row) {
    const f32x4* p = (const f32x4*)(ssp + (size_t)row * NP); f32x4 a = p[0];
#pragma unroll
    for (int k = 1; k < NP / 4; ++k) a = a + p[k];
    return rsqrtf(((a.x + a.y) + (a.z + a.w)) * (1.f / 2048.f) + 1e-6f);
}

template <int NP> __device__ __forceinline__ float row_rs_fq(const float* ssp, int row, int fq) {
    const f32x4* p = (const f32x4*)(ssp + (size_t)row * NP + fq * (NP / 4)); f32x4 a = p[0];
    if (NP == 32) a = a + p[1];
    float t = (a.x + a.y) + (a.z + a.w);
    t += __shfl_xor(t, 16); t += __shfl_xor(t, 32);
    return rsqrtf(t * (1.f / 2048.f) + 1e-6f);
}
template <int NP> __device__ __forceinline__ void row_rs_fq8(const float* ssp, int row0, int fq, float (&rsc)[2][4]) {
#pragma unroll
    for (int ai = 0; ai < 2; ++ai) {
        f32x4 a[4], b[4];
#pragma unroll
        for (int m = 0; m < 4; ++m) { const f32x4* p = (const f32x4*)(ssp + (size_t)(row0 + ai * HALF + m * 16) * NP + fq * (NP / 4)); a[m] = p[0]; if (NP == 32) b[m] = p[1]; }
#pragma unroll
        for (int m = 0; m < 4; ++m) { f32x4 v = a[m]; if (NP == 32) v = v + b[m];
            float t = (v.x + v.y) + (v.z + v.w); t += __shfl_xor(t, 16); t += __shfl_xor(t, 32);
            rsc[ai][m] = rsqrtf(t * (1.f / 2048.f) + 1e-6f); }
    }
}
struct EpiProj {
    static constexpr bool PERM = true, AFTER_DRAIN = false; __device__ static bool keep(const Unit&) { return false; }
    bf16_t *QK, *R, *P, *G; float* AFB; const float* ss;
    __device__ __forceinline__ void operator()(const f32x4 (&acc)[2][2][4][2], const Unit& u, int wr, int wc, int fr, int fq) const {
        const int row0 = u.pm * BM + wr * 64 + fr; const int pn = u.pn;
        float rsc[2][4];
        if (ss) row_rs_fq8<16>(ss, row0, fq, rsc);
        else {
#pragma unroll
            for (int ai = 0; ai < 2; ++ai)
#pragma unroll
                for (int m = 0; m < 4; ++m) rsc[ai][m] = 1.f; }
        bf16_t* base; int ldc, colt, mode;
        if (pn < 4) { base = QK; ldc = 1024; colt = pn * 256; mode = (pn < 2) ? 1 : 0; }
        else if (pn < 8) { base = R; ldc = 1024; colt = (pn - 4) * 256; mode = 2; }
        else if (pn < 12) { base = P; ldc = 1024; colt = (pn - 8) * 256; mode = 0; }
        else { base = G; ldc = 4096; colt = (pn - 12) * 256; mode = 3; }
        const int col0 = colt + wc * 32 + 8 * fq;
#pragma unroll
        for (int ai = 0; ai < 2; ++ai)
#pragma unroll
            for (int m = 0; m < 4; ++m) { bf16_t* rowp = base + (size_t)(row0 + ai * HALF + m * 16) * ldc + col0;
#pragma unroll
                for (int bj = 0; bj < 2; ++bj) { f32x4 v0 = acc[ai][bj][m][0] * rsc[ai][m], v1 = acc[ai][bj][m][1] * rsc[ai][m];
                    if (mode == 1) { v0 = v0 * 0.08838834764831845f; v1 = v1 * 0.08838834764831845f; }
                    else if (mode == 2) {
#pragma unroll
                        for (int e = 0; e < 4; ++e) { v0[e] = v0[e] * fast_sigmoid(v0[e]); v1[e] = v1[e] * fast_sigmoid(v1[e]); } }
                    else if (mode == 3) {
#pragma unroll
                        for (int e = 0; e < 4; ++e) { v0[e] = fast_sigmoid(v0[e]); v1[e] = fast_sigmoid(v1[e]); } }
                    if (mode == 3) { unsigned w0 = 0u, w1 = 0u;
#pragma unroll
                        for (int e = 0; e < 4; ++e) { w0 = __builtin_amdgcn_cvt_pk_u8_f32(__builtin_rintf(v0[e] * 255.f), e, w0); w1 = __builtin_amdgcn_cvt_pk_u8_f32(__builtin_rintf(v1[e] * 255.f), e, w1); }
                        u32x2 w = {w0, w1}; *(u32x2*)((unsigned char*)G + (size_t)(row0 + ai * HALF + m * 16) * 4096 + col0 + bj * HALF) = w; }
                    else {
                    u32x4 w; w.x = pkbf(v0[0], v0[1]); w.y = pkbf(v0[2], v0[3]); w.z = pkbf(v1[0], v1[1]); w.w = pkbf(v1[2], v1[3]);
                    *(u32x4*)(rowp + bj * HALF) = w; } } asm volatile("" ::: "memory"); }
    }
};
struct EpiVT {
    static constexpr bool PERM = true, AFTER_DRAIN = false; __device__ static bool keep(const Unit&) { return false; }
    bf16_t* VT; const float* ss;
    __device__ __forceinline__ void operator()(const f32x4 (&acc)[2][2][4][2], const Unit& u, int wr, int wc, int fr, int fq) const {
        const int dv0 = u.pm * BM + wr * 64 + fr, tok0 = u.pn * BM + wc * 32 + 8 * fq;
        f32x4 cs[2][2];
#pragma unroll
        for (int bj = 0; bj < 2; ++bj)
#pragma unroll
            for (int n = 0; n < 2; ++n) cs[bj][n] = (f32x4){1.f, 1.f, 1.f, 1.f};
        if (ss) { const float mine = row_rs<16>(ss, tok0 + (fr >> 3) * HALF + (fr & 7));
#pragma unroll
            for (int bj = 0; bj < 2; ++bj)
#pragma unroll
                for (int n = 0; n < 2; ++n)
#pragma unroll
                    for (int k = 0; k < 4; ++k) cs[bj][n][k] = __shfl(mine, fq * 16 + bj * 8 + 4 * n + k); }
#pragma unroll
        for (int ai = 0; ai < 2; ++ai)
#pragma unroll
            for (int m = 0; m < 4; ++m) { const int dv = dv0 + ai * HALF + m * 16;
#pragma unroll
                for (int bj = 0; bj < 2; ++bj) { const int tok = tok0 + bj * HALF; const int bc = tok >> 6, tin = tok & 63;
                    const f32x4 v0 = acc[ai][bj][m][0] * cs[bj][0], v1 = acc[ai][bj][m][1] * cs[bj][1];
                    u32x4 w; w.x = pkbf(v0[0], v0[1]); w.y = pkbf(v0[2], v0[3]); w.z = pkbf(v1[0], v1[1]); w.w = pkbf(v1[2], v1[3]);
                    *(u32x4*)(VT + ((size_t)bc * 1024 + dv) * 64 + tin) = w; } }
    }
};
template <bool ROWS> struct EpiScale {
    static constexpr bool PERM = true, AFTER_DRAIN = false; __device__ static bool keep(const Unit&) { return false; }
    bf16_t* O; int ldc; const float* scale; const float* ss;
    __device__ __forceinline__ void operator()(const f32x4 (&acc)[2][2][4][2], const Unit& u, int wr, int wc, int fr, int fq) const {
        const int row0 = u.pm * BM + wr * 64 + fr, col0 = u.pn * BM + wc * 32 + 8 * fq;
        f32x4 sv[2][2];
#pragma unroll
        for (int bj = 0; bj < 2; ++bj)
#pragma unroll
            for (int n = 0; n < 2; ++n) sv[bj][n] = scale ? *(const f32x4*)(scale + col0 + bj * HALF + 4 * n) : (f32x4){1.f, 1.f, 1.f, 1.f};
        float rsc[2][4];
        if (ROWS) row_rs_fq8<32>(ss, row0, fq, rsc);
#pragma unroll
        for (int ai = 0; ai < 2; ++ai)
#pragma unroll
            for (int m = 0; m < 4; ++m) { bf16_t* rowp = O + (size_t)(row0 + ai * HALF + m * 16) * ldc + col0; const float rr = ROWS ? rsc[ai][m] : 1.f;
#pragma unroll
                for (int bj = 0; bj < 2; ++bj) { const f32x4 v0 = acc[ai][bj][m][0] * sv[bj][0] * rr, v1 = acc[ai][bj][m][1] * sv[bj][1] * rr;
                    u32x4 w; w.x = pkbf(v0[0], v0[1]); w.y = pkbf(v0[2], v0[3]); w.z = pkbf(v1[0], v1[1]); w.w = pkbf(v1[2], v1[3]);
                    *(u32x4*)(rowp + bj * HALF) = w; } }
    }
};
template <bool ACCUM> struct EpiGate {
    static constexpr bool PERM = true, AFTER_DRAIN = false; __device__ static bool keep(const Unit&) { return false; }
    bf16_t* O; const bf16_t* Gt;
    __device__ __forceinline__ void operator()(const f32x4 (&acc)[2][2][4][2], const Unit& u, int wr, int wc, int fr, int fq) const {
        const int row0 = u.pm * BM + wr * 64 + fr, col0 = u.pn * BM + wc * 32 + 8 * fq;
#pragma unroll
        for (int ai = 0; ai < 2; ++ai) {
            u32x4 gwv[4][2], owv[4][2];
#pragma unroll
            for (int m = 0; m < 4; ++m)
#pragma unroll
                for (int bj = 0; bj < 2; ++bj) { const size_t row = (size_t)(row0 + ai * HALF + m * 16);
                    gwv[m][bj] = *(const u32x4*)(Gt + row * 4096 + col0 + bj * HALF);
                    if (ACCUM) owv[m][bj] = *(const u32x4*)(O + row * 2048 + col0 + bj * HALF); }
            asm volatile("" ::: "memory");
#pragma unroll
            for (int m = 0; m < 4; ++m) { const size_t row = (size_t)(row0 + ai * HALF + m * 16);
#pragma unroll
                for (int bj = 0; bj < 2; ++bj) { const u32x4 gw = gwv[m][bj];
                    f32x4 v0 = acc[ai][bj][m][0], v1 = acc[ai][bj][m][1];
                    v0[0] *= bflo(gw.x); v0[1] *= bfhi(gw.x); v0[2] *= bflo(gw.y); v0[3] *= bfhi(gw.y); v1[0] *= bflo(gw.z); v1[1] *= bfhi(gw.z); v1[2] *= bflo(gw.w); v1[3] *= bfhi(gw.w);
                    if (ACCUM) { const u32x4 ow = owv[m][bj];
                        v0[0] += bflo(ow.x); v0[1] += bfhi(ow.x); v0[2] += bflo(ow.y); v0[3] += bfhi(ow.y); v1[0] += bflo(ow.z); v1[1] += bfhi(ow.z); v1[2] += bflo(ow.w); v1[3] += bfhi(ow.w); }
                    u32x4 w; w.x = pkbf(v0[0], v0[1]); w.y = pkbf(v0[2], v0[3]); w.z = pkbf(v1[0], v1[1]); w.w = pkbf(v1[2], v1[3]);
                    *(u32x4*)(O + row * 2048 + col0 + bj * HALF) = w; } }
            asm volatile("" ::: "memory");
        }
    }
};
struct EpiMerge {
    static constexpr bool PERM = true, AFTER_DRAIN = false; __device__ static bool keep(const Unit& u) { return u.sub == 0; }
    bf16_t* O; const unsigned char* Gt;
    __device__ __forceinline__ void operator()(f32x4 (&acc)[2][2][4][2], const Unit& u, int wr, int wc, int fr, int fq) const {
        const int row0 = u.pm * BM + wr * 64 + fr, col0 = u.pn * BM + wc * 32 + 8 * fq;
#pragma unroll
        for (int ai = 0; ai < 2; ++ai) {
            u32x2 g1[4][2], g2[4][2];
#pragma unroll
            for (int m = 0; m < 4; ++m)
#pragma unroll
                for (int bj = 0; bj < 2; ++bj) { const size_t p = (size_t)(row0 + ai * HALF + m * 16) * 4096 + col0 + bj * HALF;
                    g2[m][bj] = *(const u32x2*)(Gt + p + 2048); if (u.sub == 0) g1[m][bj] = *(const u32x2*)(Gt + p); }
            asm volatile("" ::: "memory");
#pragma unroll
            for (int m = 0; m < 4; ++m)
#pragma unroll
                for (int bj = 0; bj < 2; ++bj) { const u32x2 b = g2[m][bj];
                    float s2[8];
#pragma unroll
                    for (int e = 0; e < 4; ++e) { s2[e] = (float)((b.x >> (8 * e)) & 255u) * (1.f / 255.f); s2[4 + e] = (float)((b.y >> (8 * e)) & 255u) * (1.f / 255.f); }
#pragma unroll
                    for (int e = 0; e < 8; ++e) s2[e] = fmaxf(s2[e], 8.6736174e-19f);
                    f32x4 v0 = acc[ai][bj][m][0], v1 = acc[ai][bj][m][1];
                    if (u.sub == 0) { const u32x2 a = g1[m][bj];
                        float s1[8];
#pragma unroll
                        for (int e = 0; e < 4; ++e) { s1[e] = (float)((a.x >> (8 * e)) & 255u) * (1.f / 255.f); s1[4 + e] = (float)((a.y >> (8 * e)) & 255u) * (1.f / 255.f); }
#pragma unroll
                        for (int e = 0; e < 4; ++e) { v0[e] *= s1[e] * __builtin_amdgcn_rcpf(s2[e]); v1[e] *= s1[4 + e] * __builtin_amdgcn_rcpf(s2[4 + e]); }
                        acc[ai][bj][m][0] = v0; acc[ai][bj][m][1] = v1;
                    } else {
#pragma unroll
                        for (int e = 0; e < 4; ++e) { v0[e] *= s2[e]; v1[e] *= s2[4 + e]; }
                        u32x4 w; w.x = pkbf(v0[0], v0[1]); w.y = pkbf(v0[2], v0[3]); w.z = pkbf(v1[0], v1[1]); w.w = pkbf(v1[2], v1[3]);
                        *(u32x4*)(O + (size_t)(row0 + ai * HALF + m * 16) * 2048 + col0 + bj * HALF) = w; } }
            asm volatile("" ::: "memory");
        }
    }
};
struct EpiResid {
    static constexpr bool PERM = true, AFTER_DRAIN = false; __device__ static bool keep(const Unit&) { return false; }
    const float* xin; bf16_t* XB; float* ss;
    __device__ __forceinline__ void operator()(const f32x4 (&acc)[2][2][4][2], const Unit& u, int wr, int wc, int fr, int fq) const {
        const int row0 = u.pm * BM + wr * 64 + fr, col0 = u.pn * BM + wc * 32 + 8 * fq;
#pragma unroll
        for (int h4 = 0; h4 < 4; ++h4) { const int ai = h4 >> 1, mb = (h4 & 1) * 2;
            f32x4 xv[2][2][2];
#pragma unroll
            for (int mm = 0; mm < 2; ++mm)
#pragma unroll
                for (int bj = 0; bj < 2; ++bj) { const size_t p = (size_t)(row0 + ai * HALF + (mb + mm) * 16) * 2048 + col0 + bj * HALF; xv[mm][bj][0] = *(const f32x4*)(xin + p); xv[mm][bj][1] = *(const f32x4*)(xin + p + 4); }
            asm volatile("" ::: "memory");
#pragma unroll
            for (int mm = 0; mm < 2; ++mm) { const int m = mb + mm; const int row = row0 + ai * HALF + m * 16; const size_t rb = (size_t)row * 2048 + col0; float sq = 0.f;
#pragma unroll
                for (int bj = 0; bj < 2; ++bj) { const size_t p = rb + bj * HALF;
                    const f32x4 x0 = xv[mm][bj][0] + acc[ai][bj][m][0], x1 = xv[mm][bj][1] + acc[ai][bj][m][1];
                    sq += (x0.x * x0.x + x0.y * x0.y) + (x0.z * x0.z + x0.w * x0.w) + (x1.x * x1.x + x1.y * x1.y) + (x1.z * x1.z + x1.w * x1.w);
                    u32x4 w; w.x = pkbf(x0[0], x0[1]); w.y = pkbf(x0[2], x0[3]); w.z = pkbf(x1[0], x1[1]); w.w = pkbf(x1[2], x1[3]);
                    *(u32x4*)(XB + p) = w; }
                sq += __shfl_xor(sq, 16); sq += __shfl_xor(sq, 32);
                if (fq == 0) ss[(size_t)row * 32 + u.pn * 4 + wc] = sq; }
            asm volatile("" ::: "memory");
        }
    }
};

template <class Epi, class Sched, bool ALIGN_EPI = false, bool SP2 = false>
__device__ __forceinline__ void gemm_phase(PG8_LAS unsigned char* lds, const Gemm g, const Sched& S, const Epi& E) {
    int tid_o = threadIdx.x; asm volatile("" : "+v"(tid_o));
    const int tid = tid_o, wid = __builtin_amdgcn_readfirstlane(tid >> 6), lane = tid & 63, wr = wid >> 2, wc = wid & 3, fr = lane & 15, fq = lane >> 4;
    int K_o = g.K; asm volatile("" : "+s"(K_o));
    const int K = K_o, nt = K / BK;
    unsigned voffA[2], voffB[2];
#pragma unroll
    for (int i = 0; i < 2; ++i) { int R, C; stage_rc(tid * 16 + i * 8192, R, C); const int Rb = Epi::PERM ? ((R & ~31) + perm32(R & 31)) : R;
        voffA[i] = (unsigned)(R * g.lda + C) * 2u; voffB[i] = (unsigned)(Rb * g.ldb + C) * 2u; }
    const size_t kstep = (size_t)(BK * 2);
    const size_t hstepA = (size_t)HALF * g.lda * 2, hstepB = (size_t)HALF * g.ldb * 2;
    const size_t tstepA = 2 * hstepA, tstepB = 2 * hstepB;
    const unsigned ldsw = (unsigned)wid * 1024u;
    const int aoff = lds_byte(wr * 64 + fr, fq * 8), boff = lds_byte(wc * 32 + fr, fq * 8);
#define PG8_SA(b, h) (((b) * 2 + (h)) * HTB)
#define PG8_SB(b, h) ((4 + (b) * 2 + (h)) * HTB)
#define PG8_STAGE(bufoff, gbase, voff) do { _Pragma("unroll") for (int _i = 0; _i < 2; ++_i) \
        __builtin_amdgcn_global_load_lds((const unsigned*)((const char*)(gbase) + (voff)[_i]), (PG8_LAS unsigned*)(lds + (bufoff) + ldsw + _i * 8192), 16, 0, 0); } while (0)
#define PG8_LDA(dst, b, h) do { _Pragma("unroll") for (int m = 0; m < 4; ++m) _Pragma("unroll") for (int k = 0; k < 2; ++k) dst[m][k] = *(const PG8_LAS bf16x8*)(lds + PG8_SA(b, h) + aoff + m * 2048 + k * 1024); } while (0)
#define PG8_LDB(dst, b, h) do { _Pragma("unroll") for (int n = 0; n < 2; ++n) _Pragma("unroll") for (int k = 0; k < 2; ++k) dst[n][k] = *(const PG8_LAS bf16x8*)(lds + PG8_SB(b, h) + boff + n * 2048 + k * 1024); } while (0)
#define PG8_MMA(ai, bj, At, Bt) do { __builtin_amdgcn_s_setprio(1); _Pragma("unroll") for (int m = 0; m < 4; ++m) _Pragma("unroll") for (int n = 0; n < 2; ++n) _Pragma("unroll") for (int k = 0; k < 2; ++k) \
        acc[ai][bj][m][n] = __builtin_amdgcn_mfma_f32_16x16x32_bf16(Bt[n][k], At[m][k], acc[ai][bj][m][n], 0, 0, 0); __builtin_amdgcn_s_setprio(0); } while (0)
#define PG8_WAIT_V(n) asm volatile("s_waitcnt vmcnt(" #n ")" ::: "memory")
#define PG8_WAIT_L(n) asm volatile("s_waitcnt lgkmcnt(" #n ")" ::: "memory")
#define PG8_BAR __builtin_amdgcn_s_barrier()
#define PG8_SCHED __builtin_amdgcn_sched_barrier(0)
    Unit cur, nxt; int ui = 0;
    if (!S.next(0, cur)) return;
    f32x4 acc[2][2][4][2];
    float zf = 0.f; asm volatile("" : "+v"(zf));
#pragma unroll
    for (int a = 0; a < 2; ++a)
#pragma unroll
        for (int b = 0; b < 2; ++b)
#pragma unroll
            for (int m = 0; m < 4; ++m)
#pragma unroll
                for (int n = 0; n < 2; ++n) acc[a][b][m][n] = (f32x4){zf, zf, zf, zf};
    bf16x8 At[4][2], B0[2][2], B1[2][2];
    const char* cA = (const char*)(cur.sub ? g.A2 : g.A) + (size_t)cur.pm * tstepA + (size_t)cur.pn * g.a_pn_step; const char* cB = (const char*)(cur.sub ? g.Bt2 : g.Bt) + (size_t)cur.pn * tstepB;
    S.a_ready(cur);
    if constexpr (SP2) {
        PG8_STAGE(PG8_SB(0, 0), cB, voffB); PG8_STAGE(PG8_SB(0, 1), cB + hstepB, voffB); PG8_STAGE(PG8_SA(0, 0), cA, voffA); PG8_STAGE(PG8_SA(0, 1), cA + hstepA, voffA);
        if (wr == 1) PG8_BAR;
        PG8_WAIT_V(2); PG8_BAR;
        PG8_STAGE(PG8_SB(1, 0), cB + kstep, voffB); PG8_STAGE(PG8_SA(1, 0), cA + kstep, voffA); PG8_STAGE(PG8_SB(1, 1), cB + hstepB + kstep, voffB);
        PG8_WAIT_V(6); PG8_BAR;
    } else {
        PG8_STAGE(PG8_SB(0, 0), cB, voffB); PG8_STAGE(PG8_SA(0, 0), cA, voffA); PG8_STAGE(PG8_SB(0, 1), cB + hstepB, voffB); PG8_STAGE(PG8_SA(0, 1), cA + hstepA, voffA);
        if (wr == 1) PG8_BAR;
        PG8_WAIT_V(4); PG8_BAR;
        PG8_STAGE(PG8_SB(1, 0), cB + kstep, voffB); PG8_STAGE(PG8_SA(1, 0), cA + kstep, voffA); PG8_STAGE(PG8_SB(1, 1), cB + hstepB + kstep, voffB);
        PG8_WAIT_V(6); PG8_BAR;
    }
    for (;;) {
        const bool has_next = S.next(ui + 1, nxt);
        const char* nA = has_next ? (const char*)(nxt.sub ? g.A2 : g.A) + (size_t)nxt.pm * tstepA + (size_t)nxt.pn * g.a_pn_step : cA; const char* nB = has_next ? (const char*)(nxt.sub ? g.Bt2 : g.Bt) + (size_t)nxt.pn * tstepB : cB;
        for (int t = 0; t < nt; t += 2) {
            const bool last = (t == nt - 2);
            const char* a1 = cA + (size_t)(t + 1) * kstep;
            const char* a2 = last ? nA : cA + (size_t)(t + 2) * kstep; const char* b2 = last ? nB : cB + (size_t)(t + 2) * kstep;
            const char* a3 = a2 + kstep; const char* b3 = b2 + kstep;
            if (last && has_next) S.a_ready(nxt);
            if constexpr (SP2) {
            PG8_LDB(B0, 0, 0); PG8_LDB(B1, 0, 1); PG8_SCHED; PG8_LDA(At, 0, 0); PG8_STAGE(PG8_SA(1, 1), a1 + hstepA, voffA);
            PG8_WAIT_V(8); PG8_WAIT_L(0); PG8_BAR; PG8_MMA(0, 0, At, B0); PG8_MMA(0, 1, At, B1); PG8_BAR; PG8_SCHED;
            PG8_LDA(At, 0, 1); PG8_STAGE(PG8_SB(0, 0), b2, voffB); PG8_STAGE(PG8_SB(0, 1), b2 + hstepB, voffB); PG8_STAGE(PG8_SA(0, 0), a2, voffA);
            PG8_WAIT_V(8); PG8_WAIT_L(0); PG8_BAR; PG8_MMA(1, 0, At, B0); PG8_MMA(1, 1, At, B1); PG8_BAR; PG8_SCHED;
            PG8_LDB(B0, 1, 0); PG8_LDB(B1, 1, 1); PG8_SCHED; PG8_LDA(At, 1, 0); PG8_STAGE(PG8_SA(0, 1), a2 + hstepA, voffA);
            PG8_WAIT_V(8); PG8_WAIT_L(0); PG8_BAR; PG8_MMA(0, 0, At, B0); PG8_MMA(0, 1, At, B1); PG8_BAR; PG8_SCHED;
            PG8_LDA(At, 1, 1); PG8_STAGE(PG8_SB(1, 0), b3, voffB); PG8_STAGE(PG8_SB(1, 1), b3 + hstepB, voffB); PG8_STAGE(PG8_SA(1, 0), a3, voffA);
            PG8_WAIT_V(8); PG8_WAIT_L(0); PG8_BAR; PG8_MMA(1, 0, At, B0); PG8_MMA(1, 1, At, B1); PG8_BAR; PG8_SCHED;
            } else {
            PG8_LDB(B0, 0, 0); PG8_SCHED; PG8_LDA(At, 0, 0); PG8_STAGE(PG8_SA(1, 1), a1 + hstepA, voffA);
            PG8_WAIT_L(8); PG8_BAR; PG8_WAIT_L(0); PG8_MMA(0, 0, At, B0); PG8_BAR; PG8_SCHED;
            PG8_LDB(B1, 0, 1); PG8_STAGE(PG8_SB(0, 0), b2, voffB);
            PG8_BAR; PG8_WAIT_L(0); PG8_MMA(0, 1, At, B1); PG8_BAR;
            PG8_LDA(At, 0, 1); PG8_STAGE(PG8_SA(0, 0), a2, voffA);
            PG8_BAR; PG8_WAIT_L(0); PG8_MMA(1, 0, At, B0); PG8_BAR; PG8_SCHED;
            PG8_STAGE(PG8_SB(0, 1), b2 + hstepB, voffB);
            PG8_WAIT_V(6); PG8_BAR; PG8_MMA(1, 1, At, B1); PG8_BAR;
            PG8_LDB(B0, 1, 0); PG8_SCHED; PG8_LDA(At, 1, 0); PG8_STAGE(PG8_SA(0, 1), a2 + hstepA, voffA);
            PG8_WAIT_L(8); PG8_BAR; PG8_WAIT_L(0); PG8_MMA(0, 0, At, B0); PG8_BAR; PG8_SCHED;
            PG8_LDB(B1, 1, 1); PG8_STAGE(PG8_SB(1, 0), b3, voffB);
            PG8_BAR; PG8_WAIT_L(0); PG8_MMA(0, 1, At, B1); PG8_BAR;
            PG8_LDA(At, 1, 1); PG8_STAGE(PG8_SA(1, 0), a3, voffA);
            PG8_BAR; PG8_WAIT_L(0); PG8_MMA(1, 0, At, B0); PG8_BAR; PG8_SCHED;
            PG8_STAGE(PG8_SB(1, 1), b3 + hstepB, voffB);
            PG8_WAIT_V(6); PG8_BAR; PG8_MMA(1, 1, At, B1); PG8_BAR;
            }
        }
        if constexpr (ALIGN_EPI) { if (wr == 0) PG8_BAR; }
        if constexpr (!Epi::AFTER_DRAIN) { E(acc, cur, wr, wc, fr, fq); S.done(cur); }
        if (!has_next) break;
        if (!Epi::keep(cur)) {
        float zf2 = 0.f; asm volatile("" : "+v"(zf2));
#pragma unroll
        for (int a = 0; a < 2; ++a)
#pragma unroll
            for (int b = 0; b < 2; ++b)
#pragma unroll
                for (int m = 0; m < 4; ++m)
#pragma unroll
                    for (int n = 0; n < 2; ++n) acc[a][b][m][n] = (f32x4){zf2, zf2, zf2, zf2};
        }
        cur = nxt; cA = nA; cB = nB; ++ui;
        if constexpr (ALIGN_EPI) { if (wr == 1) PG8_BAR; }
    }
    PG8_WAIT_V(0);
    if constexpr (!ALIGN_EPI) { if (wr == 0) PG8_BAR; }
    PG8_BAR;
    if constexpr (Epi::AFTER_DRAIN) { E.fused(acc, cur, wr, wc, fr, fq, lds, wid, lane); S.done(cur); }
#undef PG8_SA
#undef PG8_SB
#undef PG8_STAGE
#undef PG8_LDA
#undef PG8_LDB
#undef PG8_MMA
#undef PG8_WAIT_V
#undef PG8_WAIT_L
#undef PG8_BAR
#undef PG8_SCHED
}
}

#define GAS __attribute__((address_space(1)))
#define LAS __attribute__((address_space(3)))
typedef unsigned short bf16;
typedef unsigned v4u __attribute__((ext_vector_type(4)));
typedef float f32x4 __attribute__((ext_vector_type(4)));
typedef short bf16x8 __attribute__((ext_vector_type(8)));
typedef GAS unsigned gu32;
typedef GAS unsigned long long gu64;
#define RLX_AGENT __ATOMIC_RELAXED, __HIP_MEMORY_SCOPE_AGENT
#define LDS_WAIT() asm volatile("s_waitcnt lgkmcnt(0)" ::: "memory")
#define VM_WAIT() asm volatile("s_waitcnt vmcnt(0)" ::: "memory")
__device__ __forceinline__ unsigned long long rt() { return __builtin_amdgcn_s_memrealtime(); }
__device__ __forceinline__ unsigned f2bf(float f) { unsigned u = __builtin_bit_cast(unsigned, f); return (u + 0x7fffu + ((u >> 16) & 1u)) >> 16; }
__device__ __forceinline__ unsigned pk2(float lo, float hi) { return f2bf(lo) | (f2bf(hi) << 16); }

#define XB_TMO      128
#define XB_XCNT(j)  (256  + 64 * (j))
#define XB_XSUB(j)  (1280 + 64 * (j))
#define XB_XGEN(j)  (2304 + 64 * (j))
#define XB_TOP      3328
#define XB_TOPGEN   3392
#define XCD_BAR_WORDS 3456
#define XB_SPIN_CAP (1u << 18)

__device__ __forceinline__ unsigned xb_ld(unsigned* p)              { return __hip_atomic_load(p, __ATOMIC_RELAXED, __HIP_MEMORY_SCOPE_AGENT); }
__device__ __forceinline__ unsigned xb_add(unsigned* p, unsigned v) { return __hip_atomic_fetch_add(p, v, __ATOMIC_RELAXED, __HIP_MEMORY_SCOPE_AGENT); }
__device__ __forceinline__ unsigned xb_xcc_id() { return (unsigned)__builtin_amdgcn_s_getreg((3 << 11) | 20) & 0xFu; }
#define XB_SPIN(cond, bar) do { unsigned _sp = 0; while (cond) { __builtin_amdgcn_s_sleep(1); \
    if ((++_sp & 255u) == 0u) { if (xb_ld(&(bar)[XB_TMO])) break; if (_sp > XB_SPIN_CAP) { atomicAdd(&(bar)[XB_TMO], 1u); break; } } } } while (0)

struct XcdBarrier {
    unsigned* bar; unsigned x;
    volatile LAS unsigned* st;
};

__device__ __forceinline__ XcdBarrier xcd_barrier_post(unsigned* bar, volatile LAS unsigned* st) {
    XcdBarrier b; b.bar = bar; b.x = xb_xcc_id(); b.st = st;
    if (threadIdx.x == 0) (void)xb_add(&bar[XB_XCNT(b.x)], 1u);
    return b;
}
__device__ __forceinline__ void xcd_barrier_complete(unsigned* bar, unsigned x, unsigned& nloc, unsigned& nx) {
    const unsigned G = gridDim.x * gridDim.y * gridDim.z;
    unsigned sum, cnt, mine, sp = 0u;
    for (;;) {
        sum = 0u; cnt = 0u; mine = 0u;
#pragma unroll
        for (unsigned j = 0; j < 16; ++j) { const unsigned c = xb_ld(&bar[XB_XCNT(j)]); sum += c; cnt += (c > 0u) ? 1u : 0u; mine = (j == x) ? c : mine; }
        if (sum == G) break;
        __builtin_amdgcn_s_sleep(1);
        if ((++sp & 255u) == 0u) { if (xb_ld(&bar[XB_TMO])) break; if (sp > XB_SPIN_CAP) { atomicAdd(&bar[XB_TMO], 1u); break; } }
    }
    nloc = mine > 0u ? mine : 1u; nx = cnt > 0u ? cnt : 1u;
}

__device__ __forceinline__ void xcd_barrier(const XcdBarrier& b) {
    asm volatile("s_waitcnt vmcnt(0)" ::: "memory");
    __syncthreads();
    if (threadIdx.x == 0) {
        unsigned* bar = b.bar;
        __builtin_amdgcn_s_waitcnt(0);
        unsigned nloc = b.st[0], nx = b.st[1];
        if (nloc == 0u) { xcd_barrier_complete(bar, b.x, nloc, nx); b.st[0] = nloc; b.st[1] = nx; }
        const unsigned old = xb_add(&bar[XB_XSUB(b.x)], 1u);
        const unsigned gen = old / nloc;
        if (old + 1u == (gen + 1u) * nloc) {
            __builtin_amdgcn_fence(__ATOMIC_RELEASE, "agent");
            asm volatile("s_waitcnt vmcnt(0)" ::: "memory");
            const unsigned og = xb_add(&bar[XB_TOP], 1u);
            const unsigned tg = og / nx;
            if (og + 1u == (tg + 1u) * nx) xb_add(&bar[XB_TOPGEN], 1u);
            else XB_SPIN(xb_ld(&bar[XB_TOPGEN]) == tg, bar);
            __builtin_amdgcn_fence(__ATOMIC_ACQUIRE, "agent");
            xb_add(&bar[XB_XGEN(b.x)], 1u);
            asm volatile("s_waitcnt vmcnt(0)" ::: "memory");
        } else {
            XB_SPIN(xb_ld(&bar[XB_XGEN(b.x)]) == gen, bar);
            __builtin_amdgcn_fence(__ATOMIC_ACQUIRE, "agent");
            asm volatile("s_waitcnt vmcnt(0)" ::: "memory");
        }
    }
    __syncthreads();
}

constexpr int D = 2048, SEQ = 16384, M = 32768, DEPTH = 2;
constexpr int NCH = 256;
constexpr int NSEG = 16, CPS = NCH / NSEG;
constexpr int DIN = 8224;
constexpr float RMS_EPS = 1e-6f;
constexpr int NWAVES = 8;
constexpr int NPH = 15;

constexpr size_t MiB = 1u << 20;
constexpr size_t WS_CTL = 0, CTL_ZERO_BYTES = 1 * MiB;
constexpr size_t WS_WIN = 1 * MiB;
constexpr size_t WS_WUPG = 34 * MiB;
constexpr size_t WS_WUPP = 38 * MiB;
constexpr size_t WS_WOUT = 42 * MiB;
constexpr size_t WS_WQ = 50 * MiB;
constexpr size_t WS_POOLW = 58 * MiB;
constexpr size_t WS_SUBK = 58 * MiB + 512 * 1024;
constexpr size_t WS_USC = 59 * MiB, WS_VSC = 59 * MiB + 512 * 1024;
constexpr size_t WS_UTAB = 60 * MiB, WS_VTAB = 124 * MiB;
constexpr size_t WS_H = 188 * MiB;
constexpr size_t WS_POOLED = WS_H, WS_POOLMIX = WS_H + 64 * MiB, WS_SEGL = WS_H + 64 * MiB, WS_SIN = WS_H + 96 * MiB;
constexpr size_t WS_QK = 316 * MiB;
constexpr size_t WS_P = 380 * MiB;
constexpr size_t WS_VT = 444 * MiB;
constexpr size_t WS_R = 508 * MiB;
constexpr size_t WS_MERGED = WS_VT;
constexpr size_t WS_G = 572 * MiB;
constexpr size_t WS_PQ = WS_G, WS_IDX = 700 * MiB, WS_GATE = 716 * MiB;
constexpr size_t WS_AFB = 828 * MiB;
constexpr size_t WS_QE = 832 * MiB;
constexpr size_t WS_GLAOUT = WS_QE;
constexpr size_t WS_KDT = 896 * MiB;
constexpr size_t WS_ATTN = 960 * MiB;
constexpr size_t WS_DEC = 992 * MiB;
constexpr size_t WS_SSP1 = 994 * MiB, WS_SSP2 = 998 * MiB;
constexpr size_t WS_END = 1000 * MiB;
constexpr int CW_BAR = 4096;

constexpr int RING_BYTES = 131072;
constexpr int LDSCTL_OFF = RING_BYTES, MISC_OFF = LDSCTL_OFF + 320;
constexpr int LDS_BYTES = 147456;

typedef unsigned v2u __attribute__((ext_vector_type(2)));
typedef float f32x2 __attribute__((ext_vector_type(2)));
typedef float f32x16 __attribute__((ext_vector_type(16)));
using pg8::pkbf; using pg8::bflo; using pg8::bfhi;
__device__ __forceinline__ float bf2f(bf16 h) { return __builtin_bit_cast(float, (unsigned)h << 16); }
__device__ __forceinline__ bf16 f2bf1(float f) { return (bf16)(pkbf(f, 0.f) & 0xffffu); }
__device__ __forceinline__ float wave_sum(float v) {
#pragma unroll
    for (int o = 1; o < 64; o <<= 1) v += __shfl_xor(v, o);
    return v;
}
__device__ __forceinline__ float wave_max(float v) {
#pragma unroll
    for (int o = 1; o < 64; o <<= 1) v = fmaxf(v, __shfl_xor(v, o));
    return v;
}
__device__ __forceinline__ f32x16 mfma32(bf16x8 a, bf16x8 b, f32x16 c) { return __builtin_amdgcn_mfma_f32_32x32x16_bf16(a, b, c, 0, 0, 0); }
__device__ __forceinline__ bf16x8 mk8(unsigned a, unsigned b, unsigned c, unsigned d) { v4u t = {a, b, c, d}; return __builtin_bit_cast(bf16x8, t); }

#define LDS_BAR() do { asm volatile("s_waitcnt lgkmcnt(0)" ::: "memory"); __builtin_amdgcn_s_barrier(); asm volatile("" ::: "memory"); } while (0)
__device__ __forceinline__ void transpose_item(const float* __restrict__ W, int N, bf16* WT, int ldt, int dst_row0, int k0, int n0, LAS float* scr, int lane, const float* __restrict__ gk = nullptr) {
#pragma unroll
    for (int i = 0; i < 8; ++i) { const int kk = 8 * i + (lane >> 3), c4 = 4 * (lane & 7); f32x4 v = *(const f32x4*)(W + (size_t)(k0 + kk) * N + n0 + c4);
        if (gk) v = v * gk[k0 + kk];
        LAS float* d = scr + kk * 33 + c4; d[0] = v.x; d[1] = v.y; d[2] = v.z; d[3] = v.w; }
    LDS_WAIT(); asm volatile("" ::: "memory");
    const int c = lane & 7;
#pragma unroll
    for (int j = 0; j < 4; ++j) { const int n = (lane >> 3) + 8 * j; const LAS float* s = scr + (8 * c) * 33 + n;
        v4u o; o.x = pkbf(s[0 * 33], s[1 * 33]); o.y = pkbf(s[2 * 33], s[3 * 33]); o.z = pkbf(s[4 * 33], s[5 * 33]); o.w = pkbf(s[6 * 33], s[7 * 33]);
        *(GAS v4u*)(WT + (size_t)(dst_row0 + n) * ldt + k0 + 8 * c) = o; }
    LDS_WAIT(); asm volatile("" ::: "memory");
}
__device__ __forceinline__ void transpose_matrix(const float* W, int K, int N, bf16* WT, LAS float* scr, int lane, int gw, int NGW) {
    const int nblk = N / 32, items = (K / 64) * nblk;
    for (int it = gw; it < items; it += NGW) { const int kb = it / nblk, nb = it % nblk; transpose_item(W, N, WT, K, nb * 32, kb * 64, nb * 32, scr, lane); }
}
__device__ __forceinline__ void table_rows_fp8(const float* __restrict__ T, unsigned* __restrict__ O, float* __restrict__ inv, int rowA, int rowB, int lane, const float* __restrict__ gc = nullptr) {
    const f32x4* sa = (const f32x4*)(T + (size_t)rowA * 2048) + lane; const f32x4* sb = (const f32x4*)(T + (size_t)rowB * 2048) + lane;
    f32x4 va[8], vb[8]; float ama = 0.f, amb = 0.f;
#pragma unroll
    for (int j = 0; j < 8; ++j) { va[j] = sa[64 * j]; vb[j] = sb[64 * j]; }
    if (gc) {
#pragma unroll
        for (int j = 0; j < 8; ++j) { const f32x4 gq = ((const f32x4*)gc)[64 * j + lane]; va[j] = va[j] * gq; vb[j] = vb[j] * gq; } }
#pragma unroll
    for (int j = 0; j < 8; ++j) { ama = fmaxf(ama, fmaxf(fmaxf(fabsf(va[j].x), fabsf(va[j].y)), fmaxf(fabsf(va[j].z), fabsf(va[j].w)))); amb = fmaxf(amb, fmaxf(fmaxf(fabsf(vb[j].x), fabsf(vb[j].y)), fmaxf(fabsf(vb[j].z), fabsf(vb[j].w)))); }
#pragma unroll
    for (int o = 1; o < 64; o <<= 1) { ama = fmaxf(ama, __shfl_xor(ama, o)); amb = fmaxf(amb, __shfl_xor(amb, o)); }
    float ea = (ama > 1e-30f) ? floorf(__log2f(224.f / ama)) : 0.f; ea = fminf(fmaxf(ea, -60.f), 60.f);
    float eb = (amb > 1e-30f) ? floorf(__log2f(224.f / amb)) : 0.f; eb = fminf(fmaxf(eb, -60.f), 60.f);
    const float sca = exp2f(ea), scb = exp2f(eb);
#pragma unroll
    for (int j = 0; j < 8; ++j) { const int dw = 64 * j + lane; int w = 0;
        w = __builtin_amdgcn_cvt_pk_fp8_f32(va[j].x * sca, va[j].y * sca, w, false); w = __builtin_amdgcn_cvt_pk_fp8_f32(va[j].z * sca, va[j].w * sca, w, true);
        O[((size_t)(dw >> 5) * 16384 + rowA) * 32 + (dw & 31)] = (unsigned)w; w = 0;
        w = __builtin_amdgcn_cvt_pk_fp8_f32(vb[j].x * scb, vb[j].y * scb, w, false); w = __builtin_amdgcn_cvt_pk_fp8_f32(vb[j].z * scb, vb[j].w * scb, w, true);
        O[((size_t)(dw >> 5) * 16384 + rowB) * 32 + (dw & 31)] = (unsigned)w; }
    if (lane == 0) { inv[rowA] = exp2f(-ea); inv[rowB] = exp2f(-eb); }
}
__device__ __forceinline__ void rmsnorm_row(const float* xrow, const float* __restrict__ g, bf16* orow, int lane) {
    const f32x4* xr = (const f32x4*)xrow + lane; const f32x4* gr = (const f32x4*)g + lane;
    f32x4 v[8]; float s = 0.f;
#pragma unroll
    for (int j = 0; j < 8; ++j) { v[j] = xr[64 * j]; s += (v[j].x * v[j].x + v[j].y * v[j].y) + (v[j].z * v[j].z + v[j].w * v[j].w); }
    const float rs = rsqrtf(wave_sum(s) * (1.f / 2048.f) + RMS_EPS);
    v2u* o8 = (v2u*)orow + lane;
#pragma unroll
    for (int j = 0; j < 8; ++j) { const f32x4 gg = gr[64 * j]; v2u o; o.x = pkbf(v[j].x * rs * gg.x, v[j].y * rs * gg.y); o.y = pkbf(v[j].z * rs * gg.z, v[j].w * rs * gg.w); o8[64 * j] = o; }
}

constexpr int PA_A = 0, PA_QT = 4096, PA_Q = 8192, PA_K = PA_Q + 17408, PA_KE = PA_K + 17408, PA_BYTES = PA_KE + 17408;
static_assert(2 * PA_BYTES <= RING_BYTES, "prep LDS");
struct PrepIn { f32x4 a; unsigned q[8], k[8]; float wg[2][16]; float bias[2]; };
__device__ __forceinline__ void gla_prep_load(PrepIn& in, int uid, const bf16* __restrict__ QK, const float* __restrict__ AFB, const float* __restrict__ Wgf, const float* __restrict__ Bgf,
                                              const float* __restrict__ Wgb, const float* __restrict__ Bgb, int tid) {
    const int dir = uid & 1, h = (uid >> 1) & 3, bn = uid >> 3; const size_t row0 = (size_t)bn * 64;
    const float* Wg = dir ? Wgb : Wgf; const float* Bg = dir ? Bgb : Bgf;
    { const int t = (tid & 255) >> 2, q4 = tid & 3; in.a = *(const f32x4*)(AFB + (row0 + t) * 32 + dir * 16 + 4 * q4); }
    const int c2 = tid & 63, tq = tid >> 6;
#pragma unroll
    for (int j = 0; j < 8; ++j) { const bf16* src = QK + (row0 + tq * 8 + j) * 1024 + h * 128 + 2 * c2; in.q[j] = *(const unsigned*)src; in.k[j] = *(const unsigned*)(src + 512); }
#pragma unroll
    for (int r = 0; r < 16; ++r) { const f32x2 w2 = *(const f32x2*)(Wg + r * 512 + h * 128 + 2 * c2); in.wg[0][r] = w2.x; in.wg[1][r] = w2.y; }
    { const f32x2 b2 = *(const f32x2*)(Bg + h * 128 + 2 * c2); in.bias[0] = b2.x; in.bias[1] = b2.y; }
}
__device__ __forceinline__ void gla_prep_unit(int uid, int uid_next, PrepIn& in, LAS unsigned char* lds, const bf16* __restrict__ QK, const float* __restrict__ AFB, const float* __restrict__ Wgf, const float* __restrict__ Bgf,
                                              const float* __restrict__ Wgb, const float* __restrict__ Bgb, bf16* QE, bf16* KDT, bf16* ATTN, float* DEC, int tid, int wave, int lane) {
    const int dir = uid & 1;
    LAS float* aS = (LAS float*)(lds + PA_A); LAS float* qtot = (LAS float*)(lds + PA_QT);
    LAS bf16* qS = (LAS bf16*)(lds + PA_Q); LAS bf16* kS = (LAS bf16*)(lds + PA_K); LAS bf16* keS = (LAS bf16*)(lds + PA_KE);
    if (tid < 256) { const int t = tid >> 2, q4 = tid & 3; *(LAS f32x4*)(aS + t * 16 + 4 * q4) = in.a; }
    const int c2 = tid & 63, tq = tid >> 6;
    unsigned qv[8], kv[8]; float wg0[16], wg1[16];
#pragma unroll
    for (int j = 0; j < 8; ++j) { qv[j] = in.q[j]; kv[j] = in.k[j]; }
#pragma unroll
    for (int r = 0; r < 16; ++r) { wg0[r] = in.wg[0][r]; wg1[r] = in.wg[1][r]; }
    const float bias0 = in.bias[0], bias1 = in.bias[1];
    gla_prep_load(in, uid_next, QK, AFB, Wgf, Bgf, Wgb, Bgb, tid);
    LDS_BAR();
    float lg0[8], lg1[8], P0[8], P1[8]; float run0 = 0.f, run1 = 0.f;
#pragma unroll
    for (int j = 0; j < 8; ++j) { const int t = tq * 8 + j;
        const f32x4 a0 = *(const LAS f32x4*)(aS + t * 16), a1 = *(const LAS f32x4*)(aS + t * 16 + 4), a2 = *(const LAS f32x4*)(aS + t * 16 + 8), a3 = *(const LAS f32x4*)(aS + t * 16 + 12);
        f32x2 z2 = {bias0, bias1};
        const float av[16] = {a0.x, a0.y, a0.z, a0.w, a1.x, a1.y, a1.z, a1.w, a2.x, a2.y, a2.z, a2.w, a3.x, a3.y, a3.z, a3.w};
#pragma unroll
        for (int r2 = 0; r2 < 16; ++r2) z2 = __builtin_elementwise_fma((f32x2){av[r2], av[r2]}, (f32x2){wg0[r2], wg1[r2]}, z2);
        const float z0 = z2.x, z1 = z2.y;
        lg0[j] = (fminf(z0, 0.f) - __logf(1.f + __expf(-fabsf(z0)))) * (1.f / 16.f); lg1[j] = (fminf(z1, 0.f) - __logf(1.f + __expf(-fabsf(z1)))) * (1.f / 16.f);
        run0 += lg0[j]; run1 += lg1[j]; P0[j] = run0; P1[j] = run1; }
    *(LAS f32x2*)(qtot + tq * 128 + 2 * c2) = (f32x2){run0, run1};
    LDS_BAR();
    float btot0 = 0.f, btot1 = 0.f, off0 = 0.f, off1 = 0.f;
#pragma unroll
    for (int g8 = 0; g8 < 8; ++g8) { const f32x2 v = *(const LAS f32x2*)(qtot + g8 * 128 + 2 * c2); btot0 += v.x; btot1 += v.y;
        const bool before = dir ? (g8 > tq) : (g8 < tq); off0 += before ? v.x : 0.f; off1 += before ? v.y : 0.f; }
    const float dt0 = __expf(btot0), dt1 = __expf(btot1);
    if (tq == 0) *(f32x2*)(DEC + (size_t)uid * 128 + 2 * c2) = (f32x2){dt0, dt1};
#pragma unroll
    for (int j = 0; j < 8; ++j) { const int t = tq * 8 + j;
        const float b0 = (dir ? (run0 - P0[j] + lg0[j]) : P0[j]) + off0, b1 = (dir ? (run1 - P1[j] + lg1[j]) : P1[j]) + off1;
        const float q0 = bflo(qv[j]), q1 = bfhi(qv[j]), k0 = bflo(kv[j]), k1 = bfhi(kv[j]);
        const float e0 = __expf(b0), e1 = __expf(b1), i0 = __builtin_amdgcn_rcpf(e0), i1 = __builtin_amdgcn_rcpf(e1);
        *(LAS unsigned*)(qS + t * 136 + 2 * c2) = pkbf(q0 * e0, q1 * e1);
        *(LAS unsigned*)(keS + t * 136 + 2 * c2) = pkbf(k0 * i0, k1 * i1);
        *(LAS unsigned*)(kS + t * 136 + 2 * c2) = pkbf(k0 * (dt0 * i0), k1 * (dt1 * i1)); }
    LDS_BAR();
    const int r = lane & 31, hh = lane >> 5;
    if (wave < 4) {
        const int jt = wave >> 1, it = wave & 1;
        f32x16 acc;
#pragma unroll
        for (int e = 0; e < 16; ++e) acc[e] = 0.f;
#pragma unroll
        for (int s = 0; s < 8; ++s) { const bf16x8 A = *(const LAS bf16x8*)(keS + (32 * jt + r) * 136 + 16 * s + 8 * hh); const bf16x8 B = *(const LAS bf16x8*)(qS + (32 * it + r) * 136 + 16 * s + 8 * hh); acc = mfma32(A, B, acc); }
        const int i = 32 * it + r; float v[16];
#pragma unroll
        for (int e = 0; e < 16; ++e) { const int j = 32 * jt + (e & 3) + 8 * (e >> 2) + 4 * hh; const bool keep = dir ? (j > i) : (j <= i); v[e] = keep ? acc[e] : 0.f; }
#pragma unroll
        for (int s2 = 0; s2 < 2; ++s2) { v4u o; o.x = pkbf(v[8 * s2 + 0], v[8 * s2 + 1]); o.y = pkbf(v[8 * s2 + 2], v[8 * s2 + 3]); o.z = pkbf(v[8 * s2 + 4], v[8 * s2 + 5]); o.w = pkbf(v[8 * s2 + 6], v[8 * s2 + 7]);
            *(v4u*)(ATTN + (size_t)uid * 4096 + (size_t)((it * 4 + 2 * jt + s2) * 64 + lane) * 8) = o; }
    }
#pragma unroll
    for (int e = 0; e < 2; ++e) { const int f = wave * 2 + e;
        {
            const int it = f >> 3, ks = f & 7, dt = ks >> 1, s2 = ks & 1;
            const LAS bf16* base = qS + (32 * it + r) * 136 + 32 * dt + 16 * s2 + 4 * hh;
            const v2u lo = *(const LAS v2u*)base, hi = *(const LAS v2u*)(base + 8);
            v4u o = {lo.x, lo.y, hi.x, hi.y};
            *(v4u*)(QE + (size_t)uid * 8192 + (size_t)(f * 64 + lane) * 8) = o; }
        {
            const int dt = f >> 2, ks = f & 3, dim = 32 * dt + r;
            unsigned w[4];
#pragma unroll
            for (int p2 = 0; p2 < 4; ++p2) { const int j0 = 2 * p2, j1 = 2 * p2 + 1;
                const int t0 = 16 * ks + 8 * (j0 >> 2) + 4 * hh + (j0 & 3), t1 = 16 * ks + 8 * (j1 >> 2) + 4 * hh + (j1 & 3);
                w[p2] = (unsigned)kS[t0 * 136 + dim] | ((unsigned)kS[t1 * 136 + dim] << 16); }
            v4u o = {w[0], w[1], w[2], w[3]};
            *(v4u*)(KDT + (size_t)uid * 8192 + (size_t)(f * 64 + lane) * 8) = o; }
    }
}

__device__ __forceinline__ void pool_item(int item, const bf16* __restrict__ P, bf16* __restrict__ PO) {
    const int oct = item & 127, run = item >> 7; const int m0 = run * 32, b = m0 >> 14, t0 = m0 & (SEQ - 1);
    const int g = oct >> 5, hw = 1 << g;
    const bf16* Pb = P + (size_t)b * SEQ * 1024 + oct * 8; bf16* Ob = PO + (size_t)b * SEQ * 1024 + oct * 8;
    float s[8];
#pragma unroll
    for (int e = 0; e < 8; ++e) s[e] = 0.f;
    const int lo0 = (t0 - hw > 0) ? t0 - hw : 0, hi0 = (t0 + hw < SEQ) ? t0 + hw : SEQ;
    for (int u = lo0; u < hi0; ++u) { const v4u w = *(const v4u*)(Pb + (size_t)u * 1024);
        s[0] += bflo(w.x); s[1] += bfhi(w.x); s[2] += bflo(w.y); s[3] += bfhi(w.y); s[4] += bflo(w.z); s[5] += bfhi(w.z); s[6] += bflo(w.w); s[7] += bfhi(w.w); }
    for (int t = t0; t < t0 + 32; ++t) {
        const int lo = (t - hw > 0) ? t - hw : 0, hi = (t + hw < SEQ) ? t + hw : SEQ; const float ic = 1.f / (float)(hi - lo);
        const v4u w = *(const v4u*)(Pb + (size_t)t * 1024);
        v4u o; o.x = pkbf(s[0] * ic - bflo(w.x), s[1] * ic - bfhi(w.x)); o.y = pkbf(s[2] * ic - bflo(w.y), s[3] * ic - bfhi(w.y));
        o.z = pkbf(s[4] * ic - bflo(w.z), s[5] * ic - bfhi(w.z)); o.w = pkbf(s[6] * ic - bflo(w.w), s[7] * ic - bfhi(w.w));
        *(v4u*)(Ob + (size_t)t * 1024) = o;
        if (t - hw >= 0) { const v4u x = *(const v4u*)(Pb + (size_t)(t - hw) * 1024);
            s[0] -= bflo(x.x); s[1] -= bfhi(x.x); s[2] -= bflo(x.y); s[3] -= bfhi(x.y); s[4] -= bflo(x.z); s[5] -= bfhi(x.z); s[6] -= bflo(x.w); s[7] -= bfhi(x.w); }
        if (t + hw < SEQ) { const v4u x = *(const v4u*)(Pb + (size_t)(t + hw) * 1024);
            s[0] += bflo(x.x); s[1] += bfhi(x.x); s[2] += bflo(x.y); s[3] += bfhi(x.y); s[4] += bflo(x.z); s[5] += bfhi(x.z); s[6] += bflo(x.w); s[7] += bfhi(x.w); }
    }
}

constexpr int SB_QE = 0, SB_AT = 16384, SB_KD = 24576, SB_DEC = 40960, SB_BYTES = 41472;
template <bool FULL> __device__ __forceinline__ void gla_scan_block(int su, LAS unsigned char* lds, const bf16* __restrict__ QE, const bf16* __restrict__ ATTN, const bf16* __restrict__ KDT,
                                                                    const float* __restrict__ DEC, const bf16* __restrict__ VT, float* SEGL, float* SEGD, bf16* OF, bf16* OB,
                                                                    int tid, int wave, int lane) {
    const int bhd = su / NSEG, seg = su % NSEG, dir = bhd & 1, h = (bhd >> 1) & 3, b = bhd >> 3;
    const int r = lane & 31, hh = lane >> 5, w = wave;
    f32x16 st[4];
    if (FULL) {
#pragma unroll
        for (int dt = 0; dt < 4; ++dt)
#pragma unroll
            for (int e = 0; e < 16; ++e) st[dt][e] = 0.f;
        for (int sp = 0; sp < seg; ++sp) { const int su2 = bhd * NSEG + sp;
#pragma unroll
            for (int dt = 0; dt < 4; ++dt) {
#pragma unroll
                for (int q = 0; q < 4; ++q) { const f32x4 d4 = *(const f32x4*)(SEGD + (size_t)su2 * 128 + 32 * dt + 8 * q + 4 * hh);
                    const size_t i0 = ((size_t)((su2 * 8 + w) * 4 + dt) * 16 + 4 * q) * 64 + lane;
                    st[dt][4 * q + 0] = d4.x * st[dt][4 * q + 0] + SEGL[i0]; st[dt][4 * q + 1] = d4.y * st[dt][4 * q + 1] + SEGL[i0 + 64];
                    st[dt][4 * q + 2] = d4.z * st[dt][4 * q + 2] + SEGL[i0 + 128]; st[dt][4 * q + 3] = d4.w * st[dt][4 * q + 3] + SEGL[i0 + 192]; } } }
    } else {
#pragma unroll
        for (int dt = 0; dt < 4; ++dt)
#pragma unroll
            for (int e = 0; e < 16; ++e) st[dt][e] = 0.f;
    }
    v4u sg[5]; v4u sdec; v2u vn[8]; bf16x8 vc[4];
#define SCAN_UID(i_) ({ const int sp_ = seg * CPS + (i_); const int n_ = dir ? (NCH - 1 - sp_) : sp_; (((b * NCH + n_) * 4 + h) * 2 + dir); })
#define SCAN_LOAD(i_) do { const int uid_ = SCAN_UID(i_); \
        if (FULL) { sg[0] = *(const v4u*)(QE + (size_t)uid_ * 8192 + (size_t)tid * 8); sg[1] = *(const v4u*)(QE + (size_t)uid_ * 8192 + (size_t)(tid + 512) * 8); \
                    sg[2] = *(const v4u*)(ATTN + (size_t)uid_ * 4096 + (size_t)tid * 8); } \
        sg[3] = *(const v4u*)(KDT + (size_t)uid_ * 8192 + (size_t)tid * 8); sg[4] = *(const v4u*)(KDT + (size_t)uid_ * 8192 + (size_t)(tid + 512) * 8); \
        if (tid < 32) sdec = *(const v4u*)(DEC + (size_t)uid_ * 128 + tid * 4); \
        const bf16* vb_ = VT + ((size_t)(uid_ >> 3) * 1024 + h * 256 + 32 * w + r) * 64 + 4 * hh; \
        _Pragma("unroll") for (int ks_ = 0; ks_ < 4; ++ks_) { vn[2 * ks_] = *(const v2u*)(vb_ + 16 * ks_); vn[2 * ks_ + 1] = *(const v2u*)(vb_ + 16 * ks_ + 8); } } while (0)
#define SCAN_STORE(buf_) do { LAS unsigned char* B_ = lds + (buf_) * SB_BYTES; \
        if (FULL) { *(LAS v4u*)(B_ + SB_QE + tid * 16) = sg[0]; *(LAS v4u*)(B_ + SB_QE + (tid + 512) * 16) = sg[1]; *(LAS v4u*)(B_ + SB_AT + tid * 16) = sg[2]; } \
        *(LAS v4u*)(B_ + SB_KD + tid * 16) = sg[3]; *(LAS v4u*)(B_ + SB_KD + (tid + 512) * 16) = sg[4]; \
        if (tid < 32) *(LAS v4u*)(B_ + SB_DEC + tid * 16) = sdec; \
        _Pragma("unroll") for (int ks_ = 0; ks_ < 4; ++ks_) vc[ks_] = mk8(vn[2 * ks_].x, vn[2 * ks_].y, vn[2 * ks_ + 1].x, vn[2 * ks_ + 1].y); } while (0)
    float dprod = 1.f;
    LDS_BAR();
    SCAN_LOAD(0); SCAN_STORE(0);
    LDS_BAR();
    for (int i = 0; i < CPS; ++i) {
        const bool more = (i + 1 < CPS);
        if (more) SCAN_LOAD(i + 1);
        const LAS unsigned char* B = lds + (i & 1) * SB_BYTES;
        if (FULL) {
            f32x16 o0, o1;
#pragma unroll
            for (int e = 0; e < 16; ++e) { o0[e] = 0.f; o1[e] = 0.f; }
#pragma unroll
            for (int dt = 0; dt < 4; ++dt)
#pragma unroll
                for (int s2 = 0; s2 < 2; ++s2) { const int ks = 2 * dt + s2;
                    const bf16x8 sf = mk8(pkbf(st[dt][8 * s2 + 0], st[dt][8 * s2 + 1]), pkbf(st[dt][8 * s2 + 2], st[dt][8 * s2 + 3]), pkbf(st[dt][8 * s2 + 4], st[dt][8 * s2 + 5]), pkbf(st[dt][8 * s2 + 6], st[dt][8 * s2 + 7]));
                    const bf16x8 a0 = *(const LAS bf16x8*)(B + SB_QE + ((0 * 8 + ks) * 64 + lane) * 16); const bf16x8 a1 = *(const LAS bf16x8*)(B + SB_QE + ((1 * 8 + ks) * 64 + lane) * 16);
                    o0 = mfma32(a0, sf, o0); o1 = mfma32(a1, sf, o1); }
#pragma unroll
            for (int ks = 0; ks < 4; ++ks) { const bf16x8 a0 = *(const LAS bf16x8*)(B + SB_AT + ((0 * 4 + ks) * 64 + lane) * 16); const bf16x8 a1 = *(const LAS bf16x8*)(B + SB_AT + ((1 * 4 + ks) * 64 + lane) * 16);
                o0 = mfma32(a0, vc[ks], o0); o1 = mfma32(a1, vc[ks], o1); }
            const int uid = SCAN_UID(i);
            bf16* Ob = (dir ? OB : OF) + (size_t)(uid >> 3) * 64 * 1024 + h * 256 + 32 * w + r;
#pragma unroll
            for (int e = 0; e < 16; ++e) { const int tk = (e & 3) + 8 * (e >> 2) + 4 * hh; Ob[(size_t)tk * 1024] = f2bf1(o0[e]); Ob[(size_t)(32 + tk) * 1024] = f2bf1(o1[e]); }
        }
#pragma unroll
        for (int dt = 0; dt < 4; ++dt) {
#pragma unroll
            for (int q = 0; q < 4; ++q) { const f32x4 d4 = *(const LAS f32x4*)(B + SB_DEC + (32 * dt + 8 * q + 4 * hh) * 4);
                st[dt][4 * q + 0] *= d4.x; st[dt][4 * q + 1] *= d4.y; st[dt][4 * q + 2] *= d4.z; st[dt][4 * q + 3] *= d4.w; }
#pragma unroll
            for (int ks = 0; ks < 4; ++ks) { const bf16x8 a = *(const LAS bf16x8*)(B + SB_KD + ((dt * 4 + ks) * 64 + lane) * 16); st[dt] = mfma32(a, vc[ks], st[dt]); }
        }
        if (!FULL && tid < 128) dprod *= *(const LAS float*)(B + SB_DEC + tid * 4);
        if (more) SCAN_STORE((i + 1) & 1);
        LDS_BAR();
    }
    if (!FULL) {
#pragma unroll
        for (int dt = 0; dt < 4; ++dt)
#pragma unroll
            for (int e = 0; e < 16; ++e) SEGL[((size_t)((su * 8 + w) * 4 + dt) * 16 + e) * 64 + lane] = st[dt][e];
        if (tid < 128) SEGD[(size_t)su * 128 + tid] = dprod;
    }
#undef SCAN_UID
#undef SCAN_LOAD
#undef SCAN_STORE
}
struct FinIn { v4u f0, f1, b0, b1, r0, r1; };
__device__ __forceinline__ void gla_fin_load(FinIn& in, int m, const bf16* __restrict__ OF, const bf16* __restrict__ OB, const bf16* __restrict__ R, int lane) {
    const size_t p = (size_t)m * 1024 + 16 * lane;
    in.f0 = *(const v4u*)(OF + p); in.f1 = *(const v4u*)(OF + p + 8); in.b0 = *(const v4u*)(OB + p); in.b1 = *(const v4u*)(OB + p + 8); in.r0 = *(const v4u*)(R + p); in.r1 = *(const v4u*)(R + p + 8);
}
__device__ __forceinline__ void gla_fin_row(const FinIn& in, int m, const float (&gg)[16], bf16* GO, int lane) {
    const size_t p = (size_t)m * 1024 + 16 * lane;
    const v4u f0 = in.f0, f1 = in.f1, b0 = in.b0, b1 = in.b1, r0 = in.r0, r1 = in.r1;
    float o[16], rr[16];
#define UNP(dst, w0, w1) do { dst[0] = bflo(w0.x); dst[1] = bfhi(w0.x); dst[2] = bflo(w0.y); dst[3] = bfhi(w0.y); dst[4] = bflo(w0.z); dst[5] = bfhi(w0.z); dst[6] = bflo(w0.w); dst[7] = bfhi(w0.w); \
        dst[8] = bflo(w1.x); dst[9] = bfhi(w1.x); dst[10] = bflo(w1.y); dst[11] = bfhi(w1.y); dst[12] = bflo(w1.z); dst[13] = bfhi(w1.z); dst[14] = bflo(w1.w); dst[15] = bfhi(w1.w); } while (0)
    float t[16]; UNP(o, f0, f1); UNP(t, b0, b1); UNP(rr, r0, r1);
#undef UNP
    float ss = 0.f;
#pragma unroll
    for (int e = 0; e < 16; ++e) { o[e] += t[e]; ss += o[e] * o[e]; }
    ss += __shfl_xor(ss, 1); ss += __shfl_xor(ss, 2); ss += __shfl_xor(ss, 4); ss += __shfl_xor(ss, 8);
    const float rs = rsqrtf(ss * (1.f / 256.f) + RMS_EPS);
    unsigned w[8];
#pragma unroll
    for (int e = 0; e < 8; ++e) w[e] = pkbf(o[2 * e] * rs * gg[2 * e] * rr[2 * e], o[2 * e + 1] * rs * gg[2 * e + 1] * rr[2 * e + 1]);
    v4u o0 = {w[0], w[1], w[2], w[3]}, o1 = {w[4], w[5], w[6], w[7]};
    *(v4u*)(GO + p) = o0; *(v4u*)(GO + p + 8) = o1;
}
__device__ __forceinline__ unsigned sortable(float f) { const unsigned b = __builtin_bit_cast(unsigned, f); return b ^ ((unsigned)((int)b >> 31) | 0x80000000u); }
__device__ __forceinline__ float unsortable(unsigned u) { const unsigned b = (u & 0x80000000u) ? (u ^ 0x80000000u) : ~u; return __builtin_bit_cast(float, b); }
__device__ __forceinline__ unsigned umax3(unsigned a, unsigned b, unsigned c) { return max(max(a, b), c); }
__device__ __forceinline__ void ce_desc(unsigned& a, unsigned& b) { const unsigned hi = max(a, b), lo = min(a, b); a = hi; b = lo; }
__device__ __forceinline__ void bitonic_sort16_desc(unsigned (&x)[16]) {
#pragma unroll
    for (int k = 2; k <= 16; k <<= 1)
#pragma unroll
        for (int j = k >> 1; j > 0; j >>= 1)
#pragma unroll
            for (int i = 0; i < 16; ++i) { const int l = i ^ j; if (l > i) { if ((i & k) == 0) ce_desc(x[i], x[l]); else ce_desc(x[l], x[i]); } }
}
__device__ __forceinline__ void bitonic_merge16_desc(unsigned (&x)[16]) {
#pragma unroll
    for (int j = 8; j > 0; j >>= 1)
#pragma unroll
        for (int i = 0; i < 16; ++i) { const int l = i ^ j; if (l > i) ce_desc(x[i], x[l]); }
}
__device__ __forceinline__ void topmerge16(unsigned (&a)[16], const unsigned (&b)[16]) {
#pragma unroll
    for (int i = 0; i < 16; ++i) a[i] = max(a[i], b[15 - i]);
    bitonic_merge16_desc(a);
}
__device__ __forceinline__ void peer_half_topk(int p, int h, const LAS unsigned char* sk, const bf16* __restrict__ PQ, size_t tok, int lane, unsigned (&Lp)[16]) {
    const int hh = lane >> 5;
    const bf16* qp = PQ + tok * 2048 + h * 256 + p * 128 + 8 * hh;
    bf16x8 bq[8];
#pragma unroll
    for (int s = 0; s < 8; ++s) bq[s] = *(const bf16x8*)(qp + 16 * s);
    unsigned key[64];
#pragma unroll
    for (int nt = 0; nt < 4; ++nt) { f32x16 sc;
#pragma unroll
        for (int e = 0; e < 16; ++e) sc[e] = 0.f;
#pragma unroll
        for (int s = 0; s < 8; ++s) { const bf16x8 a = *(const LAS bf16x8*)(sk + (((p * 4 + nt) * 8 + s) * 64 + lane) * 16); sc = mfma32(a, bq[s], sc); }
#pragma unroll
        for (int e = 0; e < 16; ++e) { const int n = 32 * nt + (e & 3) + 8 * (e >> 2) + 4 * hh; key[nt * 16 + e] = (sortable(sc[e]) & ~127u) | (unsigned)(127 - n); } }
    unsigned g0[16], g1[16], g2[16], g3[16];
#pragma unroll
    for (int e = 0; e < 16; ++e) { g0[e] = key[e]; g1[e] = key[16 + e]; g2[e] = key[32 + e]; g3[e] = key[48 + e]; }
    bitonic_sort16_desc(g0); bitonic_sort16_desc(g1); bitonic_sort16_desc(g2); bitonic_sort16_desc(g3);
    topmerge16(g0, g1); topmerge16(g2, g3); topmerge16(g0, g2);
#pragma unroll
    for (int e = 0; e < 16; ++e) g1[e] = (unsigned)__shfl_xor((int)g0[e], 32);
    topmerge16(g0, g1);
#pragma unroll
    for (int e = 0; e < 16; ++e) Lp[e] = g0[e];
}
__device__ __forceinline__ void peer_topk_item(int tile, int h, const LAS unsigned char* sk  , const bf16* __restrict__ PQ, unsigned short* IDX, float* GATE, int lane) {
    const int r = lane & 31, hh = lane >> 5; const size_t tok = (size_t)tile * 32 + r;
    unsigned L[2][16];
    peer_half_topk(0, h, sk, PQ, tok, lane, L[0]);
    __builtin_amdgcn_sched_barrier(0);
#pragma unroll
    for (int a = 0; a < 16; ++a) asm volatile("" : "+v"(L[0][a]));
    peer_half_topk(1, h, sk, PQ, tok, lane, L[1]);
    __builtin_amdgcn_sched_barrier(0);
#pragma unroll
    for (int a = 0; a < 16; ++a) asm volatile("" : "+v"(L[1][a]));
    float v0[16], v1[16];
#pragma unroll
    for (int a = 0; a < 16; ++a) { v0[a] = unsortable(L[0][a] & ~127u); v1[a] = unsortable(L[1][a] & ~127u); }
#define CKEY(a_, b_) ((sortable(v0[a_] + v1[b_]) & ~255u) | (unsigned)(255 - ((a_) * 16 + (b_))))
    unsigned R[16], T[16];
#pragma unroll
    for (int b2 = 0; b2 < 16; ++b2) R[b2] = CKEY(0, b2);
#define ROWMERGE(a_, n_) do { _Pragma("unroll") for (int b2 = 0; b2 < 16; ++b2) T[b2] = (b2 < (n_)) ? CKEY(a_, (b2 < (n_) ? b2 : 0)) : 0u; topmerge16(R, T); } while (0)
    ROWMERGE(1, 8); ROWMERGE(2, 5); ROWMERGE(3, 4); ROWMERGE(4, 3); ROWMERGE(5, 2); ROWMERGE(6, 2); ROWMERGE(7, 2);
#pragma unroll
    for (int b2 = 0; b2 < 16; ++b2) T[b2] = (b2 < 8) ? CKEY((b2 < 8 ? 8 + b2 : 8), 0) : 0u;
    topmerge16(R, T);
#undef ROWMERGE
#undef CKEY
    unsigned bk[16];
#pragma unroll
    for (int rd = 0; rd < 16; ++rd) bk[rd] = R[rd];
    float gs[16]; unsigned ex[16]; float Z = 0.f; const float s0 = unsortable(bk[0] & ~255u);
#pragma unroll
    for (int k = 0; k < 16; ++k) { const unsigned flat = 255u - (bk[k] & 255u), a = flat >> 4, b2 = flat & 15u;
        unsigned k1 = 0u, k2 = 0u;
#pragma unroll
        for (int a2 = 0; a2 < 16; ++a2) { k1 = (a == (unsigned)a2) ? L[0][a2] : k1; k2 = (b2 == (unsigned)a2) ? L[1][a2] : k2; }
        ex[k] = (127u - (k1 & 127u)) * 128u + (127u - (k2 & 127u));
        gs[k] = __expf(unsortable(bk[k] & ~255u) - s0); Z += gs[k]; }
    const float iz = 1.f / Z;
    if (hh == 0) {
        unsigned short* ip = IDX + (tok * 8 + h) * 16; float* gp = GATE + (tok * 8 + h) * 16;
        v4u i0 = {ex[0] | (ex[1] << 16), ex[2] | (ex[3] << 16), ex[4] | (ex[5] << 16), ex[6] | (ex[7] << 16)}, i1 = {ex[8] | (ex[9] << 16), ex[10] | (ex[11] << 16), ex[12] | (ex[13] << 16), ex[14] | (ex[15] << 16)};
        *(v4u*)ip = i0; *(v4u*)(ip + 8) = i1;
#pragma unroll
        for (int q = 0; q < 4; ++q) { f32x4 o = {gs[4 * q] * iz, gs[4 * q + 1] * iz, gs[4 * q + 2] * iz, gs[4 * q + 3] * iz}; *(f32x4*)(gp + 4 * q) = o; }
    }
}

__device__ __forceinline__ f32x2 dot16_fp8(const v4u w, const f32x2* hv2, f32x2 s) {
#pragma unroll
    for (int d = 0; d < 4; ++d) { const f32x2 lo = __builtin_amdgcn_cvt_pk_f32_fp8((int)w[d], false), hi = __builtin_amdgcn_cvt_pk_f32_fp8((int)w[d], true);
        s = __builtin_elementwise_fma(lo, hv2[2 * d], s); s = __builtin_elementwise_fma(hi, hv2[2 * d + 1], s); }
    return s;
}
__device__ __forceinline__ float dot16_fp8_bf(const v4u w, const v4u h0, const v4u h1) {
    const unsigned hx[8] = {h0.x, h0.y, h0.z, h0.w, h1.x, h1.y, h1.z, h1.w};
    float s = 0.f;
#pragma unroll
    for (int d = 0; d < 4; ++d) { const pg8::bf16x2_t lo = __builtin_amdgcn_cvt_scalef32_pk_bf16_fp8((int)w[d], 1.0f, false), hi = __builtin_amdgcn_cvt_scalef32_pk_bf16_fp8((int)w[d], 1.0f, true);
        s = __builtin_amdgcn_fdot2_f32_bf16(lo, __builtin_bit_cast(pg8::bf16x2_t, hx[2 * d]), s, false); s = __builtin_amdgcn_fdot2_f32_bf16(hi, __builtin_bit_cast(pg8::bf16x2_t, hx[2 * d + 1]), s, false); }
    return s;
}
__device__ __forceinline__ void axpy16_fp8(const v4u w, const f32x2 a2, f32x2* acc2) {
#pragma unroll
    for (int d = 0; d < 4; ++d) { const f32x2 lo = __builtin_amdgcn_cvt_pk_f32_fp8((int)w[d], false), hi = __builtin_amdgcn_cvt_pk_f32_fp8((int)w[d], true);
        acc2[2 * d] = __builtin_elementwise_fma(lo, a2, acc2[2 * d]); acc2[2 * d + 1] = __builtin_elementwise_fma(hi, a2, acc2[2 * d + 1]); }
}
__device__ __forceinline__ float gelu_erf(float x) { return 0.5f * x * (1.f + erff(x * 0.70710678118654752f)); }
template <int CTRL> __device__ __forceinline__ float dppf(float v) { return __builtin_bit_cast(float, __builtin_amdgcn_update_dpp(0, __builtin_bit_cast(int, v), CTRL, 0xF, 0xF, true)); }
__device__ __forceinline__ float sum8(float v) { v += dppf<0xB1>(v); v += dppf<0x4E>(v); v += dppf<0x141>(v); return v; }
struct PMeta { v4u ia, ib, o0, o1, o2, o3; f32x2 x1; };
__device__ __forceinline__ void peer_meta(PMeta& m, size_t tok, const unsigned short* __restrict__ IDX, int g) {
    m.ia = *(const v4u*)(IDX + tok * 128 + g * 16); m.ib = *(const v4u*)(IDX + tok * 128 + g * 16 + 8);
}
template <bool VP> __device__ __forceinline__ void peer_issue(PMeta& m, v4u (&w)[16], const unsigned char* __restrict__ tb, size_t tok, int sl, const bf16* __restrict__ XB, const float* __restrict__ ACT, const float* X, int g, int i, int c) {
    const unsigned iw[8] = {m.ia.x, m.ia.y, m.ia.z, m.ia.w, m.ib.x, m.ib.y, m.ib.z, m.ib.w};
#pragma unroll
    for (int q = 0; q < 16; ++q) { const unsigned e = (iw[q >> 1] >> (16 * (q & 1))) & 0xffffu; w[q] = *(const v4u*)(tb + (size_t)e * 128); }
    if (VP) { const v4u* ap = (const v4u*)(ACT + tok * 128 + g * 16); m.o0 = ap[0]; m.o1 = ap[1]; m.o2 = ap[2]; m.o3 = ap[3]; m.x1 = *(const f32x2*)(X + tok * 2048 + c); }
    else { const bf16* hp = XB + tok * 2048 + sl * 128 + 16 * i; m.o0 = *(const v4u*)hp; m.o1 = *(const v4u*)(hp + 8); }
}
__device__ __forceinline__ void peer_u_compute(const PMeta& m, const v4u (&w)[16], size_t tok, int label, int sub, float* PART, int g, int i) {
    const v4u h0 = m.o0, h1 = m.o1;
    float v[16];
#pragma unroll
    for (int q = 0; q < 16; ++q) v[q] = dot16_fp8_bf(w[q], h0, h1);
    const bool up1 = (i & 4) != 0, up2 = (i & 2) != 0, up3 = (i & 1) != 0;
    float a[8], b[4], c[2];
#pragma unroll
    for (int k = 0; k < 8; ++k) { const float send = up1 ? v[k] : v[k + 8], keep = up1 ? v[k + 8] : v[k]; a[k] = keep + dppf<0x141>(send); }
#pragma unroll
    for (int k = 0; k < 4; ++k) { const float send = up2 ? a[k] : a[k + 4], keep = up2 ? a[k + 4] : a[k]; b[k] = keep + dppf<0x4E>(send); }
#pragma unroll
    for (int k = 0; k < 2; ++k) { const float send = up3 ? b[k] : b[k + 2], keep = up3 ? b[k + 2] : b[k]; c[k] = keep + dppf<0xB1>(send); }
    *(unsigned*)((bf16*)PART + ((size_t)(2 * label + sub) * M + tok) * 128 + g * 16 + 2 * i) = pkbf(c[0], c[1]);
}
template <bool VP> __device__ __forceinline__ void peer_slice_loop(int sl, int label, int sub, int tok0, int tstep, const bf16* __restrict__ XB, const float* __restrict__ ACT, const unsigned short* __restrict__ IDX,
                                                                   const unsigned char* __restrict__ TAB, float* PART, float* X, bf16* XBn, const float* __restrict__ gn, float* ssn, int lane) {
    const int g = lane >> 3, i = lane & 7;
    const int j = ((lane >> 5) & 1) * 4 + ((lane >> 4) & 1) * 2 + ((lane >> 3) & 1), c = sl * 128 + 16 * i + 2 * j;
    const unsigned char* tb = TAB + (size_t)sl * (16384 * 128) + 16 * i;
    f32x2 gg = {0.f, 0.f}; if (VP) gg = *(const f32x2*)(gn + c);
    if (tok0 >= M) return;
    const int NT = (M - tok0 + tstep - 1) / tstep;
#define PS_TOK(k_) ((size_t)(tok0 + ((k_) < NT ? (k_) : NT - 1) * tstep))
    PMeta mA, mB, mN; v4u wA[16], wB[16];
    peer_meta(mA, PS_TOK(0), IDX, g); peer_meta(mB, PS_TOK(1), IDX, g);
    asm volatile("" : "+v"(mB.ia), "+v"(mB.ib));
    peer_issue<VP>(mA, wA, tb, PS_TOK(0), sl, XB, ACT, X, g, i, c);
    int k = 0;
    for (; k + 1 < NT; k += 2) {
        peer_meta(mN, PS_TOK(k + 2), IDX, g);
        asm volatile("" ::: "memory");
        peer_issue<VP>(mB, wB, tb, PS_TOK(k + 1), sl, XB, ACT, X, g, i, c);
        asm volatile("" ::: "memory");
        peer_u_compute(mA, wA, PS_TOK(k), label, sub, PART, g, i);
        asm volatile("" ::: "memory");
        mA.ia = mN.ia; mA.ib = mN.ib;
        peer_meta(mN, PS_TOK(k + 3), IDX, g);
        asm volatile("" ::: "memory");
        peer_issue<VP>(mA, wA, tb, PS_TOK(k + 2), sl, XB, ACT, X, g, i, c);
        asm volatile("" ::: "memory");
        peer_u_compute(mB, wB, PS_TOK(k + 1), label, sub, PART, g, i);
        asm volatile("" ::: "memory");
        mB.ia = mN.ia; mB.ib = mN.ib;
    }
    if (k < NT) { peer_u_compute(mA, wA, PS_TOK(k), label, sub, PART, g, i); }
#undef PS_TOK
}
__device__ __forceinline__ void peer_combine_row(size_t tok, const float* __restrict__ PART, const unsigned short* __restrict__ IDX, const float* __restrict__ GATE, const float* __restrict__ USC, const float* __restrict__ VSC,
                                                 const float* __restrict__ ss, float* ACT, int lane) {
    float sv = ss[(tok + (lane >> 5)) * 32 + (lane & 31)];
    sv += __shfl_xor(sv, 1); sv += __shfl_xor(sv, 2); sv += __shfl_xor(sv, 4); sv += __shfl_xor(sv, 8); sv += __shfl_xor(sv, 16);
    const float rsv = rsqrtf(sv * (1.f / 2048.f) + RMS_EPS);
    const float rs[2] = {__shfl(rsv, 0), __shfl(rsv, 32)};
    f32x2 sum[2]; unsigned ew[2]; f32x2 gt[2]; unsigned pv[2][16];
#pragma unroll
    for (int t = 0; t < 2; ++t) { const size_t p = (tok + t) * 128 + 2 * lane;
        ew[t] = *(const unsigned*)(IDX + p); gt[t] = *(const f32x2*)(GATE + p);
#pragma unroll
        for (int lab = 0; lab < 16; ++lab) pv[t][lab] = *(const unsigned*)((const bf16*)PART + (size_t)lab * M * 128 + p); }
#pragma unroll
    for (int t = 0; t < 2; ++t) { sum[t] = (f32x2){0.f, 0.f};
#pragma unroll
        for (int lab = 0; lab < 16; ++lab) sum[t] = sum[t] + (f32x2){bflo(pv[t][lab]), bfhi(pv[t][lab])}; }
#pragma unroll
    for (int t = 0; t < 2; ++t) { const size_t p = (tok + t) * 128 + 2 * lane; const int e0 = ew[t] & 0xffff, e1 = ew[t] >> 16;
        *(unsigned*)((bf16*)ACT + p) = pkbf(gelu_erf(sum[t].x * rs[t] * USC[e0]) * gt[t].x * VSC[e0], gelu_erf(sum[t].y * rs[t] * USC[e1]) * gt[t].y * VSC[e1]); }
}
struct VMeta { v4u ia, ib; v4u a0, a1; f32x2 x1; };
__device__ __forceinline__ void peer_v_idx(VMeta& m, size_t tok, const unsigned short* __restrict__ IDX, int g) { m.ia = *(const v4u*)(IDX + tok * 128 + g * 16); m.ib = *(const v4u*)(IDX + tok * 128 + g * 16 + 8); }
__device__ __forceinline__ void peer_v_issue(VMeta& m, v4u (&w)[16], const unsigned char* __restrict__ vb, size_t tok, const float* __restrict__ ACT, const bf16* XB1, int g, int c) {
    const unsigned iw[8] = {m.ia.x, m.ia.y, m.ia.z, m.ia.w, m.ib.x, m.ib.y, m.ib.z, m.ib.w};
#pragma unroll
    for (int q = 0; q < 16; ++q) { const unsigned e = (iw[q >> 1] >> (16 * (q & 1))) & 0xffffu; w[q] = *(const v4u*)(vb + (size_t)e * 128); }
    const v4u* ap = (const v4u*)((const bf16*)ACT + tok * 128 + g * 16); m.a0 = ap[0]; m.a1 = ap[1];
    { const unsigned xw = *(const unsigned*)(XB1 + tok * 2048 + c); m.x1 = (f32x2){bflo(xw), bfhi(xw)}; }
}
template <bool WB> __device__ __forceinline__ void peer_v_fin(const VMeta& m, const v4u (&w)[16], size_t tok, int sl, float* X, bf16* XBn, const f32x2 gg, float* ssn, int lane, int c) {
    const v4u a0 = m.a0, a1 = m.a1;
    const float av[16] = {bflo(a0.x), bfhi(a0.x), bflo(a0.y), bfhi(a0.y), bflo(a0.z), bfhi(a0.z), bflo(a0.w), bfhi(a0.w), bflo(a1.x), bfhi(a1.x), bflo(a1.y), bfhi(a1.y), bflo(a1.z), bfhi(a1.z), bflo(a1.w), bfhi(a1.w)};
    f32x2 acc2[8];
#pragma unroll
    for (int k = 0; k < 8; ++k) acc2[k] = (f32x2){0.f, 0.f};
#pragma unroll
    for (int q = 0; q < 16; ++q) { const f32x2 a2v = {av[q], av[q]}; axpy16_fp8(w[q], a2v, acc2); }
#pragma unroll
    for (int k = 0; k < 4; ++k) { const bool up = (lane & 32) != 0; const f32x2 send = up ? acc2[k] : acc2[k + 4], keep = up ? acc2[k + 4] : acc2[k];
        acc2[k] = (f32x2){keep.x + __shfl_xor(send.x, 32), keep.y + __shfl_xor(send.y, 32)}; }
#pragma unroll
    for (int k = 0; k < 2; ++k) { const bool up = (lane & 16) != 0; const f32x2 send = up ? acc2[k] : acc2[k + 2], keep = up ? acc2[k + 2] : acc2[k];
        acc2[k] = (f32x2){keep.x + __shfl_xor(send.x, 16), keep.y + __shfl_xor(send.y, 16)}; }
    { const bool up = (lane & 8) != 0; const f32x2 send = up ? acc2[0] : acc2[1], keep = up ? acc2[1] : acc2[0];
        acc2[0] = (f32x2){keep.x + __shfl_xor(send.x, 8), keep.y + __shfl_xor(send.y, 8)}; }
    const f32x2 x2 = {m.x1.x + acc2[0].x, m.x1.y + acc2[0].y};
    *(f32x2*)(X + tok * 2048 + c) = x2;
    if (WB) *(unsigned*)(XBn + tok * 2048 + c) = pkbf(x2.x * gg.x, x2.y * gg.y);
    const float sq = wave_sum(x2.x * x2.x + x2.y * x2.y);
    ssn[tok * 16 + sl] = sq;
}
template <bool WB> __device__ __forceinline__ void peer_v_loop(int sl, int tok0, int tstep, const float* __restrict__ ACT, const unsigned short* __restrict__ IDX, const unsigned char* __restrict__ V8, float* X, bf16* XBn, const float* __restrict__ gn, float* ssn, int lane) {
    const int g = lane >> 3, i = lane & 7;
    const int j = ((lane >> 5) & 1) * 4 + ((lane >> 4) & 1) * 2 + ((lane >> 3) & 1), c = sl * 128 + 16 * i + 2 * j;
    const unsigned char* vb = V8 + (size_t)sl * (16384 * 128) + 16 * i;
    const f32x2 gg = *(const f32x2*)(gn + c);
    if (tok0 >= M) return;
    const int NT = (M - tok0 + tstep - 1) / tstep;
#define PS_TOK(k_) ((size_t)(tok0 + ((k_) < NT ? (k_) : NT - 1) * tstep))
    VMeta mA, mB, mN; v4u wA[16], wB[16];
    peer_v_idx(mA, PS_TOK(0), IDX, g); peer_v_idx(mB, PS_TOK(1), IDX, g);
    asm volatile("" : "+v"(mB.ia), "+v"(mB.ib));
    peer_v_issue(mA, wA, vb, PS_TOK(0), ACT, XBn, g, c);
    int k = 0;
    for (; k + 1 < NT; k += 2) {
        peer_v_idx(mN, PS_TOK(k + 2), IDX, g);
        asm volatile("" ::: "memory");
        peer_v_issue(mB, wB, vb, PS_TOK(k + 1), ACT, XBn, g, c);
        asm volatile("" ::: "memory");
        peer_v_fin<WB>(mA, wA, PS_TOK(k), sl, X, XBn, gg, ssn, lane, c);
        asm volatile("" ::: "memory");
        mA.ia = mN.ia; mA.ib = mN.ib;
        peer_v_idx(mN, PS_TOK(k + 3), IDX, g);
        asm volatile("" ::: "memory");
        peer_v_issue(mA, wA, vb, PS_TOK(k + 2), ACT, XBn, g, c);
        asm volatile("" ::: "memory");
        peer_v_fin<WB>(mB, wB, PS_TOK(k + 1), sl, X, XBn, gg, ssn, lane, c);
        asm volatile("" ::: "memory");
        mB.ia = mN.ia; mB.ib = mN.ib;
    }
    if (k < NT) peer_v_fin<WB>(mA, wA, PS_TOK(k), sl, X, XBn, gg, ssn, lane, c);
#undef PS_TOK
}
__device__ __forceinline__ void final_norm_row(float* xrow, const float* __restrict__ g, const float* __restrict__ ssp, int lane) {
    const float rs = rsqrtf(wave_sum(lane < 16 ? ssp[lane] : 0.f) * (1.f / 2048.f) + RMS_EPS);
    f32x4* xr = (f32x4*)xrow + lane; const f32x4* gr = (const f32x4*)g + lane;
    f32x4 v[8], gg[8];
#pragma unroll
    for (int jj = 0; jj < 8; ++jj) { v[jj] = xr[64 * jj]; gg[jj] = gr[64 * jj]; }
#pragma unroll
    for (int jj = 0; jj < 8; ++jj) xr[64 * jj] = (f32x4){v[jj].x * rs * gg[jj].x, v[jj].y * rs * gg[jj].y, v[jj].z * rs * gg[jj].z, v[jj].w * rs * gg[jj].w};
}

__device__ __forceinline__ void afb_unit(int unit, const bf16* __restrict__ H, const bf16* __restrict__ Waf, float* AFBo, const float* __restrict__ ss, int lane) {
    const int fr = lane & 15, kq = lane >> 4, row0 = unit * 16;
    const bf16* ap = H + (size_t)(row0 + fr) * 2048 + 8 * kq; const bf16* bp = Waf + (size_t)fr * 2048 + 8 * kq;
    f32x4 c0 = {0.f, 0.f, 0.f, 0.f}, c1 = {0.f, 0.f, 0.f, 0.f};
#pragma unroll 1
    for (int s0 = 0; s0 < 64; s0 += 8) {
        bf16x8 Av[8], Bv[8], Cv[8];
#pragma unroll
        for (int q = 0; q < 8; ++q) { Av[q] = *(const bf16x8*)(ap + 32 * (s0 + q)); Bv[q] = *(const bf16x8*)(bp + 32 * (s0 + q)); Cv[q] = *(const bf16x8*)(bp + 16 * 2048 + 32 * (s0 + q)); }
        asm volatile("" : "+v"(Av[0]), "+v"(Bv[0]), "+v"(Cv[0]), "+v"(Av[7]), "+v"(Bv[7]), "+v"(Cv[7]));
#pragma unroll
        for (int q = 0; q < 8; ++q) { c0 = __builtin_amdgcn_mfma_f32_16x16x32_bf16(Av[q], Bv[q], c0, 0, 0, 0); c1 = __builtin_amdgcn_mfma_f32_16x16x32_bf16(Av[q], Cv[q], c1, 0, 0, 0); }
    }
    const float mine = ss ? pg8::row_rs<16>(ss, row0 + fr) : 1.f;
#pragma unroll
    for (int e = 0; e < 4; ++e) { const int rr = 4 * kq + e; const float sc = __shfl(mine, rr); float* o = AFBo + (size_t)(row0 + rr) * 32 + fr; o[0] = c0[e] * sc; o[16] = c1[e] * sc; }
}
__device__ __forceinline__ const float* gin(const float* p) { const GAS float* g = (const GAS float*)p; asm volatile("" : "+s"(g)); return (const float*)g; }
#ifndef MK_MULTI
#define MK_MULTI 0
#endif
struct Args { const float* in[19]; float* out; unsigned char* ws; int ph_lo, ph_hi, l_lo, l_hi; };
__global__ void __launch_bounds__(NWAVES * 64, 2) fwd_kernel(Args args) {
    extern __shared__ __attribute__((aligned(16))) unsigned char lds[];
    LAS unsigned char* ldsL = (LAS unsigned char*)lds;
    volatile LAS unsigned* MISC = (volatile LAS unsigned*)(ldsL + MISC_OFF);
    const int tid0 = threadIdx.x, wave = __builtin_amdgcn_readfirstlane(tid0 >> 6);
#define PHASE_IDS() int tid = threadIdx.x; asm volatile("" : "+v"(tid)); const int lane = tid & 63; (void)lane; GAS unsigned char* wsp0 = (GAS unsigned char*)args.ws; asm volatile("" : "+s"(wsp0)); unsigned char* wsp = (unsigned char*)wsp0; GAS float* outp0 = (GAS float*)args.out; asm volatile("" : "+s"(outp0)); float* outp = (float*)outp0; int lp = l; asm volatile("" : "+s"(lp)); (void)wsp; (void)outp; (void)lp
    const int G = gridDim.x; const int bx = blockIdx.x; const int vcu = (G % 8 == 0) ? (bx % 8) * (G / 8) + bx / 8 : bx;
    const int gw = vcu * NWAVES + wave, NGW = G * NWAVES;
    unsigned char* ws = args.ws;
    gu32* ctl = (gu32*)(ws + WS_CTL);
    for (int u = tid0; u < (LDS_BYTES - LDSCTL_OFF) / 4; u += NWAVES * 64) ((LAS unsigned*)(ldsL + LDSCTL_OFF))[u] = 0u;
    __syncthreads();
    XcdBarrier bar; bar.bar = (unsigned*)(ctl + CW_BAR); bar.x = 0; bar.st = nullptr;
    if (!MK_MULTI) bar = xcd_barrier_post((unsigned*)(ctl + CW_BAR), MISC + 8);
#define GRID_BAR() do { if (!MK_MULTI) xcd_barrier(bar); } while (0)
    const int lo = args.ph_lo, hi = args.ph_hi;
#ifdef PH_ONLY
#define IN(k) ((k) == PH_ONLY && lo <= (k) && (k) < hi)
#else
#define IN(k) (lo <= (k) && (k) < hi)
#endif
#define BOTH(k) (IN(k) && IN((k) + 1))
#ifndef DUP_MASK
#define DUP_MASK 0
#endif
#define NREP(k) ((((DUP_MASK) >> (k)) & 1) && l == 0 ? 2 : 1)

#define WIN ((bf16*)(wsp + WS_WIN))
#define WUPG ((bf16*)(wsp + WS_WUPG))
#define WUPP ((bf16*)(wsp + WS_WUPP))
#define WOUT ((bf16*)(wsp + WS_WOUT))
#define WQ ((bf16*)(wsp + WS_WQ))
#define POOLW ((bf16*)(wsp + WS_POOLW))
#define SUBK ((bf16*)(wsp + WS_SUBK))
#define Hb ((bf16*)(wsp + WS_H))
#define POOLED ((bf16*)(wsp + WS_POOLED))
#define POOLMIX ((bf16*)(wsp + WS_POOLMIX))
#define QK ((bf16*)(wsp + WS_QK))
#define Pb ((bf16*)(wsp + WS_P))
#define OFb ((bf16*)(wsp + WS_QK))
#define OBb ((bf16*)(wsp + WS_P))
#define VT ((bf16*)(wsp + WS_VT))
#define Rb ((bf16*)(wsp + WS_R))
#define MERGED ((bf16*)(wsp + WS_MERGED))
#define Gb ((bf16*)(wsp + WS_G))
#define PQ ((bf16*)(wsp + WS_PQ))
#define QE ((bf16*)(wsp + WS_QE))
#define GLAOUT ((bf16*)(wsp + WS_GLAOUT))
#define KDT ((bf16*)(wsp + WS_KDT))
#define ATTN ((bf16*)(wsp + WS_ATTN))
#define USC ((float*)(wsp + WS_USC))
#define VSC ((float*)(wsp + WS_VSC))
#define UTAB (wsp + WS_UTAB)
#define VTAB (wsp + WS_VTAB)
#define SEGL ((float*)(wsp + WS_SEGL))
#define SIN ((float*)(wsp + WS_SIN))
#define IDX ((unsigned short*)(wsp + WS_IDX))
#define GATE ((float*)(wsp + WS_GATE))
#define AFB ((float*)(wsp + WS_AFB))
#define DEC ((float*)(wsp + WS_DEC))
#define SSP1 ((float*)(wsp + WS_SSP1))
#define SSP2 ((float*)(wsp + WS_SSP2))
#define PART ((float*)(wsp + WS_QK))
#define ACT ((float*)(wsp + WS_QE))
#define GIN(k_) gin(args.in[k_])
#define x_in ((lp == 0) ? GIN(0) : (const float*)outp)
#define w_in (GIN(2) + (size_t)lp * D * DIN)
#define ssin ((lp == 0) ? (const float*)nullptr : (const float*)SSP2)
#define ss1 SSP1
#define ss2 SSP2
    for (int l = args.l_lo; l < args.l_hi; ++l) {
        if (IN(0)) { PHASE_IDS(); for (int rep = 0; rep < NREP(0); ++rep) {
            LAS float* scr = (LAS float*)(ldsL + wave * 16384);
            { const float* sk = GIN(15) + (size_t)lp * 262144;
              const float* w_upg = GIN(8) + (size_t)lp * 1024 * 2048; const float* w_upp = GIN(11) + (size_t)lp * 1024 * 2048; const float* w_o = GIN(12) + (size_t)lp * 2048 * 2048; const float* w_q = GIN(14) + (size_t)lp * 2048 * 2048;
              const float* w_pool = GIN(9) + (size_t)lp * 4 * 65536;
              constexpr int I_IN = 32 * 257, I_UP = 16 * 64, I_SQ = 32 * 64, I_PL = 4 * 32, I_SK = 512;
              constexpr int E_IN = I_IN, E_UPG = E_IN + I_UP, E_UPP = E_UPG + I_UP, E_O = E_UPP + I_SQ, E_Q = E_O + I_SQ, E_PL = E_Q + I_PL, E_ALL = E_PL + I_SK;
              for (int it0 = gw; it0 < E_ALL; it0 += NGW) { int it = it0;
                if (it < E_IN) { const int kb = it / 257, nb = it % 257, n0 = nb * 32;
                    int d; if (n0 < 1024) d = n0; else if (n0 < 2048) d = n0 + 6400; else if (n0 < 3072) d = n0 - 1024; else if (n0 == 3072) d = 7168; else d = n0 - 1056;
                    transpose_item(w_in, DIN, WIN, 2048, d, kb * 64, n0, scr, lane); }
                else if (it < E_UPG) { it -= E_IN;  transpose_item(w_upg, 2048, WUPG, 1024, (it % 64) * 32, (it / 64) * 64, (it % 64) * 32, scr, lane); }
                else if (it < E_UPP) { it -= E_UPG; transpose_item(w_upp, 2048, WUPP, 1024, (it % 64) * 32, (it / 64) * 64, (it % 64) * 32, scr, lane); }
                else if (it < E_O)   { it -= E_UPP; transpose_item(w_o, 2048, WOUT, 2048, (it % 64) * 32, (it / 64) * 64, (it % 64) * 32, scr, lane); }
                else if (it < E_Q)   { it -= E_O;   transpose_item(w_q, 2048, WQ, 2048, (it % 64) * 32, (it / 64) * 64, (it % 64) * 32, scr, lane, GIN(13) + (size_t)lp * D); }
                else if (it < E_PL)  { it -= E_Q; const int g = it >> 5, r5 = it & 31; transpose_item(w_pool + (size_t)g * 65536, 256, POOLW + (size_t)g * 65536, 256, (r5 % 8) * 32, (r5 / 8) * 64, (r5 % 8) * 32, scr, lane); }
                else { const int f = it - E_PL; const int hp = f >> 5, nt = (f >> 3) & 3, s5 = f & 7, r = lane & 31, hh = lane >> 5;
                    const float* src = sk + ((size_t)hp * 128 + 32 * nt + r) * 128 + 16 * s5 + 8 * hh; const f32x4 a = *(const f32x4*)src, b = *(const f32x4*)(src + 4);
                    v4u o = {pkbf(a.x, a.y), pkbf(a.z, a.w), pkbf(b.x, b.y), pkbf(b.z, b.w)}; *(v4u*)(SUBK + ((size_t)f * 64 + lane) * 8) = o; } } }
            { const float* ut = GIN(16) + (size_t)lp * 16384 * 2048; const float* vt = GIN(17) + (size_t)lp * 16384 * 2048;
              for (int row = gw; row < 16384; row += NGW) { if (row < 8192)
                table_rows_fp8(ut, (unsigned*)UTAB, USC, row, row + 8192, lane, GIN(13) + (size_t)lp * D); else table_rows_fp8(vt, (unsigned*)VTAB, VSC, row - 8192, row, lane); } }
            if (lp == 0) for (int m = gw; m < M; m += NGW) rmsnorm_row(x_in + (size_t)m * D, GIN(1), Hb + (size_t)m * D, lane);
            if (rep + 1 < NREP(0)) GRID_BAR(); }
            if (BOTH(0)) GRID_BAR();
        }
        if (IN(1)) { PHASE_IDS(); for (int rep = 0; rep < NREP(1); ++rep) {
            { pg8::Gemm g{Hb, WIN, M, 7168, 2048, 2048, 2048, 0, nullptr, nullptr}; pg8::StaticOrder S; S.init(M, 7168, G, bx);
              pg8::EpiProj E{QK, Rb, Pb, Gb, AFB, ssin};
              pg8::gemm_phase<pg8::EpiProj, pg8::StaticOrder, true, true>(ldsL, g, S, E); }
            { pg8::Gemm g{WIN + (size_t)7424 * 2048, Hb, 1024, M, 2048, 2048, 2048, 0, nullptr, nullptr}; pg8::StaticOrder S; S.init(1024, M, G, bx);
              pg8::EpiVT E{VT, ssin};
              pg8::gemm_phase<pg8::EpiVT, pg8::StaticOrder, true, true>(ldsL, g, S, E); }
            for (int unit = gw; unit < M / 16; unit += NGW) afb_unit(unit, Hb, WIN + (size_t)7168 * 2048, AFB, ssin, lane);
            if (rep + 1 < NREP(1)) GRID_BAR(); }
            if (BOTH(1)) GRID_BAR();
        }
        if (IN(2)) { PHASE_IDS(); for (int rep = 0; rep < NREP(2); ++rep) {
            if (vcu < 4096) { PrepIn pin; gla_prep_load(pin, vcu, QK, AFB, GIN(3) + (size_t)lp * 8192, GIN(4) + (size_t)lp * 512, GIN(5) + (size_t)lp * 8192, GIN(6) + (size_t)lp * 512, tid);
                __syncthreads();
                int pb = 0;
                for (int uid = vcu; uid < 4096; uid += G, pb ^= 1)
                    gla_prep_unit(uid, (uid + G < 4096) ? uid + G : uid, pin, ldsL + pb * PA_BYTES, QK, AFB, GIN(3) + (size_t)lp * 8192, GIN(4) + (size_t)lp * 512, GIN(5) + (size_t)lp * 8192, GIN(6) + (size_t)lp * 512, QE, KDT, ATTN, DEC, tid, wave, lane);
                __syncthreads(); }
            for (int item = vcu * 512 + tid; item < (M / 32) * 128; item += G * 512) pool_item(item, Pb, POOLED);
            if (rep + 1 < NREP(2)) GRID_BAR(); }
            if (BOTH(2)) GRID_BAR();
        }
        if (IN(3)) { PHASE_IDS(); for (int rep = 0; rep < NREP(3); ++rep) {
            for (int su = vcu; su < 16 * NSEG; su += G) gla_scan_block<false>(su, ldsL, QE, ATTN, KDT, DEC, VT, SEGL, SIN, OFb, OBb, tid, wave, lane);
            if (rep + 1 < NREP(3)) GRID_BAR(); }
            if (BOTH(3)) GRID_BAR();
        }
        if (IN(5)) { PHASE_IDS(); for (int rep = 0; rep < NREP(5); ++rep) {
            for (int su = vcu; su < 16 * NSEG; su += G) gla_scan_block<true>(su, ldsL, QE, ATTN, KDT, DEC, VT, SEGL, SIN, OFb, OBb, tid, wave, lane);
            if (rep + 1 < NREP(5)) GRID_BAR(); }
            if (BOTH(5)) GRID_BAR();
        }
        if (IN(6)) { PHASE_IDS(); for (int rep = 0; rep < NREP(6); ++rep) {
            { float gg[16]; { const f32x4* gp = (const f32x4*)(GIN(7) + (size_t)lp * 1024 + 16 * lane);
#pragma unroll
                for (int q = 0; q < 4; ++q) { const f32x4 x = gp[q]; gg[4 * q] = x.x; gg[4 * q + 1] = x.y; gg[4 * q + 2] = x.z; gg[4 * q + 3] = x.w; } }
              for (int m = gw; m < M; m += 2 * NGW) { const int m2 = (m + NGW < M) ? m + NGW : m;
                  FinIn ia, ib; gla_fin_load(ia, m, OFb, OBb, Rb, lane); gla_fin_load(ib, m2, OFb, OBb, Rb, lane);
                  gla_fin_row(ia, m, gg, GLAOUT, lane); if (m2 != m) gla_fin_row(ib, m2, gg, GLAOUT, lane); } }
            { pg8::Gemm g{POOLED, POOLW, M, 1024, 256, 1024, 256, 512, nullptr, nullptr}; pg8::StaticOrder S; S.init(M, 1024, G, bx);
              pg8::EpiScale<false> E{POOLMIX, 1024, GIN(10) + (size_t)lp * 1024, nullptr};
              pg8::gemm_phase<pg8::EpiScale<false>, pg8::StaticOrder, true, true>(ldsL, g, S, E); }
            if (rep + 1 < NREP(6)) GRID_BAR(); }
            if (BOTH(6)) GRID_BAR();
        }
        if (IN(7)) { PHASE_IDS(); for (int rep = 0; rep < NREP(7); ++rep) {
            { pg8::Gemm g{GLAOUT, WUPG, M, 2048, 1024, 1024, 1024, 0, POOLMIX, WUPP}; pg8::TwoPartOrder S; S.init(M, 2048, G, bx);
              pg8::EpiMerge E{MERGED, (const unsigned char*)Gb};
              pg8::gemm_phase<pg8::EpiMerge, pg8::TwoPartOrder, true, true>(ldsL, g, S, E); }
            if (rep + 1 < NREP(7)) GRID_BAR(); }
            if (BOTH(7)) GRID_BAR();
        }
        if (IN(8)) { PHASE_IDS(); for (int rep = 0; rep < NREP(8); ++rep) {
            { pg8::Gemm g{MERGED, WOUT, M, 2048, 2048, 2048, 2048, 0, nullptr, nullptr}; pg8::StaticOrder S; S.init(M, 2048, G, bx);
              pg8::EpiResid E{x_in, Hb, ss1};
              pg8::gemm_phase<pg8::EpiResid, pg8::StaticOrder, true, true>(ldsL, g, S, E); }
            if (rep + 1 < NREP(8)) GRID_BAR(); }
            if (BOTH(8)) GRID_BAR();
        }
        if (IN(9)) { PHASE_IDS(); for (int rep = 0; rep < NREP(9); ++rep) {
            { pg8::Gemm g{Hb, WQ, M, 2048, 2048, 2048, 2048, 0, nullptr, nullptr}; pg8::StaticOrder S; S.init(M, 2048, G, bx);
              pg8::EpiScale<true> E{PQ, 2048, nullptr, ss1};
              pg8::gemm_phase<pg8::EpiScale<true>, pg8::StaticOrder, true, true>(ldsL, g, S, E); }
            if (rep + 1 < NREP(9)) GRID_BAR(); }
            if (BOTH(9)) GRID_BAR();
        }
        if (IN(10)) { PHASE_IDS(); for (int rep = 0; rep < NREP(10); ++rep) {
            for (int j = 0; j < 4; ++j) {
                __syncthreads();
                for (int i = tid; i < 8192; i += 512) *(LAS v4u*)(ldsL + i * 16) = *(const v4u*)((const unsigned char*)SUBK + (size_t)j * 131072 + (size_t)i * 16);
                __syncthreads();
                const int hsel = wave >> 2, h = 2 * j + hsel;
                for (int tile = vcu * 4 + (wave & 3); tile < M / 32; tile += G * 4) peer_topk_item(tile, h, ldsL + hsel * 65536, PQ, IDX, GATE, lane);
            }
            if (rep + 1 < NREP(10)) GRID_BAR(); }
            if (BOTH(10)) GRID_BAR();
        }
        if (IN(11)) { PHASE_IDS(); for (int rep = 0; rep < NREP(11); ++rep) {
            const int label = bx & 7, rank = bx >> 3, nrank = (G - label + 7) >> 3;
            for (int sub = 0; sub < 2; ++sub)
                peer_slice_loop<false>(2 * label + sub, label, sub, rank * NWAVES + wave, nrank * NWAVES, Hb, ACT, IDX, UTAB, PART, outp, Hb, nullptr, nullptr, lane);
            if (rep + 1 < NREP(11)) GRID_BAR(); }
            if (BOTH(11)) GRID_BAR();
        }
        if (IN(12)) { PHASE_IDS(); for (int rep = 0; rep < NREP(12); ++rep) {
            for (int tok = 2 * gw; tok < M; tok += 2 * NGW) peer_combine_row((size_t)tok, PART, IDX, GATE, USC, VSC, ss1, ACT, lane);
            if (rep + 1 < NREP(12)) GRID_BAR(); }
            if (BOTH(12)) GRID_BAR();
        }
        if (IN(13)) { PHASE_IDS();
            const int last = (lp == DEPTH - 1);
            const float* gn = last ? GIN(18) : GIN(1) + (size_t)(lp + 1) * D;
            const int label = bx & 7, rank = bx >> 3, nrank = (G - label + 7) >> 3;
            for (int sub = 0; sub < 2; ++sub)
                if (last) peer_v_loop<false>(2 * label + sub, rank * NWAVES + wave, nrank * NWAVES, ACT, IDX, VTAB, outp, Hb, gn, ss2, lane);
                else      peer_v_loop<true>(2 * label + sub, rank * NWAVES + wave, nrank * NWAVES, ACT, IDX, VTAB, outp, Hb, gn, ss2, lane);
            if ((BOTH(13) && last) || (lo == 0 && hi == NPH && l + 1 < args.l_hi)) GRID_BAR();
        }
        if (IN(14) && l == DEPTH - 1) { PHASE_IDS();
            for (int m = gw; m < M; m += NGW) final_norm_row(outp + (size_t)m * D, GIN(18), ss2 + (size_t)m * 16, lane);
        }
    }
#undef IN
#undef BOTH
#undef GRID_BAR
}

#undef WIN
#undef WUPG
#undef WUPP
#undef WOUT
#undef WQ
#undef POOLW
#undef SUBK
#undef Hb
#undef POOLED
#undef POOLMIX
#undef QK
#undef Pb
#undef OFb
#undef OBb
#undef VT
#undef Rb
#undef MERGED
#undef Gb
#undef PQ
#undef QE
#undef GLAOUT
#undef KDT
#undef ATTN
#undef USC
#undef VSC
#undef UTAB
#undef VTAB
#undef SEGL
#undef SIN
#undef IDX
#undef GATE
#undef AFB
#undef DEC
#undef SSP1
#undef SSP2
#undef PART
#undef ACT
#undef GIN
#undef x_in
#undef w_in
#undef ssin
#undef ss1
#undef ss2
extern "C" void kernel_launch(void* const* d_in, const int* in_sizes, int n_in, void* d_out, int out_size, void* d_ws, size_t ws_size, hipStream_t stream) {
    static int grid = 0;
    if (grid == 0) {
        if (n_in != 19 || in_sizes[0] != M * D || out_size != M * D || ws_size < WS_END) { fprintf(stderr, "kernel_launch: unexpected shapes / workspace (n_in %d, ws %zu, need %zu); nothing launched\n", n_in, ws_size, (size_t)WS_END); grid = -1; return; }
        int dev = 0, cus = 0, per_cu = 0;
        if (hipGetDevice(&dev) != hipSuccess || hipDeviceGetAttribute(&cus, hipDeviceAttributeMultiprocessorCount, dev) != hipSuccess) { grid = -1; return; }
        if (hipFuncSetAttribute((const void*)fwd_kernel, hipFuncAttributeMaxDynamicSharedMemorySize, LDS_BYTES) != hipSuccess) { fprintf(stderr, "kernel_launch: hipFuncSetAttribute failed\n"); grid = -1; return; }
        if (hipOccupancyMaxActiveBlocksPerMultiprocessor(&per_cu, (const void*)fwd_kernel, NWAVES * 64, LDS_BYTES) != hipSuccess || per_cu < 1) { fprintf(stderr, "kernel_launch: occupancy query reports %d blocks per CU\n", per_cu); }
        (void)hipGetLastError();
        grid = cus;
    }
    if (grid < 0) return;
    if (hipMemsetAsync((char*)d_ws + WS_CTL, 0, CTL_ZERO_BYTES, stream) != hipSuccess) return;
    Args a{};
    for (int i = 0; i < 19; ++i) a.in[i] = (const float*)d_in[i];
    a.out = (float*)d_out; a.ws = (unsigned char*)d_ws;
#if MK_MULTI
    for (int l = 0; l < DEPTH; ++l)
        for (int ph = 0; ph < NPH; ++ph) { a.ph_lo = ph; a.ph_hi = ph + 1; a.l_lo = l; a.l_hi = l + 1;
            hipLaunchKernelGGL(fwd_kernel, dim3(grid), dim3(NWAVES * 64), LDS_BYTES, stream, a); }
#else
    a.ph_lo = 0; a.ph_hi = NPH; a.l_lo = 0; a.l_hi = DEPTH;
    hipLaunchKernelGGL(fwd_kernel, dim3(grid), dim3(NWAVES * 64), LDS_BYTES, stream, a);
#endif
}
```

```cpp
#include <hip/hip_runtime.h>
#include <cstdio>
#include <cstdint>
namespace pg8 {
#define PG8_LAS __attribute__((address_space(3)))
typedef unsigned short bf16_t;
typedef short bf16x8 __attribute__((ext_vector_type(8)));
typedef float f32x4 __attribute__((ext_vector_type(4)));
typedef unsigned u32x4 __attribute__((ext_vector_type(4)));
typedef unsigned u32x2 __attribute__((ext_vector_type(2)));
constexpr int BM = 256, BK = 64, HALF = 128, HTB = HALF * BK * 2  , STAGE_BYTES = 8 * HTB, NXCD = 8, WGM = 8;

__host__ __device__ __forceinline__ int lds_byte(int r, int c) { const int st = (r >> 4) * 2 + (c >> 5), rr = r & 15, cc = c & 31, ob = rr * 64 + cc * 2; return st * 1024 + (ob ^ (((ob >> 9) & 1) << 5)); }
__host__ __device__ __forceinline__ void stage_rc(int b, int& R, int& C) { const int st = b / 1024, sb = b % 1024, swz = sb ^ (((sb >> 9) & 1) << 5); R = (st >> 1) * 16 + swz / 64; C = (st & 1) * 32 + (swz % 64) / 2; }
__host__ __device__ __forceinline__ int perm32(int rho) { const int n = rho >> 4, i = rho & 15; return 8 * (i >> 2) + 4 * n + (i & 3); }

struct Unit { int pm, pn, sub; };
struct Gemm { const bf16_t* A; const bf16_t* Bt; int M, N, K, lda, ldb, a_pn_step; const bf16_t* A2; const bf16_t* Bt2; };

struct StaticOrder {
    int nM, nN, nwg, G, c;
    __host__ __device__ void init(int M, int N, int G_, int c_) { nM = M / BM; nN = N / BM; nwg = nM * nN; G = G_; c = c_; }
    __host__ __device__ bool next(int i, Unit& u) const {
        const long L = (long)i * G + c; if (L >= nwg) return false;
        int wgid = (int)L; { const int q = nwg / NXCD, r = nwg % NXCD, xcd = wgid % NXCD, off = wgid / NXCD; wgid = (xcd < r ? xcd * (q + 1) : r * (q + 1) + (xcd - r) * q) + off; }
        const int nig = WGM * nN, gid = wgid / nig, fm = gid * WGM, gsz = (nM - fm) < WGM ? (nM - fm) : WGM;
        u.pm = fm + ((wgid % nig) % gsz); u.pn = (wgid % nig) / gsz; u.sub = 0; return true;
    }
    __device__ __forceinline__ void a_ready(const Unit&) const {}
    __device__ __forceinline__ void done(const Unit&) const {}
};

struct TwoPartOrder : StaticOrder {
    __host__ __device__ bool next(int i, Unit& u) const { if (!StaticOrder::next(i >> 1, u)) return false; u.sub = i & 1; return true; }
};
typedef float f32x2 __attribute__((ext_vector_type(2)));
typedef __bf16 bf16x2_t __attribute__((ext_vector_type(2)));
__device__ __forceinline__ unsigned pkbf(float lo, float hi) { f32x2 v = {lo, hi}; bf16x2_t b = __builtin_convertvector(v, bf16x2_t); return __builtin_bit_cast(unsigned, b); }
__device__ __forceinline__ float bflo(unsigned w) { return __builtin_bit_cast(float, w << 16); }
__device__ __forceinline__ float bfhi(unsigned w) { return __builtin_bit_cast(float, w & 0xffff0000u); }
__device__ __forceinline__ float fast_sigmoid(float x) { return __builtin_amdgcn_rcpf(1.f + __expf(-x)); }
template <int NP> __device__ __forceinline__ float row_rs(const float* ssp, int row) {
    const f32x4* p = (const f32x4*)(ssp + (size_t)row * NP); f32x4 a = p[0];
#pragma unroll
    for (int k = 1; k < NP / 4; ++k) a = a + p[k];
    return rsqrtf(((a.x + a.y) + (a.z + a.w)) * (1.f / 2048.f) + 1e-6f);
}

template <int NP> __device__ __forceinline__ float row_rs_fq(const float* ssp, int row, int fq) {
    const f32x4* p = (const f32x4*)(ssp + (size_t)row * NP + fq * (NP / 4)); f32x4 a = p[0];
    if (NP == 32) a = a + p[1];
    float t = (a.x + a.y) + (a.z + a.w);
    t += __shfl_xor(t, 16); t += __shfl_xor(t, 32);
    return rsqrtf(t * (1.f / 2048.f) + 1e-6f);
}
template <int NP> __device__ __forceinline__ void row_rs_fq8(const float* ssp, int row0, int fq, float (&rsc)[2][4]) {
#pragma unroll
    for (int ai = 0; ai < 2; ++ai) {
        f32x4 a[4], b[4];
#pragma unroll
        for (int m = 0; m < 4; ++m) { const f32x4* p = (const f32x4*)(ssp + (size_t)(row0 + ai * HALF + m * 16) * NP + fq * (NP / 4)); a[m] = p[0]; if (NP == 32) b[m] = p[1]; }
#pragma unroll
        for (int m = 0; m < 4; ++m) { f32x4 v = a[m]; if (NP == 32) v = v + b[m];
            float t = (v.x + v.y) + (v.z + v.w); t += __shfl_xor(t, 16); t += __shfl_xor(t, 32);
            rsc[ai][m] = rsqrtf(t * (1.f / 2048.f) + 1e-6f); }
    }
}
struct EpiProj {
    static constexpr bool PERM = true, AFTER_DRAIN = false; __device__ static bool keep(const Unit&) { return false; }
    bf16_t *QK, *R, *P, *G; float* AFB; const float* ss;
    __device__ __forceinline__ void operator()(const f32x4 (&acc)[2][2][4][2], const Unit& u, int wr, int wc, int fr, int fq) const {
        const int row0 = u.pm * BM + wr * 64 + fr; const int pn = u.pn;
        float rsc[2][4];
        if (ss) row_rs_fq8<16>(ss, row0, fq, rsc);
        else {
#pragma unroll
            for (int ai = 0; ai < 2; ++ai)
#pragma unroll
                for (int m = 0; m < 4; ++m) rsc[ai][m] = 1.f; }
        bf16_t* base; int ldc, colt, mode;
        if (pn < 4) { base = QK; ldc = 1024; colt = pn * 256; mode = (pn < 2) ? 1 : 0; }
        else if (pn < 8) { base = R; ldc = 1024; colt = (pn - 4) * 256; mode = 2; }
        else if (pn < 12) { base = P; ldc = 1024; colt = (pn - 8) * 256; mode = 0; }
        else { base = G; ldc = 4096; colt = (pn - 12) * 256; mode = 3; }
        const int col0 = colt + wc * 32 + 8 * fq;
#pragma unroll
        for (int ai = 0; ai < 2; ++ai)
#pragma unroll
            for (int m = 0; m < 4; ++m) { bf16_t* rowp = base + (size_t)(row0 + ai * HALF + m * 16) * ldc + col0;
#pragma unroll
                for (int bj = 0; bj < 2; ++bj) { f32x4 v0 = acc[ai][bj][m][0] * rsc[ai][m], v1 = acc[ai][bj][m][1] * rsc[ai][m];
                    if (mode == 1) { v0 = v0 * 0.08838834764831845f; v1 = v1 * 0.08838834764831845f; }
                    else if (mode == 2) {
#pragma unroll
                        for (int e = 0; e < 4; ++e) { v0[e] = v0[e] * fast_sigmoid(v0[e]); v1[e] = v1[e] * fast_sigmoid(v1[e]); } }
                    else if (mode == 3) {
#pragma unroll
                        for (int e = 0; e < 4; ++e) { v0[e] = fast_sigmoid(v0[e]); v1[e] = fast_sigmoid(v1[e]); } }
                    if (mode == 3) { unsigned w0 = 0u, w1 = 0u;
#pragma unroll
                        for (int e = 0; e < 4; ++e) { w0 = __builtin_amdgcn_cvt_pk_u8_f32(__builtin_rintf(v0[e] * 255.f), e, w0); w1 = __builtin_amdgcn_cvt_pk_u8_f32(__builtin_rintf(v1[e] * 255.f), e, w1); }
                        u32x2 w = {w0, w1}; *(u32x2*)((unsigned char*)G + (size_t)(row0 + ai * HALF + m * 16) * 4096 + col0 + bj * HALF) = w; }
                    else {
                    u32x4 w; w.x = pkbf(v0[0], v0[1]); w.y = pkbf(v0[2], v0[3]); w.z = pkbf(v1[0], v1[1]); w.w = pkbf(v1[2], v1[3]);
                    *(u32x4*)(rowp + bj * HALF) = w; } } asm volatile("" ::: "memory"); }
    }
};
struct EpiVT {
    static constexpr bool PERM = true, AFTER_DRAIN = false; __device__ static bool keep(const Unit&) { return false; }
    bf16_t* VT; const float* ss;
    __device__ __forceinline__ void operator()(const f32x4 (&acc)[2][2][4][2], const Unit& u, int wr, int wc, int fr, int fq) const {
        const int dv0 = u.pm * BM + wr * 64 + fr, tok0 = u.pn * BM + wc * 32 + 8 * fq;
        f32x4 cs[2][2];
#pragma unroll
        for (int bj = 0; bj < 2; ++bj)
#pragma unroll
            for (int n = 0; n < 2; ++n) cs[bj][n] = (f32x4){1.f, 1.f, 1.f, 1.f};
        if (ss) { const float mine = row_rs<16>(ss, tok0 + (fr >> 3) * HALF + (fr & 7));
#pragma unroll
            for (int bj = 0; bj < 2; ++bj)
#pragma unroll
                for (int n = 0; n < 2; ++n)
#pragma unroll
                    for (int k = 0; k < 4; ++k) cs[bj][n][k] = __shfl(mine, fq * 16 + bj * 8 + 4 * n + k); }
#pragma unroll
        for (int ai = 0; ai < 2; ++ai)
#pragma unroll
            for (int m = 0; m < 4; ++m) { const int dv = dv0 + ai * HALF + m * 16;
#pragma unroll
                for (int bj = 0; bj < 2; ++bj) { const int tok = tok0 + bj * HALF; const int bc = tok >> 6, tin = tok & 63;
                    const f32x4 v0 = acc[ai][bj][m][0] * cs[bj][0], v1 = acc[ai][bj][m][1] * cs[bj][1];
                    u32x4 w; w.x = pkbf(v0[0], v0[1]); w.y = pkbf(v0[2], v0[3]); w.z = pkbf(v1[0], v1[1]); w.w = pkbf(v1[2], v1[3]);
                    *(u32x4*)(VT + ((size_t)bc * 1024 + dv) * 64 + tin) = w; } }
    }
};
template <bool ROWS> struct EpiScale {
    static constexpr bool PERM = true, AFTER_DRAIN = false; __device__ static bool keep(const Unit&) { return false; }
    bf16_t* O; int ldc; const float* scale; const float* ss;
    __device__ __forceinline__ void operator()(const f32x4 (&acc)[2][2][4][2], const Unit& u, int wr, int wc, int fr, int fq) const {
        const int row0 = u.pm * BM + wr * 64 + fr, col0 = u.pn * BM + wc * 32 + 8 * fq;
        f32x4 sv[2][2];
#pragma unroll
        for (int bj = 0; bj < 2; ++bj)
#pragma unroll
            for (int n = 0; n < 2; ++n) sv[bj][n] = scale ? *(const f32x4*)(scale + col0 + bj * HALF + 4 * n) : (f32x4){1.f, 1.f, 1.f, 1.f};
        float rsc[2][4];
        if (ROWS) row_rs_fq8<32>(ss, row0, fq, rsc);
#pragma unroll
        for (int ai = 0; ai < 2; ++ai)
#pragma unroll
            for (int m = 0; m < 4; ++m) { bf16_t* rowp = O + (size_t)(row0 + ai * HALF + m * 16) * ldc + col0; const float rr = ROWS ? rsc[ai][m] : 1.f;
#pragma unroll
                for (int bj = 0; bj < 2; ++bj) { const f32x4 v0 = acc[ai][bj][m][0] * sv[bj][0] * rr, v1 = acc[ai][bj][m][1] * sv[bj][1] * rr;
                    u32x4 w; w.x = pkbf(v0[0], v0[1]); w.y = pkbf(v0[2], v0[3]); w.z = pkbf(v1[0], v1[1]); w.w = pkbf(v1[2], v1[3]);
                    *(u32x4*)(rowp + bj * HALF) = w; } }
    }
};
template <bool ACCUM> struct EpiGate {
    static constexpr bool PERM = true, AFTER_DRAIN = false; __device__ static bool keep(const Unit&) { return false; }
    bf16_t* O; const bf16_t* Gt;
    __device__ __forceinline__ void operator()(const f32x4 (&acc)[2][2][4][2], const Unit& u, int wr, int wc, int fr, int fq) const {
        const int row0 = u.pm * BM + wr * 64 + fr, col0 = u.pn * BM + wc * 32 + 8 * fq;
#pragma unroll
        for (int ai = 0; ai < 2; ++ai) {
            u32x4 gwv[4][2], owv[4][2];
#pragma unroll
            for (int m = 0; m < 4; ++m)
#pragma unroll
                for (int bj = 0; bj < 2; ++bj) { const size_t row = (size_t)(row0 + ai * HALF + m * 16);
                    gwv[m][bj] = *(const u32x4*)(Gt + row * 4096 + col0 + bj * HALF);
                    if (ACCUM) owv[m][bj] = *(const u32x4*)(O + row * 2048 + col0 + bj * HALF); }
            asm volatile("" ::: "memory");
#pragma unroll
            for (int m = 0; m < 4; ++m) { const size_t row = (size_t)(row0 + ai * HALF + m * 16);
#pragma unroll
                for (int bj = 0; bj < 2; ++bj) { const u32x4 gw = gwv[m][bj];
                    f32x4 v0 = acc[ai][bj][m][0], v1 = acc[ai][bj][m][1];
                    v0[0] *= bflo(gw.x); v0[1] *= bfhi(gw.x); v0[2] *= bflo(gw.y); v0[3] *= bfhi(gw.y); v1[0] *= bflo(gw.z); v1[1] *= bfhi(gw.z); v1[2] *= bflo(gw.w); v1[3] *= bfhi(gw.w);
                    if (ACCUM) { const u32x4 ow = owv[m][bj];
                        v0[0] += bflo(ow.x); v0[1] += bfhi(ow.x); v0[2] += bflo(ow.y); v0[3] += bfhi(ow.y); v1[0] += bflo(ow.z); v1[1] += bfhi(ow.z); v1[2] += bflo(ow.w); v1[3] += bfhi(ow.w); }
                    u32x4 w; w.x = pkbf(v0[0], v0[1]); w.y = pkbf(v0[2], v0[3]); w.z = pkbf(v1[0], v1[1]); w.w = pkbf(v1[2], v1[3]);
                    *(u32x4*)(O + row * 2048 + col0 + bj * HALF) = w; } }
            asm volatile("" ::: "memory");
        }
    }
};
struct EpiMerge {
    static constexpr bool PERM = true, AFTER_DRAIN = false; __device__ static bool keep(const Unit& u) { return u.sub == 0; }
    bf16_t* O; const unsigned char* Gt;
    __device__ __forceinline__ void operator()(f32x4 (&acc)[2][2][4][2], const Unit& u, int wr, int wc, int fr, int fq) const {
        const int row0 = u.pm * BM + wr * 64 + fr, col0 = u.pn * BM + wc * 32 + 8 * fq;
#pragma unroll
        for (int ai = 0; ai < 2; ++ai) {
            u32x2 g1[4][2], g2[4][2];
#pragma unroll
            for (int m = 0; m < 4; ++m)
#pragma unroll
                for (int bj = 0; bj < 2; ++bj) { const size_t p = (size_t)(row0 + ai * HALF + m * 16) * 4096 + col0 + bj * HALF;
                    g2[m][bj] = *(const u32x2*)(Gt + p + 2048); if (u.sub == 0) g1[m][bj] = *(const u32x2*)(Gt + p); }
            asm volatile("" ::: "memory");
#pragma unroll
            for (int m = 0; m < 4; ++m)
#pragma unroll
                for (int bj = 0; bj < 2; ++bj) { const u32x2 b = g2[m][bj];
                    float s2[8];
#pragma unroll
                    for (int e = 0; e < 4; ++e) { s2[e] = (float)((b.x >> (8 * e)) & 255u) * (1.f / 255.f); s2[4 + e] = (float)((b.y >> (8 * e)) & 255u) * (1.f / 255.f); }
#pragma unroll
                    for (int e = 0; e < 8; ++e) s2[e] = fmaxf(s2[e], 8.6736174e-19f);
                    f32x4 v0 = acc[ai][bj][m][0], v1 = acc[ai][bj][m][1];
                    if (u.sub == 0) { const u32x2 a = g1[m][bj];
                        float s1[8];
#pragma unroll
                        for (int e = 0; e < 4; ++e) { s1[e] = (float)((a.x >> (8 * e)) & 255u) * (1.f / 255.f); s1[4 + e] = (float)((a.y >> (8 * e)) & 255u) * (1.f / 255.f); }
#pragma unroll
                        for (int e = 0; e < 4; ++e) { v0[e] *= s1[e] * __builtin_amdgcn_rcpf(s2[e]); v1[e] *= s1[4 + e] * __builtin_amdgcn_rcpf(s2[4 + e]); }
                        acc[ai][bj][m][0] = v0; acc[ai][bj][m][1] = v1;
                    } else {
#pragma unroll
                        for (int e = 0; e < 4; ++e) { v0[e] *= s2[e]; v1[e] *= s2[4 + e]; }
                        u32x4 w; w.x = pkbf(v0[0], v0[1]); w.y = pkbf(v0[2], v0[3]); w.z = pkbf(v1[0], v1[1]); w.w = pkbf(v1[2], v1[3]);
                        *(u32x4*)(O + (size_t)(row0 + ai * HALF + m * 16) * 2048 + col0 + bj * HALF) = w; } }
            asm volatile("" ::: "memory");
        }
    }
};
struct EpiResid {
    static constexpr bool PERM = true, AFTER_DRAIN = false; __device__ static bool keep(const Unit&) { return false; }
    const float* xin; bf16_t* XB; float* ss;
    __device__ __forceinline__ void operator()(const f32x4 (&acc)[2][2][4][2], const Unit& u, int wr, int wc, int fr, int fq) const {
        const int row0 = u.pm * BM + wr * 64 + fr, col0 = u.pn * BM + wc * 32 + 8 * fq;
#pragma unroll
        for (int h4 = 0; h4 < 4; ++h4) { const int ai = h4 >> 1, mb = (h4 & 1) * 2;
            f32x4 xv[2][2][2];
#pragma unroll
            for (int mm = 0; mm < 2; ++mm)
#pragma unroll
                for (int bj = 0; bj < 2; ++bj) { const size_t p = (size_t)(row0 + ai * HALF + (mb + mm) * 16) * 2048 + col0 + bj * HALF; xv[mm][bj][0] = *(const f32x4*)(xin + p); xv[mm][bj][1] = *(const f32x4*)(xin + p + 4); }
            asm volatile("" ::: "memory");
#pragma unroll
            for (int mm = 0; mm < 2; ++mm) { const int m = mb + mm; const int row = row0 + ai * HALF + m * 16; const size_t rb = (size_t)row * 2048 + col0; float sq = 0.f;
#pragma unroll
                for (int bj = 0; bj < 2; ++bj) { const size_t p = rb + bj * HALF;
                    const f32x4 x0 = xv[mm][bj][0] + acc[ai][bj][m][0], x1 = xv[mm][bj][1] + acc[ai][bj][m][1];
                    sq += (x0.x * x0.x + x0.y * x0.y) + (x0.z * x0.z + x0.w * x0.w) + (x1.x * x1.x + x1.y * x1.y) + (x1.z * x1.z + x1.w * x1.w);
                    u32x4 w; w.x = pkbf(x0[0], x0[1]); w.y = pkbf(x0[2], x0[3]); w.z = pkbf(x1[0], x1[1]); w.w = pkbf(x1[2], x1[3]);
                    *(u32x4*)(XB + p) = w; }
                sq += __shfl_xor(sq, 16); sq += __shfl_xor(sq, 32);
                if (fq == 0) ss[(size_t)row * 32 + u.pn * 4 + wc] = sq; }
            asm volatile("" ::: "memory");
        }
    }
};

template <class Epi, class Sched, bool ALIGN_EPI = false, bool SP2 = false>
__device__ __forceinline__ void gemm_phase(PG8_LAS unsigned char* lds, const Gemm g, const Sched& S, const Epi& E) {
    int tid_o = threadIdx.x; asm volatile("" : "+v"(tid_o));
    const int tid = tid_o, wid = __builtin_amdgcn_readfirstlane(tid >> 6), lane = tid & 63, wr = wid >> 2, wc = wid & 3, fr = lane & 15, fq = lane >> 4;
    int K_o = g.K; asm volatile("" : "+s"(K_o));
    const int K = K_o, nt = K / BK;
    unsigned voffA[2], voffB[2];
#pragma unroll
    for (int i = 0; i < 2; ++i) { int R, C; stage_rc(tid * 16 + i * 8192, R, C); const int Rb = Epi::PERM ? ((R & ~31) + perm32(R & 31)) : R;
        voffA[i] = (unsigned)(R * g.lda + C) * 2u; voffB[i] = (unsigned)(Rb * g.ldb + C) * 2u; }
    const size_t kstep = (size_t)(BK * 2);
    const size_t hstepA = (size_t)HALF * g.lda * 2, hstepB = (size_t)HALF * g.ldb * 2;
    const size_t tstepA = 2 * hstepA, tstepB = 2 * hstepB;
    const unsigned ldsw = (unsigned)wid * 1024u;
    const int aoff = lds_byte(wr * 64 + fr, fq * 8), boff = lds_byte(wc * 32 + fr, fq * 8);
#define PG8_SA(b, h) (((b) * 2 + (h)) * HTB)
#define PG8_SB(b, h) ((4 + (b) * 2 + (h)) * HTB)
#define PG8_STAGE(bufoff, gbase, voff) do { _Pragma("unroll") for (int _i = 0; _i < 2; ++_i) \
        __builtin_amdgcn_global_load_lds((const unsigned*)((const char*)(gbase) + (voff)[_i]), (PG8_LAS unsigned*)(lds + (bufoff) + ldsw + _i * 8192), 16, 0, 0); } while (0)
#define PG8_LDA(dst, b, h) do { _Pragma("unroll") for (int m = 0; m < 4; ++m) _Pragma("unroll") for (int k = 0; k < 2; ++k) dst[m][k] = *(const PG8_LAS bf16x8*)(lds + PG8_SA(b, h) + aoff + m * 2048 + k * 1024); } while (0)
#define PG8_LDB(dst, b, h) do { _Pragma("unroll") for (int n = 0; n < 2; ++n) _Pragma("unroll") for (int k = 0; k < 2; ++k) dst[n][k] = *(const PG8_LAS bf16x8*)(lds + PG8_SB(b, h) + boff + n * 2048 + k * 1024); } while (0)
#define PG8_MMA(ai, bj, At, Bt) do { __builtin_amdgcn_s_setprio(1); _Pragma("unroll") for (int m = 0; m < 4; ++m) _Pragma("unroll") for (int n = 0; n < 2; ++n) _Pragma("unroll") for (int k = 0; k < 2; ++k) \
        acc[ai][bj][m][n] = __builtin_amdgcn_mfma_f32_16x16x32_bf16(Bt[n][k], At[m][k], acc[ai][bj][m][n], 0, 0, 0); __builtin_amdgcn_s_setprio(0); } while (0)
#define PG8_WAIT_V(n) asm volatile("s_waitcnt vmcnt(" #n ")" ::: "memory")
#define PG8_WAIT_L(n) asm volatile("s_waitcnt lgkmcnt(" #n ")" ::: "memory")
#define PG8_BAR __builtin_amdgcn_s_barrier()
#define PG8_SCHED __builtin_amdgcn_sched_barrier(0)
    Unit cur, nxt; int ui = 0;
    if (!S.next(0, cur)) return;
    f32x4 acc[2][2][4][2];
    float zf = 0.f; asm volatile("" : "+v"(zf));
#pragma unroll
    for (int a = 0; a < 2; ++a)
#pragma unroll
        for (int b = 0; b < 2; ++b)
#pragma unroll
            for (int m = 0; m < 4; ++m)
#pragma unroll
                for (int n = 0; n < 2; ++n) acc[a][b][m][n] = (f32x4){zf, zf, zf, zf};
    bf16x8 At[4][2], B0[2][2], B1[2][2];
    const char* cA = (const char*)(cur.sub ? g.A2 : g.A) + (size_t)cur.pm * tstepA + (size_t)cur.pn * g.a_pn_step; const char* cB = (const char*)(cur.sub ? g.Bt2 : g.Bt) + (size_t)cur.pn * tstepB;
    S.a_ready(cur);
    if constexpr (SP2) {
        PG8_STAGE(PG8_SB(0, 0), cB, voffB); PG8_STAGE(PG8_SB(0, 1), cB + hstepB, voffB); PG8_STAGE(PG8_SA(0, 0), cA, voffA); PG8_STAGE(PG8_SA(0, 1), cA + hstepA, voffA);
        if (wr == 1) PG8_BAR;
        PG8_WAIT_V(2); PG8_BAR;
        PG8_STAGE(PG8_SB(1, 0), cB + kstep, voffB); PG8_STAGE(PG8_SA(1, 0), cA + kstep, voffA); PG8_STAGE(PG8_SB(1, 1), cB + hstepB + kstep, voffB);
        PG8_WAIT_V(6); PG8_BAR;
    } else {
        PG8_STAGE(PG8_SB(0, 0), cB, voffB); PG8_STAGE(PG8_SA(0, 0), cA, voffA); PG8_STAGE(PG8_SB(0, 1), cB + hstepB, voffB); PG8_STAGE(PG8_SA(0, 1), cA + hstepA, voffA);
        if (wr == 1) PG8_BAR;
        PG8_WAIT_V(4); PG8_BAR;
        PG8_STAGE(PG8_SB(1, 0), cB + kstep, voffB); PG8_STAGE(PG8_SA(1, 0), cA + kstep, voffA); PG8_STAGE(PG8_SB(1, 1), cB + hstepB + kstep, voffB);
        PG8_WAIT_V(6); PG8_BAR;
    }
    for (;;) {
        const bool has_next = S.next(ui + 1, nxt);
        const char* nA = has_next ? (const char*)(nxt.sub ? g.A2 : g.A) + (size_t)nxt.pm * tstepA + (size_t)nxt.pn * g.a_pn_step : cA; const char* nB = has_next ? (const char*)(nxt.sub ? g.Bt2 : g.Bt) + (size_t)nxt.pn * tstepB : cB;
        for (int t = 0; t < nt; t += 2) {
            const bool last = (t == nt - 2);
            const char* a1 = cA + (size_t)(t + 1) * kstep;
            const char* a2 = last ? nA : cA + (size_t)(t + 2) * kstep; const char* b2 = last ? nB : cB + (size_t)(t + 2) * kstep;
            const char* a3 = a2 + kstep; const char* b3 = b2 + kstep;
            if (last && has_next) S.a_ready(nxt);
            if constexpr (SP2) {
            PG8_LDB(B0, 0, 0); PG8_LDB(B1, 0, 1); PG8_SCHED; PG8_LDA(At, 0, 0); PG8_STAGE(PG8_SA(1, 1), a1 + hstepA, voffA);
            PG8_WAIT_V(8); PG8_WAIT_L(0); PG8_BAR; PG8_MMA(0, 0, At, B0); PG8_MMA(0, 1, At, B1); PG8_BAR; PG8_SCHED;
            PG8_LDA(At, 0, 1); PG8_STAGE(PG8_SB(0, 0), b2, voffB); PG8_STAGE(PG8_SB(0, 1), b2 + hstepB, voffB); PG8_STAGE(PG8_SA(0, 0), a2, voffA);
            PG8_WAIT_V(8); PG8_WAIT_L(0); PG8_BAR; PG8_MMA(1, 0, At, B0); PG8_MMA(1, 1, At, B1); PG8_BAR; PG8_SCHED;
            PG8_LDB(B0, 1, 0); PG8_LDB(B1, 1, 1); PG8_SCHED; PG8_LDA(At, 1, 0); PG8_STAGE(PG8_SA(0, 1), a2 + hstepA, voffA);
            PG8_WAIT_V(8); PG8_WAIT_L(0); PG8_BAR; PG8_MMA(0, 0, At, B0); PG8_MMA(0, 1, At, B1); PG8_BAR; PG8_SCHED;
            PG8_LDA(At, 1, 1); PG8_STAGE(PG8_SB(1, 0), b3, voffB); PG8_STAGE(PG8_SB(1, 1), b3 + hstepB, voffB); PG8_STAGE(PG8_SA(1, 0), a3, voffA);
            PG8_WAIT_V(8); PG8_WAIT_L(0); PG8_BAR; PG8_MMA(1, 0, At, B0); PG8_MMA(1, 1, At, B1); PG8_BAR; PG8_SCHED;
            } else {
            PG8_LDB(B0, 0, 0); PG8_SCHED; PG8_LDA(At, 0, 0); PG8_STAGE(PG8_SA(1, 1), a1 + hstepA, voffA);
            PG8_WAIT_L(8); PG8_BAR; PG8_WAIT_L(0); PG8_MMA(0, 0, At, B0); PG8_BAR; PG8_SCHED;
            PG8_LDB(B1, 0, 1); PG8_STAGE(PG8_SB(0, 0), b2, voffB);
            PG8_BAR; PG8_WAIT_L(0); PG8_MMA(0, 1, At, B1); PG8_BAR;
            PG8_LDA(At, 0, 1); PG8_STAGE(PG8_SA(0, 0), a2, voffA);
            PG8_BAR; PG8_WAIT_L(0); PG8_MMA(1, 0, At, B0); PG8_BAR; PG8_SCHED;
            PG8_STAGE(PG8_SB(0, 1), b2 + hstepB, voffB);
            PG8_WAIT_V(6); PG8_BAR; PG8_MMA(1, 1, At, B1); PG8_BAR;
            PG8_LDB(B0, 1, 0); PG8_SCHED; PG8_LDA(At, 1, 0); PG8_STAGE(PG8_SA(0, 1), a2 + hstepA, voffA);
            PG8_WAIT_L(8); PG8_BAR; PG8_WAIT_L(0); PG8_MMA(0, 0, At, B0); PG8_BAR; PG8_SCHED;
            PG8_LDB(B1, 1, 1); PG8_STAGE(PG8_SB(1, 0), b3, voffB);
            PG8_BAR; PG8_WAIT_L(0); PG8_MMA(0, 1, At, B1); PG8_BAR;
            PG8_LDA(At, 1, 1); PG8_STAGE(PG8_SA(1, 0), a3, voffA);
            PG8_BAR; PG8_WAIT_L(0); PG8_MMA(1, 0, At, B0); PG8_BAR; PG8_SCHED;
            PG8_STAGE(PG8_SB(1, 1), b3 + hstepB, voffB);
            PG8_WAIT_V(6); PG8_BAR; PG8_MMA(1, 1, At, B1); PG8_BAR;
            }
        }
        if constexpr (ALIGN_EPI) { if (wr == 0) PG8_BAR; }
        if constexpr (!Epi::AFTER_DRAIN) { E(acc, cur, wr, wc, fr, fq); S.done(cur); }
        if (!has_next) break;
        if (!Epi::keep(cur)) {
        float zf2 = 0.f; asm volatile("" : "+v"(zf2));
#pragma unroll
        for (int a = 0; a < 2; ++a)
#pragma unroll
            for (int b = 0; b < 2; ++b)
#pragma unroll
                for (int m = 0; m < 4; ++m)
#pragma unroll
                    for (int n = 0; n < 2; ++n) acc[a][b][m][n] = (f32x4){zf2, zf2, zf2, zf2};
        }
        cur = nxt; cA = nA; cB = nB; ++ui;
        if constexpr (ALIGN_EPI) { if (wr == 1) PG8_BAR; }
    }
    PG8_WAIT_V(0);
    if constexpr (!ALIGN_EPI) { if (wr == 0) PG8_BAR; }
    PG8_BAR;
    if constexpr (Epi::AFTER_DRAIN) { E.fused(acc, cur, wr, wc, fr, fq, lds, wid, lane); S.done(cur); }
#undef PG8_SA
#undef PG8_SB
#undef PG8_STAGE
#undef PG8_LDA
#undef PG8_LDB
#undef PG8_MMA
#undef PG8_WAIT_V
#undef PG8_WAIT_L
#undef PG8_BAR
#undef PG8_SCHED
}
}

#define GAS __attribute__((address_space(1)))
#define LAS __attribute__((address_space(3)))
typedef unsigned short bf16;
typedef unsigned v4u __attribute__((ext_vector_type(4)));
typedef float f32x4 __attribute__((ext_vector_type(4)));
typedef short bf16x8 __attribute__((ext_vector_type(8)));
typedef GAS unsigned gu32;
typedef GAS unsigned long long gu64;
#define RLX_AGENT __ATOMIC_RELAXED, __HIP_MEMORY_SCOPE_AGENT
#define LDS_WAIT() asm volatile("s_waitcnt lgkmcnt(0)" ::: "memory")
#define VM_WAIT() asm volatile("s_waitcnt vmcnt(0)" ::: "memory")
__device__ __forceinline__ unsigned long long rt() { return __builtin_amdgcn_s_memrealtime(); }
__device__ __forceinline__ unsigned f2bf(float f) { unsigned u = __builtin_bit_cast(unsigned, f); return (u + 0x7fffu + ((u >> 16) & 1u)) >> 16; }
__device__ __forceinline__ unsigned pk2(float lo, float hi) { return f2bf(lo) | (f2bf(hi) << 16); }

#define XB_TMO      128
#define XB_XCNT(j)  (256  + 64 * (j))
#define XB_XSUB(j)  (1280 + 64 * (j))
#define XB_XGEN(j)  (2304 + 64 * (j))
#define XB_TOP      3328
#define XB_TOPGEN   3392
#define XCD_BAR_WORDS 3456
#define XB_SPIN_CAP (1u << 18)

__device__ __forceinline__ unsigned xb_ld(unsigned* p)              { return __hip_atomic_load(p, __ATOMIC_RELAXED, __HIP_MEMORY_SCOPE_AGENT); }
__device__ __forceinline__ unsigned xb_add(unsigned* p, unsigned v) { return __hip_atomic_fetch_add(p, v, __ATOMIC_RELAXED, __HIP_MEMORY_SCOPE_AGENT); }
__device__ __forceinline__ unsigned xb_xcc_id() { return (unsigned)__builtin_amdgcn_s_getreg((3 << 11) | 20) & 0xFu; }
#define XB_SPIN(cond, bar) do { unsigned _sp = 0; while (cond) { __builtin_amdgcn_s_sleep(1); \
    if ((++_sp & 255u) == 0u) { if (xb_ld(&(bar)[XB_TMO])) break; if (_sp > XB_SPIN_CAP) { atomicAdd(&(bar)[XB_TMO], 1u); break; } } } } while (0)

struct XcdBarrier {
    unsigned* bar; unsigned x;
    volatile LAS unsigned* st;
};

__device__ __forceinline__ XcdBarrier xcd_barrier_post(unsigned* bar, volatile LAS unsigned* st) {
    XcdBarrier b; b.bar = bar; b.x = xb_xcc_id(); b.st = st;
    if (threadIdx.x == 0) (void)xb_add(&bar[XB_XCNT(b.x)], 1u);
    return b;
}
__device__ __forceinline__ void xcd_barrier_complete(unsigned* bar, unsigned x, unsigned& nloc, unsigned& nx) {
    const unsigned G = gridDim.x * gridDim.y * gridDim.z;
    unsigned sum, cnt, mine, sp = 0u;
    for (;;) {
        sum = 0u; cnt = 0u; mine = 0u;
#pragma unroll
        for (unsigned j = 0; j < 16; ++j) { const unsigned c = xb_ld(&bar[XB_XCNT(j)]); sum += c; cnt += (c > 0u) ? 1u : 0u; mine = (j == x) ? c : mine; }
        if (sum == G) break;
        __builtin_amdgcn_s_sleep(1);
        if ((++sp & 255u) == 0u) { if (xb_ld(&bar[XB_TMO])) break; if (sp > XB_SPIN_CAP) { atomicAdd(&bar[XB_TMO], 1u); break; } }
    }
    nloc = mine > 0u ? mine : 1u; nx = cnt > 0u ? cnt : 1u;
}

__device__ __forceinline__ void xcd_barrier(const XcdBarrier& b) {
    asm volatile("s_waitcnt vmcnt(0)" ::: "memory");
    __syncthreads();
    if (threadIdx.x == 0) {
        unsigned* bar = b.bar;
        __builtin_amdgcn_s_waitcnt(0);
        unsigned nloc = b.st[0], nx = b.st[1];
        if (nloc == 0u) { xcd_barrier_complete(bar, b.x, nloc, nx); b.st[0] = nloc; b.st[1] = nx; }
        const unsigned old = xb_add(&bar[XB_XSUB(b.x)], 1u);
        const unsigned gen = old / nloc;
        if (old + 1u == (gen + 1u) * nloc) {
            __builtin_amdgcn_fence(__ATOMIC_RELEASE, "agent");
            asm volatile("s_waitcnt vmcnt(0)" ::: "memory");
            const unsigned og = xb_add(&bar[XB_TOP], 1u);
            const unsigned tg = og / nx;
            if (og + 1u == (tg + 1u) * nx) xb_add(&bar[XB_TOPGEN], 1u);
            else XB_SPIN(xb_ld(&bar[XB_TOPGEN]) == tg, bar);
            __builtin_amdgcn_fence(__ATOMIC_ACQUIRE, "agent");
            xb_add(&bar[XB_XGEN(b.x)], 1u);
            asm volatile("s_waitcnt vmcnt(0)" ::: "memory");
        } else {
            XB_SPIN(xb_ld(&bar[XB_XGEN(b.x)]) == gen, bar);
            __builtin_amdgcn_fence(__ATOMIC_ACQUIRE, "agent");
            asm volatile("s_waitcnt vmcnt(0)" ::: "memory");
        }
    }
    __syncthreads();
}

constexpr int D = 2048, SEQ = 16384, M = 32768, DEPTH = 2;
constexpr int NCH = 256;
constexpr int NSEG = 16, CPS = NCH / NSEG;
constexpr int DIN = 8224;
constexpr float RMS_EPS = 1e-6f;
constexpr int NWAVES = 8;
constexpr int NPH = 15;

constexpr size_t MiB = 1u << 20;
constexpr size_t WS_CTL = 0, CTL_ZERO_BYTES = 1 * MiB;
constexpr size_t WS_WIN = 1 * MiB;
constexpr size_t WS_WUPG = 34 * MiB;
constexpr size_t WS_WUPP = 38 * MiB;
constexpr size_t WS_WOUT = 42 * MiB;
constexpr size_t WS_WQ = 50 * MiB;
constexpr size_t WS_POOLW = 58 * MiB;
constexpr size_t WS_SUBK = 58 * MiB + 512 * 1024;
constexpr size_t WS_USC = 59 * MiB, WS_VSC = 59 * MiB + 512 * 1024;
constexpr size_t WS_UTAB = 60 * MiB, WS_VTAB = 124 * MiB;
constexpr size_t WS_H = 188 * MiB;
constexpr size_t WS_POOLED = WS_H, WS_POOLMIX = WS_H + 64 * MiB, WS_SEGL = WS_H + 64 * MiB, WS_SIN = WS_H + 96 * MiB;
constexpr size_t WS_QK = 316 * MiB;
constexpr size_t WS_P = 380 * MiB;
constexpr size_t WS_VT = 444 * MiB;
constexpr size_t WS_R = 508 * MiB;
constexpr size_t WS_MERGED = WS_VT;
constexpr size_t WS_G = 572 * MiB;
constexpr size_t WS_PQ = WS_G, WS_IDX = 700 * MiB, WS_GATE = 716 * MiB;
constexpr size_t WS_AFB = 828 * MiB;
constexpr size_t WS_QE = 832 * MiB;
constexpr size_t WS_GLAOUT = WS_QE;
constexpr size_t WS_KDT = 896 * MiB;
constexpr size_t WS_ATTN = 960 * MiB;
constexpr size_t WS_DEC = 992 * MiB;
constexpr size_t WS_SSP1 = 994 * MiB, WS_SSP2 = 998 * MiB;
constexpr size_t WS_END = 1000 * MiB;
constexpr int CW_BAR = 4096;

constexpr int RING_BYTES = 131072;
constexpr int LDSCTL_OFF = RING_BYTES, MISC_OFF = LDSCTL_OFF + 320;
constexpr int LDS_BYTES = 147456;

typedef unsigned v2u __attribute__((ext_vector_type(2)));
typedef float f32x2 __attribute__((ext_vector_type(2)));
typedef float f32x16 __attribute__((ext_vector_type(16)));
using pg8::pkbf; using pg8::bflo; using pg8::bfhi;
__device__ __forceinline__ float bf2f(bf16 h) { return __builtin_bit_cast(float, (unsigned)h << 16); }
__device__ __forceinline__ bf16 f2bf1(float f) { return (bf16)(pkbf(f, 0.f) & 0xffffu); }
__device__ __forceinline__ float wave_sum(float v) {
#pragma unroll
    for (int o = 1; o < 64; o <<= 1) v += __shfl_xor(v, o);
    return v;
}
__device__ __forceinline__ float wave_max(float v) {
#pragma unroll
    for (int o = 1; o < 64; o <<= 1) v = fmaxf(v, __shfl_xor(v, o));
    return v;
}
__device__ __forceinline__ f32x16 mfma32(bf16x8 a, bf16x8 b, f32x16 c) { return __builtin_amdgcn_mfma_f32_32x32x16_bf16(a, b, c, 0, 0, 0); }
__device__ __forceinline__ bf16x8 mk8(unsigned a, unsigned b, unsigned c, unsigned d) { v4u t = {a, b, c, d}; return __builtin_bit_cast(bf16x8, t); }

#define LDS_BAR() do { asm volatile("s_waitcnt lgkmcnt(0)" ::: "memory"); __builtin_amdgcn_s_barrier(); asm volatile("" ::: "memory"); } while (0)
__device__ __forceinline__ void transpose_item(const float* __restrict__ W, int N, bf16* WT, int ldt, int dst_row0, int k0, int n0, LAS float* scr, int lane, const float* __restrict__ gk = nullptr) {
#pragma unroll
    for (int i = 0; i < 8; ++i) { const int kk = 8 * i + (lane >> 3), c4 = 4 * (lane & 7); f32x4 v = *(const f32x4*)(W + (size_t)(k0 + kk) * N + n0 + c4);
        if (gk) v = v * gk[k0 + kk];
        LAS float* d = scr + kk * 33 + c4; d[0] = v.x; d[1] = v.y; d[2] = v.z; d[3] = v.w; }
    LDS_WAIT(); asm volatile("" ::: "memory");
    const int c = lane & 7;
#pragma unroll
    for (int j = 0; j < 4; ++j) { const int n = (lane >> 3) + 8 * j; const LAS float* s = scr + (8 * c) * 33 + n;
        v4u o; o.x = pkbf(s[0 * 33], s[1 * 33]); o.y = pkbf(s[2 * 33], s[3 * 33]); o.z = pkbf(s[4 * 33], s[5 * 33]); o.w = pkbf(s[6 * 33], s[7 * 33]);
        *(GAS v4u*)(WT + (size_t)(dst_row0 + n) * ldt + k0 + 8 * c) = o; }
    LDS_WAIT(); asm volatile("" ::: "memory");
}
__device__ __forceinline__ void transpose_matrix(const float* W, int K, int N, bf16* WT, LAS float* scr, int lane, int gw, int NGW) {
    const int nblk = N / 32, items = (K / 64) * nblk;
    for (int it = gw; it < items; it += NGW) { const int kb = it / nblk, nb = it % nblk; transpose_item(W, N, WT, K, nb * 32, kb * 64, nb * 32, scr, lane); }
}
__device__ __forceinline__ void table_rows_fp8(const float* __restrict__ T, unsigned* __restrict__ O, float* __restrict__ inv, int rowA, int rowB, int lane, const float* __restrict__ gc = nullptr) {
    const f32x4* sa = (const f32x4*)(T + (size_t)rowA * 2048) + lane; const f32x4* sb = (const f32x4*)(T + (size_t)rowB * 2048) + lane;
    f32x4 va[8], vb[8]; float ama = 0.f, amb = 0.f;
#pragma unroll
    for (int j = 0; j < 8; ++j) { va[j] = sa[64 * j]; vb[j] = sb[64 * j]; }
    if (gc) {
#pragma unroll
        for (int j = 0; j < 8; ++j) { const f32x4 gq = ((const f32x4*)gc)[64 * j + lane]; va[j] = va[j] * gq; vb[j] = vb[j] * gq; } }
#pragma unroll
    for (int j = 0; j < 8; ++j) { ama = fmaxf(ama, fmaxf(fmaxf(fabsf(va[j].x), fabsf(va[j].y)), fmaxf(fabsf(va[j].z), fabsf(va[j].w)))); amb = fmaxf(amb, fmaxf(fmaxf(fabsf(vb[j].x), fabsf(vb[j].y)), fmaxf(fabsf(vb[j].z), fabsf(vb[j].w)))); }
#pragma unroll
    for (int o = 1; o < 64; o <<= 1) { ama = fmaxf(ama, __shfl_xor(ama, o)); amb = fmaxf(amb, __shfl_xor(amb, o)); }
    float ea = (ama > 1e-30f) ? floorf(__log2f(224.f / ama)) : 0.f; ea = fminf(fmaxf(ea, -60.f), 60.f);
    float eb = (amb > 1e-30f) ? floorf(__log2f(224.f / amb)) : 0.f; eb = fminf(fmaxf(eb, -60.f), 60.f);
    const float sca = exp2f(ea), scb = exp2f(eb);
#pragma unroll
    for (int j = 0; j < 8; ++j) { const int dw = 64 * j + lane; int w = 0;
        w = __builtin_amdgcn_cvt_pk_fp8_f32(va[j].x * sca, va[j].y * sca, w, false); w = __builtin_amdgcn_cvt_pk_fp8_f32(va[j].z * sca, va[j].w * sca, w, true);
        O[((size_t)(dw >> 5) * 16384 + rowA) * 32 + (dw & 31)] = (unsigned)w; w = 0;
        w = __builtin_amdgcn_cvt_pk_fp8_f32(vb[j].x * scb, vb[j].y * scb, w, false); w = __builtin_amdgcn_cvt_pk_fp8_f32(vb[j].z * scb, vb[j].w * scb, w, true);
        O[((size_t)(dw >> 5) * 16384 + rowB) * 32 + (dw & 31)] = (unsigned)w; }
    if (lane == 0) { inv[rowA] = exp2f(-ea); inv[rowB] = exp2f(-eb); }
}
__device__ __forceinline__ void rmsnorm_row(const float* xrow, const float* __restrict__ g, bf16* orow, int lane) {
    const f32x4* xr = (const f32x4*)xrow + lane; const f32x4* gr = (const f32x4*)g + lane;
    f32x4 v[8]; float s = 0.f;
#pragma unroll
    for (int j = 0; j < 8; ++j) { v[j] = xr[64 * j]; s += (v[j].x * v[j].x + v[j].y * v[j].y) + (v[j].z * v[j].z + v[j].w * v[j].w); }
    const float rs = rsqrtf(wave_sum(s) * (1.f / 2048.f) + RMS_EPS);
    v2u* o8 = (v2u*)orow + lane;
#pragma unroll
    for (int j = 0; j < 8; ++j) { const f32x4 gg = gr[64 * j]; v2u o; o.x = pkbf(v[j].x * rs * gg.x, v[j].y * rs * gg.y); o.y = pkbf(v[j].z * rs * gg.z, v[j].w * rs * gg.w); o8[64 * j] = o; }
}

constexpr int PA_A = 0, PA_QT = 4096, PA_Q = 8192, PA_K = PA_Q + 17408, PA_KE = PA_K + 17408, PA_BYTES = PA_KE + 17408;
static_assert(2 * PA_BYTES <= RING_BYTES, "prep LDS");
struct PrepIn { f32x4 a; unsigned q[8], k[8]; float wg[2][16]; float bias[2]; };
__device__ __forceinline__ void gla_prep_load(PrepIn& in, int uid, const bf16* __restrict__ QK, const float* __restrict__ AFB, const float* __restrict__ Wgf, const float* __restrict__ Bgf,
                                              const float* __restrict__ Wgb, const float* __restrict__ Bgb, int tid) {
    const int dir = uid & 1, h = (uid >> 1) & 3, bn = uid >> 3; const size_t row0 = (size_t)bn * 64;
    const float* Wg = dir ? Wgb : Wgf; const float* Bg = dir ? Bgb : Bgf;
    { const int t = (tid & 255) >> 2, q4 = tid & 3; in.a = *(const f32x4*)(AFB + (row0 + t) * 32 + dir * 16 + 4 * q4); }
    const int c2 = tid & 63, tq = tid >> 6;
#pragma unroll
    for (int j = 0; j < 8; ++j) { const bf16* src = QK + (row0 + tq * 8 + j) * 1024 + h * 128 + 2 * c2; in.q[j] = *(const unsigned*)src; in.k[j] = *(const unsigned*)(src + 512); }
#pragma unroll
    for (int r = 0; r < 16; ++r) { const f32x2 w2 = *(const f32x2*)(Wg + r * 512 + h * 128 + 2 * c2); in.wg[0][r] = w2.x; in.wg[1][r] = w2.y; }
    { const f32x2 b2 = *(const f32x2*)(Bg + h * 128 + 2 * c2); in.bias[0] = b2.x; in.bias[1] = b2.y; }
}
__device__ __forceinline__ void gla_prep_unit(int uid, int uid_next, PrepIn& in, LAS unsigned char* lds, const bf16* __restrict__ QK, const float* __restrict__ AFB, const float* __restrict__ Wgf, const float* __restrict__ Bgf,
                                              const float* __restrict__ Wgb, const float* __restrict__ Bgb, bf16* QE, bf16* KDT, bf16* ATTN, float* DEC, int tid, int wave, int lane) {
    const int dir = uid & 1;
    LAS float* aS = (LAS float*)(lds + PA_A); LAS float* qtot = (LAS float*)(lds + PA_QT);
    LAS bf16* qS = (LAS bf16*)(lds + PA_Q); LAS bf16* kS = (LAS bf16*)(lds + PA_K); LAS bf16* keS = (LAS bf16*)(lds + PA_KE);
    if (tid < 256) { const int t = tid >> 2, q4 = tid & 3; *(LAS f32x4*)(aS + t * 16 + 4 * q4) = in.a; }
    const int c2 = tid & 63, tq = tid >> 6;
    unsigned qv[8], kv[8]; float wg0[16], wg1[16];
#pragma unroll
    for (int j = 0; j < 8; ++j) { qv[j] = in.q[j]; kv[j] = in.k[j]; }
#pragma unroll
    for (int r = 0; r < 16; ++r) { wg0[r] = in.wg[0][r]; wg1[r] = in.wg[1][r]; }
    const float bias0 = in.bias[0], bias1 = in.bias[1];
    gla_prep_load(in, uid_next, QK, AFB, Wgf, Bgf, Wgb, Bgb, tid);
    LDS_BAR();
    float lg0[8], lg1[8], P0[8], P1[8]; float run0 = 0.f, run1 = 0.f;
#pragma unroll
    for (int j = 0; j < 8; ++j) { const int t = tq * 8 + j;
        const f32x4 a0 = *(const LAS f32x4*)(aS + t * 16), a1 = *(const LAS f32x4*)(aS + t * 16 + 4), a2 = *(const LAS f32x4*)(aS + t * 16 + 8), a3 = *(const LAS f32x4*)(aS + t * 16 + 12);
        f32x2 z2 = {bias0, bias1};
        const float av[16] = {a0.x, a0.y, a0.z, a0.w, a1.x, a1.y, a1.z, a1.w, a2.x, a2.y, a2.z, a2.w, a3.x, a3.y, a3.z, a3.w};
#pragma unroll
        for (int r2 = 0; r2 < 16; ++r2) z2 = __builtin_elementwise_fma((f32x2){av[r2], av[r2]}, (f32x2){wg0[r2], wg1[r2]}, z2);
        const float z0 = z2.x, z1 = z2.y;
        lg0[j] = (fminf(z0, 0.f) - __logf(1.f + __expf(-fabsf(z0)))) * (1.f / 16.f); lg1[j] = (fminf(z1, 0.f) - __logf(1.f + __expf(-fabsf(z1)))) * (1.f / 16.f);
        run0 += lg0[j]; run1 += lg1[j]; P0[j] = run0; P1[j] = run1; }
    *(LAS f32x2*)(qtot + tq * 128 + 2 * c2) = (f32x2){run0, run1};
    LDS_BAR();
    float btot0 = 0.f, btot1 = 0.f, off0 = 0.f, off1 = 0.f;
#pragma unroll
    for (int g8 = 0; g8 < 8; ++g8) { const f32x2 v = *(const LAS f32x2*)(qtot + g8 * 128 + 2 * c2); btot0 += v.x; btot1 += v.y;
        const bool before = dir ? (g8 > tq) : (g8 < tq); off0 += before ? v.x : 0.f; off1 += before ? v.y : 0.f; }
    const float dt0 = __expf(btot0), dt1 = __expf(btot1);
    if (tq == 0) *(f32x2*)(DEC + (size_t)uid * 128 + 2 * c2) = (f32x2){dt0, dt1};
#pragma unroll
    for (int j = 0; j < 8; ++j) { const int t = tq * 8 + j;
        const float b0 = (dir ? (run0 - P0[j] + lg0[j]) : P0[j]) + off0, b1 = (dir ? (run1 - P1[j] + lg1[j]) : P1[j]) + off1;
        const float q0 = bflo(qv[j]), q1 = bfhi(qv[j]), k0 = bflo(kv[j]), k1 = bfhi(kv[j]);
        const float e0 = __expf(b0), e1 = __expf(b1), i0 = __builtin_amdgcn_rcpf(e0), i1 = __builtin_amdgcn_rcpf(e1);
        *(LAS unsigned*)(qS + t * 136 + 2 * c2) = pkbf(q0 * e0, q1 * e1);
        *(LAS unsigned*)(keS + t * 136 + 2 * c2) = pkbf(k0 * i0, k1 * i1);
        *(LAS unsigned*)(kS + t * 136 + 2 * c2) = pkbf(k0 * (dt0 * i0), k1 * (dt1 * i1)); }
    LDS_BAR();
    const int r = lane & 31, hh = lane >> 5;
    if (wave < 4) {
        const int jt = wave >> 1, it = wave & 1;
        f32x16 acc;
#pragma unroll
        for (int e = 0; e < 16; ++e) acc[e] = 0.f;
#pragma unroll
        for (int s = 0; s < 8; ++s) { const bf16x8 A = *(const LAS bf16x8*)(keS + (32 * jt + r) * 136 + 16 * s + 8 * hh); const bf16x8 B = *(const LAS bf16x8*)(qS + (32 * it + r) * 136 + 16 * s + 8 * hh); acc = mfma32(A, B, acc); }
        const int i = 32 * it + r; float v[16];
#pragma unroll
        for (int e = 0; e < 16; ++e) { const int j = 32 * jt + (e & 3) + 8 * (e >> 2) + 4 * hh; const bool keep = dir ? (j > i) : (j <= i); v[e] = keep ? acc[e] : 0.f; }
#pragma unroll
        for (int s2 = 0; s2 < 2; ++s2) { v4u o; o.x = pkbf(v[8 * s2 + 0], v[8 * s2 + 1]); o.y = pkbf(v[8 * s2 + 2], v[8 * s2 + 3]); o.z = pkbf(v[8 * s2 + 4], v[8 * s2 + 5]); o.w = pkbf(v[8 * s2 + 6], v[8 * s2 + 7]);
            *(v4u*)(ATTN + (size_t)uid * 4096 + (size_t)((it * 4 + 2 * jt + s2) * 64 + lane) * 8) = o; }
    }
#pragma unroll
    for (int e = 0; e < 2; ++e) { const int f = wave * 2 + e;
        {
            const int it = f >> 3, ks = f & 7, dt = ks >> 1, s2 = ks & 1;
            const LAS bf16* base = qS + (32 * it + r) * 136 + 32 * dt + 16 * s2 + 4 * hh;
            const v2u lo = *(const LAS v2u*)base, hi = *(const LAS v2u*)(base + 8);
            v4u o = {lo.x, lo.y, hi.x, hi.y};
            *(v4u*)(QE + (size_t)uid * 8192 + (size_t)(f * 64 + lane) * 8) = o; }
        {
            const int dt = f >> 2, ks = f & 3, dim = 32 * dt + r;
            unsigned w[4];
#pragma unroll
            for (int p2 = 0; p2 < 4; ++p2) { const int j0 = 2 * p2, j1 = 2 * p2 + 1;
                const int t0 = 16 * ks + 8 * (j0 >> 2) + 4 * hh + (j0 & 3), t1 = 16 * ks + 8 * (j1 >> 2) + 4 * hh + (j1 & 3);
                w[p2] = (unsigned)kS[t0 * 136 + dim] | ((unsigned)kS[t1 * 136 + dim] << 16); }
            v4u o = {w[0], w[1], w[2], w[3]};
            *(v4u*)(KDT + (size_t)uid * 8192 + (size_t)(f * 64 + lane) * 8) = o; }
    }
}

__device__ __forceinline__ void pool_item(int item, const bf16* __restrict__ P, bf16* __restrict__ PO) {
    const int oct = item & 127, run = item >> 7; const int m0 = run * 32, b = m0 >> 14, t0 = m0 & (SEQ - 1);
    const int g = oct >> 5, hw = 1 << g;
    const bf16* Pb = P + (size_t)b * SEQ * 1024 + oct * 8; bf16* Ob = PO + (size_t)b * SEQ * 1024 + oct * 8;
    float s[8];
#pragma unroll
    for (int e = 0; e < 8; ++e) s[e] = 0.f;
    const int lo0 = (t0 - hw > 0) ? t0 - hw : 0, hi0 = (t0 + hw < SEQ) ? t0 + hw : SEQ;
    for (int u = lo0; u < hi0; ++u) { const v4u w = *(const v4u*)(Pb + (size_t)u * 1024);
        s[0] += bflo(w.x); s[1] += bfhi(w.x); s[2] += bflo(w.y); s[3] += bfhi(w.y); s[4] += bflo(w.z); s[5] += bfhi(w.z); s[6] += bflo(w.w); s[7] += bfhi(w.w); }
    for (int t = t0; t < t0 + 32; ++t) {
        const int lo = (t - hw > 0) ? t - hw : 0, hi = (t + hw < SEQ) ? t + hw : SEQ; const float ic = 1.f / (float)(hi - lo);
        const v4u w = *(const v4u*)(Pb + (size_t)t * 1024);
        v4u o; o.x = pkbf(s[0] * ic - bflo(w.x), s[1] * ic - bfhi(w.x)); o.y = pkbf(s[2] * ic - bflo(w.y), s[3] * ic - bfhi(w.y));
        o.z = pkbf(s[4] * ic - bflo(w.z), s[5] * ic - bfhi(w.z)); o.w = pkbf(s[6] * ic - bflo(w.w), s[7] * ic - bfhi(w.w));
        *(v4u*)(Ob + (size_t)t * 1024) = o;
        if (t - hw >= 0) { const v4u x = *(const v4u*)(Pb + (size_t)(t - hw) * 1024);
            s[0] -= bflo(x.x); s[1] -= bfhi(x.x); s[2] -= bflo(x.y); s[3] -= bfhi(x.y); s[4] -= bflo(x.z); s[5] -= bfhi(x.z); s[6] -= bflo(x.w); s[7] -= bfhi(x.w); }
        if (t + hw < SEQ) { const v4u x = *(const v4u*)(Pb + (size_t)(t + hw) * 1024);
            s[0] += bflo(x.x); s[1] += bfhi(x.x); s[2] += bflo(x.y); s[3] += bfhi(x.y); s[4] += bflo(x.z); s[5] += bfhi(x.z); s[6] += bflo(x.w); s[7] += bfhi(x.w); }
    }
}

constexpr int SB_QE = 0, SB_AT = 16384, SB_KD = 24576, SB_DEC = 40960, SB_BYTES = 41472;
template <bool FULL> __device__ __forceinline__ void gla_scan_block(int su, LAS unsigned char* lds, const bf16* __restrict__ QE, const bf16* __restrict__ ATTN, const bf16* __restrict__ KDT,
                                                                    const float* __restrict__ DEC, const bf16* __restrict__ VT, float* SEGL, float* SEGD, bf16* OF, bf16* OB,
                                                                    int tid, int wave, int lane) {
    const int bhd = su / NSEG, seg = su % NSEG, dir = bhd & 1, h = (bhd >> 1) & 3, b = bhd >> 3;
    const int r = lane & 31, hh = lane >> 5, w = wave;
    f32x16 st[4];
    if (FULL) {
#pragma unroll
        for (int dt = 0; dt < 4; ++dt)
#pragma unroll
            for (int e = 0; e < 16; ++e) st[dt][e] = 0.f;
        for (int sp = 0; sp < seg; ++sp) { const int su2 = bhd * NSEG + sp;
#pragma unroll
            for (int dt = 0; dt < 4; ++dt) {
#pragma unroll
                for (int q = 0; q < 4; ++q) { const f32x4 d4 = *(const f32x4*)(SEGD + (size_t)su2 * 128 + 32 * dt + 8 * q + 4 * hh);
                    const size_t i0 = ((size_t)((su2 * 8 + w) * 4 + dt) * 16 + 4 * q) * 64 + lane;
                    st[dt][4 * q + 0] = d4.x * st[dt][4 * q + 0] + SEGL[i0]; st[dt][4 * q + 1] = d4.y * st[dt][4 * q + 1] + SEGL[i0 + 64];
                    st[dt][4 * q + 2] = d4.z * st[dt][4 * q + 2] + SEGL[i0 + 128]; st[dt][4 * q + 3] = d4.w * st[dt][4 * q + 3] + SEGL[i0 + 192]; } } }
    } else {
#pragma unroll
        for (int dt = 0; dt < 4; ++dt)
#pragma unroll
            for (int e = 0; e < 16; ++e) st[dt][e] = 0.f;
    }
    v4u sg[5]; v4u sdec; v2u vn[8]; bf16x8 vc[4];
#define SCAN_UID(i_) ({ const int sp_ = seg * CPS + (i_); const int n_ = dir ? (NCH - 1 - sp_) : sp_; (((b * NCH + n_) * 4 + h) * 2 + dir); })
#define SCAN_LOAD(i_) do { const int uid_ = SCAN_UID(i_); \
        if (FULL) { sg[0] = *(const v4u*)(QE + (size_t)uid_ * 8192 + (size_t)tid * 8); sg[1] = *(const v4u*)(QE + (size_t)uid_ * 8192 + (size_t)(tid + 512) * 8); \
                    sg[2] = *(const v4u*)(ATTN + (size_t)uid_ * 4096 + (size_t)tid * 8); } \
        sg[3] = *(const v4u*)(KDT + (size_t)uid_ * 8192 + (size_t)tid * 8); sg[4] = *(const v4u*)(KDT + (size_t)uid_ * 8192 + (size_t)(tid + 512) * 8); \
        if (tid < 32) sdec = *(const v4u*)(DEC + (size_t)uid_ * 128 + tid * 4); \
        const bf16* vb_ = VT + ((size_t)(uid_ >> 3) * 1024 + h * 256 + 32 * w + r) * 64 + 4 * hh; \
        _Pragma("unroll") for (int ks_ = 0; ks_ < 4; ++ks_) { vn[2 * ks_] = *(const v2u*)(vb_ + 16 * ks_); vn[2 * ks_ + 1] = *(const v2u*)(vb_ + 16 * ks_ + 8); } } while (0)
#define SCAN_STORE(buf_) do { LAS unsigned char* B_ = lds + (buf_) * SB_BYTES; \
        if (FULL) { *(LAS v4u*)(B_ + SB_QE + tid * 16) = sg[0]; *(LAS v4u*)(B_ + SB_QE + (tid + 512) * 16) = sg[1]; *(LAS v4u*)(B_ + SB_AT + tid * 16) = sg[2]; } \
        *(LAS v4u*)(B_ + SB_KD + tid * 16) = sg[3]; *(LAS v4u*)(B_ + SB_KD + (tid + 512) * 16) = sg[4]; \
        if (tid < 32) *(LAS v4u*)(B_ + SB_DEC + tid * 16) = sdec; \
        _Pragma("unroll") for (int ks_ = 0; ks_ < 4; ++ks_) vc[ks_] = mk8(vn[2 * ks_].x, vn[2 * ks_].y, vn[2 * ks_ + 1].x, vn[2 * ks_ + 1].y); } while (0)
    float dprod = 1.f;
    LDS_BAR();
    SCAN_LOAD(0); SCAN_STORE(0);
    LDS_BAR();
    for (int i = 0; i < CPS; ++i) {
        const bool more = (i + 1 < CPS);
        if (more) SCAN_LOAD(i + 1);
        const LAS unsigned char* B = lds + (i & 1) * SB_BYTES;
        if (FULL) {
            f32x16 o0, o1;
#pragma unroll
            for (int e = 0; e < 16; ++e) { o0[e] = 0.f; o1[e] = 0.f; }
#pragma unroll
            for (int dt = 0; dt < 4; ++dt)
#pragma unroll
                for (int s2 = 0; s2 < 2; ++s2) { const int ks = 2 * dt + s2;
                    const bf16x8 sf = mk8(pkbf(st[dt][8 * s2 + 0], st[dt][8 * s2 + 1]), pkbf(st[dt][8 * s2 + 2], st[dt][8 * s2 + 3]), pkbf(st[dt][8 * s2 + 4], st[dt][8 * s2 + 5]), pkbf(st[dt][8 * s2 + 6], st[dt][8 * s2 + 7]));
                    const bf16x8 a0 = *(const LAS bf16x8*)(B + SB_QE + ((0 * 8 + ks) * 64 + lane) * 16); const bf16x8 a1 = *(const LAS bf16x8*)(B + SB_QE + ((1 * 8 + ks) * 64 + lane) * 16);
                    o0 = mfma32(a0, sf, o0); o1 = mfma32(a1, sf, o1); }
#pragma unroll
            for (int ks = 0; ks < 4; ++ks) { const bf16x8 a0 = *(const LAS bf16x8*)(B + SB_AT + ((0 * 4 + ks) * 64 + lane) * 16); const bf16x8 a1 = *(const LAS bf16x8*)(B + SB_AT + ((1 * 4 + ks) * 64 + lane) * 16);
                o0 = mfma32(a0, vc[ks], o0); o1 = mfma32(a1, vc[ks], o1); }
            const int uid = SCAN_UID(i);
            bf16* Ob = (dir ? OB : OF) + (size_t)(uid >> 3) * 64 * 1024 + h * 256 + 32 * w + r;
#pragma unroll
            for (int e = 0; e < 16; ++e) { const int tk = (e & 3) + 8 * (e >> 2) + 4 * hh; Ob[(size_t)tk * 1024] = f2bf1(o0[e]); Ob[(size_t)(32 + tk) * 1024] = f2bf1(o1[e]); }
        }
#pragma unroll
        for (int dt = 0; dt < 4; ++dt) {
#pragma unroll
            for (int q = 0; q < 4; ++q) { const f32x4 d4 = *(const LAS f32x4*)(B + SB_DEC + (32 * dt + 8 * q + 4 * hh) * 4);
                st[dt][4 * q + 0] *= d4.x; st[dt][4 * q + 1] *= d4.y; st[dt][4 * q + 2] *= d4.z; st[dt][4 * q + 3] *= d4.w; }
#pragma unroll
            for (int ks = 0; ks < 4; ++ks) { const bf16x8 a = *(const LAS bf16x8*)(B + SB_KD + ((dt * 4 + ks) * 64 + lane) * 16); st[dt] = mfma32(a, vc[ks], st[dt]); }
        }
        if (!FULL && tid < 128) dprod *= *(const LAS float*)(B + SB_DEC + tid * 4);
        if (more) SCAN_STORE((i + 1) & 1);
        LDS_BAR();
    }
    if (!FULL) {
#pragma unroll
        for (int dt = 0; dt < 4; ++dt)
#pragma unroll
            for (int e = 0; e < 16; ++e) SEGL[((size_t)((su * 8 + w) * 4 + dt) * 16 + e) * 64 + lane] = st[dt][e];
        if (tid < 128) SEGD[(size_t)su * 128 + tid] = dprod;
    }
#undef SCAN_UID
#undef SCAN_LOAD
#undef SCAN_STORE
}
struct FinIn { v4u f0, f1, b0, b1, r0, r1; };
__device__ __forceinline__ void gla_fin_load(FinIn& in, int m, const bf16* __restrict__ OF, const bf16* __restrict__ OB, const bf16* __restrict__ R, int lane) {
    const size_t p = (size_t)m * 1024 + 16 * lane;
    in.f0 = *(const v4u*)(OF + p); in.f1 = *(const v4u*)(OF + p + 8); in.b0 = *(const v4u*)(OB + p); in.b1 = *(const v4u*)(OB + p + 8); in.r0 = *(const v4u*)(R + p); in.r1 = *(const v4u*)(R + p + 8);
}
__device__ __forceinline__ void gla_fin_row(const FinIn& in, int m, const float (&gg)[16], bf16* GO, int lane) {
    const size_t p = (size_t)m * 1024 + 16 * lane;
    const v4u f0 = in.f0, f1 = in.f1, b0 = in.b0, b1 = in.b1, r0 = in.r0, r1 = in.r1;
    float o[16], rr[16];
#define UNP(dst, w0, w1) do { dst[0] = bflo(w0.x); dst[1] = bfhi(w0.x); dst[2] = bflo(w0.y); dst[3] = bfhi(w0.y); dst[4] = bflo(w0.z); dst[5] = bfhi(w0.z); dst[6] = bflo(w0.w); dst[7] = bfhi(w0.w); \
        dst[8] = bflo(w1.x); dst[9] = bfhi(w1.x); dst[10] = bflo(w1.y); dst[11] = bfhi(w1.y); dst[12] = bflo(w1.z); dst[13] = bfhi(w1.z); dst[14] = bflo(w1.w); dst[15] = bfhi(w1.w); } while (0)
    float t[16]; UNP(o, f0, f1); UNP(t, b0, b1); UNP(rr, r0, r1);
#undef UNP
    float ss = 0.f;
#pragma unroll
    for (int e = 0; e < 16; ++e) { o[e] += t[e]; ss += o[e] * o[e]; }
    ss += __shfl_xor(ss, 1); ss += __shfl_xor(ss, 2); ss += __shfl_xor(ss, 4); ss += __shfl_xor(ss, 8);
    const float rs = rsqrtf(ss * (1.f / 256.f) + RMS_EPS);
    unsigned w[8];
#pragma unroll
    for (int e = 0; e < 8; ++e) w[e] = pkbf(o[2 * e] * rs * gg[2 * e] * rr[2 * e], o[2 * e + 1] * rs * gg[2 * e + 1] * rr[2 * e + 1]);
    v4u o0 = {w[0], w[1], w[2], w[3]}, o1 = {w[4], w[5], w[6], w[7]};
    *(v4u*)(GO + p) = o0; *(v4u*)(GO + p + 8) = o1;
}
__device__ __forceinline__ unsigned sortable(float f) { const unsigned b = __builtin_bit_cast(unsigned, f); return b ^ ((unsigned)((int)b >> 31) | 0x80000000u); }
__device__ __forceinline__ float unsortable(unsigned u) { const unsigned b = (u & 0x80000000u) ? (u ^ 0x80000000u) : ~u; return __builtin_bit_cast(float, b); }
__device__ __forceinline__ unsigned umax3(unsigned a, unsigned b, unsigned c) { return max(max(a, b), c); }
__device__ __forceinline__ void ce_desc(unsigned& a, unsigned& b) { const unsigned hi = max(a, b), lo = min(a, b); a = hi; b = lo; }
__device__ __forceinline__ void bitonic_sort16_desc(unsigned (&x)[16]) {
#pragma unroll
    for (int k = 2; k <= 16; k <<= 1)
#pragma unroll
        for (int j = k >> 1; j > 0; j >>= 1)
#pragma unroll
            for (int i = 0; i < 16; ++i) { const int l = i ^ j; if (l > i) { if ((i & k) == 0) ce_desc(x[i], x[l]); else ce_desc(x[l], x[i]); } }
}
__device__ __forceinline__ void bitonic_merge16_desc(unsigned (&x)[16]) {
#pragma unroll
    for (int j = 8; j > 0; j >>= 1)
#pragma unroll
        for (int i = 0; i < 16; ++i) { const int l = i ^ j; if (l > i) ce_desc(x[i], x[l]); }
}
__device__ __forceinline__ void topmerge16(unsigned (&a)[16], const unsigned (&b)[16]) {
#pragma unroll
    for (int i = 0; i < 16; ++i) a[i] = max(a[i], b[15 - i]);
    bitonic_merge16_desc(a);
}
__device__ __forceinline__ void peer_half_topk(int p, int h, const LAS unsigned char* sk, const bf16* __restrict__ PQ, size_t tok, int lane, unsigned (&Lp)[16]) {
    const int hh = lane >> 5;
    const bf16* qp = PQ + tok * 2048 + h * 256 + p * 128 + 8 * hh;
    bf16x8 bq[8];
#pragma unroll
    for (int s = 0; s < 8; ++s) bq[s] = *(const bf16x8*)(qp + 16 * s);
    unsigned key[64];
#pragma unroll
    for (int nt = 0; nt < 4; ++nt) { f32x16 sc;
#pragma unroll
        for (int e = 0; e < 16; ++e) sc[e] = 0.f;
#pragma unroll
        for (int s = 0; s < 8; ++s) { const bf16x8 a = *(const LAS bf16x8*)(sk + (((p * 4 + nt) * 8 + s) * 64 + lane) * 16); sc = mfma32(a, bq[s], sc); }
#pragma unroll
        for (int e = 0; e < 16; ++e) { const int n = 32 * nt + (e & 3) + 8 * (e >> 2) + 4 * hh; key[nt * 16 + e] = (sortable(sc[e]) & ~127u) | (unsigned)(127 - n); } }
    unsigned g0[16], g1[16], g2[16], g3[16];
#pragma unroll
    for (int e = 0; e < 16; ++e) { g0[e] = key[e]; g1[e] = key[16 + e]; g2[e] = key[32 + e]; g3[e] = key[48 + e]; }
    bitonic_sort16_desc(g0); bitonic_sort16_desc(g1); bitonic_sort16_desc(g2); bitonic_sort16_desc(g3);
    topmerge16(g0, g1); topmerge16(g2, g3); topmerge16(g0, g2);
#pragma unroll
    for (int e = 0; e < 16; ++e) g1[e] = (unsigned)__shfl_xor((int)g0[e], 32);
    topmerge16(g0, g1);
#pragma unroll
    for (int e = 0; e < 16; ++e) Lp[e] = g0[e];
}
__device__ __forceinline__ void peer_topk_item(int tile, int h, const LAS unsigned char* sk  , const bf16* __restrict__ PQ, unsigned short* IDX, float* GATE, int lane) {
    const int r = lane & 31, hh = lane >> 5; const size_t tok = (size_t)tile * 32 + r;
    unsigned L[2][16];
    peer_half_topk(0, h, sk, PQ, tok, lane, L[0]);
    __builtin_amdgcn_sched_barrier(0);
#pragma unroll
    for (int a = 0; a < 16; ++a) asm volatile("" : "+v"(L[0][a]));
    peer_half_topk(1, h, sk, PQ, tok, lane, L[1]);
    __builtin_amdgcn_sched_barrier(0);
#pragma unroll
    for (int a = 0; a < 16; ++a) asm volatile("" : "+v"(L[1][a]));
    float v0[16], v1[16];
#pragma unroll
    for (int a = 0; a < 16; ++a) { v0[a] = unsortable(L[0][a] & ~127u); v1[a] = unsortable(L[1][a] & ~127u); }
#define CKEY(a_, b_) ((sortable(v0[a_] + v1[b_]) & ~255u) | (unsigned)(255 - ((a_) * 16 + (b_))))
    unsigned R[16], T[16];
#pragma unroll
    for (int b2 = 0; b2 < 16; ++b2) R[b2] = CKEY(0, b2);
#define ROWMERGE(a_, n_) do { _Pragma("unroll") for (int b2 = 0; b2 < 16; ++b2) T[b2] = (b2 < (n_)) ? CKEY(a_, (b2 < (n_) ? b2 : 0)) : 0u; topmerge16(R, T); } while (0)
    ROWMERGE(1, 8); ROWMERGE(2, 5); ROWMERGE(3, 4); ROWMERGE(4, 3); ROWMERGE(5, 2); ROWMERGE(6, 2); ROWMERGE(7, 2);
#pragma unroll
    for (int b2 = 0; b2 < 16; ++b2) T[b2] = (b2 < 8) ? CKEY((b2 < 8 ? 8 + b2 : 8), 0) : 0u;
    topmerge16(R, T);
#undef ROWMERGE
#undef CKEY
    unsigned bk[16];
#pragma unroll
    for (int rd = 0; rd < 16; ++rd) bk[rd] = R[rd];
    float gs[16]; unsigned ex[16]; float Z = 0.f; const float s0 = unsortable(bk[0] & ~255u);
#pragma unroll
    for (int k = 0; k < 16; ++k) { const unsigned flat = 255u - (bk[k] & 255u), a = flat >> 4, b2 = flat & 15u;
        unsigned k1 = 0u, k2 = 0u;
#pragma unroll
        for (int a2 = 0; a2 < 16; ++a2) { k1 = (a == (unsigned)a2) ? L[0][a2] : k1; k2 = (b2 == (unsigned)a2) ? L[1][a2] : k2; }
        ex[k] = (127u - (k1 & 127u)) * 128u + (127u - (k2 & 127u));
        gs[k] = __expf(unsortable(bk[k] & ~255u) - s0); Z += gs[k]; }
    const float iz = 1.f / Z;
    if (hh == 0) {
        unsigned short* ip = IDX + (tok * 8 + h) * 16; float* gp = GATE + (tok * 8 + h) * 16;
        v4u i0 = {ex[0] | (ex[1] << 16), ex[2] | (ex[3] << 16), ex[4] | (ex[5] << 16), ex[6] | (ex[7] << 16)}, i1 = {ex[8] | (ex[9] << 16), ex[10] | (ex[11] << 16), ex[12] | (ex[13] << 16), ex[14] | (ex[15] << 16)};
        *(v4u*)ip = i0; *(v4u*)(ip + 8) = i1;
#pragma unroll
        for (int q = 0; q < 4; ++q) { f32x4 o = {gs[4 * q] * iz, gs[4 * q + 1] * iz, gs[4 * q + 2] * iz, gs[4 * q + 3] * iz}; *(f32x4*)(gp + 4 * q) = o; }
    }
}

__device__ __forceinline__ f32x2 dot16_fp8(const v4u w, const f32x2* hv2, f32x2 s) {
#pragma unroll
    for (int d = 0; d < 4; ++d) { const f32x2 lo = __builtin_amdgcn_cvt_pk_f32_fp8((int)w[d], false), hi = __builtin_amdgcn_cvt_pk_f32_fp8((int)w[d], true);
        s = __builtin_elementwise_fma(lo, hv2[2 * d], s); s = __builtin_elementwise_fma(hi, hv2[2 * d + 1], s); }
    return s;
}
__device__ __forceinline__ float dot16_fp8_bf(const v4u w, const v4u h0, const v4u h1) {
    const unsigned hx[8] = {h0.x, h0.y, h0.z, h0.w, h1.x, h1.y, h1.z, h1.w};
    float s = 0.f;
#pragma unroll
    for (int d = 0; d < 4; ++d) { const pg8::bf16x2_t lo = __builtin_amdgcn_cvt_scalef32_pk_bf16_fp8((int)w[d], 1.0f, false), hi = __builtin_amdgcn_cvt_scalef32_pk_bf16_fp8((int)w[d], 1.0f, true);
        s = __builtin_amdgcn_fdot2_f32_bf16(lo, __builtin_bit_cast(pg8::bf16x2_t, hx[2 * d]), s, false); s = __builtin_amdgcn_fdot2_f32_bf16(hi, __builtin_bit_cast(pg8::bf16x2_t, hx[2 * d + 1]), s, false); }
    return s;
}
__device__ __forceinline__ void axpy16_fp8(const v4u w, const f32x2 a2, f32x2* acc2) {
#pragma unroll
    for (int d = 0; d < 4; ++d) { const f32x2 lo = __builtin_amdgcn_cvt_pk_f32_fp8((int)w[d], false), hi = __builtin_amdgcn_cvt_pk_f32_fp8((int)w[d], true);
        acc2[2 * d] = __builtin_elementwise_fma(lo, a2, acc2[2 * d]); acc2[2 * d + 1] = __builtin_elementwise_fma(hi, a2, acc2[2 * d + 1]); }
}
__device__ __forceinline__ float gelu_erf(float x) { return 0.5f * x * (1.f + erff(x * 0.70710678118654752f)); }
template <int CTRL> __device__ __forceinline__ float dppf(float v) { return __builtin_bit_cast(float, __builtin_amdgcn_update_dpp(0, __builtin_bit_cast(int, v), CTRL, 0xF, 0xF, true)); }
__device__ __forceinline__ void swap32(float& a, float& b) { asm("s_nop 1\n\tv_permlane32_swap_b32 %0, %1" : "+v"(a), "+v"(b)); }
__device__ __forceinline__ void swap16(float& a, float& b) { asm("s_nop 1\n\tv_permlane16_swap_b32 %0, %1" : "+v"(a), "+v"(b)); }
__device__ __forceinline__ float wave_sum_valu(float v) {
    v += dppf<0xB1>(v); v += dppf<0x4E>(v); v += dppf<0x141>(v); v += dppf<0x140>(v);
    float a = v, b = v; swap16(a, b); v = a + b; a = v; b = v; swap32(a, b); return a + b;
}
__device__ __forceinline__ float sum8(float v) { v += dppf<0xB1>(v); v += dppf<0x4E>(v); v += dppf<0x141>(v); return v; }
struct PMeta { v4u ia, ib, o0, o1, o2, o3; f32x2 x1; };
__device__ __forceinline__ void peer_meta(PMeta& m, size_t tok, const unsigned short* __restrict__ IDX, int g) {
    m.ia = *(const v4u*)(IDX + tok * 128 + g * 16); m.ib = *(const v4u*)(IDX + tok * 128 + g * 16 + 8);
}
template <bool VP> __device__ __forceinline__ void peer_issue(PMeta& m, v4u (&w)[16], const unsigned char* __restrict__ tb, size_t tok, int sl, const bf16* __restrict__ XB, const float* __restrict__ ACT, const float* X, int g, int i, int c) {
    const unsigned iw[8] = {m.ia.x, m.ia.y, m.ia.z, m.ia.w, m.ib.x, m.ib.y, m.ib.z, m.ib.w};
#pragma unroll
    for (int q = 0; q < 16; ++q) { const unsigned e = (iw[q >> 1] >> (16 * (q & 1))) & 0xffffu; w[q] = *(const v4u*)(tb + (size_t)e * 128); }
    if (VP) { const v4u* ap = (const v4u*)(ACT + tok * 128 + g * 16); m.o0 = ap[0]; m.o1 = ap[1]; m.o2 = ap[2]; m.o3 = ap[3]; m.x1 = *(const f32x2*)(X + tok * 2048 + c); }
    else { const bf16* hp = XB + tok * 2048 + sl * 128 + 16 * i; m.o0 = *(const v4u*)hp; m.o1 = *(const v4u*)(hp + 8); }
}
__device__ __forceinline__ void peer_u_compute(const PMeta& m, const v4u (&w)[16], size_t tok, int label, int sub, float* PART, int g, int i) {
    const v4u h0 = m.o0, h1 = m.o1;
    float v[16];
#pragma unroll
    for (int q = 0; q < 16; ++q) v[q] = dot16_fp8_bf(w[q], h0, h1);
    const bool up1 = (i & 4) != 0, up2 = (i & 2) != 0, up3 = (i & 1) != 0;
    float a[8], b[4], c[2];
#pragma unroll
    for (int k = 0; k < 8; ++k) { const float send = up1 ? v[k] : v[k + 8], keep = up1 ? v[k + 8] : v[k]; a[k] = keep + dppf<0x141>(send); }
#pragma unroll
    for (int k = 0; k < 4; ++k) { const float send = up2 ? a[k] : a[k + 4], keep = up2 ? a[k + 4] : a[k]; b[k] = keep + dppf<0x4E>(send); }
#pragma unroll
    for (int k = 0; k < 2; ++k) { const float send = up3 ? b[k] : b[k + 2], keep = up3 ? b[k + 2] : b[k]; c[k] = keep + dppf<0xB1>(send); }
    *(unsigned*)((bf16*)PART + ((size_t)(2 * label + sub) * M + tok) * 128 + g * 16 + 2 * i) = pkbf(c[0], c[1]);
}
template <bool VP> __device__ __forceinline__ void peer_slice_loop(int sl, int label, int sub, int tok0, int tstep, const bf16* __restrict__ XB, const float* __restrict__ ACT, const unsigned short* __restrict__ IDX,
                                                                   const unsigned char* __restrict__ TAB, float* PART, float* X, bf16* XBn, const float* __restrict__ gn, float* ssn, int lane) {
    const int g = lane >> 3, i = lane & 7;
    const int j = ((lane >> 5) & 1) * 4 + ((lane >> 4) & 1) * 2 + ((lane >> 3) & 1), c = sl * 128 + 16 * i + 2 * j;
    const unsigned char* tb = TAB + (size_t)sl * (16384 * 128) + 16 * i;
    f32x2 gg = {0.f, 0.f}; if (VP) gg = *(const f32x2*)(gn + c);
    if (tok0 >= M) return;
    const int NT = (M - tok0 + tstep - 1) / tstep;
#define PS_TOK(k_) ((size_t)(tok0 + ((k_) < NT ? (k_) : NT - 1) * tstep))
    PMeta mA, mB, mN; v4u wA[16], wB[16];
    peer_meta(mA, PS_TOK(0), IDX, g); peer_meta(mB, PS_TOK(1), IDX, g);
    asm volatile("" : "+v"(mB.ia), "+v"(mB.ib));
    peer_issue<VP>(mA, wA, tb, PS_TOK(0), sl, XB, ACT, X, g, i, c);
    int k = 0;
    for (; k + 1 < NT; k += 2) {
        peer_meta(mN, PS_TOK(k + 2), IDX, g);
        asm volatile("" ::: "memory");
        peer_issue<VP>(mB, wB, tb, PS_TOK(k + 1), sl, XB, ACT, X, g, i, c);
        asm volatile("" ::: "memory");
        peer_u_compute(mA, wA, PS_TOK(k), label, sub, PART, g, i);
        asm volatile("" ::: "memory");
        mA.ia = mN.ia; mA.ib = mN.ib;
        peer_meta(mN, PS_TOK(k + 3), IDX, g);
        asm volatile("" ::: "memory");
        peer_issue<VP>(mA, wA, tb, PS_TOK(k + 2), sl, XB, ACT, X, g, i, c);
        asm volatile("" ::: "memory");
        peer_u_compute(mB, wB, PS_TOK(k + 1), label, sub, PART, g, i);
        asm volatile("" ::: "memory");
        mB.ia = mN.ia; mB.ib = mN.ib;
    }
    if (k < NT) { peer_u_compute(mA, wA, PS_TOK(k), label, sub, PART, g, i); }
#undef PS_TOK
}
__device__ __forceinline__ void peer_combine_row(size_t tok, const float* __restrict__ PART, const unsigned short* __restrict__ IDX, const float* __restrict__ GATE, const float* __restrict__ USC, const float* __restrict__ VSC,
                                                 const float* __restrict__ ss, float* ACT, int lane) {
    float sv = ss[(tok + (lane >> 5)) * 32 + (lane & 31)];
    sv += __shfl_xor(sv, 1); sv += __shfl_xor(sv, 2); sv += __shfl_xor(sv, 4); sv += __shfl_xor(sv, 8); sv += __shfl_xor(sv, 16);
    const float rsv = rsqrtf(sv * (1.f / 2048.f) + RMS_EPS);
    const float rs[2] = {__shfl(rsv, 0), __shfl(rsv, 32)};
    f32x2 sum[2]; unsigned ew[2]; f32x2 gt[2]; unsigned pv[2][16];
#pragma unroll
    for (int t = 0; t < 2; ++t) { const size_t p = (tok + t) * 128 + 2 * lane;
        ew[t] = *(const unsigned*)(IDX + p); gt[t] = *(const f32x2*)(GATE + p);
#pragma unroll
        for (int lab = 0; lab < 16; ++lab) pv[t][lab] = *(const unsigned*)((const bf16*)PART + (size_t)lab * M * 128 + p); }
#pragma unroll
    for (int t = 0; t < 2; ++t) { sum[t] = (f32x2){0.f, 0.f};
#pragma unroll
        for (int lab = 0; lab < 16; ++lab) sum[t] = sum[t] + (f32x2){bflo(pv[t][lab]), bfhi(pv[t][lab])}; }
#pragma unroll
    for (int t = 0; t < 2; ++t) { const size_t p = (tok + t) * 128 + 2 * lane; const int e0 = ew[t] & 0xffff, e1 = ew[t] >> 16;
        *(unsigned*)((bf16*)ACT + p) = pkbf(gelu_erf(sum[t].x * rs[t] * USC[e0]) * gt[t].x * VSC[e0], gelu_erf(sum[t].y * rs[t] * USC[e1]) * gt[t].y * VSC[e1]); }
}
struct VMeta { v4u ia, ib; v4u a0, a1; f32x2 x1; };
__device__ __forceinline__ void peer_v_idx(VMeta& m, size_t tok, const unsigned short* __restrict__ IDX, int g) { m.ia = *(const v4u*)(IDX + tok * 128 + g * 16); m.ib = *(const v4u*)(IDX + tok * 128 + g * 16 + 8); }
__device__ __forceinline__ void peer_v_issue(VMeta& m, v4u (&w)[16], const unsigned char* __restrict__ vb, size_t tok, const float* __restrict__ ACT, const bf16* XB1, int g, int c) {
    const unsigned iw[8] = {m.ia.x, m.ia.y, m.ia.z, m.ia.w, m.ib.x, m.ib.y, m.ib.z, m.ib.w};
#pragma unroll
    for (int q = 0; q < 16; ++q) { const unsigned e = (iw[q >> 1] >> (16 * (q & 1))) & 0xffffu; w[q] = *(const v4u*)(vb + (size_t)e * 128); }
    const v4u* ap = (const v4u*)((const bf16*)ACT + tok * 128 + g * 16); m.a0 = ap[0]; m.a1 = ap[1];
    { const unsigned xw = *(const unsigned*)(XB1 + tok * 2048 + c); m.x1 = (f32x2){bflo(xw), bfhi(xw)}; }
}
template <bool WB> __device__ __forceinline__ void peer_v_fin(const VMeta& m, const v4u (&w)[16], size_t tok, int sl, float* X, bf16* XBn, const f32x2 gg, float* ssn, int lane, int c) {
    const v4u a0 = m.a0, a1 = m.a1;
    const float av[16] = {bflo(a0.x), bfhi(a0.x), bflo(a0.y), bfhi(a0.y), bflo(a0.z), bfhi(a0.z), bflo(a0.w), bfhi(a0.w), bflo(a1.x), bfhi(a1.x), bflo(a1.y), bfhi(a1.y), bflo(a1.z), bfhi(a1.z), bflo(a1.w), bfhi(a1.w)};
    f32x2 acc2[8];
#pragma unroll
    for (int k = 0; k < 8; ++k) acc2[k] = (f32x2){0.f, 0.f};
#pragma unroll
    for (int q = 0; q < 16; ++q) { const f32x2 a2v = {av[q], av[q]}; axpy16_fp8(w[q], a2v, acc2); }
#pragma unroll
    for (int k = 0; k < 4; ++k) { float x0 = acc2[k].x, y0 = acc2[k + 4].x, x1 = acc2[k].y, y1 = acc2[k + 4].y; swap32(x0, y0); swap32(x1, y1); acc2[k] = (f32x2){x0 + y0, x1 + y1}; }
#pragma unroll
    for (int k = 0; k < 2; ++k) { float x0 = acc2[k].x, y0 = acc2[k + 2].x, x1 = acc2[k].y, y1 = acc2[k + 2].y; swap16(x0, y0); swap16(x1, y1); acc2[k] = (f32x2){x0 + y0, x1 + y1}; }
    { const bool up = (lane & 8) != 0; const f32x2 send = up ? acc2[0] : acc2[1], keep = up ? acc2[1] : acc2[0];
        acc2[0] = (f32x2){keep.x + dppf<0x128>(send.x), keep.y + dppf<0x128>(send.y)}; }
    const f32x2 x2 = {m.x1.x + acc2[0].x, m.x1.y + acc2[0].y};
    *(f32x2*)(X + tok * 2048 + c) = x2;
    if (WB) *(unsigned*)(XBn + tok * 2048 + c) = pkbf(x2.x * gg.x, x2.y * gg.y);
    const float sq = wave_sum_valu(x2.x * x2.x + x2.y * x2.y);
    ssn[tok * 16 + sl] = sq;
}
template <bool WB> __device__ __forceinline__ void peer_v_loop(int sl, int tok0, int tstep, const float* __restrict__ ACT, const unsigned short* __restrict__ IDX, const unsigned char* __restrict__ V8, float* X, bf16* XBn, const float* __restrict__ gn, float* ssn, int lane) {
    const int g = lane >> 3, i = lane & 7;
    const int j = ((lane >> 5) & 1) * 4 + ((lane >> 4) & 1) * 2 + ((lane >> 3) & 1), c = sl * 128 + 16 * i + 2 * j;
    const unsigned char* vb = V8 + (size_t)sl * (16384 * 128) + 16 * i;
    const f32x2 gg = *(const f32x2*)(gn + c);
    if (tok0 >= M) return;
    const int NT = (M - tok0 + tstep - 1) / tstep;
#define PS_TOK(k_) ((size_t)(tok0 + ((k_) < NT ? (k_) : NT - 1) * tstep))
    VMeta mA, mB, mN; v4u wA[16], wB[16];
    peer_v_idx(mA, PS_TOK(0), IDX, g); peer_v_idx(mB, PS_TOK(1), IDX, g);
    asm volatile("" : "+v"(mB.ia), "+v"(mB.ib));
    peer_v_issue(mA, wA, vb, PS_TOK(0), ACT, XBn, g, c);
    int k = 0;
    for (; k + 1 < NT; k += 2) {
        peer_v_idx(mN, PS_TOK(k + 2), IDX, g);
        asm volatile("" ::: "memory");
        peer_v_issue(mB, wB, vb, PS_TOK(k + 1), ACT, XBn, g, c);
        asm volatile("" ::: "memory");
        peer_v_fin<WB>(mA, wA, PS_TOK(k), sl, X, XBn, gg, ssn, lane, c);
        asm volatile("" ::: "memory");
        mA.ia = mN.ia; mA.ib = mN.ib;
        peer_v_idx(mN, PS_TOK(k + 3), IDX, g);
        asm volatile("" ::: "memory");
        peer_v_issue(mA, wA, vb, PS_TOK(k + 2), ACT, XBn, g, c);
        asm volatile("" ::: "memory");
        peer_v_fin<WB>(mB, wB, PS_TOK(k + 1), sl, X, XBn, gg, ssn, lane, c);
        asm volatile("" ::: "memory");
        mB.ia = mN.ia; mB.ib = mN.ib;
    }
    if (k < NT) peer_v_fin<WB>(mA, wA, PS_TOK(k), sl, X, XBn, gg, ssn, lane, c);
#undef PS_TOK
}
__device__ __forceinline__ void final_norm_row(float* xrow, const float* __restrict__ g, const float* __restrict__ ssp, int lane) {
    const float rs = rsqrtf(wave_sum(lane < 16 ? ssp[lane] : 0.f) * (1.f / 2048.f) + RMS_EPS);
    f32x4* xr = (f32x4*)xrow + lane; const f32x4* gr = (const f32x4*)g + lane;
    f32x4 v[8], gg[8];
#pragma unroll
    for (int jj = 0; jj < 8; ++jj) { v[jj] = xr[64 * jj]; gg[jj] = gr[64 * jj]; }
#pragma unroll
    for (int jj = 0; jj < 8; ++jj) xr[64 * jj] = (f32x4){v[jj].x * rs * gg[jj].x, v[jj].y * rs * gg[jj].y, v[jj].z * rs * gg[jj].z, v[jj].w * rs * gg[jj].w};
}

__device__ __forceinline__ void afb_unit(int unit, const bf16* __restrict__ H, const bf16* __restrict__ Waf, float* AFBo, const float* __restrict__ ss, int lane) {
    const int fr = lane & 15, kq = lane >> 4, row0 = unit * 16;
    const bf16* ap = H + (size_t)(row0 + fr) * 2048 + 8 * kq; const bf16* bp = Waf + (size_t)fr * 2048 + 8 * kq;
    f32x4 c0 = {0.f, 0.f, 0.f, 0.f}, c1 = {0.f, 0.f, 0.f, 0.f};
#pragma unroll 1
    for (int s0 = 0; s0 < 64; s0 += 8) {
        bf16x8 Av[8], Bv[8], Cv[8];
#pragma unroll
        for (int q = 0; q < 8; ++q) { Av[q] = *(const bf16x8*)(ap + 32 * (s0 + q)); Bv[q] = *(const bf16x8*)(bp + 32 * (s0 + q)); Cv[q] = *(const bf16x8*)(bp + 16 * 2048 + 32 * (s0 + q)); }
        asm volatile("" : "+v"(Av[0]), "+v"(Bv[0]), "+v"(Cv[0]), "+v"(Av[7]), "+v"(Bv[7]), "+v"(Cv[7]));
#pragma unroll
        for (int q = 0; q < 8; ++q) { c0 = __builtin_amdgcn_mfma_f32_16x16x32_bf16(Av[q], Bv[q], c0, 0, 0, 0); c1 = __builtin_amdgcn_mfma_f32_16x16x32_bf16(Av[q], Cv[q], c1, 0, 0, 0); }
    }
    const float mine = ss ? pg8::row_rs<16>(ss, row0 + fr) : 1.f;
#pragma unroll
    for (int e = 0; e < 4; ++e) { const int rr = 4 * kq + e; const float sc = __shfl(mine, rr); float* o = AFBo + (size_t)(row0 + rr) * 32 + fr; o[0] = c0[e] * sc; o[16] = c1[e] * sc; }
}
__device__ __forceinline__ const float* gin(const float* p) { const GAS float* g = (const GAS float*)p; asm volatile("" : "+s"(g)); return (const float*)g; }
#ifndef MK_MULTI
#define MK_MULTI 0
#endif
struct Args { const float* in[19]; float* out; unsigned char* ws; int ph_lo, ph_hi, l_lo, l_hi; };
__global__ void __launch_bounds__(NWAVES * 64, 2) fwd_kernel(Args args) {
    extern __shared__ __attribute__((aligned(16))) unsigned char lds[];
    LAS unsigned char* ldsL = (LAS unsigned char*)lds;
    volatile LAS unsigned* MISC = (volatile LAS unsigned*)(ldsL + MISC_OFF);
    const int tid0 = threadIdx.x, wave = __builtin_amdgcn_readfirstlane(tid0 >> 6);
#define PHASE_IDS() int tid = threadIdx.x; asm volatile("" : "+v"(tid)); const int lane = tid & 63; (void)lane; GAS unsigned char* wsp0 = (GAS unsigned char*)args.ws; asm volatile("" : "+s"(wsp0)); unsigned char* wsp = (unsigned char*)wsp0; GAS float* outp0 = (GAS float*)args.out; asm volatile("" : "+s"(outp0)); float* outp = (float*)outp0; int lp = l; asm volatile("" : "+s"(lp)); (void)wsp; (void)outp; (void)lp
    const int G = gridDim.x; const int bx = blockIdx.x; const int vcu = (G % 8 == 0) ? (bx % 8) * (G / 8) + bx / 8 : bx;
    const int gw = vcu * NWAVES + wave, NGW = G * NWAVES;
    unsigned char* ws = args.ws;
    gu32* ctl = (gu32*)(ws + WS_CTL);
    for (int u = tid0; u < (LDS_BYTES - LDSCTL_OFF) / 4; u += NWAVES * 64) ((LAS unsigned*)(ldsL + LDSCTL_OFF))[u] = 0u;
    __syncthreads();
    XcdBarrier bar; bar.bar = (unsigned*)(ctl + CW_BAR); bar.x = 0; bar.st = nullptr;
    if (!MK_MULTI) bar = xcd_barrier_post((unsigned*)(ctl + CW_BAR), MISC + 8);
#define GRID_BAR() do { if (!MK_MULTI) xcd_barrier(bar); } while (0)
    const int lo = args.ph_lo, hi = args.ph_hi;
#ifdef PH_ONLY
#define IN(k) ((k) == PH_ONLY && lo <= (k) && (k) < hi)
#else
#define IN(k) (lo <= (k) && (k) < hi)
#endif
#define BOTH(k) (IN(k) && IN((k) + 1))
#ifndef DUP_MASK
#define DUP_MASK 0
#endif
#define NREP(k) ((((DUP_MASK) >> (k)) & 1) && l == 0 ? 2 : 1)

#define WIN ((bf16*)(wsp + WS_WIN))
#define WUPG ((bf16*)(wsp + WS_WUPG))
#define WUPP ((bf16*)(wsp + WS_WUPP))
#define WOUT ((bf16*)(wsp + WS_WOUT))
#define WQ ((bf16*)(wsp + WS_WQ))
#define POOLW ((bf16*)(wsp + WS_POOLW))
#define SUBK ((bf16*)(wsp + WS_SUBK))
#define Hb ((bf16*)(wsp + WS_H))
#define POOLED ((bf16*)(wsp + WS_POOLED))
#define POOLMIX ((bf16*)(wsp + WS_POOLMIX))
#define QK ((bf16*)(wsp + WS_QK))
#define Pb ((bf16*)(wsp + WS_P))
#define OFb ((bf16*)(wsp + WS_QK))
#define OBb ((bf16*)(wsp + WS_P))
#define VT ((bf16*)(wsp + WS_VT))
#define Rb ((bf16*)(wsp + WS_R))
#define MERGED ((bf16*)(wsp + WS_MERGED))
#define Gb ((bf16*)(wsp + WS_G))
#define PQ ((bf16*)(wsp + WS_PQ))
#define QE ((bf16*)(wsp + WS_QE))
#define GLAOUT ((bf16*)(wsp + WS_GLAOUT))
#define KDT ((bf16*)(wsp + WS_KDT))
#define ATTN ((bf16*)(wsp + WS_ATTN))
#define USC ((float*)(wsp + WS_USC))
#define VSC ((float*)(wsp + WS_VSC))
#define UTAB (wsp + WS_UTAB)
#define VTAB (wsp + WS_VTAB)
#define SEGL ((float*)(wsp + WS_SEGL))
#define SIN ((float*)(wsp + WS_SIN))
#define IDX ((unsigned short*)(wsp + WS_IDX))
#define GATE ((float*)(wsp + WS_GATE))
#define AFB ((float*)(wsp + WS_AFB))
#define DEC ((float*)(wsp + WS_DEC))
#define SSP1 ((float*)(wsp + WS_SSP1))
#define SSP2 ((float*)(wsp + WS_SSP2))
#define PART ((float*)(wsp + WS_QK))
#define ACT ((float*)(wsp + WS_QE))
#define GIN(k_) gin(args.in[k_])
#define x_in ((lp == 0) ? GIN(0) : (const float*)outp)
#define w_in (GIN(2) + (size_t)lp * D * DIN)
#define ssin ((lp == 0) ? (const float*)nullptr : (const float*)SSP2)
#define ss1 SSP1
#define ss2 SSP2
    for (int l = args.l_lo; l < args.l_hi; ++l) {
        if (IN(0)) { PHASE_IDS(); for (int rep = 0; rep < NREP(0); ++rep) {
            LAS float* scr = (LAS float*)(ldsL + wave * 16384);
            { const float* sk = GIN(15) + (size_t)lp * 262144;
              const float* w_upg = GIN(8) + (size_t)lp * 1024 * 2048; const float* w_upp = GIN(11) + (size_t)lp * 1024 * 2048; const float* w_o = GIN(12) + (size_t)lp * 2048 * 2048; const float* w_q = GIN(14) + (size_t)lp * 2048 * 2048;
              const float* w_pool = GIN(9) + (size_t)lp * 4 * 65536;
              constexpr int I_IN = 32 * 257, I_UP = 16 * 64, I_SQ = 32 * 64, I_PL = 4 * 32, I_SK = 512;
              constexpr int E_IN = I_IN, E_UPG = E_IN + I_UP, E_UPP = E_UPG + I_UP, E_O = E_UPP + I_SQ, E_Q = E_O + I_SQ, E_PL = E_Q + I_PL, E_ALL = E_PL + I_SK;
              for (int it0 = gw; it0 < E_ALL; it0 += NGW) { int it = it0;
                if (it < E_IN) { const int kb = it / 257, nb = it % 257, n0 = nb * 32;
                    int d; if (n0 < 1024) d = n0; else if (n0 < 2048) d = n0 + 6400; else if (n0 < 3072) d = n0 - 1024; else if (n0 == 3072) d = 7168; else d = n0 - 1056;
                    transpose_item(w_in, DIN, WIN, 2048, d, kb * 64, n0, scr, lane); }
                else if (it < E_UPG) { it -= E_IN;  transpose_item(w_upg, 2048, WUPG, 1024, (it % 64) * 32, (it / 64) * 64, (it % 64) * 32, scr, lane); }
                else if (it < E_UPP) { it -= E_UPG; transpose_item(w_upp, 2048, WUPP, 1024, (it % 64) * 32, (it / 64) * 64, (it % 64) * 32, scr, lane); }
                else if (it < E_O)   { it -= E_UPP; transpose_item(w_o, 2048, WOUT, 2048, (it % 64) * 32, (it / 64) * 64, (it % 64) * 32, scr, lane); }
                else if (it < E_Q)   { it -= E_O;   transpose_item(w_q, 2048, WQ, 2048, (it % 64) * 32, (it / 64) * 64, (it % 64) * 32, scr, lane, GIN(13) + (size_t)lp * D); }
                else if (it < E_PL)  { it -= E_Q; const int g = it >> 5, r5 = it & 31; transpose_item(w_pool + (size_t)g * 65536, 256, POOLW + (size_t)g * 65536, 256, (r5 % 8) * 32, (r5 / 8) * 64, (r5 % 8) * 32, scr, lane); }
                else { const int f = it - E_PL; const int hp = f >> 5, nt = (f >> 3) & 3, s5 = f & 7, r = lane & 31, hh = lane >> 5;
                    const float* src = sk + ((size_t)hp * 128 + 32 * nt + r) * 128 + 16 * s5 + 8 * hh; const f32x4 a = *(const f32x4*)src, b = *(const f32x4*)(src + 4);
                    v4u o = {pkbf(a.x, a.y), pkbf(a.z, a.w), pkbf(b.x, b.y), pkbf(b.z, b.w)}; *(v4u*)(SUBK + ((size_t)f * 64 + lane) * 8) = o; } } }
            { const float* ut = GIN(16) + (size_t)lp * 16384 * 2048; const float* vt = GIN(17) + (size_t)lp * 16384 * 2048;
              for (int row = gw; row < 16384; row += NGW) { if (row < 8192)
                table_rows_fp8(ut, (unsigned*)UTAB, USC, row, row + 8192, lane, GIN(13) + (size_t)lp * D); else table_rows_fp8(vt, (unsigned*)VTAB, VSC, row - 8192, row, lane); } }
            if (lp == 0) for (int m = gw; m < M; m += NGW) rmsnorm_row(x_in + (size_t)m * D, GIN(1), Hb + (size_t)m * D, lane);
            if (rep + 1 < NREP(0)) GRID_BAR(); }
            if (BOTH(0)) GRID_BAR();
        }
        if (IN(1)) { PHASE_IDS(); for (int rep = 0; rep < NREP(1); ++rep) {
            { pg8::Gemm g{Hb, WIN, M, 7168, 2048, 2048, 2048, 0, nullptr, nullptr}; pg8::StaticOrder S; S.init(M, 7168, G, bx);
              pg8::EpiProj E{QK, Rb, Pb, Gb, AFB, ssin};
              pg8::gemm_phase<pg8::EpiProj, pg8::StaticOrder, true, true>(ldsL, g, S, E); }
            { pg8::Gemm g{WIN + (size_t)7424 * 2048, Hb, 1024, M, 2048, 2048, 2048, 0, nullptr, nullptr}; pg8::StaticOrder S; S.init(1024, M, G, bx);
              pg8::EpiVT E{VT, ssin};
              pg8::gemm_phase<pg8::EpiVT, pg8::StaticOrder, true, true>(ldsL, g, S, E); }
            for (int unit = gw; unit < M / 16; unit += NGW) afb_unit(unit, Hb, WIN + (size_t)7168 * 2048, AFB, ssin, lane);
            if (rep + 1 < NREP(1)) GRID_BAR(); }
            if (BOTH(1)) GRID_BAR();
        }
        if (IN(2)) { PHASE_IDS(); for (int rep = 0; rep < NREP(2); ++rep) {
            if (vcu < 4096) { PrepIn pin; gla_prep_load(pin, vcu, QK, AFB, GIN(3) + (size_t)lp * 8192, GIN(4) + (size_t)lp * 512, GIN(5) + (size_t)lp * 8192, GIN(6) + (size_t)lp * 512, tid);
                __syncthreads();
                int pb = 0;
                for (int uid = vcu; uid < 4096; uid += G, pb ^= 1)
                    gla_prep_unit(uid, (uid + G < 4096) ? uid + G : uid, pin, ldsL + pb * PA_BYTES, QK, AFB, GIN(3) + (size_t)lp * 8192, GIN(4) + (size_t)lp * 512, GIN(5) + (size_t)lp * 8192, GIN(6) + (size_t)lp * 512, QE, KDT, ATTN, DEC, tid, wave, lane);
                __syncthreads(); }
            for (int item = vcu * 512 + tid; item < (M / 32) * 128; item += G * 512) pool_item(item, Pb, POOLED);
            if (rep + 1 < NREP(2)) GRID_BAR(); }
            if (BOTH(2)) GRID_BAR();
        }
        if (IN(3)) { PHASE_IDS(); for (int rep = 0; rep < NREP(3); ++rep) {
            for (int su = vcu; su < 16 * NSEG; su += G) gla_scan_block<false>(su, ldsL, QE, ATTN, KDT, DEC, VT, SEGL, SIN, OFb, OBb, tid, wave, lane);
            if (rep + 1 < NREP(3)) GRID_BAR(); }
            if (BOTH(3)) GRID_BAR();
        }
        if (IN(5)) { PHASE_IDS(); for (int rep = 0; rep < NREP(5); ++rep) {
            for (int su = vcu; su < 16 * NSEG; su += G) gla_scan_block<true>(su, ldsL, QE, ATTN, KDT, DEC, VT, SEGL, SIN, OFb, OBb, tid, wave, lane);
            if (rep + 1 < NREP(5)) GRID_BAR(); }
            if (BOTH(5)) GRID_BAR();
        }
        if (IN(6)) { PHASE_IDS(); for (int rep = 0; rep < NREP(6); ++rep) {
            { float gg[16]; { const f32x4* gp = (const f32x4*)(GIN(7) + (size_t)lp * 1024 + 16 * lane);
#pragma unroll
                for (int q = 0; q < 4; ++q) { const f32x4 x = gp[q]; gg[4 * q] = x.x; gg[4 * q + 1] = x.y; gg[4 * q + 2] = x.z; gg[4 * q + 3] = x.w; } }
              for (int m = gw; m < M; m += 2 * NGW) { const int m2 = (m + NGW < M) ? m + NGW : m;
                  FinIn ia, ib; gla_fin_load(ia, m, OFb, OBb, Rb, lane); gla_fin_load(ib, m2, OFb, OBb, Rb, lane);
                  gla_fin_row(ia, m, gg, GLAOUT, lane); if (m2 != m) gla_fin_row(ib, m2, gg, GLAOUT, lane); } }
            { pg8::Gemm g{POOLED, POOLW, M, 1024, 256, 1024, 256, 512, nullptr, nullptr}; pg8::StaticOrder S; S.init(M, 1024, G, bx);
              pg8::EpiScale<false> E{POOLMIX, 1024, GIN(10) + (size_t)lp * 1024, nullptr};
              pg8::gemm_phase<pg8::EpiScale<false>, pg8::StaticOrder, true, true>(ldsL, g, S, E); }
            if (rep + 1 < NREP(6)) GRID_BAR(); }
            if (BOTH(6)) GRID_BAR();
        }
        if (IN(7)) { PHASE_IDS(); for (int rep = 0; rep < NREP(7); ++rep) {
            { pg8::Gemm g{GLAOUT, WUPG, M, 2048, 1024, 1024, 1024, 0, POOLMIX, WUPP}; pg8::TwoPartOrder S; S.init(M, 2048, G, bx);
              pg8::EpiMerge E{MERGED, (const unsigned char*)Gb};
              pg8::gemm_phase<pg8::EpiMerge, pg8::TwoPartOrder, true, true>(ldsL, g, S, E); }
            if (rep + 1 < NREP(7)) GRID_BAR(); }
            if (BOTH(7)) GRID_BAR();
        }
        if (IN(8)) { PHASE_IDS(); for (int rep = 0; rep < NREP(8); ++rep) {
            { pg8::Gemm g{MERGED, WOUT, M, 2048, 2048, 2048, 2048, 0, nullptr, nullptr}; pg8::StaticOrder S; S.init(M, 2048, G, bx);
              pg8::EpiResid E{x_in, Hb, ss1};
              pg8::gemm_phase<pg8::EpiResid, pg8::StaticOrder, true, true>(ldsL, g, S, E); }
            if (rep + 1 < NREP(8)) GRID_BAR(); }
            if (BOTH(8)) GRID_BAR();
        }
        if (IN(9)) { PHASE_IDS(); for (int rep = 0; rep < NREP(9); ++rep) {
            { pg8::Gemm g{Hb, WQ, M, 2048, 2048, 2048, 2048, 0, nullptr, nullptr}; pg8::StaticOrder S; S.init(M, 2048, G, bx);
              pg8::EpiScale<true> E{PQ, 2048, nullptr, ss1};
              pg8::gemm_phase<pg8::EpiScale<true>, pg8::StaticOrder, true, true>(ldsL, g, S, E); }
            if (rep + 1 < NREP(9)) GRID_BAR(); }
            if (BOTH(9)) GRID_BAR();
        }
        if (IN(10)) { PHASE_IDS(); for (int rep = 0; rep < NREP(10); ++rep) {
            for (int j = 0; j < 4; ++j) {
                __syncthreads();
                for (int i = tid; i < 8192; i += 512) *(LAS v4u*)(ldsL + i * 16) = *(const v4u*)((const unsigned char*)SUBK + (size_t)j * 131072 + (size_t)i * 16);
                __syncthreads();
                const int hsel = wave >> 2, h = 2 * j + hsel;
                for (int tile = vcu * 4 + (wave & 3); tile < M / 32; tile += G * 4) peer_topk_item(tile, h, ldsL + hsel * 65536, PQ, IDX, GATE, lane);
            }
            if (rep + 1 < NREP(10)) GRID_BAR(); }
            if (BOTH(10)) GRID_BAR();
        }
        if (IN(11)) { PHASE_IDS(); for (int rep = 0; rep < NREP(11); ++rep) {
            const int label = bx & 7, rank = bx >> 3, nrank = (G - label + 7) >> 3;
            for (int sub = 0; sub < 2; ++sub)
                peer_slice_loop<false>(2 * label + sub, label, sub, rank * NWAVES + wave, nrank * NWAVES, Hb, ACT, IDX, UTAB, PART, outp, Hb, nullptr, nullptr, lane);
            if (rep + 1 < NREP(11)) GRID_BAR(); }
            if (BOTH(11)) GRID_BAR();
        }
        if (IN(12)) { PHASE_IDS(); for (int rep = 0; rep < NREP(12); ++rep) {
            for (int tok = 2 * gw; tok < M; tok += 2 * NGW) peer_combine_row((size_t)tok, PART, IDX, GATE, USC, VSC, ss1, ACT, lane);
            if (rep + 1 < NREP(12)) GRID_BAR(); }
            if (BOTH(12)) GRID_BAR();
        }
        if (IN(13)) { PHASE_IDS();
            const int last = (lp == DEPTH - 1);
            const float* gn = last ? GIN(18) : GIN(1) + (size_t)(lp + 1) * D;
            const int label = bx & 7, rank = bx >> 3, nrank = (G - label + 7) >> 3;
            for (int sub = 0; sub < 2; ++sub)
                if (last) peer_v_loop<false>(2 * label + sub, rank * NWAVES + wave, nrank * NWAVES, ACT, IDX, VTAB, outp, Hb, gn, ss2, lane);
                else      peer_v_loop<true>(2 * label + sub, rank * NWAVES + wave, nrank * NWAVES, ACT, IDX, VTAB, outp, Hb, gn, ss2, lane);
            if ((BOTH(13) && last) || (lo == 0 && hi == NPH && l + 1 < args.l_hi)) GRID_BAR();
        }
        if (IN(14) && l == DEPTH - 1) { PHASE_IDS();
            for (int m = gw; m < M; m += NGW) final_norm_row(outp + (size_t)m * D, GIN(18), ss2 + (size_t)m * 16, lane);
        }
    }
#undef IN
#undef BOTH
#undef GRID_BAR
}

#undef WIN
#undef WUPG
#undef WUPP
#undef WOUT
#undef WQ
#undef POOLW
#undef SUBK
#undef Hb
#undef POOLED
#undef POOLMIX
#undef QK
#undef Pb
#undef OFb
#undef OBb
#undef VT
#undef Rb
#undef MERGED
#undef Gb
#undef PQ
#undef QE
#undef GLAOUT
#undef KDT
#undef ATTN
#undef USC
#undef VSC
#undef UTAB
#undef VTAB
#undef SEGL
#undef SIN
#undef IDX
#undef GATE
#undef AFB
#undef DEC
#undef SSP1
#undef SSP2
#undef PART
#undef ACT
#undef GIN
#undef x_in
#undef w_in
#undef ssin
#undef ss1
#undef ss2
extern "C" void kernel_launch(void* const* d_in, const int* in_sizes, int n_in, void* d_out, int out_size, void* d_ws, size_t ws_size, hipStream_t stream) {
    static int grid = 0;
    if (grid == 0) {
        if (n_in != 19 || in_sizes[0] != M * D || out_size != M * D || ws_size < WS_END) { fprintf(stderr, "kernel_launch: unexpected shapes / workspace (n_in %d, ws %zu, need %zu); nothing launched\n", n_in, ws_size, (size_t)WS_END); grid = -1; return; }
        int dev = 0, cus = 0, per_cu = 0;
        if (hipGetDevice(&dev) != hipSuccess || hipDeviceGetAttribute(&cus, hipDeviceAttributeMultiprocessorCount, dev) != hipSuccess) { grid = -1; return; }
        if (hipFuncSetAttribute((const void*)fwd_kernel, hipFuncAttributeMaxDynamicSharedMemorySize, LDS_BYTES) != hipSuccess) { fprintf(stderr, "kernel_launch: hipFuncSetAttribute failed\n"); grid = -1; return; }
        if (hipOccupancyMaxActiveBlocksPerMultiprocessor(&per_cu, (const void*)fwd_kernel, NWAVES * 64, LDS_BYTES) != hipSuccess || per_cu < 1) { fprintf(stderr, "kernel_launch: occupancy query reports %d blocks per CU\n", per_cu); }
        (void)hipGetLastError();
        grid = cus;
    }
    if (grid < 0) return;
    if (hipMemsetAsync((char*)d_ws + WS_CTL, 0, CTL_ZERO_BYTES, stream) != hipSuccess) return;
    Args a{};
    for (int i = 0; i < 19; ++i) a.in[i] = (const float*)d_in[i];
    a.out = (float*)d_out; a.ws = (unsigned char*)d_ws;
#if MK_MULTI
    for (int l = 0; l < DEPTH; ++l)
        for (int ph = 0; ph < NPH; ++ph) { a.ph_lo = ph; a.ph_hi = ph + 1; a.l_lo = l; a.l_hi = l + 1;
            hipLaunchKernelGGL(fwd_kernel, dim3(grid), dim3(NWAVES * 64), LDS_BYTES, stream, a); }
#else
    a.ph_lo = 0; a.ph_hi = NPH; a.l_lo = 0; a.l_hi = DEPTH;
    hipLaunchKernelGGL(fwd_kernel, dim3(grid), dim3(NWAVES * 64), LDS_BYTES, stream, a);
#endif
}
```

```cpp
#include <hip/hip_runtime.h>
#include <cstdio>
#include <cstdint>
namespace pg8 {
#define PG8_LAS __attribute__((address_space(3)))
typedef unsigned short bf16_t;
typedef short bf16x8 __attribute__((ext_vector_type(8)));
typedef float f32x4 __attribute__((ext_vector_type(4)));
typedef unsigned u32x4 __attribute__((ext_vector_type(4)));
typedef unsigned u32x2 __attribute__((ext_vector_type(2)));
constexpr int BM = 256, BK = 64, HALF = 128, HTB = HALF * BK * 2  , STAGE_BYTES = 8 * HTB, NXCD = 8, WGM = 8;

__host__ __device__ __forceinline__ int lds_byte(int r, int c) { const int st = (r >> 4) * 2 + (c >> 5), rr = r & 15, cc = c & 31, ob = rr * 64 + cc * 2; return st * 1024 + (ob ^ (((ob >> 9) & 1) << 5)); }
__host__ __device__ __forceinline__ void stage_rc(int b, int& R, int& C) { const int st = b / 1024, sb = b % 1024, swz = sb ^ (((sb >> 9) & 1) << 5); R = (st >> 1) * 16 + swz / 64; C = (st & 1) * 32 + (swz % 64) / 2; }
__host__ __device__ __forceinline__ int perm32(int rho) { const int n = rho >> 4, i = rho & 15; return 8 * (i >> 2) + 4 * n + (i & 3); }

struct Unit { int pm, pn, sub; };
struct Gemm { const bf16_t* A; const bf16_t* Bt; int M, N, K, lda, ldb, a_pn_step; const bf16_t* A2; const bf16_t* Bt2; };

struct StaticOrder {
    int nM, nN, nwg, G, c;
    __host__ __device__ void init(int M, int N, int G_, int c_) { nM = M / BM; nN = N / BM; nwg = nM * nN; G = G_; c = c_; }
    __host__ __device__ bool next(int i, Unit& u) const {
        const long L = (long)i * G + c; if (L >= nwg) return false;
        int wgid = (int)L; { const int q = nwg / NXCD, r = nwg % NXCD, xcd = wgid % NXCD, off = wgid / NXCD; wgid = (xcd < r ? xcd * (q + 1) : r * (q + 1) + (xcd - r) * q) + off; }
        const int nig = WGM * nN, gid = wgid / nig, fm = gid * WGM, gsz = (nM - fm) < WGM ? (nM - fm) : WGM;
        u.pm = fm + ((wgid % nig) % gsz); u.pn = (wgid % nig) / gsz; u.sub = 0; return true;
    }
    __device__ __forceinline__ void a_ready(const Unit&) const {}
    __device__ __forceinline__ void done(const Unit&) const {}
};

struct TwoPartOrder : StaticOrder {
    __host__ __device__ bool next(int i, Unit& u) const { if (!StaticOrder::next(i >> 1, u)) return false; u.sub = i & 1; return true; }
};
typedef float f32x2 __attribute__((ext_vector_type(2)));
typedef __bf16 bf16x2_t __attribute__((ext_vector_type(2)));
__device__ __forceinline__ unsigned pkbf(float lo, float hi) { f32x2 v = {lo, hi}; bf16x2_t b = __builtin_convertvector(v, bf16x2_t); return __builtin_bit_cast(unsigned, b); }
__device__ __forceinline__ float bflo(unsigned w) { return __builtin_bit_cast(float, w << 16); }
__device__ __forceinline__ float bfhi(unsigned w) { return __builtin_bit_cast(float, w & 0xffff0000u); }
__device__ __forceinline__ float fast_sigmoid(float x) { return __builtin_amdgcn_rcpf(1.f + __expf(-x)); }
template <int NP> __device__ __forceinline__ float row_rs(const float* ssp, int row) {
    const f32x4* p = (const f32x4*)(ssp + (size_t)row * NP); f32x4 a = p[0];
#pragma unroll
    for (int k = 1; k < NP / 4; ++k) a = a + p[k];
    return rsqrtf(((a.x + a.y) + (a.z + a.w)) * (1.f / 2048.f) + 1e-6f);
}

template <int NP> __device__ __forceinline__ float row_rs_fq(const float* ssp, int row, int fq) {
    const f32x4* p = (const f32x4*)(ssp + (size_t)row * NP + fq * (NP / 4)); f32x4 a = p[0];
    if (NP == 32) a = a + p[1];
    float t = (a.x + a.y) + (a.z + a.w);
    t += __shfl_xor(t, 16); t += __shfl_xor(t, 32);
    return rsqrtf(t * (1.f / 2048.f) + 1e-6f);
}
template <int NP> __device__ __forceinline__ void row_rs_fq8(const float* ssp, int row0, int fq, float (&rsc)[2][4]) {
#pragma unroll
    for (int ai = 0; ai < 2; ++ai) {
        f32x4 a[4], b[4];
#pragma unroll
        for (int m = 0; m < 4; ++m) { const f32x4* p = (const f32x4*)(ssp + (size_t)(row0 + ai * HALF + m * 16) * NP + fq * (NP / 4)); a[m] = p[0]; if (NP == 32) b[m] = p[1]; }
#pragma unroll
        for (int m = 0; m < 4; ++m) { f32x4 v = a[m]; if (NP == 32) v = v + b[m];
            float t = (v.x + v.y) + (v.z + v.w); t += __shfl_xor(t, 16); t += __shfl_xor(t, 32);
            rsc[ai][m] = rsqrtf(t * (1.f / 2048.f) + 1e-6f); }
    }
}
struct EpiProj {
    static constexpr bool PERM = true, AFTER_DRAIN = false; __device__ static bool keep(const Unit&) { return false; }
    bf16_t *QK, *R, *P, *G; float* AFB; const float* ss;
    __device__ __forceinline__ void operator()(const f32x4 (&acc)[2][2][4][2], const Unit& u, int wr, int wc, int fr, int fq) const {
        const int row0 = u.pm * BM + wr * 64 + fr; const int pn = u.pn;
        float rsc[2][4];
        if (ss) row_rs_fq8<16>(ss, row0, fq, rsc);
        else {
#pragma unroll
            for (int ai = 0; ai < 2; ++ai)
#pragma unroll
                for (int m = 0; m < 4; ++m) rsc[ai][m] = 1.f; }
        bf16_t* base; int ldc, colt, mode;
        if (pn < 4) { base = QK; ldc = 1024; colt = pn * 256; mode = (pn < 2) ? 1 : 0; }
        else if (pn < 8) { base = R; ldc = 1024; colt = (pn - 4) * 256; mode = 2; }
        else if (pn < 12) { base = P; ldc = 1024; colt = (pn - 8) * 256; mode = 0; }
        else { base = G; ldc = 4096; colt = (pn - 12) * 256; mode = 3; }
        const int col0 = colt + wc * 32 + 8 * fq;
#pragma unroll
        for (int ai = 0; ai < 2; ++ai)
#pragma unroll
            for (int m = 0; m < 4; ++m) { bf16_t* rowp = base + (size_t)(row0 + ai * HALF + m * 16) * ldc + col0;
#pragma unroll
                for (int bj = 0; bj < 2; ++bj) { f32x4 v0 = acc[ai][bj][m][0] * rsc[ai][m], v1 = acc[ai][bj][m][1] * rsc[ai][m];
                    if (mode == 1) { v0 = v0 * 0.08838834764831845f; v1 = v1 * 0.08838834764831845f; }
                    else if (mode == 2) {
#pragma unroll
                        for (int e = 0; e < 4; ++e) { v0[e] = v0[e] * fast_sigmoid(v0[e]); v1[e] = v1[e] * fast_sigmoid(v1[e]); } }
                    else if (mode == 3) {
#pragma unroll
                        for (int e = 0; e < 4; ++e) { v0[e] = fast_sigmoid(v0[e]); v1[e] = fast_sigmoid(v1[e]); } }
                    if (mode == 3) { unsigned w0 = 0u, w1 = 0u;
#pragma unroll
                        for (int e = 0; e < 4; ++e) { w0 = __builtin_amdgcn_cvt_pk_u8_f32(__builtin_rintf(v0[e] * 255.f), e, w0); w1 = __builtin_amdgcn_cvt_pk_u8_f32(__builtin_rintf(v1[e] * 255.f), e, w1); }
                        u32x2 w = {w0, w1}; *(u32x2*)((unsigned char*)G + (size_t)(row0 + ai * HALF + m * 16) * 4096 + col0 + bj * HALF) = w; }
                    else {
                    u32x4 w; w.x = pkbf(v0[0], v0[1]); w.y = pkbf(v0[2], v0[3]); w.z = pkbf(v1[0], v1[1]); w.w = pkbf(v1[2], v1[3]);
                    *(u32x4*)(rowp + bj * HALF) = w; } } asm volatile("" ::: "memory"); }
    }
};
struct EpiVT {
    static constexpr bool PERM = true, AFTER_DRAIN = false; __device__ static bool keep(const Unit&) { return false; }
    bf16_t* VT; const float* ss;
    __device__ __forceinline__ void operator()(const f32x4 (&acc)[2][2][4][2], const Unit& u, int wr, int wc, int fr, int fq) const {
        const int dv0 = u.pm * BM + wr * 64 + fr, tok0 = u.pn * BM + wc * 32 + 8 * fq;
        f32x4 cs[2][2];
#pragma unroll
        for (int bj = 0; bj < 2; ++bj)
#pragma unroll
            for (int n = 0; n < 2; ++n) cs[bj][n] = (f32x4){1.f, 1.f, 1.f, 1.f};
        if (ss) { const float mine = row_rs<16>(ss, tok0 + (fr >> 3) * HALF + (fr & 7));
#pragma unroll
            for (int bj = 0; bj < 2; ++bj)
#pragma unroll
                for (int n = 0; n < 2; ++n)
#pragma unroll
                    for (int k = 0; k < 4; ++k) cs[bj][n][k] = __shfl(mine, fq * 16 + bj * 8 + 4 * n + k); }
#pragma unroll
        for (int ai = 0; ai < 2; ++ai)
#pragma unroll
            for (int m = 0; m < 4; ++m) { const int dv = dv0 + ai * HALF + m * 16;
#pragma unroll
                for (int bj = 0; bj < 2; ++bj) { const int tok = tok0 + bj * HALF; const int bc = tok >> 6, tin = tok & 63;
                    const f32x4 v0 = acc[ai][bj][m][0] * cs[bj][0], v1 = acc[ai][bj][m][1] * cs[bj][1];
                    u32x4 w; w.x = pkbf(v0[0], v0[1]); w.y = pkbf(v0[2], v0[3]); w.z = pkbf(v1[0], v1[1]); w.w = pkbf(v1[2], v1[3]);
                    *(u32x4*)(VT + ((size_t)bc * 1024 + dv) * 64 + tin) = w; } }
    }
};
template <bool ROWS> struct EpiScale {
    static constexpr bool PERM = true, AFTER_DRAIN = false; __device__ static bool keep(const Unit&) { return false; }
    bf16_t* O; int ldc; const float* scale; const float* ss;
    __device__ __forceinline__ void operator()(const f32x4 (&acc)[2][2][4][2], const Unit& u, int wr, int wc, int fr, int fq) const {
        const int row0 = u.pm * BM + wr * 64 + fr, col0 = u.pn * BM + wc * 32 + 8 * fq;
        f32x4 sv[2][2];
#pragma unroll
        for (int bj = 0; bj < 2; ++bj)
#pragma unroll
            for (int n = 0; n < 2; ++n) sv[bj][n] = scale ? *(const f32x4*)(scale + col0 + bj * HALF + 4 * n) : (f32x4){1.f, 1.f, 1.f, 1.f};
        float rsc[2][4];
        if (ROWS) row_rs_fq8<32>(ss, row0, fq, rsc);
#pragma unroll
        for (int ai = 0; ai < 2; ++ai)
#pragma unroll
            for (int m = 0; m < 4; ++m) { bf16_t* rowp = O + (size_t)(row0 + ai * HALF + m * 16) * ldc + col0; const float rr = ROWS ? rsc[ai][m] : 1.f;
#pragma unroll
                for (int bj = 0; bj < 2; ++bj) { const f32x4 v0 = acc[ai][bj][m][0] * sv[bj][0] * rr, v1 = acc[ai][bj][m][1] * sv[bj][1] * rr;
                    u32x4 w; w.x = pkbf(v0[0], v0[1]); w.y = pkbf(v0[2], v0[3]); w.z = pkbf(v1[0], v1[1]); w.w = pkbf(v1[2], v1[3]);
                    *(u32x4*)(rowp + bj * HALF) = w; } }
    }
};
template <bool ACCUM> struct EpiGate {
    static constexpr bool PERM = true, AFTER_DRAIN = false; __device__ static bool keep(const Unit&) { return false; }
    bf16_t* O; const bf16_t* Gt;
    __device__ __forceinline__ void operator()(const f32x4 (&acc)[2][2][4][2], const Unit& u, int wr, int wc, int fr, int fq) const {
        const int row0 = u.pm * BM + wr * 64 + fr, col0 = u.pn * BM + wc * 32 + 8 * fq;
#pragma unroll
        for (int ai = 0; ai < 2; ++ai) {
            u32x4 gwv[4][2], owv[4][2];
#pragma unroll
            for (int m = 0; m < 4; ++m)
#pragma unroll
                for (int bj = 0; bj < 2; ++bj) { const size_t row = (size_t)(row0 + ai * HALF + m * 16);
                    gwv[m][bj] = *(const u32x4*)(Gt + row * 4096 + col0 + bj * HALF);
                    if (ACCUM) owv[m][bj] = *(const u32x4*)(O + row * 2048 + col0 + bj * HALF); }
            asm volatile("" ::: "memory");
#pragma unroll
            for (int m = 0; m < 4; ++m) { const size_t row = (size_t)(row0 + ai * HALF + m * 16);
#pragma unroll
                for (int bj = 0; bj < 2; ++bj) { const u32x4 gw = gwv[m][bj];
                    f32x4 v0 = acc[ai][bj][m][0], v1 = acc[ai][bj][m][1];
                    v0[0] *= bflo(gw.x); v0[1] *= bfhi(gw.x); v0[2] *= bflo(gw.y); v0[3] *= bfhi(gw.y); v1[0] *= bflo(gw.z); v1[1] *= bfhi(gw.z); v1[2] *= bflo(gw.w); v1[3] *= bfhi(gw.w);
                    if (ACCUM) { const u32x4 ow = owv[m][bj];
                        v0[0] += bflo(ow.x); v0[1] += bfhi(ow.x); v0[2] += bflo(ow.y); v0[3] += bfhi(ow.y); v1[0] += bflo(ow.z); v1[1] += bfhi(ow.z); v1[2] += bflo(ow.w); v1[3] += bfhi(ow.w); }
                    u32x4 w; w.x = pkbf(v0[0], v0[1]); w.y = pkbf(v0[2], v0[3]); w.z = pkbf(v1[0], v1[1]); w.w = pkbf(v1[2], v1[3]);
                    *(u32x4*)(O + row * 2048 + col0 + bj * HALF) = w; } }
            asm volatile("" ::: "memory");
        }
    }
};
struct EpiMerge {
    static constexpr bool PERM = true, AFTER_DRAIN = false; __device__ static bool keep(const Unit& u) { return u.sub == 0; }
    bf16_t* O; const unsigned char* Gt;
    __device__ __forceinline__ void operator()(f32x4 (&acc)[2][2][4][2], const Unit& u, int wr, int wc, int fr, int fq) const {
        const int row0 = u.pm * BM + wr * 64 + fr, col0 = u.pn * BM + wc * 32 + 8 * fq;
#pragma unroll
        for (int ai = 0; ai < 2; ++ai) {
            u32x2 g1[4][2], g2[4][2];
#pragma unroll
            for (int m = 0; m < 4; ++m)
#pragma unroll
                for (int bj = 0; bj < 2; ++bj) { const size_t p = (size_t)(row0 + ai * HALF + m * 16) * 4096 + col0 + bj * HALF;
                    g2[m][bj] = *(const u32x2*)(Gt + p + 2048); if (u.sub == 0) g1[m][bj] = *(const u32x2*)(Gt + p); }
            asm volatile("" ::: "memory");
#pragma unroll
            for (int m = 0; m < 4; ++m)
#pragma unroll
                for (int bj = 0; bj < 2; ++bj) { const u32x2 b = g2[m][bj];
                    float s2[8];
#pragma unroll
                    for (int e = 0; e < 4; ++e) { s2[e] = (float)((b.x >> (8 * e)) & 255u) * (1.f / 255.f); s2[4 + e] = (float)((b.y >> (8 * e)) & 255u) * (1.f / 255.f); }
#pragma unroll
                    for (int e = 0; e < 8; ++e) s2[e] = fmaxf(s2[e], 8.6736174e-19f);
                    f32x4 v0 = acc[ai][bj][m][0], v1 = acc[ai][bj][m][1];
                    if (u.sub == 0) { const u32x2 a = g1[m][bj];
                        float s1[8];
#pragma unroll
                        for (int e = 0; e < 4; ++e) { s1[e] = (float)((a.x >> (8 * e)) & 255u) * (1.f / 255.f); s1[4 + e] = (float)((a.y >> (8 * e)) & 255u) * (1.f / 255.f); }
#pragma unroll
                        for (int e = 0; e < 4; ++e) { v0[e] *= s1[e] * __builtin_amdgcn_rcpf(s2[e]); v1[e] *= s1[4 + e] * __builtin_amdgcn_rcpf(s2[4 + e]); }
                        acc[ai][bj][m][0] = v0; acc[ai][bj][m][1] = v1;
                    } else {
#pragma unroll
                        for (int e = 0; e < 4; ++e) { v0[e] *= s2[e]; v1[e] *= s2[4 + e]; }
                        u32x4 w; w.x = pkbf(v0[0], v0[1]); w.y = pkbf(v0[2], v0[3]); w.z = pkbf(v1[0], v1[1]); w.w = pkbf(v1[2], v1[3]);
                        *(u32x4*)(O + (size_t)(row0 + ai * HALF + m * 16) * 2048 + col0 + bj * HALF) = w; } }
            asm volatile("" ::: "memory");
        }
    }
};
struct EpiResid {
    static constexpr bool PERM = true, AFTER_DRAIN = false; __device__ static bool keep(const Unit&) { return false; }
    const float* xin; bf16_t* XB; float* ss;
    __device__ __forceinline__ void operator()(const f32x4 (&acc)[2][2][4][2], const Unit& u, int wr, int wc, int fr, int fq) const {
        const int row0 = u.pm * BM + wr * 64 + fr, col0 = u.pn * BM + wc * 32 + 8 * fq;
#pragma unroll
        for (int h4 = 0; h4 < 4; ++h4) { const int ai = h4 >> 1, mb = (h4 & 1) * 2;
            f32x4 xv[2][2][2];
#pragma unroll
            for (int mm = 0; mm < 2; ++mm)
#pragma unroll
                for (int bj = 0; bj < 2; ++bj) { const size_t p = (size_t)(row0 + ai * HALF + (mb + mm) * 16) * 2048 + col0 + bj * HALF; xv[mm][bj][0] = *(const f32x4*)(xin + p); xv[mm][bj][1] = *(const f32x4*)(xin + p + 4); }
            asm volatile("" ::: "memory");
#pragma unroll
            for (int mm = 0; mm < 2; ++mm) { const int m = mb + mm; const int row = row0 + ai * HALF + m * 16; const size_t rb = (size_t)row * 2048 + col0; float sq = 0.f;
#pragma unroll
                for (int bj = 0; bj < 2; ++bj) { const size_t p = rb + bj * HALF;
                    const f32x4 x0 = xv[mm][bj][0] + acc[ai][bj][m][0], x1 = xv[mm][bj][1] + acc[ai][bj][m][1];
                    sq += (x0.x * x0.x + x0.y * x0.y) + (x0.z * x0.z + x0.w * x0.w) + (x1.x * x1.x + x1.y * x1.y) + (x1.z * x1.z + x1.w * x1.w);
                    u32x4 w; w.x = pkbf(x0[0], x0[1]); w.y = pkbf(x0[2], x0[3]); w.z = pkbf(x1[0], x1[1]); w.w = pkbf(x1[2], x1[3]);
                    *(u32x4*)(XB + p) = w; }
                sq += __shfl_xor(sq, 16); sq += __shfl_xor(sq, 32);
                if (fq == 0) ss[(size_t)row * 32 + u.pn * 4 + wc] = sq; }
            asm volatile("" ::: "memory");
        }
    }
};

template <class Epi, class Sched, bool ALIGN_EPI = false, bool SP2 = false>
__device__ __forceinline__ void gemm_phase(PG8_LAS unsigned char* lds, const Gemm g, const Sched& S, const Epi& E) {
    int tid_o = threadIdx.x; asm volatile("" : "+v"(tid_o));
    const int tid = tid_o, wid = __builtin_amdgcn_readfirstlane(tid >> 6), lane = tid & 63, wr = wid >> 2, wc = wid & 3, fr = lane & 15, fq = lane >> 4;
    int K_o = g.K; asm volatile("" : "+s"(K_o));
    const int K = K_o, nt = K / BK;
    unsigned voffA[2], voffB[2];
#pragma unroll
    for (int i = 0; i < 2; ++i) { int R, C; stage_rc(tid * 16 + i * 8192, R, C); const int Rb = Epi::PERM ? ((R & ~31) + perm32(R & 31)) : R;
        voffA[i] = (unsigned)(R * g.lda + C) * 2u; voffB[i] = (unsigned)(Rb * g.ldb + C) * 2u; }
    const size_t kstep = (size_t)(BK * 2);
    const size_t hstepA = (size_t)HALF * g.lda * 2, hstepB = (size_t)HALF * g.ldb * 2;
    const size_t tstepA = 2 * hstepA, tstepB = 2 * hstepB;
    const unsigned ldsw = (unsigned)wid * 1024u;
    const int aoff = lds_byte(wr * 64 + fr, fq * 8), boff = lds_byte(wc * 32 + fr, fq * 8);
#define PG8_SA(b, h) (((b) * 2 + (h)) * HTB)
#define PG8_SB(b, h) ((4 + (b) * 2 + (h)) * HTB)
#define PG8_STAGE(bufoff, gbase, voff) do { _Pragma("unroll") for (int _i = 0; _i < 2; ++_i) \
        __builtin_amdgcn_global_load_lds((const unsigned*)((const char*)(gbase) + (voff)[_i]), (PG8_LAS unsigned*)(lds + (bufoff) + ldsw + _i * 8192), 16, 0, 0); } while (0)
#define PG8_LDA(dst, b, h) do { _Pragma("unroll") for (int m = 0; m < 4; ++m) _Pragma("unroll") for (int k = 0; k < 2; ++k) dst[m][k] = *(const PG8_LAS bf16x8*)(lds + PG8_SA(b, h) + aoff + m * 2048 + k * 1024); } while (0)
#define PG8_LDB(dst, b, h) do { _Pragma("unroll") for (int n = 0; n < 2; ++n) _Pragma("unroll") for (int k = 0; k < 2; ++k) dst[n][k] = *(const PG8_LAS bf16x8*)(lds + PG8_SB(b, h) + boff + n * 2048 + k * 1024); } while (0)
#define PG8_MMA(ai, bj, At, Bt) do { __builtin_amdgcn_s_setprio(1); _Pragma("unroll") for (int m = 0; m < 4; ++m) _Pragma("unroll") for (int n = 0; n < 2; ++n) _Pragma("unroll") for (int k = 0; k < 2; ++k) \
        acc[ai][bj][m][n] = __builtin_amdgcn_mfma_f32_16x16x32_bf16(Bt[n][k], At[m][k], acc[ai][bj][m][n], 0, 0, 0); __builtin_amdgcn_s_setprio(0); } while (0)
#define PG8_WAIT_V(n) asm volatile("s_waitcnt vmcnt(" #n ")" ::: "memory")
#define PG8_WAIT_L(n) asm volatile("s_waitcnt lgkmcnt(" #n ")" ::: "memory")
#define PG8_BAR __builtin_amdgcn_s_barrier()
#define PG8_SCHED __builtin_amdgcn_sched_barrier(0)
    Unit cur, nxt; int ui = 0;
    if (!S.next(0, cur)) return;
    f32x4 acc[2][2][4][2];
    float zf = 0.f; asm volatile("" : "+v"(zf));
#pragma unroll
    for (int a = 0; a < 2; ++a)
#pragma unroll
        for (int b = 0; b < 2; ++b)
#pragma unroll
            for (int m = 0; m < 4; ++m)
#pragma unroll
                for (int n = 0; n < 2; ++n) acc[a][b][m][n] = (f32x4){zf, zf, zf, zf};
    bf16x8 At[4][2], B0[2][2], B1[2][2];
    const char* cA = (const char*)(cur.sub ? g.A2 : g.A) + (size_t)cur.pm * tstepA + (size_t)cur.pn * g.a_pn_step; const char* cB = (const char*)(cur.sub ? g.Bt2 : g.Bt) + (size_t)cur.pn * tstepB;
    S.a_ready(cur);
    if constexpr (SP2) {
        PG8_STAGE(PG8_SB(0, 0), cB, voffB); PG8_STAGE(PG8_SB(0, 1), cB + hstepB, voffB); PG8_STAGE(PG8_SA(0, 0), cA, voffA); PG8_STAGE(PG8_SA(0, 1), cA + hstepA, voffA);
        if (wr == 1) PG8_BAR;
        PG8_WAIT_V(2); PG8_BAR;
        PG8_STAGE(PG8_SB(1, 0), cB + kstep, voffB); PG8_STAGE(PG8_SA(1, 0), cA + kstep, voffA); PG8_STAGE(PG8_SB(1, 1), cB + hstepB + kstep, voffB);
        PG8_WAIT_V(6); PG8_BAR;
    } else {
        PG8_STAGE(PG8_SB(0, 0), cB, voffB); PG8_STAGE(PG8_SA(0, 0), cA, voffA); PG8_STAGE(PG8_SB(0, 1), cB + hstepB, voffB); PG8_STAGE(PG8_SA(0, 1), cA + hstepA, voffA);
        if (wr == 1) PG8_BAR;
        PG8_WAIT_V(4); PG8_BAR;
        PG8_STAGE(PG8_SB(1, 0), cB + kstep, voffB); PG8_STAGE(PG8_SA(1, 0), cA + kstep, voffA); PG8_STAGE(PG8_SB(1, 1), cB + hstepB + kstep, voffB);
        PG8_WAIT_V(6); PG8_BAR;
    }
    for (;;) {
        const bool has_next = S.next(ui + 1, nxt);
        const char* nA = has_next ? (const char*)(nxt.sub ? g.A2 : g.A) + (size_t)nxt.pm * tstepA + (size_t)nxt.pn * g.a_pn_step : cA; const char* nB = has_next ? (const char*)(nxt.sub ? g.Bt2 : g.Bt) + (size_t)nxt.pn * tstepB : cB;
        for (int t = 0; t < nt; t += 2) {
            const bool last = (t == nt - 2);
            const char* a1 = cA + (size_t)(t + 1) * kstep;
            const char* a2 = last ? nA : cA + (size_t)(t + 2) * kstep; const char* b2 = last ? nB : cB + (size_t)(t + 2) * kstep;
            const char* a3 = a2 + kstep; const char* b3 = b2 + kstep;
            if (last && has_next) S.a_ready(nxt);
            if constexpr (SP2) {
            PG8_LDB(B0, 0, 0); PG8_LDB(B1, 0, 1); PG8_SCHED; PG8_LDA(At, 0, 0); PG8_STAGE(PG8_SA(1, 1), a1 + hstepA, voffA);
            PG8_WAIT_V(8); PG8_WAIT_L(0); PG8_BAR; PG8_MMA(0, 0, At, B0); PG8_MMA(0, 1, At, B1); PG8_BAR; PG8_SCHED;
            PG8_LDA(At, 0, 1); PG8_STAGE(PG8_SB(0, 0), b2, voffB); PG8_STAGE(PG8_SB(0, 1), b2 + hstepB, voffB); PG8_STAGE(PG8_SA(0, 0), a2, voffA);
            PG8_WAIT_V(8); PG8_WAIT_L(0); PG8_BAR; PG8_MMA(1, 0, At, B0); PG8_MMA(1, 1, At, B1); PG8_BAR; PG8_SCHED;
            PG8_LDB(B0, 1, 0); PG8_LDB(B1, 1, 1); PG8_SCHED; PG8_LDA(At, 1, 0); PG8_STAGE(PG8_SA(0, 1), a2 + hstepA, voffA);
            PG8_WAIT_V(8); PG8_WAIT_L(0); PG8_BAR; PG8_MMA(0, 0, At, B0); PG8_MMA(0, 1, At, B1); PG8_BAR; PG8_SCHED;
            PG8_LDA(At, 1, 1); PG8_STAGE(PG8_SB(1, 0), b3, voffB); PG8_STAGE(PG8_SB(1, 1), b3 + hstepB, voffB); PG8_STAGE(PG8_SA(1, 0), a3, voffA);
            PG8_WAIT_V(8); PG8_WAIT_L(0); PG8_BAR; PG8_MMA(1, 0, At, B0); PG8_MMA(1, 1, At, B1); PG8_BAR; PG8_SCHED;
            } else {
            PG8_LDB(B0, 0, 0); PG8_SCHED; PG8_LDA(At, 0, 0); PG8_STAGE(PG8_SA(1, 1), a1 + hstepA, voffA);
            PG8_WAIT_L(8); PG8_BAR; PG8_WAIT_L(0); PG8_MMA(0, 0, At, B0); PG8_BAR; PG8_SCHED;
            PG8_LDB(B1, 0, 1); PG8_STAGE(PG8_SB(0, 0), b2, voffB);
            PG8_BAR; PG8_WAIT_L(0); PG8_MMA(0, 1, At, B1); PG8_BAR;
            PG8_LDA(At, 0, 1); PG8_STAGE(PG8_SA(0, 0), a2, voffA);
            PG8_BAR; PG8_WAIT_L(0); PG8_MMA(1, 0, At, B0); PG8_BAR; PG8_SCHED;
            PG8_STAGE(PG8_SB(0, 1), b2 + hstepB, voffB);
            PG8_WAIT_V(6); PG8_BAR; PG8_MMA(1, 1, At, B1); PG8_BAR;
            PG8_LDB(B0, 1, 0); PG8_SCHED; PG8_LDA(At, 1, 0); PG8_STAGE(PG8_SA(0, 1), a2 + hstepA, voffA);
            PG8_WAIT_L(8); PG8_BAR; PG8_WAIT_L(0); PG8_MMA(0, 0, At, B0); PG8_BAR; PG8_SCHED;
            PG8_LDB(B1, 1, 1); PG8_STAGE(PG8_SB(1, 0), b3, voffB);
            PG8_BAR; PG8_WAIT_L(0); PG8_MMA(0, 1, At, B1); PG8_BAR;
            PG8_LDA(At, 1, 1); PG8_STAGE(PG8_SA(1, 0), a3, voffA);
            PG8_BAR; PG8_WAIT_L(0); PG8_MMA(1, 0, At, B0); PG8_BAR; PG8_SCHED;
            PG8_STAGE(PG8_SB(1, 1), b3 + hstepB, voffB);
            PG8_WAIT_V(6); PG8_BAR; PG8_MMA(1, 1, At, B1); PG8_BAR;
            }
        }
        if constexpr (ALIGN_EPI) { if (wr == 0) PG8_BAR; }
        if constexpr (!Epi::AFTER_DRAIN) { E(acc, cur, wr, wc, fr, fq); S.done(cur); }
        if (!has_next) break;
        if (!Epi::keep(cur)) {
        float zf2 = 0.f; asm volatile("" : "+v"(zf2));
#pragma unroll
        for (int a = 0; a < 2; ++a)
#pragma unroll
            for (int b = 0; b < 2; ++b)
#pragma unroll
                for (int m = 0; m < 4; ++m)
#pragma unroll
                    for (int n = 0; n < 2; ++n) acc[a][b][m][n] = (f32x4){zf2, zf2, zf2, zf2};
        }
        cur = nxt; cA = nA; cB = nB; ++ui;
        if constexpr (ALIGN_EPI) { if (wr == 1) PG8_BAR; }
    }
    PG8_WAIT_V(0);
    if constexpr (!ALIGN_EPI) { if (wr == 0) PG8_BAR; }
    PG8_BAR;
    if constexpr (Epi::AFTER_DRAIN) { E.fused(acc, cur, wr, wc, fr, fq, lds, wid, lane); S.done(cur); }
#undef PG8_SA
#undef PG8_SB
#undef PG8_STAGE
#undef PG8_LDA
#undef PG8_LDB
#undef PG8_MMA
#undef PG8_WAIT_V
#undef PG8_WAIT_L
#undef PG8_BAR
#undef PG8_SCHED
}
}

#define GAS __attribute__((address_space(1)))
#define LAS __attribute__((address_space(3)))
typedef unsigned short bf16;
typedef unsigned v4u __attribute__((ext_vector_type(4)));
typedef float f32x4 __attribute__((ext_vector_type(4)));
typedef short bf16x8 __attribute__((ext_vector_type(8)));
typedef GAS unsigned gu32;
typedef GAS unsigned long long gu64;
#define RLX_AGENT __ATOMIC_RELAXED, __HIP_MEMORY_SCOPE_AGENT
#define LDS_WAIT() asm volatile("s_waitcnt lgkmcnt(0)" ::: "memory")
#define VM_WAIT() asm volatile("s_waitcnt vmcnt(0)" ::: "memory")
__device__ __forceinline__ unsigned long long rt() { return __builtin_amdgcn_s_memrealtime(); }
__device__ __forceinline__ unsigned f2bf(float f) { unsigned u = __builtin_bit_cast(unsigned, f); return (u + 0x7fffu + ((u >> 16) & 1u)) >> 16; }
__device__ __forceinline__ unsigned pk2(float lo, float hi) { return f2bf(lo) | (f2bf(hi) << 16); }

#define XB_TMO      128
#define XB_XCNT(j)  (256  + 64 * (j))
#define XB_XSUB(j)  (1280 + 64 * (j))
#define XB_XGEN(j)  (2304 + 64 * (j))
#define XB_TOP      3328
#define XB_TOPGEN   3392
#define XCD_BAR_WORDS 3456
#define XB_SPIN_CAP (1u << 18)

__device__ __forceinline__ unsigned xb_ld(unsigned* p)              { return __hip_atomic_load(p, __ATOMIC_RELAXED, __HIP_MEMORY_SCOPE_AGENT); }
__device__ __forceinline__ unsigned xb_add(unsigned* p, unsigned v) { return __hip_atomic_fetch_add(p, v, __ATOMIC_RELAXED, __HIP_MEMORY_SCOPE_AGENT); }
__device__ __forceinline__ unsigned xb_xcc_id() { return (unsigned)__builtin_amdgcn_s_getreg((3 << 11) | 20) & 0xFu; }
#define XB_SPIN(cond, bar) do { unsigned _sp = 0; while (cond) { __builtin_amdgcn_s_sleep(1); \
    if ((++_sp & 255u) == 0u) { if (xb_ld(&(bar)[XB_TMO])) break; if (_sp > XB_SPIN_CAP) { atomicAdd(&(bar)[XB_TMO], 1u); break; } } } } while (0)

struct XcdBarrier {
    unsigned* bar; unsigned x;
    volatile LAS unsigned* st;
};

__device__ __forceinline__ XcdBarrier xcd_barrier_post(unsigned* bar, volatile LAS unsigned* st) {
    XcdBarrier b; b.bar = bar; b.x = xb_xcc_id(); b.st = st;
    if (threadIdx.x == 0) (void)xb_add(&bar[XB_XCNT(b.x)], 1u);
    return b;
}
__device__ __forceinline__ void xcd_barrier_complete(unsigned* bar, unsigned x, unsigned& nloc, unsigned& nx) {
    const unsigned G = gridDim.x * gridDim.y * gridDim.z;
    unsigned sum, cnt, mine, sp = 0u;
    for (;;) {
        sum = 0u; cnt = 0u; mine = 0u;
#pragma unroll
        for (unsigned j = 0; j < 16; ++j) { const unsigned c = xb_ld(&bar[XB_XCNT(j)]); sum += c; cnt += (c > 0u) ? 1u : 0u; mine = (j == x) ? c : mine; }
        if (sum == G) break;
        __builtin_amdgcn_s_sleep(1);
        if ((++sp & 255u) == 0u) { if (xb_ld(&bar[XB_TMO])) break; if (sp > XB_SPIN_CAP) { atomicAdd(&bar[XB_TMO], 1u); break; } }
    }
    nloc = mine > 0u ? mine : 1u; nx = cnt > 0u ? cnt : 1u;
}

__device__ __forceinline__ void xcd_barrier(const XcdBarrier& b) {
    asm volatile("s_waitcnt vmcnt(0)" ::: "memory");
    __syncthreads();
    if (threadIdx.x == 0) {
        unsigned* bar = b.bar;
        __builtin_amdgcn_s_waitcnt(0);
        unsigned nloc = b.st[0], nx = b.st[1];
        if (nloc == 0u) { xcd_barrier_complete(bar, b.x, nloc, nx); b.st[0] = nloc; b.st[1] = nx; }
        const unsigned old = xb_add(&bar[XB_XSUB(b.x)], 1u);
        const unsigned gen = old / nloc;
        if (old + 1u == (gen + 1u) * nloc) {
            __builtin_amdgcn_fence(__ATOMIC_RELEASE, "agent");
            asm volatile("s_waitcnt vmcnt(0)" ::: "memory");
            const unsigned og = xb_add(&bar[XB_TOP], 1u);
            const unsigned tg = og / nx;
            if (og + 1u == (tg + 1u) * nx) xb_add(&bar[XB_TOPGEN], 1u);
            else XB_SPIN(xb_ld(&bar[XB_TOPGEN]) == tg, bar);
            __builtin_amdgcn_fence(__ATOMIC_ACQUIRE, "agent");
            xb_add(&bar[XB_XGEN(b.x)], 1u);
            asm volatile("s_waitcnt vmcnt(0)" ::: "memory");
        } else {
            XB_SPIN(xb_ld(&bar[XB_XGEN(b.x)]) == gen, bar);
            __builtin_amdgcn_fence(__ATOMIC_ACQUIRE, "agent");
            asm volatile("s_waitcnt vmcnt(0)" ::: "memory");
        }
    }
    __syncthreads();
}

constexpr int D = 2048, SEQ = 16384, M = 32768, DEPTH = 2;
constexpr int NCH = 256;
constexpr int NSEG = 16, CPS = NCH / NSEG;
constexpr int DIN = 8224;
constexpr float RMS_EPS = 1e-6f;
constexpr int NWAVES = 8;
constexpr int NPH = 15;

constexpr size_t MiB = 1u << 20;
constexpr size_t WS_CTL = 0, CTL_ZERO_BYTES = 1 * MiB;
constexpr size_t WS_WIN = 1 * MiB;
constexpr size_t WS_WUPG = 34 * MiB;
constexpr size_t WS_WUPP = 38 * MiB;
constexpr size_t WS_WOUT = 42 * MiB;
constexpr size_t WS_WQ = 50 * MiB;
constexpr size_t WS_POOLW = 58 * MiB;
constexpr size_t WS_SUBK = 58 * MiB + 512 * 1024;
constexpr size_t WS_USC = 59 * MiB, WS_VSC = 59 * MiB + 512 * 1024;
constexpr size_t WS_UTAB = 60 * MiB, WS_VTAB = 124 * MiB;
constexpr size_t WS_H = 188 * MiB;
constexpr size_t WS_POOLED = WS_H, WS_POOLMIX = WS_H + 64 * MiB, WS_SEGL = WS_H + 64 * MiB, WS_SIN = WS_H + 96 * MiB;
constexpr size_t WS_QK = 316 * MiB;
constexpr size_t WS_P = 380 * MiB;
constexpr size_t WS_VT = 444 * MiB;
constexpr size_t WS_R = 508 * MiB;
constexpr size_t WS_MERGED = WS_VT;
constexpr size_t WS_G = 572 * MiB;
constexpr size_t WS_PQ = WS_G, WS_IDX = 700 * MiB, WS_GATE = 716 * MiB;
constexpr size_t WS_AFB = 828 * MiB;
constexpr size_t WS_QE = 832 * MiB;
constexpr size_t WS_GLAOUT = WS_QE;
constexpr size_t WS_KDT = 896 * MiB;
constexpr size_t WS_ATTN = 960 * MiB;
constexpr size_t WS_DEC = 992 * MiB;
constexpr size_t WS_SSP1 = 994 * MiB, WS_SSP2 = 998 * MiB;
constexpr size_t WS_END = 1000 * MiB;
constexpr int CW_BAR = 4096;

constexpr int RING_BYTES = 131072;
constexpr int LDSCTL_OFF = RING_BYTES, MISC_OFF = LDSCTL_OFF + 320;
constexpr int LDS_BYTES = 147456;

typedef unsigned v2u __attribute__((ext_vector_type(2)));
typedef float f32x2 __attribute__((ext_vector_type(2)));
typedef float f32x16 __attribute__((ext_vector_type(16)));
using pg8::pkbf; using pg8::bflo; using pg8::bfhi;
__device__ __forceinline__ float bf2f(bf16 h) { return __builtin_bit_cast(float, (unsigned)h << 16); }
__device__ __forceinline__ bf16 f2bf1(float f) { return (bf16)(pkbf(f, 0.f) & 0xffffu); }
__device__ __forceinline__ float wave_sum(float v) {
#pragma unroll
    for (int o = 1; o < 64; o <<= 1) v += __shfl_xor(v, o);
    return v;
}
__device__ __forceinline__ float wave_max(float v) {
#pragma unroll
    for (int o = 1; o < 64; o <<= 1) v = fmaxf(v, __shfl_xor(v, o));
    return v;
}
__device__ __forceinline__ f32x16 mfma32(bf16x8 a, bf16x8 b, f32x16 c) { return __builtin_amdgcn_mfma_f32_32x32x16_bf16(a, b, c, 0, 0, 0); }
__device__ __forceinline__ bf16x8 mk8(unsigned a, unsigned b, unsigned c, unsigned d) { v4u t = {a, b, c, d}; return __builtin_bit_cast(bf16x8, t); }

#define LDS_BAR() do { asm volatile("s_waitcnt lgkmcnt(0)" ::: "memory"); __builtin_amdgcn_s_barrier(); asm volatile("" ::: "memory"); } while (0)
__device__ __forceinline__ void transpose_item(const float* __restrict__ W, int N, bf16* WT, int ldt, int dst_row0, int k0, int n0, LAS float* scr, int lane, const float* __restrict__ gk = nullptr) {
#pragma unroll
    for (int i = 0; i < 8; ++i) { const int kk = 8 * i + (lane >> 3), c4 = 4 * (lane & 7); f32x4 v = *(const f32x4*)(W + (size_t)(k0 + kk) * N + n0 + c4);
        if (gk) v = v * gk[k0 + kk];
        LAS float* d = scr + kk * 33 + c4; d[0] = v.x; d[1] = v.y; d[2] = v.z; d[3] = v.w; }
    LDS_WAIT(); asm volatile("" ::: "memory");
    const int c = lane & 7;
#pragma unroll
    for (int j = 0; j < 4; ++j) { const int n = (lane >> 3) + 8 * j; const LAS float* s = scr + (8 * c) * 33 + n;
        v4u o; o.x = pkbf(s[0 * 33], s[1 * 33]); o.y = pkbf(s[2 * 33], s[3 * 33]); o.z = pkbf(s[4 * 33], s[5 * 33]); o.w = pkbf(s[6 * 33], s[7 * 33]);
        *(GAS v4u*)(WT + (size_t)(dst_row0 + n) * ldt + k0 + 8 * c) = o; }
    LDS_WAIT(); asm volatile("" ::: "memory");
}
__device__ __forceinline__ void transpose_matrix(const float* W, int K, int N, bf16* WT, LAS float* scr, int lane, int gw, int NGW) {
    const int nblk = N / 32, items = (K / 64) * nblk;
    for (int it = gw; it < items; it += NGW) { const int kb = it / nblk, nb = it % nblk; transpose_item(W, N, WT, K, nb * 32, kb * 64, nb * 32, scr, lane); }
}
__device__ __forceinline__ void table_rows_fp8(const float* __restrict__ T, unsigned* __restrict__ O, float* __restrict__ inv, int rowA, int rowB, int lane, const float* __restrict__ gc = nullptr) {
    const f32x4* sa = (const f32x4*)(T + (size_t)rowA * 2048) + lane; const f32x4* sb = (const f32x4*)(T + (size_t)rowB * 2048) + lane;
    f32x4 va[8], vb[8]; float ama = 0.f, amb = 0.f;
#pragma unroll
    for (int j = 0; j < 8; ++j) { va[j] = sa[64 * j]; vb[j] = sb[64 * j]; }
    if (gc) {
#pragma unroll
        for (int j = 0; j < 8; ++j) { const f32x4 gq = ((const f32x4*)gc)[64 * j + lane]; va[j] = va[j] * gq; vb[j] = vb[j] * gq; } }
#pragma unroll
    for (int j = 0; j < 8; ++j) { ama = fmaxf(ama, fmaxf(fmaxf(fabsf(va[j].x), fabsf(va[j].y)), fmaxf(fabsf(va[j].z), fabsf(va[j].w)))); amb = fmaxf(amb, fmaxf(fmaxf(fabsf(vb[j].x), fabsf(vb[j].y)), fmaxf(fabsf(vb[j].z), fabsf(vb[j].w)))); }
#pragma unroll
    for (int o = 1; o < 64; o <<= 1) { ama = fmaxf(ama, __shfl_xor(ama, o)); amb = fmaxf(amb, __shfl_xor(amb, o)); }
    float ea = (ama > 1e-30f) ? floorf(__log2f(224.f / ama)) : 0.f; ea = fminf(fmaxf(ea, -60.f), 60.f);
    float eb = (amb > 1e-30f) ? floorf(__log2f(224.f / amb)) : 0.f; eb = fminf(fmaxf(eb, -60.f), 60.f);
    const float sca = exp2f(ea), scb = exp2f(eb);
#pragma unroll
    for (int j = 0; j < 8; ++j) { const int dw = 64 * j + lane; int w = 0;
        w = __builtin_amdgcn_cvt_pk_fp8_f32(va[j].x * sca, va[j].y * sca, w, false); w = __builtin_amdgcn_cvt_pk_fp8_f32(va[j].z * sca, va[j].w * sca, w, true);
        O[((size_t)(dw >> 5) * 16384 + rowA) * 32 + (dw & 31)] = (unsigned)w; w = 0;
        w = __builtin_amdgcn_cvt_pk_fp8_f32(vb[j].x * scb, vb[j].y * scb, w, false); w = __builtin_amdgcn_cvt_pk_fp8_f32(vb[j].z * scb, vb[j].w * scb, w, true);
        O[((size_t)(dw >> 5) * 16384 + rowB) * 32 + (dw & 31)] = (unsigned)w; }
    if (lane == 0) { inv[rowA] = exp2f(-ea); inv[rowB] = exp2f(-eb); }
}
__device__ __forceinline__ void rmsnorm_row(const float* xrow, const float* __restrict__ g, bf16* orow, int lane) {
    const f32x4* xr = (const f32x4*)xrow + lane; const f32x4* gr = (const f32x4*)g + lane;
    f32x4 v[8]; float s = 0.f;
#pragma unroll
    for (int j = 0; j < 8; ++j) { v[j] = xr[64 * j]; s += (v[j].x * v[j].x + v[j].y * v[j].y) + (v[j].z * v[j].z + v[j].w * v[j].w); }
    const float rs = rsqrtf(wave_sum(s) * (1.f / 2048.f) + RMS_EPS);
    v2u* o8 = (v2u*)orow + lane;
#pragma unroll
    for (int j = 0; j < 8; ++j) { const f32x4 gg = gr[64 * j]; v2u o; o.x = pkbf(v[j].x * rs * gg.x, v[j].y * rs * gg.y); o.y = pkbf(v[j].z * rs * gg.z, v[j].w * rs * gg.w); o8[64 * j] = o; }
}

constexpr int PA_A = 0, PA_QT = 4096, PA_Q = 8192, PA_K = PA_Q + 17408, PA_KE = PA_K + 17408, PA_BYTES = PA_KE + 17408;
static_assert(2 * PA_BYTES <= RING_BYTES, "prep LDS");
struct PrepIn { f32x4 a; unsigned q[8], k[8]; float wg[2][16]; float bias[2]; };
__device__ __forceinline__ void gla_prep_load(PrepIn& in, int uid, const bf16* __restrict__ QK, const float* __restrict__ AFB, const float* __restrict__ Wgf, const float* __restrict__ Bgf,
                                              const float* __restrict__ Wgb, const float* __restrict__ Bgb, int tid) {
    const int dir = uid & 1, h = (uid >> 1) & 3, bn = uid >> 3; const size_t row0 = (size_t)bn * 64;
    const float* Wg = dir ? Wgb : Wgf; const float* Bg = dir ? Bgb : Bgf;
    { const int t = (tid & 255) >> 2, q4 = tid & 3; in.a = *(const f32x4*)(AFB + (row0 + t) * 32 + dir * 16 + 4 * q4); }
    const int c2 = tid & 63, tq = tid >> 6;
#pragma unroll
    for (int j = 0; j < 8; ++j) { const bf16* src = QK + (row0 + tq * 8 + j) * 1024 + h * 128 + 2 * c2; in.q[j] = *(const unsigned*)src; in.k[j] = *(const unsigned*)(src + 512); }
#pragma unroll
    for (int r = 0; r < 16; ++r) { const f32x2 w2 = *(const f32x2*)(Wg + r * 512 + h * 128 + 2 * c2); in.wg[0][r] = w2.x; in.wg[1][r] = w2.y; }
    { const f32x2 b2 = *(const f32x2*)(Bg + h * 128 + 2 * c2); in.bias[0] = b2.x; in.bias[1] = b2.y; }
}
__device__ __forceinline__ void gla_prep_unit(int uid, int uid_next, PrepIn& in, LAS unsigned char* lds, const bf16* __restrict__ QK, const float* __restrict__ AFB, const float* __restrict__ Wgf, const float* __restrict__ Bgf,
                                              const float* __restrict__ Wgb, const float* __restrict__ Bgb, bf16* QE, bf16* KDT, bf16* ATTN, float* DEC, int tid, int wave, int lane) {
    const int dir = uid & 1;
    LAS float* aS = (LAS float*)(lds + PA_A); LAS float* qtot = (LAS float*)(lds + PA_QT);
    LAS bf16* qS = (LAS bf16*)(lds + PA_Q); LAS bf16* kS = (LAS bf16*)(lds + PA_K); LAS bf16* keS = (LAS bf16*)(lds + PA_KE);
    if (tid < 256) { const int t = tid >> 2, q4 = tid & 3; *(LAS f32x4*)(aS + t * 16 + 4 * q4) = in.a; }
    const int c2 = tid & 63, tq = tid >> 6;
    unsigned qv[8], kv[8]; float wg0[16], wg1[16];
#pragma unroll
    for (int j = 0; j < 8; ++j) { qv[j] = in.q[j]; kv[j] = in.k[j]; }
#pragma unroll
    for (int r = 0; r < 16; ++r) { wg0[r] = in.wg[0][r]; wg1[r] = in.wg[1][r]; }
    const float bias0 = in.bias[0], bias1 = in.bias[1];
    gla_prep_load(in, uid_next, QK, AFB, Wgf, Bgf, Wgb, Bgb, tid);
    LDS_BAR();
    float lg0[8], lg1[8], P0[8], P1[8]; float run0 = 0.f, run1 = 0.f;
#pragma unroll
    for (int j = 0; j < 8; ++j) { const int t = tq * 8 + j;
        const f32x4 a0 = *(const LAS f32x4*)(aS + t * 16), a1 = *(const LAS f32x4*)(aS + t * 16 + 4), a2 = *(const LAS f32x4*)(aS + t * 16 + 8), a3 = *(const LAS f32x4*)(aS + t * 16 + 12);
        f32x2 z2 = {bias0, bias1};
        const float av[16] = {a0.x, a0.y, a0.z, a0.w, a1.x, a1.y, a1.z, a1.w, a2.x, a2.y, a2.z, a2.w, a3.x, a3.y, a3.z, a3.w};
#pragma unroll
        for (int r2 = 0; r2 < 16; ++r2) z2 = __builtin_elementwise_fma((f32x2){av[r2], av[r2]}, (f32x2){wg0[r2], wg1[r2]}, z2);
        const float z0 = z2.x, z1 = z2.y;
        lg0[j] = (fminf(z0, 0.f) - __logf(1.f + __expf(-fabsf(z0)))) * (1.f / 16.f); lg1[j] = (fminf(z1, 0.f) - __logf(1.f + __expf(-fabsf(z1)))) * (1.f / 16.f);
        run0 += lg0[j]; run1 += lg1[j]; P0[j] = run0; P1[j] = run1; }
    *(LAS f32x2*)(qtot + tq * 128 + 2 * c2) = (f32x2){run0, run1};
    LDS_BAR();
    float btot0 = 0.f, btot1 = 0.f, off0 = 0.f, off1 = 0.f;
#pragma unroll
    for (int g8 = 0; g8 < 8; ++g8) { const f32x2 v = *(const LAS f32x2*)(qtot + g8 * 128 + 2 * c2); btot0 += v.x; btot1 += v.y;
        const bool before = dir ? (g8 > tq) : (g8 < tq); off0 += before ? v.x : 0.f; off1 += before ? v.y : 0.f; }
    const float dt0 = __expf(btot0), dt1 = __expf(btot1);
    if (tq == 0) *(f32x2*)(DEC + (size_t)uid * 128 + 2 * c2) = (f32x2){dt0, dt1};
#pragma unroll
    for (int j = 0; j < 8; ++j) { const int t = tq * 8 + j;
        const float b0 = (dir ? (run0 - P0[j] + lg0[j]) : P0[j]) + off0, b1 = (dir ? (run1 - P1[j] + lg1[j]) : P1[j]) + off1;
        const float q0 = bflo(qv[j]), q1 = bfhi(qv[j]), k0 = bflo(kv[j]), k1 = bfhi(kv[j]);
        const float e0 = __expf(b0), e1 = __expf(b1), i0 = __builtin_amdgcn_rcpf(e0), i1 = __builtin_amdgcn_rcpf(e1);
        *(LAS unsigned*)(qS + t * 136 + 2 * c2) = pkbf(q0 * e0, q1 * e1);
        *(LAS unsigned*)(keS + t * 136 + 2 * c2) = pkbf(k0 * i0, k1 * i1);
        *(LAS unsigned*)(kS + t * 136 + 2 * c2) = pkbf(k0 * (dt0 * i0), k1 * (dt1 * i1)); }
    LDS_BAR();
    const int r = lane & 31, hh = lane >> 5;
    if (wave < 4) {
        const int jt = wave >> 1, it = wave & 1;
        f32x16 acc;
#pragma unroll
        for (int e = 0; e < 16; ++e) acc[e] = 0.f;
#pragma unroll
        for (int s = 0; s < 8; ++s) { const bf16x8 A = *(const LAS bf16x8*)(keS + (32 * jt + r) * 136 + 16 * s + 8 * hh); const bf16x8 B = *(const LAS bf16x8*)(qS + (32 * it + r) * 136 + 16 * s + 8 * hh); acc = mfma32(A, B, acc); }
        const int i = 32 * it + r; float v[16];
#pragma unroll
        for (int e = 0; e < 16; ++e) { const int j = 32 * jt + (e & 3) + 8 * (e >> 2) + 4 * hh; const bool keep = dir ? (j > i) : (j <= i); v[e] = keep ? acc[e] : 0.f; }
#pragma unroll
        for (int s2 = 0; s2 < 2; ++s2) { v4u o; o.x = pkbf(v[8 * s2 + 0], v[8 * s2 + 1]); o.y = pkbf(v[8 * s2 + 2], v[8 * s2 + 3]); o.z = pkbf(v[8 * s2 + 4], v[8 * s2 + 5]); o.w = pkbf(v[8 * s2 + 6], v[8 * s2 + 7]);
            *(v4u*)(ATTN + (size_t)uid * 4096 + (size_t)((it * 4 + 2 * jt + s2) * 64 + lane) * 8) = o; }
    }
#pragma unroll
    for (int e = 0; e < 2; ++e) { const int f = wave * 2 + e;
        {
            const int it = f >> 3, ks = f & 7, dt = ks >> 1, s2 = ks & 1;
            const LAS bf16* base = qS + (32 * it + r) * 136 + 32 * dt + 16 * s2 + 4 * hh;
            const v2u lo = *(const LAS v2u*)base, hi = *(const LAS v2u*)(base + 8);
            v4u o = {lo.x, lo.y, hi.x, hi.y};
            *(v4u*)(QE + (size_t)uid * 8192 + (size_t)(f * 64 + lane) * 8) = o; }
        {
            const int dt = f >> 2, ks = f & 3, dim = 32 * dt + r;
            unsigned w[4];
#pragma unroll
            for (int p2 = 0; p2 < 4; ++p2) { const int j0 = 2 * p2, j1 = 2 * p2 + 1;
                const int t0 = 16 * ks + 8 * (j0 >> 2) + 4 * hh + (j0 & 3), t1 = 16 * ks + 8 * (j1 >> 2) + 4 * hh + (j1 & 3);
                w[p2] = (unsigned)kS[t0 * 136 + dim] | ((unsigned)kS[t1 * 136 + dim] << 16); }
            v4u o = {w[0], w[1], w[2], w[3]};
            *(v4u*)(KDT + (size_t)uid * 8192 + (size_t)(f * 64 + lane) * 8) = o; }
    }
}

__device__ __forceinline__ void pool_item(int item, const bf16* __restrict__ P, bf16* __restrict__ PO) {
    const int oct = item & 127, run = item >> 7; const int m0 = run * 32, b = m0 >> 14, t0 = m0 & (SEQ - 1);
    const int g = oct >> 5, hw = 1 << g;
    const bf16* Pb = P + (size_t)b * SEQ * 1024 + oct * 8; bf16* Ob = PO + (size_t)b * SEQ * 1024 + oct * 8;
    float s[8];
#pragma unroll
    for (int e = 0; e < 8; ++e) s[e] = 0.f;
    const int lo0 = (t0 - hw > 0) ? t0 - hw : 0, hi0 = (t0 + hw < SEQ) ? t0 + hw : SEQ;
    for (int u = lo0; u < hi0; ++u) { const v4u w = *(const v4u*)(Pb + (size_t)u * 1024);
        s[0] += bflo(w.x); s[1] += bfhi(w.x); s[2] += bflo(w.y); s[3] += bfhi(w.y); s[4] += bflo(w.z); s[5] += bfhi(w.z); s[6] += bflo(w.w); s[7] += bfhi(w.w); }
    for (int t = t0; t < t0 + 32; ++t) {
        const int lo = (t - hw > 0) ? t - hw : 0, hi = (t + hw < SEQ) ? t + hw : SEQ; const float ic = 1.f / (float)(hi - lo);
        const v4u w = *(const v4u*)(Pb + (size_t)t * 1024);
        v4u o; o.x = pkbf(s[0] * ic - bflo(w.x), s[1] * ic - bfhi(w.x)); o.y = pkbf(s[2] * ic - bflo(w.y), s[3] * ic - bfhi(w.y));
        o.z = pkbf(s[4] * ic - bflo(w.z), s[5] * ic - bfhi(w.z)); o.w = pkbf(s[6] * ic - bflo(w.w), s[7] * ic - bfhi(w.w));
        *(v4u*)(Ob + (size_t)t * 1024) = o;
        if (t - hw >= 0) { const v4u x = *(const v4u*)(Pb + (size_t)(t - hw) * 1024);
            s[0] -= bflo(x.x); s[1] -= bfhi(x.x); s[2] -= bflo(x.y); s[3] -= bfhi(x.y); s[4] -= bflo(x.z); s[5] -= bfhi(x.z); s[6] -= bflo(x.w); s[7] -= bfhi(x.w); }
        if (t + hw < SEQ) { const v4u x = *(const v4u*)(Pb + (size_t)(t + hw) * 1024);
            s[0] += bflo(x.x); s[1] += bfhi(x.x); s[2] += bflo(x.y); s[3] += bfhi(x.y); s[4] += bflo(x.z); s[5] += bfhi(x.z); s[6] += bflo(x.w); s[7] += bfhi(x.w); }
    }
}

constexpr int SB_QE = 0, SB_AT = 16384, SB_KD = 24576, SB_DEC = 40960, SB_BYTES = 41472;
template <bool FULL> __device__ __forceinline__ void gla_scan_block(int su, LAS unsigned char* lds, const bf16* __restrict__ QE, const bf16* __restrict__ ATTN, const bf16* __restrict__ KDT,
                                                                    const float* __restrict__ DEC, const bf16* __restrict__ VT, float* SEGL, float* SEGD, bf16* OF, bf16* OB,
                                                                    int tid, int wave, int lane) {
    const int bhd = su / NSEG, seg = su % NSEG, dir = bhd & 1, h = (bhd >> 1) & 3, b = bhd >> 3;
    const int r = lane & 31, hh = lane >> 5, w = wave;
    f32x16 st[4];
    if (FULL) {
#pragma unroll
        for (int dt = 0; dt < 4; ++dt)
#pragma unroll
            for (int e = 0; e < 16; ++e) st[dt][e] = 0.f;
        for (int sp = 0; sp < seg; ++sp) { const int su2 = bhd * NSEG + sp;
#pragma unroll
            for (int dt = 0; dt < 4; ++dt) {
#pragma unroll
                for (int q = 0; q < 4; ++q) { const f32x4 d4 = *(const f32x4*)(SEGD + (size_t)su2 * 128 + 32 * dt + 8 * q + 4 * hh);
                    const size_t i0 = ((size_t)((su2 * 8 + w) * 4 + dt) * 16 + 4 * q) * 64 + lane;
                    st[dt][4 * q + 0] = d4.x * st[dt][4 * q + 0] + SEGL[i0]; st[dt][4 * q + 1] = d4.y * st[dt][4 * q + 1] + SEGL[i0 + 64];
                    st[dt][4 * q + 2] = d4.z * st[dt][4 * q + 2] + SEGL[i0 + 128]; st[dt][4 * q + 3] = d4.w * st[dt][4 * q + 3] + SEGL[i0 + 192]; } } }
    } else {
#pragma unroll
        for (int dt = 0; dt < 4; ++dt)
#pragma unroll
            for (int e = 0; e < 16; ++e) st[dt][e] = 0.f;
    }
    v4u sg[5]; v4u sdec; v2u vn[8]; bf16x8 vc[4];
#define SCAN_UID(i_) ({ const int sp_ = seg * CPS + (i_); const int n_ = dir ? (NCH - 1 - sp_) : sp_; (((b * NCH + n_) * 4 + h) * 2 + dir); })
#define SCAN_LOAD(i_) do { const int uid_ = SCAN_UID(i_); \
        if (FULL) { sg[0] = *(const v4u*)(QE + (size_t)uid_ * 8192 + (size_t)tid * 8); sg[1] = *(const v4u*)(QE + (size_t)uid_ * 8192 + (size_t)(tid + 512) * 8); \
                    sg[2] = *(const v4u*)(ATTN + (size_t)uid_ * 4096 + (size_t)tid * 8); } \
        sg[3] = *(const v4u*)(KDT + (size_t)uid_ * 8192 + (size_t)tid * 8); sg[4] = *(const v4u*)(KDT + (size_t)uid_ * 8192 + (size_t)(tid + 512) * 8); \
        if (tid < 32) sdec = *(const v4u*)(DEC + (size_t)uid_ * 128 + tid * 4); \
        const bf16* vb_ = VT + ((size_t)(uid_ >> 3) * 1024 + h * 256 + 32 * w + r) * 64 + 4 * hh; \
        _Pragma("unroll") for (int ks_ = 0; ks_ < 4; ++ks_) { vn[2 * ks_] = *(const v2u*)(vb_ + 16 * ks_); vn[2 * ks_ + 1] = *(const v2u*)(vb_ + 16 * ks_ + 8); } } while (0)
#define SCAN_STORE(buf_) do { LAS unsigned char* B_ = lds + (buf_) * SB_BYTES; \
        if (FULL) { *(LAS v4u*)(B_ + SB_QE + tid * 16) = sg[0]; *(LAS v4u*)(B_ + SB_QE + (tid + 512) * 16) = sg[1]; *(LAS v4u*)(B_ + SB_AT + tid * 16) = sg[2]; } \
        *(LAS v4u*)(B_ + SB_KD + tid * 16) = sg[3]; *(LAS v4u*)(B_ + SB_KD + (tid + 512) * 16) = sg[4]; \
        if (tid < 32) *(LAS v4u*)(B_ + SB_DEC + tid * 16) = sdec; \
        _Pragma("unroll") for (int ks_ = 0; ks_ < 4; ++ks_) vc[ks_] = mk8(vn[2 * ks_].x, vn[2 * ks_].y, vn[2 * ks_ + 1].x, vn[2 * ks_ + 1].y); } while (0)
    float dprod = 1.f;
    LDS_BAR();
    SCAN_LOAD(0); SCAN_STORE(0);
    LDS_BAR();
    for (int i = 0; i < CPS; ++i) {
        const bool more = (i + 1 < CPS);
        if (more) SCAN_LOAD(i + 1);
        const LAS unsigned char* B = lds + (i & 1) * SB_BYTES;
        if (FULL) {
            f32x16 o0, o1;
#pragma unroll
            for (int e = 0; e < 16; ++e) { o0[e] = 0.f; o1[e] = 0.f; }
#pragma unroll
            for (int dt = 0; dt < 4; ++dt)
#pragma unroll
                for (int s2 = 0; s2 < 2; ++s2) { const int ks = 2 * dt + s2;
                    const bf16x8 sf = mk8(pkbf(st[dt][8 * s2 + 0], st[dt][8 * s2 + 1]), pkbf(st[dt][8 * s2 + 2], st[dt][8 * s2 + 3]), pkbf(st[dt][8 * s2 + 4], st[dt][8 * s2 + 5]), pkbf(st[dt][8 * s2 + 6], st[dt][8 * s2 + 7]));
                    const bf16x8 a0 = *(const LAS bf16x8*)(B + SB_QE + ((0 * 8 + ks) * 64 + lane) * 16); const bf16x8 a1 = *(const LAS bf16x8*)(B + SB_QE + ((1 * 8 + ks) * 64 + lane) * 16);
                    o0 = mfma32(a0, sf, o0); o1 = mfma32(a1, sf, o1); }
#pragma unroll
            for (int ks = 0; ks < 4; ++ks) { const bf16x8 a0 = *(const LAS bf16x8*)(B + SB_AT + ((0 * 4 + ks) * 64 + lane) * 16); const bf16x8 a1 = *(const LAS bf16x8*)(B + SB_AT + ((1 * 4 + ks) * 64 + lane) * 16);
                o0 = mfma32(a0, vc[ks], o0); o1 = mfma32(a1, vc[ks], o1); }
            const int uid = SCAN_UID(i);
            bf16* Ob = (dir ? OB : OF) + (size_t)(uid >> 3) * 64 * 1024 + h * 256 + 32 * w + r;
#pragma unroll
            for (int e = 0; e < 16; ++e) { const int tk = (e & 3) + 8 * (e >> 2) + 4 * hh; Ob[(size_t)tk * 1024] = f2bf1(o0[e]); Ob[(size_t)(32 + tk) * 1024] = f2bf1(o1[e]); }
        }
#pragma unroll
        for (int dt = 0; dt < 4; ++dt) {
#pragma unroll
            for (int q = 0; q < 4; ++q) { const f32x4 d4 = *(const LAS f32x4*)(B + SB_DEC + (32 * dt + 8 * q + 4 * hh) * 4);
                st[dt][4 * q + 0] *= d4.x; st[dt][4 * q + 1] *= d4.y; st[dt][4 * q + 2] *= d4.z; st[dt][4 * q + 3] *= d4.w; }
#pragma unroll
            for (int ks = 0; ks < 4; ++ks) { const bf16x8 a = *(const LAS bf16x8*)(B + SB_KD + ((dt * 4 + ks) * 64 + lane) * 16); st[dt] = mfma32(a, vc[ks], st[dt]); }
        }
        if (!FULL && tid < 128) dprod *= *(const LAS float*)(B + SB_DEC + tid * 4);
        if (more) SCAN_STORE((i + 1) & 1);
        LDS_BAR();
    }
    if (!FULL) {
#pragma unroll
        for (int dt = 0; dt < 4; ++dt)
#pragma unroll
            for (int e = 0; e < 16; ++e) SEGL[((size_t)((su * 8 + w) * 4 + dt) * 16 + e) * 64 + lane] = st[dt][e];
        if (tid < 128) SEGD[(size_t)su * 128 + tid] = dprod;
    }
#undef SCAN_UID
#undef SCAN_LOAD
#undef SCAN_STORE
}
struct FinIn { v4u f0, f1, b0, b1, r0, r1; };
__device__ __forceinline__ void gla_fin_load(FinIn& in, int m, const bf16* __restrict__ OF, const bf16* __restrict__ OB, const bf16* __restrict__ R, int lane) {
    const size_t p = (size_t)m * 1024 + 16 * lane;
    in.f0 = *(const v4u*)(OF + p); in.f1 = *(const v4u*)(OF + p + 8); in.b0 = *(const v4u*)(OB + p); in.b1 = *(const v4u*)(OB + p + 8); in.r0 = *(const v4u*)(R + p); in.r1 = *(const v4u*)(R + p + 8);
}
__device__ __forceinline__ void gla_fin_row(const FinIn& in, int m, const float (&gg)[16], bf16* GO, int lane) {
    const size_t p = (size_t)m * 1024 + 16 * lane;
    const v4u f0 = in.f0, f1 = in.f1, b0 = in.b0, b1 = in.b1, r0 = in.r0, r1 = in.r1;
    float o[16], rr[16];
#define UNP(dst, w0, w1) do { dst[0] = bflo(w0.x); dst[1] = bfhi(w0.x); dst[2] = bflo(w0.y); dst[3] = bfhi(w0.y); dst[4] = bflo(w0.z); dst[5] = bfhi(w0.z); dst[6] = bflo(w0.w); dst[7] = bfhi(w0.w); \
        dst[8] = bflo(w1.x); dst[9] = bfhi(w1.x); dst[10] = bflo(w1.y); dst[11] = bfhi(w1.y); dst[12] = bflo(w1.z); dst[13] = bfhi(w1.z); dst[14] = bflo(w1.w); dst[15] = bfhi(w1.w); } while (0)
    float t[16]; UNP(o, f0, f1); UNP(t, b0, b1); UNP(rr, r0, r1);
#undef UNP
    float ss = 0.f;
#pragma unroll
    for (int e = 0; e < 16; ++e) { o[e] += t[e]; ss += o[e] * o[e]; }
    ss += __shfl_xor(ss, 1); ss += __shfl_xor(ss, 2); ss += __shfl_xor(ss, 4); ss += __shfl_xor(ss, 8);
    const float rs = rsqrtf(ss * (1.f / 256.f) + RMS_EPS);
    unsigned w[8];
#pragma unroll
    for (int e = 0; e < 8; ++e) w[e] = pkbf(o[2 * e] * rs * gg[2 * e] * rr[2 * e], o[2 * e + 1] * rs * gg[2 * e + 1] * rr[2 * e + 1]);
    v4u o0 = {w[0], w[1], w[2], w[3]}, o1 = {w[4], w[5], w[6], w[7]};
    *(v4u*)(GO + p) = o0; *(v4u*)(GO + p + 8) = o1;
}
__device__ __forceinline__ unsigned sortable(float f) { const unsigned b = __builtin_bit_cast(unsigned, f); return b ^ ((unsigned)((int)b >> 31) | 0x80000000u); }
__device__ __forceinline__ float unsortable(unsigned u) { const unsigned b = (u & 0x80000000u) ? (u ^ 0x80000000u) : ~u; return __builtin_bit_cast(float, b); }
__device__ __forceinline__ unsigned umax3(unsigned a, unsigned b, unsigned c) { return max(max(a, b), c); }
__device__ __forceinline__ void ce_desc(unsigned& a, unsigned& b) { const unsigned hi = max(a, b), lo = min(a, b); a = hi; b = lo; }
__device__ __forceinline__ void bitonic_sort16_desc(unsigned (&x)[16]) {
#pragma unroll
    for (int k = 2; k <= 16; k <<= 1)
#pragma unroll
        for (int j = k >> 1; j > 0; j >>= 1)
#pragma unroll
            for (int i = 0; i < 16; ++i) { const int l = i ^ j; if (l > i) { if ((i & k) == 0) ce_desc(x[i], x[l]); else ce_desc(x[l], x[i]); } }
}
__device__ __forceinline__ void bitonic_merge16_desc(unsigned (&x)[16]) {
#pragma unroll
    for (int j = 8; j > 0; j >>= 1)
#pragma unroll
        for (int i = 0; i < 16; ++i) { const int l = i ^ j; if (l > i) ce_desc(x[i], x[l]); }
}
__device__ __forceinline__ void topmerge16(unsigned (&a)[16], const unsigned (&b)[16]) {
#pragma unroll
    for (int i = 0; i < 16; ++i) a[i] = max(a[i], b[15 - i]);
    bitonic_merge16_desc(a);
}
__device__ __forceinline__ void peer_half_topk(int p, int h, const LAS unsigned char* sk, const bf16* __restrict__ PQ, size_t tok, int lane, unsigned (&Lp)[16]) {
    const int hh = lane >> 5;
    const bf16* qp = PQ + tok * 2048 + h * 256 + p * 128 + 8 * hh;
    bf16x8 bq[8];
#pragma unroll
    for (int s = 0; s < 8; ++s) bq[s] = *(const bf16x8*)(qp + 16 * s);
    unsigned key[64];
#pragma unroll
    for (int nt = 0; nt < 4; ++nt) { f32x16 sc;
#pragma unroll
        for (int e = 0; e < 16; ++e) sc[e] = 0.f;
#pragma unroll
        for (int s = 0; s < 8; ++s) { const bf16x8 a = *(const LAS bf16x8*)(sk + (((p * 4 + nt) * 8 + s) * 64 + lane) * 16); sc = mfma32(a, bq[s], sc); }
#pragma unroll
        for (int e = 0; e < 16; ++e) { const int n = 32 * nt + (e & 3) + 8 * (e >> 2) + 4 * hh; key[nt * 16 + e] = (sortable(sc[e]) & ~127u) | (unsigned)(127 - n); } }
    unsigned g0[16], g1[16], g2[16], g3[16];
#pragma unroll
    for (int e = 0; e < 16; ++e) { g0[e] = key[e]; g1[e] = key[16 + e]; g2[e] = key[32 + e]; g3[e] = key[48 + e]; }
    bitonic_sort16_desc(g0); bitonic_sort16_desc(g1); bitonic_sort16_desc(g2); bitonic_sort16_desc(g3);
    topmerge16(g0, g1); topmerge16(g2, g3); topmerge16(g0, g2);
#pragma unroll
    for (int e = 0; e < 16; ++e) g1[e] = (unsigned)__shfl_xor((int)g0[e], 32);
    topmerge16(g0, g1);
#pragma unroll
    for (int e = 0; e < 16; ++e) Lp[e] = g0[e];
}
__device__ __forceinline__ void peer_topk_item(int tile, int h, const LAS unsigned char* sk  , const bf16* __restrict__ PQ, unsigned short* IDX, float* GATE, int lane) {
    const int r = lane & 31, hh = lane >> 5; const size_t tok = (size_t)tile * 32 + r;
    unsigned L[2][16];
    peer_half_topk(0, h, sk, PQ, tok, lane, L[0]);
    __builtin_amdgcn_sched_barrier(0);
#pragma unroll
    for (int a = 0; a < 16; ++a) asm volatile("" : "+v"(L[0][a]));
    peer_half_topk(1, h, sk, PQ, tok, lane, L[1]);
    __builtin_amdgcn_sched_barrier(0);
#pragma unroll
    for (int a = 0; a < 16; ++a) asm volatile("" : "+v"(L[1][a]));
    float v0[16], v1[16];
#pragma unroll
    for (int a = 0; a < 16; ++a) { v0[a] = unsortable(L[0][a] & ~127u); v1[a] = unsortable(L[1][a] & ~127u); }
#define CKEY(a_, b_) ((sortable(v0[a_] + v1[b_]) & ~255u) | (unsigned)(255 - ((a_) * 16 + (b_))))
    unsigned R[16], T[16];
#pragma unroll
    for (int b2 = 0; b2 < 16; ++b2) R[b2] = CKEY(0, b2);
#define ROWMERGE(a_, n_) do { _Pragma("unroll") for (int b2 = 0; b2 < 16; ++b2) T[b2] = (b2 < (n_)) ? CKEY(a_, (b2 < (n_) ? b2 : 0)) : 0u; topmerge16(R, T); } while (0)
    ROWMERGE(1, 8); ROWMERGE(2, 5); ROWMERGE(3, 4); ROWMERGE(4, 3); ROWMERGE(5, 2); ROWMERGE(6, 2); ROWMERGE(7, 2);
#pragma unroll
    for (int b2 = 0; b2 < 16; ++b2) T[b2] = (b2 < 8) ? CKEY((b2 < 8 ? 8 + b2 : 8), 0) : 0u;
    topmerge16(R, T);
#undef ROWMERGE
#undef CKEY
    unsigned bk[16];
#pragma unroll
    for (int rd = 0; rd < 16; ++rd) bk[rd] = R[rd];
    float gs[16]; unsigned ex[16]; float Z = 0.f; const float s0 = unsortable(bk[0] & ~255u);
#pragma unroll
    for (int k = 0; k < 16; ++k) { const unsigned flat = 255u - (bk[k] & 255u), a = flat >> 4, b2 = flat & 15u;
        unsigned k1 = 0u, k2 = 0u;
#pragma unroll
        for (int a2 = 0; a2 < 16; ++a2) { k1 = (a == (unsigned)a2) ? L[0][a2] : k1; k2 = (b2 == (unsigned)a2) ? L[1][a2] : k2; }
        ex[k] = (127u - (k1 & 127u)) * 128u + (127u - (k2 & 127u));
        gs[k] = __expf(unsortable(bk[k] & ~255u) - s0); Z += gs[k]; }
    const float iz = 1.f / Z;
    if (hh == 0) {
        unsigned short* ip = IDX + (tok * 8 + h) * 16; float* gp = GATE + (tok * 8 + h) * 16;
        v4u i0 = {ex[0] | (ex[1] << 16), ex[2] | (ex[3] << 16), ex[4] | (ex[5] << 16), ex[6] | (ex[7] << 16)}, i1 = {ex[8] | (ex[9] << 16), ex[10] | (ex[11] << 16), ex[12] | (ex[13] << 16), ex[14] | (ex[15] << 16)};
        *(v4u*)ip = i0; *(v4u*)(ip + 8) = i1;
#pragma unroll
        for (int q = 0; q < 4; ++q) { f32x4 o = {gs[4 * q] * iz, gs[4 * q + 1] * iz, gs[4 * q + 2] * iz, gs[4 * q + 3] * iz}; *(f32x4*)(gp + 4 * q) = o; }
    }
}

__device__ __forceinline__ f32x2 dot16_fp8(const v4u w, const f32x2* hv2, f32x2 s) {
#pragma unroll
    for (int d = 0; d < 4; ++d) { const f32x2 lo = __builtin_amdgcn_cvt_pk_f32_fp8((int)w[d], false), hi = __builtin_amdgcn_cvt_pk_f32_fp8((int)w[d], true);
        s = __builtin_elementwise_fma(lo, hv2[2 * d], s); s = __builtin_elementwise_fma(hi, hv2[2 * d + 1], s); }
    return s;
}
__device__ __forceinline__ float dot16_fp8_bf(const v4u w, const v4u h0, const v4u h1) {
    const unsigned hx[8] = {h0.x, h0.y, h0.z, h0.w, h1.x, h1.y, h1.z, h1.w};
    float s = 0.f;
#pragma unroll
    for (int d = 0; d < 4; ++d) { const pg8::bf16x2_t lo = __builtin_amdgcn_cvt_scalef32_pk_bf16_fp8((int)w[d], 1.0f, false), hi = __builtin_amdgcn_cvt_scalef32_pk_bf16_fp8((int)w[d], 1.0f, true);
        s = __builtin_amdgcn_fdot2_f32_bf16(lo, __builtin_bit_cast(pg8::bf16x2_t, hx[2 * d]), s, false); s = __builtin_amdgcn_fdot2_f32_bf16(hi, __builtin_bit_cast(pg8::bf16x2_t, hx[2 * d + 1]), s, false); }
    return s;
}
__device__ __forceinline__ void axpy16_fp8(const v4u w, const f32x2 a2, f32x2* acc2) {
#pragma unroll
    for (int d = 0; d < 4; ++d) { const f32x2 lo = __builtin_amdgcn_cvt_pk_f32_fp8((int)w[d], false), hi = __builtin_amdgcn_cvt_pk_f32_fp8((int)w[d], true);
        acc2[2 * d] = __builtin_elementwise_fma(lo, a2, acc2[2 * d]); acc2[2 * d + 1] = __builtin_elementwise_fma(hi, a2, acc2[2 * d + 1]); }
}
__device__ __forceinline__ float gelu_erf(float x) { return 0.5f * x * (1.f + erff(x * 0.70710678118654752f)); }
template <int CTRL> __device__ __forceinline__ float dppf(float v) { return __builtin_bit_cast(float, __builtin_amdgcn_update_dpp(0, __builtin_bit_cast(int, v), CTRL, 0xF, 0xF, true)); }
__device__ __forceinline__ void swap32(float& a, float& b) { asm("s_nop 1\n\tv_permlane32_swap_b32 %0, %1" : "+v"(a), "+v"(b)); }
__device__ __forceinline__ void swap16(float& a, float& b) { asm("s_nop 1\n\tv_permlane16_swap_b32 %0, %1" : "+v"(a), "+v"(b)); }
__device__ __forceinline__ float wave_sum_valu(float v) {
    v += dppf<0xB1>(v); v += dppf<0x4E>(v); v += dppf<0x141>(v); v += dppf<0x140>(v);
    float a = v, b = v; swap16(a, b); v = a + b; a = v; b = v; swap32(a, b); return a + b;
}
__device__ __forceinline__ float sum8(float v) { v += dppf<0xB1>(v); v += dppf<0x4E>(v); v += dppf<0x141>(v); return v; }
struct PMeta { v4u ia, ib, o0, o1, o2, o3; f32x2 x1; };
__device__ __forceinline__ void peer_meta(PMeta& m, size_t tok, const unsigned short* __restrict__ IDX, int g) {
    m.ia = *(const v4u*)(IDX + tok * 128 + g * 16); m.ib = *(const v4u*)(IDX + tok * 128 + g * 16 + 8);
}
template <bool VP> __device__ __forceinline__ void peer_issue(PMeta& m, v4u (&w)[16], const unsigned char* __restrict__ tb, size_t tok, int sl, const bf16* __restrict__ XB, const float* __restrict__ ACT, const float* X, int g, int i, int c) {
    const unsigned iw[8] = {m.ia.x, m.ia.y, m.ia.z, m.ia.w, m.ib.x, m.ib.y, m.ib.z, m.ib.w}; const unsigned o16 = 16u * (unsigned)i;
#pragma unroll
    for (int q = 0; q < 16; ++q) { const unsigned e = (iw[q >> 1] >> (16 * (q & 1))) & 0xffffu; w[q] = *(const v4u*)(tb + ((e << 7) | o16)); }
    if (VP) { const v4u* ap = (const v4u*)(ACT + tok * 128 + g * 16); m.o0 = ap[0]; m.o1 = ap[1]; m.o2 = ap[2]; m.o3 = ap[3]; m.x1 = *(const f32x2*)(X + tok * 2048 + c); }
    else { const bf16* hp = XB + tok * 2048 + sl * 128 + 16 * i; m.o0 = *(const v4u*)hp; m.o1 = *(const v4u*)(hp + 8); }
}
__device__ __forceinline__ void peer_u_compute(const PMeta& m, const v4u (&w)[16], size_t tok, int label, int sub, float* PART, int g, int i) {
    const v4u h0 = m.o0, h1 = m.o1;
    float v[16];
#pragma unroll
    for (int q = 0; q < 16; ++q) v[q] = dot16_fp8_bf(w[q], h0, h1);
    const bool up1 = (i & 4) != 0, up2 = (i & 2) != 0, up3 = (i & 1) != 0;
    float a[8], b[4], c[2];
#pragma unroll
    for (int k = 0; k < 8; ++k) { const float send = up1 ? v[k] : v[k + 8], keep = up1 ? v[k + 8] : v[k]; a[k] = keep + dppf<0x141>(send); }
#pragma unroll
    for (int k = 0; k < 4; ++k) { const float send = up2 ? a[k] : a[k + 4], keep = up2 ? a[k + 4] : a[k]; b[k] = keep + dppf<0x4E>(send); }
#pragma unroll
    for (int k = 0; k < 2; ++k) { const float send = up3 ? b[k] : b[k + 2], keep = up3 ? b[k + 2] : b[k]; c[k] = keep + dppf<0xB1>(send); }
    *(unsigned*)((bf16*)PART + ((size_t)(2 * label + sub) * M + tok) * 128 + g * 16 + 2 * i) = pkbf(c[0], c[1]);
}
template <bool VP> __device__ __forceinline__ void peer_slice_loop(int sl, int label, int sub, int tok0, int tstep, const bf16* __restrict__ XB, const float* __restrict__ ACT, const unsigned short* __restrict__ IDX,
                                                                   const unsigned char* __restrict__ TAB, float* PART, float* X, bf16* XBn, const float* __restrict__ gn, float* ssn, int lane) {
    const int g = lane >> 3, i = lane & 7;
    const int j = ((lane >> 5) & 1) * 4 + ((lane >> 4) & 1) * 2 + ((lane >> 3) & 1), c = sl * 128 + 16 * i + 2 * j;
    const unsigned char* tb = TAB + (size_t)sl * (16384 * 128);
    f32x2 gg = {0.f, 0.f}; if (VP) gg = *(const f32x2*)(gn + c);
    if (tok0 >= M) return;
    const int NT = (M - tok0 + tstep - 1) / tstep;
#define PS_TOK(k_) ((size_t)(tok0 + ((k_) < NT ? (k_) : NT - 1) * tstep))
    PMeta mA, mB, mN; v4u wA[16], wB[16];
    peer_meta(mA, PS_TOK(0), IDX, g); peer_meta(mB, PS_TOK(1), IDX, g);
    asm volatile("" : "+v"(mB.ia), "+v"(mB.ib));
    peer_issue<VP>(mA, wA, tb, PS_TOK(0), sl, XB, ACT, X, g, i, c);
    int k = 0;
    for (; k + 1 < NT; k += 2) {
        peer_meta(mN, PS_TOK(k + 2), IDX, g);
        asm volatile("" ::: "memory");
        peer_issue<VP>(mB, wB, tb, PS_TOK(k + 1), sl, XB, ACT, X, g, i, c);
        asm volatile("" ::: "memory");
        peer_u_compute(mA, wA, PS_TOK(k), label, sub, PART, g, i);
        asm volatile("" ::: "memory");
        mA.ia = mN.ia; mA.ib = mN.ib;
        peer_meta(mN, PS_TOK(k + 3), IDX, g);
        asm volatile("" ::: "memory");
        peer_issue<VP>(mA, wA, tb, PS_TOK(k + 2), sl, XB, ACT, X, g, i, c);
        asm volatile("" ::: "memory");
        peer_u_compute(mB, wB, PS_TOK(k + 1), label, sub, PART, g, i);
        asm volatile("" ::: "memory");
        mB.ia = mN.ia; mB.ib = mN.ib;
    }
    if (k < NT) { peer_u_compute(mA, wA, PS_TOK(k), label, sub, PART, g, i); }
#undef PS_TOK
}
__device__ __forceinline__ void peer_combine_row(size_t tok, const float* __restrict__ PART, const unsigned short* __restrict__ IDX, const float* __restrict__ GATE, const float* __restrict__ USC, const float* __restrict__ VSC,
                                                 const float* __restrict__ ss, float* ACT, int lane) {
    float sv = ss[(tok + (lane >> 5)) * 32 + (lane & 31)];
    sv += __shfl_xor(sv, 1); sv += __shfl_xor(sv, 2); sv += __shfl_xor(sv, 4); sv += __shfl_xor(sv, 8); sv += __shfl_xor(sv, 16);
    const float rsv = rsqrtf(sv * (1.f / 2048.f) + RMS_EPS);
    const float rs[2] = {__shfl(rsv, 0), __shfl(rsv, 32)};
    f32x2 sum[2]; unsigned ew[2]; f32x2 gt[2]; unsigned pv[2][16];
#pragma unroll
    for (int t = 0; t < 2; ++t) { const size_t p = (tok + t) * 128 + 2 * lane;
        ew[t] = *(const unsigned*)(IDX + p); gt[t] = *(const f32x2*)(GATE + p);
#pragma unroll
        for (int lab = 0; lab < 16; ++lab) pv[t][lab] = *(const unsigned*)((const bf16*)PART + (size_t)lab * M * 128 + p); }
#pragma unroll
    for (int t = 0; t < 2; ++t) { sum[t] = (f32x2){0.f, 0.f};
#pragma unroll
        for (int lab = 0; lab < 16; ++lab) sum[t] = sum[t] + (f32x2){bflo(pv[t][lab]), bfhi(pv[t][lab])}; }
#pragma unroll
    for (int t = 0; t < 2; ++t) { const size_t p = (tok + t) * 128 + 2 * lane; const int e0 = ew[t] & 0xffff, e1 = ew[t] >> 16;
        *(unsigned*)((bf16*)ACT + p) = pkbf(gelu_erf(sum[t].x * rs[t] * USC[e0]) * gt[t].x * VSC[e0], gelu_erf(sum[t].y * rs[t] * USC[e1]) * gt[t].y * VSC[e1]); }
}
struct VMeta { v4u ia, ib; v4u a0, a1; f32x2 x1; };
__device__ __forceinline__ void peer_v_idx(VMeta& m, size_t tok, const unsigned short* __restrict__ IDX, int g) { m.ia = *(const v4u*)(IDX + tok * 128 + g * 16); m.ib = *(const v4u*)(IDX + tok * 128 + g * 16 + 8); }
__device__ __forceinline__ void peer_v_issue(VMeta& m, v4u (&w)[16], const unsigned char* __restrict__ vb, size_t tok, const float* __restrict__ ACT, const bf16* XB1, int g, int c) {
    const unsigned iw[8] = {m.ia.x, m.ia.y, m.ia.z, m.ia.w, m.ib.x, m.ib.y, m.ib.z, m.ib.w};
#pragma unroll
    for (int q = 0; q < 16; ++q) { const unsigned e = (iw[q >> 1] >> (16 * (q & 1))) & 0xffffu; w[q] = *(const v4u*)(vb + (size_t)e * 128); }
    const v4u* ap = (const v4u*)((const bf16*)ACT + tok * 128 + g * 16); m.a0 = ap[0]; m.a1 = ap[1];
    { const unsigned xw = *(const unsigned*)(XB1 + tok * 2048 + c); m.x1 = (f32x2){bflo(xw), bfhi(xw)}; }
}
template <bool WB> __device__ __forceinline__ void peer_v_fin(const VMeta& m, const v4u (&w)[16], size_t tok, int sl, float* X, bf16* XBn, const f32x2 gg, float* ssn, int lane, int c) {
    const v4u a0 = m.a0, a1 = m.a1;
    const float av[16] = {bflo(a0.x), bfhi(a0.x), bflo(a0.y), bfhi(a0.y), bflo(a0.z), bfhi(a0.z), bflo(a0.w), bfhi(a0.w), bflo(a1.x), bfhi(a1.x), bflo(a1.y), bfhi(a1.y), bflo(a1.z), bfhi(a1.z), bflo(a1.w), bfhi(a1.w)};
    f32x2 acc2[8];
#pragma unroll
    for (int k = 0; k < 8; ++k) acc2[k] = (f32x2){0.f, 0.f};
#pragma unroll
    for (int q = 0; q < 16; ++q) { const f32x2 a2v = {av[q], av[q]}; axpy16_fp8(w[q], a2v, acc2); }
#pragma unroll
    for (int k = 0; k < 4; ++k) { float x0 = acc2[k].x, y0 = acc2[k + 4].x, x1 = acc2[k].y, y1 = acc2[k + 4].y; swap32(x0, y0); swap32(x1, y1); acc2[k] = (f32x2){x0 + y0, x1 + y1}; }
#pragma unroll
    for (int k = 0; k < 2; ++k) { float x0 = acc2[k].x, y0 = acc2[k + 2].x, x1 = acc2[k].y, y1 = acc2[k + 2].y; swap16(x0, y0); swap16(x1, y1); acc2[k] = (f32x2){x0 + y0, x1 + y1}; }
    { const bool up = (lane & 8) != 0; const f32x2 send = up ? acc2[0] : acc2[1], keep = up ? acc2[1] : acc2[0];
        acc2[0] = (f32x2){keep.x + dppf<0x128>(send.x), keep.y + dppf<0x128>(send.y)}; }
    const f32x2 x2 = {m.x1.x + acc2[0].x, m.x1.y + acc2[0].y};
    *(f32x2*)(X + tok * 2048 + c) = x2;
    if (WB) *(unsigned*)(XBn + tok * 2048 + c) = pkbf(x2.x * gg.x, x2.y * gg.y);
    const float sq = wave_sum_valu(x2.x * x2.x + x2.y * x2.y);
    ssn[tok * 16 + sl] = sq;
}
template <bool WB> __device__ __forceinline__ void peer_v_loop(int sl, int tok0, int tstep, const float* __restrict__ ACT, const unsigned short* __restrict__ IDX, const unsigned char* __restrict__ V8, float* X, bf16* XBn, const float* __restrict__ gn, float* ssn, int lane) {
    const int g = lane >> 3, i = lane & 7;
    const int j = ((lane >> 5) & 1) * 4 + ((lane >> 4) & 1) * 2 + ((lane >> 3) & 1), c = sl * 128 + 16 * i + 2 * j;
    const unsigned char* vb = V8 + (size_t)sl * (16384 * 128) + 16 * i;
    const f32x2 gg = *(const f32x2*)(gn + c);
    if (tok0 >= M) return;
    const int NT = (M - tok0 + tstep - 1) / tstep;
#define PS_TOK(k_) ((size_t)(tok0 + ((k_) < NT ? (k_) : NT - 1) * tstep))
    VMeta mA, mB, mN; v4u wA[16], wB[16];
    peer_v_idx(mA, PS_TOK(0), IDX, g); peer_v_idx(mB, PS_TOK(1), IDX, g);
    asm volatile("" : "+v"(mB.ia), "+v"(mB.ib));
    peer_v_issue(mA, wA, vb, PS_TOK(0), ACT, XBn, g, c);
    int k = 0;
    for (; k + 1 < NT; k += 2) {
        peer_v_idx(mN, PS_TOK(k + 2), IDX, g);
        asm volatile("" ::: "memory");
        peer_v_issue(mB, wB, vb, PS_TOK(k + 1), ACT, XBn, g, c);
        asm volatile("" ::: "memory");
        peer_v_fin<WB>(mA, wA, PS_TOK(k), sl, X, XBn, gg, ssn, lane, c);
        asm volatile("" ::: "memory");
        mA.ia = mN.ia; mA.ib = mN.ib;
        peer_v_idx(mN, PS_TOK(k + 3), IDX, g);
        asm volatile("" ::: "memory");
        peer_v_issue(mA, wA, vb, PS_TOK(k + 2), ACT, XBn, g, c);
        asm volatile("" ::: "memory");
        peer_v_fin<WB>(mB, wB, PS_TOK(k + 1), sl, X, XBn, gg, ssn, lane, c);
        asm volatile("" ::: "memory");
        mB.ia = mN.ia; mB.ib = mN.ib;
    }
    if (k < NT) peer_v_fin<WB>(mA, wA, PS_TOK(k), sl, X, XBn, gg, ssn, lane, c);
#undef PS_TOK
}
__device__ __forceinline__ void final_norm_row(float* xrow, const float* __restrict__ g, const float* __restrict__ ssp, int lane) {
    const float rs = rsqrtf(wave_sum(lane < 16 ? ssp[lane] : 0.f) * (1.f / 2048.f) + RMS_EPS);
    f32x4* xr = (f32x4*)xrow + lane; const f32x4* gr = (const f32x4*)g + lane;
    f32x4 v[8], gg[8];
#pragma unroll
    for (int jj = 0; jj < 8; ++jj) { v[jj] = xr[64 * jj]; gg[jj] = gr[64 * jj]; }
#pragma unroll
    for (int jj = 0; jj < 8; ++jj) xr[64 * jj] = (f32x4){v[jj].x * rs * gg[jj].x, v[jj].y * rs * gg[jj].y, v[jj].z * rs * gg[jj].z, v[jj].w * rs * gg[jj].w};
}

__device__ __forceinline__ void afb_unit(int unit, const bf16* __restrict__ H, const bf16* __restrict__ Waf, float* AFBo, const float* __restrict__ ss, int lane) {
    const int fr = lane & 15, kq = lane >> 4, row0 = unit * 16;
    const bf16* ap = H + (size_t)(row0 + fr) * 2048 + 8 * kq; const bf16* bp = Waf + (size_t)fr * 2048 + 8 * kq;
    f32x4 c0 = {0.f, 0.f, 0.f, 0.f}, c1 = {0.f, 0.f, 0.f, 0.f};
#pragma unroll 1
    for (int s0 = 0; s0 < 64; s0 += 8) {
        bf16x8 Av[8], Bv[8], Cv[8];
#pragma unroll
        for (int q = 0; q < 8; ++q) { Av[q] = *(const bf16x8*)(ap + 32 * (s0 + q)); Bv[q] = *(const bf16x8*)(bp + 32 * (s0 + q)); Cv[q] = *(const bf16x8*)(bp + 16 * 2048 + 32 * (s0 + q)); }
        asm volatile("" : "+v"(Av[0]), "+v"(Bv[0]), "+v"(Cv[0]), "+v"(Av[7]), "+v"(Bv[7]), "+v"(Cv[7]));
#pragma unroll
        for (int q = 0; q < 8; ++q) { c0 = __builtin_amdgcn_mfma_f32_16x16x32_bf16(Av[q], Bv[q], c0, 0, 0, 0); c1 = __builtin_amdgcn_mfma_f32_16x16x32_bf16(Av[q], Cv[q], c1, 0, 0, 0); }
    }
    const float mine = ss ? pg8::row_rs<16>(ss, row0 + fr) : 1.f;
#pragma unroll
    for (int e = 0; e < 4; ++e) { const int rr = 4 * kq + e; const float sc = __shfl(mine, rr); float* o = AFBo + (size_t)(row0 + rr) * 32 + fr; o[0] = c0[e] * sc; o[16] = c1[e] * sc; }
}
__device__ __forceinline__ const float* gin(const float* p) { const GAS float* g = (const GAS float*)p; asm volatile("" : "+s"(g)); return (const float*)g; }
#ifndef MK_MULTI
#define MK_MULTI 0
#endif
struct Args { const float* in[19]; float* out; unsigned char* ws; int ph_lo, ph_hi, l_lo, l_hi; };
__global__ void __launch_bounds__(NWAVES * 64, 2) fwd_kernel(Args args) {
    extern __shared__ __attribute__((aligned(16))) unsigned char lds[];
    LAS unsigned char* ldsL = (LAS unsigned char*)lds;
    volatile LAS unsigned* MISC = (volatile LAS unsigned*)(ldsL + MISC_OFF);
    const int tid0 = threadIdx.x, wave = __builtin_amdgcn_readfirstlane(tid0 >> 6);
#define PHASE_IDS() int tid = threadIdx.x; asm volatile("" : "+v"(tid)); const int lane = tid & 63; (void)lane; GAS unsigned char* wsp0 = (GAS unsigned char*)args.ws; asm volatile("" : "+s"(wsp0)); unsigned char* wsp = (unsigned char*)wsp0; GAS float* outp0 = (GAS float*)args.out; asm volatile("" : "+s"(outp0)); float* outp = (float*)outp0; int lp = l; asm volatile("" : "+s"(lp)); (void)wsp; (void)outp; (void)lp
    const int G = gridDim.x; const int bx = blockIdx.x; const int vcu = (G % 8 == 0) ? (bx % 8) * (G / 8) + bx / 8 : bx;
    const int gw = vcu * NWAVES + wave, NGW = G * NWAVES;
    unsigned char* ws = args.ws;
    gu32* ctl = (gu32*)(ws + WS_CTL);
    for (int u = tid0; u < (LDS_BYTES - LDSCTL_OFF) / 4; u += NWAVES * 64) ((LAS unsigned*)(ldsL + LDSCTL_OFF))[u] = 0u;
    __syncthreads();
    XcdBarrier bar; bar.bar = (unsigned*)(ctl + CW_BAR); bar.x = 0; bar.st = nullptr;
    if (!MK_MULTI) bar = xcd_barrier_post((unsigned*)(ctl + CW_BAR), MISC + 8);
#define GRID_BAR() do { if (!MK_MULTI) xcd_barrier(bar); } while (0)
    const int lo = args.ph_lo, hi = args.ph_hi;
#ifdef PH_ONLY
#define IN(k) ((k) == PH_ONLY && lo <= (k) && (k) < hi)
#else
#define IN(k) (lo <= (k) && (k) < hi)
#endif
#define BOTH(k) (IN(k) && IN((k) + 1))
#ifndef DUP_MASK
#define DUP_MASK 0
#endif
#define NREP(k) ((((DUP_MASK) >> (k)) & 1) && l == 0 ? 2 : 1)

#define WIN ((bf16*)(wsp + WS_WIN))
#define WUPG ((bf16*)(wsp + WS_WUPG))
#define WUPP ((bf16*)(wsp + WS_WUPP))
#define WOUT ((bf16*)(wsp + WS_WOUT))
#define WQ ((bf16*)(wsp + WS_WQ))
#define POOLW ((bf16*)(wsp + WS_POOLW))
#define SUBK ((bf16*)(wsp + WS_SUBK))
#define Hb ((bf16*)(wsp + WS_H))
#define POOLED ((bf16*)(wsp + WS_POOLED))
#define POOLMIX ((bf16*)(wsp + WS_POOLMIX))
#define QK ((bf16*)(wsp + WS_QK))
#define Pb ((bf16*)(wsp + WS_P))
#define OFb ((bf16*)(wsp + WS_QK))
#define OBb ((bf16*)(wsp + WS_P))
#define VT ((bf16*)(wsp + WS_VT))
#define Rb ((bf16*)(wsp + WS_R))
#define MERGED ((bf16*)(wsp + WS_MERGED))
#define Gb ((bf16*)(wsp + WS_G))
#define PQ ((bf16*)(wsp + WS_PQ))
#define QE ((bf16*)(wsp + WS_QE))
#define GLAOUT ((bf16*)(wsp + WS_GLAOUT))
#define KDT ((bf16*)(wsp + WS_KDT))
#define ATTN ((bf16*)(wsp + WS_ATTN))
#define USC ((float*)(wsp + WS_USC))
#define VSC ((float*)(wsp + WS_VSC))
#define UTAB (wsp + WS_UTAB)
#define VTAB (wsp + WS_VTAB)
#define SEGL ((float*)(wsp + WS_SEGL))
#define SIN ((float*)(wsp + WS_SIN))
#define IDX ((unsigned short*)(wsp + WS_IDX))
#define GATE ((float*)(wsp + WS_GATE))
#define AFB ((float*)(wsp + WS_AFB))
#define DEC ((float*)(wsp + WS_DEC))
#define SSP1 ((float*)(wsp + WS_SSP1))
#define SSP2 ((float*)(wsp + WS_SSP2))
#define PART ((float*)(wsp + WS_QK))
#define ACT ((float*)(wsp + WS_QE))
#define GIN(k_) gin(args.in[k_])
#define x_in ((lp == 0) ? GIN(0) : (const float*)outp)
#define w_in (GIN(2) + (size_t)lp * D * DIN)
#define ssin ((lp == 0) ? (const float*)nullptr : (const float*)SSP2)
#define ss1 SSP1
#define ss2 SSP2
    for (int l = args.l_lo; l < args.l_hi; ++l) {
        if (IN(0)) { PHASE_IDS(); for (int rep = 0; rep < NREP(0); ++rep) {
            LAS float* scr = (LAS float*)(ldsL + wave * 16384);
            { const float* sk = GIN(15) + (size_t)lp * 262144;
              const float* w_upg = GIN(8) + (size_t)lp * 1024 * 2048; const float* w_upp = GIN(11) + (size_t)lp * 1024 * 2048; const float* w_o = GIN(12) + (size_t)lp * 2048 * 2048; const float* w_q = GIN(14) + (size_t)lp * 2048 * 2048;
              const float* w_pool = GIN(9) + (size_t)lp * 4 * 65536;
              constexpr int I_IN = 32 * 257, I_UP = 16 * 64, I_SQ = 32 * 64, I_PL = 4 * 32, I_SK = 512;
              constexpr int E_IN = I_IN, E_UPG = E_IN + I_UP, E_UPP = E_UPG + I_UP, E_O = E_UPP + I_SQ, E_Q = E_O + I_SQ, E_PL = E_Q + I_PL, E_ALL = E_PL + I_SK;
              for (int it0 = gw; it0 < E_ALL; it0 += NGW) { int it = it0;
                if (it < E_IN) { const int kb = it / 257, nb = it % 257, n0 = nb * 32;
                    int d; if (n0 < 1024) d = n0; else if (n0 < 2048) d = n0 + 6400; else if (n0 < 3072) d = n0 - 1024; else if (n0 == 3072) d = 7168; else d = n0 - 1056;
                    transpose_item(w_in, DIN, WIN, 2048, d, kb * 64, n0, scr, lane); }
                else if (it < E_UPG) { it -= E_IN;  transpose_item(w_upg, 2048, WUPG, 1024, (it % 64) * 32, (it / 64) * 64, (it % 64) * 32, scr, lane); }
                else if (it < E_UPP) { it -= E_UPG; transpose_item(w_upp, 2048, WUPP, 1024, (it % 64) * 32, (it / 64) * 64, (it % 64) * 32, scr, lane); }
                else if (it < E_O)   { it -= E_UPP; transpose_item(w_o, 2048, WOUT, 2048, (it % 64) * 32, (it / 64) * 64, (it % 64) * 32, scr, lane); }
                else if (it < E_Q)   { it -= E_O;   transpose_item(w_q, 2048, WQ, 2048, (it % 64) * 32, (it / 64) * 64, (it % 64) * 32, scr, lane, GIN(13) + (size_t)lp * D); }
                else if (it < E_PL)  { it -= E_Q; const int g = it >> 5, r5 = it & 31; transpose_item(w_pool + (size_t)g * 65536, 256, POOLW + (size_t)g * 65536, 256, (r5 % 8) * 32, (r5 / 8) * 64, (r5 % 8) * 32, scr, lane); }
                else { const int f = it - E_PL; const int hp = f >> 5, nt = (f >> 3) & 3, s5 = f & 7, r = lane & 31, hh = lane >> 5;
                    const float* src = sk + ((size_t)hp * 128 + 32 * nt + r) * 128 + 16 * s5 + 8 * hh; const f32x4 a = *(const f32x4*)src, b = *(const f32x4*)(src + 4);
                    v4u o = {pkbf(a.x, a.y), pkbf(a.z, a.w), pkbf(b.x, b.y), pkbf(b.z, b.w)}; *(v4u*)(SUBK + ((size_t)f * 64 + lane) * 8) = o; } } }
            { const float* ut = GIN(16) + (size_t)lp * 16384 * 2048; const float* vt = GIN(17) + (size_t)lp * 16384 * 2048;
              for (int row = gw; row < 16384; row += NGW) { if (row < 8192)
                table_rows_fp8(ut, (unsigned*)UTAB, USC, row, row + 8192, lane, GIN(13) + (size_t)lp * D); else table_rows_fp8(vt, (unsigned*)VTAB, VSC, row - 8192, row, lane); } }
            if (lp == 0) for (int m = gw; m < M; m += NGW) rmsnorm_row(x_in + (size_t)m * D, GIN(1), Hb + (size_t)m * D, lane);
            if (rep + 1 < NREP(0)) GRID_BAR(); }
            if (BOTH(0)) GRID_BAR();
        }
        if (IN(1)) { PHASE_IDS(); for (int rep = 0; rep < NREP(1); ++rep) {
            { pg8::Gemm g{Hb, WIN, M, 7168, 2048, 2048, 2048, 0, nullptr, nullptr}; pg8::StaticOrder S; S.init(M, 7168, G, bx);
              pg8::EpiProj E{QK, Rb, Pb, Gb, AFB, ssin};
              pg8::gemm_phase<pg8::EpiProj, pg8::StaticOrder, true, true>(ldsL, g, S, E); }
            { pg8::Gemm g{WIN + (size_t)7424 * 2048, Hb, 1024, M, 2048, 2048, 2048, 0, nullptr, nullptr}; pg8::StaticOrder S; S.init(1024, M, G, bx);
              pg8::EpiVT E{VT, ssin};
              pg8::gemm_phase<pg8::EpiVT, pg8::StaticOrder, true, true>(ldsL, g, S, E); }
            for (int unit = gw; unit < M / 16; unit += NGW) afb_unit(unit, Hb, WIN + (size_t)7168 * 2048, AFB, ssin, lane);
            if (rep + 1 < NREP(1)) GRID_BAR(); }
            if (BOTH(1)) GRID_BAR();
        }
        if (IN(2)) { PHASE_IDS(); for (int rep = 0; rep < NREP(2); ++rep) {
            if (vcu < 4096) { PrepIn pin; gla_prep_load(pin, vcu, QK, AFB, GIN(3) + (size_t)lp * 8192, GIN(4) + (size_t)lp * 512, GIN(5) + (size_t)lp * 8192, GIN(6) + (size_t)lp * 512, tid);
                __syncthreads();
                int pb = 0;
                for (int uid = vcu; uid < 4096; uid += G, pb ^= 1)
                    gla_prep_unit(uid, (uid + G < 4096) ? uid + G : uid, pin, ldsL + pb * PA_BYTES, QK, AFB, GIN(3) + (size_t)lp * 8192, GIN(4) + (size_t)lp * 512, GIN(5) + (size_t)lp * 8192, GIN(6) + (size_t)lp * 512, QE, KDT, ATTN, DEC, tid, wave, lane);
                __syncthreads(); }
            for (int item = vcu * 512 + tid; item < (M / 32) * 128; item += G * 512) pool_item(item, Pb, POOLED);
            if (rep + 1 < NREP(2)) GRID_BAR(); }
            if (BOTH(2)) GRID_BAR();
        }
        if (IN(3)) { PHASE_IDS(); for (int rep = 0; rep < NREP(3); ++rep) {
            for (int su = vcu; su < 16 * NSEG; su += G) gla_scan_block<false>(su, ldsL, QE, ATTN, KDT, DEC, VT, SEGL, SIN, OFb, OBb, tid, wave, lane);
            if (rep + 1 < NREP(3)) GRID_BAR(); }
            if (BOTH(3)) GRID_BAR();
        }
        if (IN(5)) { PHASE_IDS(); for (int rep = 0; rep < NREP(5); ++rep) {
            for (int su = vcu; su < 16 * NSEG; su += G) gla_scan_block<true>(su, ldsL, QE, ATTN, KDT, DEC, VT, SEGL, SIN, OFb, OBb, tid, wave, lane);
            if (rep + 1 < NREP(5)) GRID_BAR(); }
            if (BOTH(5)) GRID_BAR();
        }
        if (IN(6)) { PHASE_IDS(); for (int rep = 0; rep < NREP(6); ++rep) {
            { float gg[16]; { const f32x4* gp = (const f32x4*)(GIN(7) + (size_t)lp * 1024 + 16 * lane);
#pragma unroll
                for (int q = 0; q < 4; ++q) { const f32x4 x = gp[q]; gg[4 * q] = x.x; gg[4 * q + 1] = x.y; gg[4 * q + 2] = x.z; gg[4 * q + 3] = x.w; } }
              for (int m = gw; m < M; m += 2 * NGW) { const int m2 = (m + NGW < M) ? m + NGW : m;
                  FinIn ia, ib; gla_fin_load(ia, m, OFb, OBb, Rb, lane); gla_fin_load(ib, m2, OFb, OBb, Rb, lane);
                  gla_fin_row(ia, m, gg, GLAOUT, lane); if (m2 != m) gla_fin_row(ib, m2, gg, GLAOUT, lane); } }
            { pg8::Gemm g{POOLED, POOLW, M, 1024, 256, 1024, 256, 512, nullptr, nullptr}; pg8::StaticOrder S; S.init(M, 1024, G, bx);
              pg8::EpiScale<false> E{POOLMIX, 1024, GIN(10) + (size_t)lp * 1024, nullptr};
              pg8::gemm_phase<pg8::EpiScale<false>, pg8::StaticOrder, true, true>(ldsL, g, S, E); }
            if (rep + 1 < NREP(6)) GRID_BAR(); }
            if (BOTH(6)) GRID_BAR();
        }
        if (IN(7)) { PHASE_IDS(); for (int rep = 0; rep < NREP(7); ++rep) {
            { pg8::Gemm g{GLAOUT, WUPG, M, 2048, 1024, 1024, 1024, 0, POOLMIX, WUPP}; pg8::TwoPartOrder S; S.init(M, 2048, G, bx);
              pg8::EpiMerge E{MERGED, (const unsigned char*)Gb};
              pg8::gemm_phase<pg8::EpiMerge, pg8::TwoPartOrder, true, true>(ldsL, g, S, E); }
            if (rep + 1 < NREP(7)) GRID_BAR(); }
            if (BOTH(7)) GRID_BAR();
        }
        if (IN(8)) { PHASE_IDS(); for (int rep = 0; rep < NREP(8); ++rep) {
            { pg8::Gemm g{MERGED, WOUT, M, 2048, 2048, 2048, 2048, 0, nullptr, nullptr}; pg8::StaticOrder S; S.init(M, 2048, G, bx);
              pg8::EpiResid E{x_in, Hb, ss1};
              pg8::gemm_phase<pg8::EpiResid, pg8::StaticOrder, true, true>(ldsL, g, S, E); }
            if (rep + 1 < NREP(8)) GRID_BAR(); }
            if (BOTH(8)) GRID_BAR();
        }
        if (IN(9)) { PHASE_IDS(); for (int rep = 0; rep < NREP(9); ++rep) {
            { pg8::Gemm g{Hb, WQ, M, 2048, 2048, 2048, 2048, 0, nullptr, nullptr}; pg8::StaticOrder S; S.init(M, 2048, G, bx);
              pg8::EpiScale<true> E{PQ, 2048, nullptr, ss1};
              pg8::gemm_phase<pg8::EpiScale<true>, pg8::StaticOrder, true, true>(ldsL, g, S, E); }
            if (rep + 1 < NREP(9)) GRID_BAR(); }
            if (BOTH(9)) GRID_BAR();
        }
        if (IN(10)) { PHASE_IDS(); for (int rep = 0; rep < NREP(10); ++rep) {
            for (int j = 0; j < 4; ++j) {
                __syncthreads();
                for (int i = tid; i < 8192; i += 512) *(LAS v4u*)(ldsL + i * 16) = *(const v4u*)((const unsigned char*)SUBK + (size_t)j * 131072 + (size_t)i * 16);
                __syncthreads();
                const int hsel = wave >> 2, h = 2 * j + hsel;
                for (int tile = vcu * 4 + (wave & 3); tile < M / 32; tile += G * 4) peer_topk_item(tile, h, ldsL + hsel * 65536, PQ, IDX, GATE, lane);
            }
            if (rep + 1 < NREP(10)) GRID_BAR(); }
            if (BOTH(10)) GRID_BAR();
        }
        if (IN(11)) { PHASE_IDS(); for (int rep = 0; rep < NREP(11); ++rep) {
            const int label = bx & 7, rank = bx >> 3, nrank = (G - label + 7) >> 3;
            for (int sub = 0; sub < 2; ++sub)
                peer_slice_loop<false>(2 * label + sub, label, sub, rank * NWAVES + wave, nrank * NWAVES, Hb, ACT, IDX, UTAB, PART, outp, Hb, nullptr, nullptr, lane);
            if (rep + 1 < NREP(11)) GRID_BAR(); }
            if (BOTH(11)) GRID_BAR();
        }
        if (IN(12)) { PHASE_IDS(); for (int rep = 0; rep < NREP(12); ++rep) {
            for (int tok = 2 * gw; tok < M; tok += 2 * NGW) peer_combine_row((size_t)tok, PART, IDX, GATE, USC, VSC, ss1, ACT, lane);
            if (rep + 1 < NREP(12)) GRID_BAR(); }
            if (BOTH(12)) GRID_BAR();
        }
        if (IN(13)) { PHASE_IDS();
            const int last = (lp == DEPTH - 1);
            const float* gn = last ? GIN(18) : GIN(1) + (size_t)(lp + 1) * D;
            const int label = bx & 7, rank = bx >> 3, nrank = (G - label + 7) >> 3;
            for (int sub = 0; sub < 2; ++sub)
                if (last) peer_v_loop<false>(2 * label + sub, rank * NWAVES + wave, nrank * NWAVES, ACT, IDX, VTAB, outp, Hb, gn, ss2, lane);
                else      peer_v_loop<true>(2 * label + sub, rank * NWAVES + wave, nrank * NWAVES, ACT, IDX, VTAB, outp, Hb, gn, ss2, lane);
            if ((BOTH(13) && last) || (lo == 0 && hi == NPH && l + 1 < args.l_hi)) GRID_BAR();
        }
        if (IN(14) && l == DEPTH - 1) { PHASE_IDS();
            for (int m = gw; m < M; m += NGW) final_norm_row(outp + (size_t)m * D, GIN(18), ss2 + (size_t)m * 16, lane);
        }
    }
#undef IN
#undef BOTH
#undef GRID_BAR
}

#undef WIN
#undef WUPG
#undef WUPP
#undef WOUT
#undef WQ
#undef POOLW
#undef SUBK
#undef Hb
#undef POOLED
#undef POOLMIX
#undef QK
#undef Pb
#undef OFb
#undef OBb
#undef VT
#undef Rb
#undef MERGED
#undef Gb
#undef PQ
#undef QE
#undef GLAOUT
#undef KDT
#undef ATTN
#undef USC
#undef VSC
#undef UTAB
#undef VTAB
#undef SEGL
#undef SIN
#undef IDX
#undef GATE
#undef AFB
#undef DEC
#undef SSP1
#undef SSP2
#undef PART
#undef ACT
#undef GIN
#undef x_in
#undef w_in
#undef ssin
#undef ss1
#undef ss2
extern "C" void kernel_launch(void* const* d_in, const int* in_sizes, int n_in, void* d_out, int out_size, void* d_ws, size_t ws_size, hipStream_t stream) {
    static int grid = 0;
    if (grid == 0) {
        if (n_in != 19 || in_sizes[0] != M * D || out_size != M * D || ws_size < WS_END) { fprintf(stderr, "kernel_launch: unexpected shapes / workspace (n_in %d, ws %zu, need %zu); nothing launched\n", n_in, ws_size, (size_t)WS_END); grid = -1; return; }
        int dev = 0, cus = 0, per_cu = 0;
        if (hipGetDevice(&dev) != hipSuccess || hipDeviceGetAttribute(&cus, hipDeviceAttributeMultiprocessorCount, dev) != hipSuccess) { grid = -1; return; }
        if (hipFuncSetAttribute((const void*)fwd_kernel, hipFuncAttributeMaxDynamicSharedMemorySize, LDS_BYTES) != hipSuccess) { fprintf(stderr, "kernel_launch: hipFuncSetAttribute failed\n"); grid = -1; return; }
        if (hipOccupancyMaxActiveBlocksPerMultiprocessor(&per_cu, (const void*)fwd_kernel, NWAVES * 64, LDS_BYTES) != hipSuccess || per_cu < 1) { fprintf(stderr, "kernel_launch: occupancy query reports %d blocks per CU\n", per_cu); }
        (void)hipGetLastError();
        grid = cus;
    }
    if (grid < 0) return;
    if (hipMemsetAsync((char*)d_ws + WS_CTL, 0, CTL_ZERO_BYTES, stream) != hipSuccess) return;
    Args a{};
    for (int i = 0; i < 19; ++i) a.in[i] = (const float*)d_in[i];
    a.out = (float*)d_out; a.ws = (unsigned char*)d_ws;
#if MK_MULTI
    for (int l = 0; l < DEPTH; ++l)
        for (int ph = 0; ph < NPH; ++ph) { a.ph_lo = ph; a.ph_hi = ph + 1; a.l_lo = l; a.l_hi = l + 1;
            hipLaunchKernelGGL(fwd_kernel, dim3(grid), dim3(NWAVES * 64), LDS_BYTES, stream, a); }
#else
    a.ph_lo = 0; a.ph_hi = NPH; a.l_lo = 0; a.l_hi = DEPTH;
    hipLaunchKernelGGL(fwd_kernel, dim3(grid), dim3(NWAVES * 64), LDS_BYTES, stream, a);
#endif
}
```

```cpp
#include <hip/hip_runtime.h>
#include <cstdio>
#include <cstdint>
namespace pg8 {
#define PG8_LAS __attribute__((address_space(3)))
typedef unsigned short bf16_t;
typedef short bf16x8 __attribute__((ext_vector_type(8)));
typedef float f32x4 __attribute__((ext_vector_type(4)));
typedef unsigned u32x4 __attribute__((ext_vector_type(4)));
typedef unsigned u32x2 __attribute__((ext_vector_type(2)));
constexpr int BM = 256, BK = 64, HALF = 128, HTB = HALF * BK * 2  , STAGE_BYTES = 8 * HTB, NXCD = 8, WGM = 8;

__host__ __device__ __forceinline__ int lds_byte(int r, int c) { const int st = (r >> 4) * 2 + (c >> 5), rr = r & 15, cc = c & 31, ob = rr * 64 + cc * 2; return st * 1024 + (ob ^ (((ob >> 9) & 1) << 5)); }
__host__ __device__ __forceinline__ void stage_rc(int b, int& R, int& C) { const int st = b / 1024, sb = b % 1024, swz = sb ^ (((sb >> 9) & 1) << 5); R = (st >> 1) * 16 + swz / 64; C = (st & 1) * 32 + (swz % 64) / 2; }
__host__ __device__ __forceinline__ int perm32(int rho) { const int n = rho >> 4, i = rho & 15; return 8 * (i >> 2) + 4 * n + (i & 3); }

struct Unit { int pm, pn, sub; };
struct Gemm { const bf16_t* A; const bf16_t* Bt; int M, N, K, lda, ldb, a_pn_step; const bf16_t* A2; const bf16_t* Bt2; };

struct StaticOrder {
    int nM, nN, nwg, G, c;
    __host__ __device__ void init(int M, int N, int G_, int c_) { nM = M / BM; nN = N / BM; nwg = nM * nN; G = G_; c = c_; }
    __host__ __device__ bool next(int i, Unit& u) const {
        const long L = (long)i * G + c; if (L >= nwg) return false;
        int wgid = (int)L; { const int q = nwg / NXCD, r = nwg % NXCD, xcd = wgid % NXCD, off = wgid / NXCD; wgid = (xcd < r ? xcd * (q + 1) : r * (q + 1) + (xcd - r) * q) + off; }
        const int nig = WGM * nN, gid = wgid / nig, fm = gid * WGM, gsz = (nM - fm) < WGM ? (nM - fm) : WGM;
        u.pm = fm + ((wgid % nig) % gsz); u.pn = (wgid % nig) / gsz; u.sub = 0; return true;
    }
    __device__ __forceinline__ void a_ready(const Unit&) const {}
    __device__ __forceinline__ void done(const Unit&) const {}
};

struct TwoPartOrder : StaticOrder {
    __host__ __device__ bool next(int i, Unit& u) const { if (!StaticOrder::next(i >> 1, u)) return false; u.sub = i & 1; return true; }
};
typedef float f32x2 __attribute__((ext_vector_type(2)));
typedef __bf16 bf16x2_t __attribute__((ext_vector_type(2)));
__device__ __forceinline__ unsigned pkbf(float lo, float hi) { f32x2 v = {lo, hi}; bf16x2_t b = __builtin_convertvector(v, bf16x2_t); return __builtin_bit_cast(unsigned, b); }
__device__ __forceinline__ float bflo(unsigned w) { return __builtin_bit_cast(float, w << 16); }
__device__ __forceinline__ float bfhi(unsigned w) { return __builtin_bit_cast(float, w & 0xffff0000u); }
__device__ __forceinline__ float fast_sigmoid(float x) { return __builtin_amdgcn_rcpf(1.f + __expf(-x)); }
template <int NP> __device__ __forceinline__ float row_rs(const float* ssp, int row) {
    const f32x4* p = (const f32x4*)(ssp + (size_t)row * NP); f32x4 a = p[0];
#pragma unroll
    for (int k = 1; k < NP / 4; ++k) a = a + p[k];
    return rsqrtf(((a.x + a.y) + (a.z + a.w)) * (1.f / 2048.f) + 1e-6f);
}

template <int NP> __device__ __forceinline__ float row_rs_fq(const float* ssp, int row, int fq) {
    const f32x4* p = (const f32x4*)(ssp + (size_t)row * NP + fq * (NP / 4)); f32x4 a = p[0];
    if (NP == 32) a = a + p[1];
    float t = (a.x + a.y) + (a.z + a.w);
    t += __shfl_xor(t, 16); t += __shfl_xor(t, 32);
    return rsqrtf(t * (1.f / 2048.f) + 1e-6f);
}
template <int NP> __device__ __forceinline__ void row_rs_fq8(const float* ssp, int row0, int fq, float (&rsc)[2][4]) {
#pragma unroll
    for (int ai = 0; ai < 2; ++ai) {
        f32x4 a[4], b[4];
#pragma unroll
        for (int m = 0; m < 4; ++m) { const f32x4* p = (const f32x4*)(ssp + (size_t)(row0 + ai * HALF + m * 16) * NP + fq * (NP / 4)); a[m] = p[0]; if (NP == 32) b[m] = p[1]; }
#pragma unroll
        for (int m = 0; m < 4; ++m) { f32x4 v = a[m]; if (NP == 32) v = v + b[m];
            float t = (v.x + v.y) + (v.z + v.w); t += __shfl_xor(t, 16); t += __shfl_xor(t, 32);
            rsc[ai][m] = rsqrtf(t * (1.f / 2048.f) + 1e-6f); }
    }
}
struct EpiProj {
    static constexpr bool PERM = true, AFTER_DRAIN = false; __device__ static bool keep(const Unit&) { return false; }
    bf16_t *QK, *R, *P, *G; float* AFB; const float* ss;
    __device__ __forceinline__ void operator()(const f32x4 (&acc)[2][2][4][2], const Unit& u, int wr, int wc, int fr, int fq) const {
        const int row0 = u.pm * BM + wr * 64 + fr; const int pn = u.pn;
        float rsc[2][4];
        if (ss) row_rs_fq8<16>(ss, row0, fq, rsc);
        else {
#pragma unroll
            for (int ai = 0; ai < 2; ++ai)
#pragma unroll
                for (int m = 0; m < 4; ++m) rsc[ai][m] = 1.f; }
        bf16_t* base; int ldc, colt, mode;
        if (pn < 4) { base = QK; ldc = 1024; colt = pn * 256; mode = (pn < 2) ? 1 : 0; }
        else if (pn < 8) { base = R; ldc = 1024; colt = (pn - 4) * 256; mode = 2; }
        else if (pn < 12) { base = P; ldc = 1024; colt = (pn - 8) * 256; mode = 0; }
        else { base = G; ldc = 4096; colt = (pn - 12) * 256; mode = 3; }
        const int col0 = colt + wc * 32 + 8 * fq;
#pragma unroll
        for (int ai = 0; ai < 2; ++ai)
#pragma unroll
            for (int m = 0; m < 4; ++m) { bf16_t* rowp = base + (size_t)(row0 + ai * HALF + m * 16) * ldc + col0;
#pragma unroll
                for (int bj = 0; bj < 2; ++bj) { f32x4 v0 = acc[ai][bj][m][0] * rsc[ai][m], v1 = acc[ai][bj][m][1] * rsc[ai][m];
                    if (mode == 1) { v0 = v0 * 0.08838834764831845f; v1 = v1 * 0.08838834764831845f; }
                    else if (mode == 2) {
#pragma unroll
                        for (int e = 0; e < 4; ++e) { v0[e] = v0[e] * fast_sigmoid(v0[e]); v1[e] = v1[e] * fast_sigmoid(v1[e]); } }
                    else if (mode == 3) {
#pragma unroll
                        for (int e = 0; e < 4; ++e) { v0[e] = fast_sigmoid(v0[e]); v1[e] = fast_sigmoid(v1[e]); } }
                    if (mode == 3) { unsigned w0 = 0u, w1 = 0u;
#pragma unroll
                        for (int e = 0; e < 4; ++e) { w0 = __builtin_amdgcn_cvt_pk_u8_f32(__builtin_rintf(v0[e] * 255.f), e, w0); w1 = __builtin_amdgcn_cvt_pk_u8_f32(__builtin_rintf(v1[e] * 255.f), e, w1); }
                        u32x2 w = {w0, w1}; *(u32x2*)((unsigned char*)G + (size_t)(row0 + ai * HALF + m * 16) * 4096 + col0 + bj * HALF) = w; }
                    else {
                    u32x4 w; w.x = pkbf(v0[0], v0[1]); w.y = pkbf(v0[2], v0[3]); w.z = pkbf(v1[0], v1[1]); w.w = pkbf(v1[2], v1[3]);
                    *(u32x4*)(rowp + bj * HALF) = w; } } asm volatile("" ::: "memory"); }
    }
};
struct EpiVT {
    static constexpr bool PERM = true, AFTER_DRAIN = false; __device__ static bool keep(const Unit&) { return false; }
    bf16_t* VT; const float* ss;
    __device__ __forceinline__ void operator()(const f32x4 (&acc)[2][2][4][2], const Unit& u, int wr, int wc, int fr, int fq) const {
        const int dv0 = u.pm * BM + wr * 64 + fr, tok0 = u.pn * BM + wc * 32 + 8 * fq;
        f32x4 cs[2][2];
#pragma unroll
        for (int bj = 0; bj < 2; ++bj)
#pragma unroll
            for (int n = 0; n < 2; ++n) cs[bj][n] = (f32x4){1.f, 1.f, 1.f, 1.f};
        if (ss) { const float mine = row_rs<16>(ss, tok0 + (fr >> 3) * HALF + (fr & 7));
#pragma unroll
            for (int bj = 0; bj < 2; ++bj)
#pragma unroll
                for (int n = 0; n < 2; ++n)
#pragma unroll
                    for (int k = 0; k < 4; ++k) cs[bj][n][k] = __shfl(mine, fq * 16 + bj * 8 + 4 * n + k); }
#pragma unroll
        for (int ai = 0; ai < 2; ++ai)
#pragma unroll
            for (int m = 0; m < 4; ++m) { const int dv = dv0 + ai * HALF + m * 16;
#pragma unroll
                for (int bj = 0; bj < 2; ++bj) { const int tok = tok0 + bj * HALF; const int bc = tok >> 6, tin = tok & 63;
                    const f32x4 v0 = acc[ai][bj][m][0] * cs[bj][0], v1 = acc[ai][bj][m][1] * cs[bj][1];
                    u32x4 w; w.x = pkbf(v0[0], v0[1]); w.y = pkbf(v0[2], v0[3]); w.z = pkbf(v1[0], v1[1]); w.w = pkbf(v1[2], v1[3]);
                    *(u32x4*)(VT + ((size_t)bc * 1024 + dv) * 64 + tin) = w; } }
    }
};
template <bool ROWS> struct EpiScale {
    static constexpr bool PERM = true, AFTER_DRAIN = false; __device__ static bool keep(const Unit&) { return false; }
    bf16_t* O; int ldc; const float* scale; const float* ss;
    __device__ __forceinline__ void operator()(const f32x4 (&acc)[2][2][4][2], const Unit& u, int wr, int wc, int fr, int fq) const {
        const int row0 = u.pm * BM + wr * 64 + fr, col0 = u.pn * BM + wc * 32 + 8 * fq;
        f32x4 sv[2][2];
#pragma unroll
        for (int bj = 0; bj < 2; ++bj)
#pragma unroll
            for (int n = 0; n < 2; ++n) sv[bj][n] = scale ? *(const f32x4*)(scale + col0 + bj * HALF + 4 * n) : (f32x4){1.f, 1.f, 1.f, 1.f};
        float rsc[2][4];
        if (ROWS) row_rs_fq8<32>(ss, row0, fq, rsc);
#pragma unroll
        for (int ai = 0; ai < 2; ++ai)
#pragma unroll
            for (int m = 0; m < 4; ++m) { bf16_t* rowp = O + (size_t)(row0 + ai * HALF + m * 16) * ldc + col0; const float rr = ROWS ? rsc[ai][m] : 1.f;
#pragma unroll
                for (int bj = 0; bj < 2; ++bj) { const f32x4 v0 = acc[ai][bj][m][0] * sv[bj][0] * rr, v1 = acc[ai][bj][m][1] * sv[bj][1] * rr;
                    u32x4 w; w.x = pkbf(v0[0], v0[1]); w.y = pkbf(v0[2], v0[3]); w.z = pkbf(v1[0], v1[1]); w.w = pkbf(v1[2], v1[3]);
                    *(u32x4*)(rowp + bj * HALF) = w; } }
    }
};
template <bool ACCUM> struct EpiGate {
    static constexpr bool PERM = true, AFTER_DRAIN = false; __device__ static bool keep(const Unit&) { return false; }
    bf16_t* O; const bf16_t* Gt;
    __device__ __forceinline__ void operator()(const f32x4 (&acc)[2][2][4][2], const Unit& u, int wr, int wc, int fr, int fq) const {
        const int row0 = u.pm * BM + wr * 64 + fr, col0 = u.pn * BM + wc * 32 + 8 * fq;
#pragma unroll
        for (int ai = 0; ai < 2; ++ai) {
            u32x4 gwv[4][2], owv[4][2];
#pragma unroll
            for (int m = 0; m < 4; ++m)
#pragma unroll
                for (int bj = 0; bj < 2; ++bj) { const size_t row = (size_t)(row0 + ai * HALF + m * 16);
                    gwv[m][bj] = *(const u32x4*)(Gt + row * 4096 + col0 + bj * HALF);
                    if (ACCUM) owv[m][bj] = *(const u32x4*)(O + row * 2048 + col0 + bj * HALF); }
            asm volatile("" ::: "memory");
#pragma unroll
            for (int m = 0; m < 4; ++m) { const size_t row = (size_t)(row0 + ai * HALF + m * 16);
#pragma unroll
                for (int bj = 0; bj < 2; ++bj) { const u32x4 gw = gwv[m][bj];
                    f32x4 v0 = acc[ai][bj][m][0], v1 = acc[ai][bj][m][1];
                    v0[0] *= bflo(gw.x); v0[1] *= bfhi(gw.x); v0[2] *= bflo(gw.y); v0[3] *= bfhi(gw.y); v1[0] *= bflo(gw.z); v1[1] *= bfhi(gw.z); v1[2] *= bflo(gw.w); v1[3] *= bfhi(gw.w);
                    if (ACCUM) { const u32x4 ow = owv[m][bj];
                        v0[0] += bflo(ow.x); v0[1] += bfhi(ow.x); v0[2] += bflo(ow.y); v0[3] += bfhi(ow.y); v1[0] += bflo(ow.z); v1[1] += bfhi(ow.z); v1[2] += bflo(ow.w); v1[3] += bfhi(ow.w); }
                    u32x4 w; w.x = pkbf(v0[0], v0[1]); w.y = pkbf(v0[2], v0[3]); w.z = pkbf(v1[0], v1[1]); w.w = pkbf(v1[2], v1[3]);
                    *(u32x4*)(O + row * 2048 + col0 + bj * HALF) = w; } }
            asm volatile("" ::: "memory");
        }
    }
};
struct EpiMerge {
    static constexpr bool PERM = true, AFTER_DRAIN = false; __device__ static bool keep(const Unit& u) { return u.sub == 0; }
    bf16_t* O; const unsigned char* Gt;
    __device__ __forceinline__ void operator()(f32x4 (&acc)[2][2][4][2], const Unit& u, int wr, int wc, int fr, int fq) const {
        const int row0 = u.pm * BM + wr * 64 + fr, col0 = u.pn * BM + wc * 32 + 8 * fq;
#pragma unroll
        for (int ai = 0; ai < 2; ++ai) {
            u32x2 g1[4][2], g2[4][2];
#pragma unroll
            for (int m = 0; m < 4; ++m)
#pragma unroll
                for (int bj = 0; bj < 2; ++bj) { const size_t p = (size_t)(row0 + ai * HALF + m * 16) * 4096 + col0 + bj * HALF;
                    g2[m][bj] = *(const u32x2*)(Gt + p + 2048); if (u.sub == 0) g1[m][bj] = *(const u32x2*)(Gt + p); }
            asm volatile("" ::: "memory");
#pragma unroll
            for (int m = 0; m < 4; ++m)
#pragma unroll
                for (int bj = 0; bj < 2; ++bj) { const u32x2 b = g2[m][bj];
                    float s2[8];
#pragma unroll
                    for (int e = 0; e < 4; ++e) { s2[e] = (float)((b.x >> (8 * e)) & 255u) * (1.f / 255.f); s2[4 + e] = (float)((b.y >> (8 * e)) & 255u) * (1.f / 255.f); }
#pragma unroll
                    for (int e = 0; e < 8; ++e) s2[e] = fmaxf(s2[e], 8.6736174e-19f);
                    f32x4 v0 = acc[ai][bj][m][0], v1 = acc[ai][bj][m][1];
                    if (u.sub == 0) { const u32x2 a = g1[m][bj];
                        float s1[8];
#pragma unroll
                        for (int e = 0; e < 4; ++e) { s1[e] = (float)((a.x >> (8 * e)) & 255u) * (1.f / 255.f); s1[4 + e] = (float)((a.y >> (8 * e)) & 255u) * (1.f / 255.f); }
#pragma unroll
                        for (int e = 0; e < 4; ++e) { v0[e] *= s1[e] * __builtin_amdgcn_rcpf(s2[e]); v1[e] *= s1[4 + e] * __builtin_amdgcn_rcpf(s2[4 + e]); }
                        acc[ai][bj][m][0] = v0; acc[ai][bj][m][1] = v1;
                    } else {
#pragma unroll
                        for (int e = 0; e < 4; ++e) { v0[e] *= s2[e]; v1[e] *= s2[4 + e]; }
                        u32x4 w; w.x = pkbf(v0[0], v0[1]); w.y = pkbf(v0[2], v0[3]); w.z = pkbf(v1[0], v1[1]); w.w = pkbf(v1[2], v1[3]);
                        *(u32x4*)(O + (size_t)(row0 + ai * HALF + m * 16) * 2048 + col0 + bj * HALF) = w; } }
            asm volatile("" ::: "memory");
        }
    }
};
template <bool XBF> struct EpiResid {
    static constexpr bool PERM = true, AFTER_DRAIN = false; __device__ static bool keep(const Unit&) { return false; }
    const void* xin; bf16_t* XB; float* ss;
    __device__ __forceinline__ void operator()(const f32x4 (&acc)[2][2][4][2], const Unit& u, int wr, int wc, int fr, int fq) const {
        const int row0 = u.pm * BM + wr * 64 + fr, col0 = u.pn * BM + wc * 32 + 8 * fq;
#pragma unroll
        for (int h4 = 0; h4 < 4; ++h4) { const int ai = h4 >> 1, mb = (h4 & 1) * 2;
            f32x4 xv[2][2][2];
            if constexpr (XBF) {
                u32x4 xb[2][2];
#pragma unroll
                for (int mm = 0; mm < 2; ++mm)
#pragma unroll
                    for (int bj = 0; bj < 2; ++bj) { const size_t p = (size_t)(row0 + ai * HALF + (mb + mm) * 16) * 2048 + col0 + bj * HALF; xb[mm][bj] = *(const u32x4*)((const bf16_t*)xin + p); }
                asm volatile("" ::: "memory");
#pragma unroll
                for (int mm = 0; mm < 2; ++mm)
#pragma unroll
                    for (int bj = 0; bj < 2; ++bj) { const u32x4 w = xb[mm][bj]; xv[mm][bj][0] = (f32x4){bflo(w.x), bfhi(w.x), bflo(w.y), bfhi(w.y)}; xv[mm][bj][1] = (f32x4){bflo(w.z), bfhi(w.z), bflo(w.w), bfhi(w.w)}; }
            } else {
#pragma unroll
                for (int mm = 0; mm < 2; ++mm)
#pragma unroll
                    for (int bj = 0; bj < 2; ++bj) { const size_t p = (size_t)(row0 + ai * HALF + (mb + mm) * 16) * 2048 + col0 + bj * HALF; xv[mm][bj][0] = *(const f32x4*)((const float*)xin + p); xv[mm][bj][1] = *(const f32x4*)((const float*)xin + p + 4); }
                asm volatile("" ::: "memory");
            }
#pragma unroll
            for (int mm = 0; mm < 2; ++mm) { const int m = mb + mm; const int row = row0 + ai * HALF + m * 16; const size_t rb = (size_t)row * 2048 + col0; float sq = 0.f;
#pragma unroll
                for (int bj = 0; bj < 2; ++bj) { const size_t p = rb + bj * HALF;
                    const f32x4 x0 = xv[mm][bj][0] + acc[ai][bj][m][0], x1 = xv[mm][bj][1] + acc[ai][bj][m][1];
                    sq += (x0.x * x0.x + x0.y * x0.y) + (x0.z * x0.z + x0.w * x0.w) + (x1.x * x1.x + x1.y * x1.y) + (x1.z * x1.z + x1.w * x1.w);
                    u32x4 w; w.x = pkbf(x0[0], x0[1]); w.y = pkbf(x0[2], x0[3]); w.z = pkbf(x1[0], x1[1]); w.w = pkbf(x1[2], x1[3]);
                    *(u32x4*)(XB + p) = w; }
                sq += __shfl_xor(sq, 16); sq += __shfl_xor(sq, 32);
                if (fq == 0) ss[(size_t)row * 32 + u.pn * 4 + wc] = sq; }
            asm volatile("" ::: "memory");
        }
    }
};

template <class Epi, class Sched, bool ALIGN_EPI = false, bool SP2 = false>
__device__ __forceinline__ void gemm_phase(PG8_LAS unsigned char* lds, const Gemm g, const Sched& S, const Epi& E) {
    int tid_o = threadIdx.x; asm volatile("" : "+v"(tid_o));
    const int tid = tid_o, wid = __builtin_amdgcn_readfirstlane(tid >> 6), lane = tid & 63, wr = wid >> 2, wc = wid & 3, fr = lane & 15, fq = lane >> 4;
    int K_o = g.K; asm volatile("" : "+s"(K_o));
    const int K = K_o, nt = K / BK;
    unsigned voffA[2], voffB[2];
#pragma unroll
    for (int i = 0; i < 2; ++i) { int R, C; stage_rc(tid * 16 + i * 8192, R, C); const int Rb = Epi::PERM ? ((R & ~31) + perm32(R & 31)) : R;
        voffA[i] = (unsigned)(R * g.lda + C) * 2u; voffB[i] = (unsigned)(Rb * g.ldb + C) * 2u; }
    const size_t kstep = (size_t)(BK * 2);
    const size_t hstepA = (size_t)HALF * g.lda * 2, hstepB = (size_t)HALF * g.ldb * 2;
    const size_t tstepA = 2 * hstepA, tstepB = 2 * hstepB;
    const unsigned ldsw = (unsigned)wid * 1024u;
    const int aoff = lds_byte(wr * 64 + fr, fq * 8), boff = lds_byte(wc * 32 + fr, fq * 8);
#define PG8_SA(b, h) (((b) * 2 + (h)) * HTB)
#define PG8_SB(b, h) ((4 + (b) * 2 + (h)) * HTB)
#define PG8_STAGE(bufoff, gbase, voff) do { _Pragma("unroll") for (int _i = 0; _i < 2; ++_i) \
        __builtin_amdgcn_global_load_lds((const unsigned*)((const char*)(gbase) + (voff)[_i]), (PG8_LAS unsigned*)(lds + (bufoff) + ldsw + _i * 8192), 16, 0, 0); } while (0)
#define PG8_LDA(dst, b, h) do { _Pragma("unroll") for (int m = 0; m < 4; ++m) _Pragma("unroll") for (int k = 0; k < 2; ++k) dst[m][k] = *(const PG8_LAS bf16x8*)(lds + PG8_SA(b, h) + aoff + m * 2048 + k * 1024); } while (0)
#define PG8_LDB(dst, b, h) do { _Pragma("unroll") for (int n = 0; n < 2; ++n) _Pragma("unroll") for (int k = 0; k < 2; ++k) dst[n][k] = *(const PG8_LAS bf16x8*)(lds + PG8_SB(b, h) + boff + n * 2048 + k * 1024); } while (0)
#define PG8_MMA(ai, bj, At, Bt) do { __builtin_amdgcn_s_setprio(1); _Pragma("unroll") for (int m = 0; m < 4; ++m) _Pragma("unroll") for (int n = 0; n < 2; ++n) _Pragma("unroll") for (int k = 0; k < 2; ++k) \
        acc[ai][bj][m][n] = __builtin_amdgcn_mfma_f32_16x16x32_bf16(Bt[n][k], At[m][k], acc[ai][bj][m][n], 0, 0, 0); __builtin_amdgcn_s_setprio(0); } while (0)
#define PG8_WAIT_V(n) asm volatile("s_waitcnt vmcnt(" #n ")" ::: "memory")
#define PG8_WAIT_L(n) asm volatile("s_waitcnt lgkmcnt(" #n ")" ::: "memory")
#define PG8_BAR __builtin_amdgcn_s_barrier()
#define PG8_SCHED __builtin_amdgcn_sched_barrier(0)
    Unit cur, nxt; int ui = 0;
    if (!S.next(0, cur)) return;
    f32x4 acc[2][2][4][2];
    float zf = 0.f; asm volatile("" : "+v"(zf));
#pragma unroll
    for (int a = 0; a < 2; ++a)
#pragma unroll
        for (int b = 0; b < 2; ++b)
#pragma unroll
            for (int m = 0; m < 4; ++m)
#pragma unroll
                for (int n = 0; n < 2; ++n) acc[a][b][m][n] = (f32x4){zf, zf, zf, zf};
    bf16x8 At[4][2], B0[2][2], B1[2][2];
    const char* cA = (const char*)(cur.sub ? g.A2 : g.A) + (size_t)cur.pm * tstepA + (size_t)cur.pn * g.a_pn_step; const char* cB = (const char*)(cur.sub ? g.Bt2 : g.Bt) + (size_t)cur.pn * tstepB;
    S.a_ready(cur);
    if constexpr (SP2) {
        PG8_STAGE(PG8_SB(0, 0), cB, voffB); PG8_STAGE(PG8_SB(0, 1), cB + hstepB, voffB); PG8_STAGE(PG8_SA(0, 0), cA, voffA); PG8_STAGE(PG8_SA(0, 1), cA + hstepA, voffA);
        if (wr == 1) PG8_BAR;
        PG8_WAIT_V(2); PG8_BAR;
        PG8_STAGE(PG8_SB(1, 0), cB + kstep, voffB); PG8_STAGE(PG8_SA(1, 0), cA + kstep, voffA); PG8_STAGE(PG8_SB(1, 1), cB + hstepB + kstep, voffB);
        PG8_WAIT_V(6); PG8_BAR;
    } else {
        PG8_STAGE(PG8_SB(0, 0), cB, voffB); PG8_STAGE(PG8_SA(0, 0), cA, voffA); PG8_STAGE(PG8_SB(0, 1), cB + hstepB, voffB); PG8_STAGE(PG8_SA(0, 1), cA + hstepA, voffA);
        if (wr == 1) PG8_BAR;
        PG8_WAIT_V(4); PG8_BAR;
        PG8_STAGE(PG8_SB(1, 0), cB + kstep, voffB); PG8_STAGE(PG8_SA(1, 0), cA + kstep, voffA); PG8_STAGE(PG8_SB(1, 1), cB + hstepB + kstep, voffB);
        PG8_WAIT_V(6); PG8_BAR;
    }
    for (;;) {
        const bool has_next = S.next(ui + 1, nxt);
        const char* nA = has_next ? (const char*)(nxt.sub ? g.A2 : g.A) + (size_t)nxt.pm * tstepA + (size_t)nxt.pn * g.a_pn_step : cA; const char* nB = has_next ? (const char*)(nxt.sub ? g.Bt2 : g.Bt) + (size_t)nxt.pn * tstepB : cB;
        for (int t = 0; t < nt; t += 2) {
            const bool last = (t == nt - 2);
            const char* a1 = cA + (size_t)(t + 1) * kstep;
            const char* a2 = last ? nA : cA + (size_t)(t + 2) * kstep; const char* b2 = last ? nB : cB + (size_t)(t + 2) * kstep;
            const char* a3 = a2 + kstep; const char* b3 = b2 + kstep;
            if (last && has_next) S.a_ready(nxt);
            if constexpr (SP2) {
            PG8_LDB(B0, 0, 0); PG8_LDB(B1, 0, 1); PG8_SCHED; PG8_LDA(At, 0, 0); PG8_STAGE(PG8_SA(1, 1), a1 + hstepA, voffA);
            PG8_WAIT_V(8); PG8_WAIT_L(0); PG8_BAR; PG8_MMA(0, 0, At, B0); PG8_MMA(0, 1, At, B1); PG8_BAR; PG8_SCHED;
            PG8_LDA(At, 0, 1); PG8_STAGE(PG8_SB(0, 0), b2, voffB); PG8_STAGE(PG8_SB(0, 1), b2 + hstepB, voffB); PG8_STAGE(PG8_SA(0, 0), a2, voffA);
            PG8_WAIT_V(8); PG8_WAIT_L(0); PG8_BAR; PG8_MMA(1, 0, At, B0); PG8_MMA(1, 1, At, B1); PG8_BAR; PG8_SCHED;
            PG8_LDB(B0, 1, 0); PG8_LDB(B1, 1, 1); PG8_SCHED; PG8_LDA(At, 1, 0); PG8_STAGE(PG8_SA(0, 1), a2 + hstepA, voffA);
            PG8_WAIT_V(8); PG8_WAIT_L(0); PG8_BAR; PG8_MMA(0, 0, At, B0); PG8_MMA(0, 1, At, B1); PG8_BAR; PG8_SCHED;
            PG8_LDA(At, 1, 1); PG8_STAGE(PG8_SB(1, 0), b3, voffB); PG8_STAGE(PG8_SB(1, 1), b3 + hstepB, voffB); PG8_STAGE(PG8_SA(1, 0), a3, voffA);
            PG8_WAIT_V(8); PG8_WAIT_L(0); PG8_BAR; PG8_MMA(1, 0, At, B0); PG8_MMA(1, 1, At, B1); PG8_BAR; PG8_SCHED;
            } else {
            PG8_LDB(B0, 0, 0); PG8_SCHED; PG8_LDA(At, 0, 0); PG8_STAGE(PG8_SA(1, 1), a1 + hstepA, voffA);
            PG8_WAIT_L(8); PG8_BAR; PG8_WAIT_L(0); PG8_MMA(0, 0, At, B0); PG8_BAR; PG8_SCHED;
            PG8_LDB(B1, 0, 1); PG8_STAGE(PG8_SB(0, 0), b2, voffB);
            PG8_BAR; PG8_WAIT_L(0); PG8_MMA(0, 1, At, B1); PG8_BAR;
            PG8_LDA(At, 0, 1); PG8_STAGE(PG8_SA(0, 0), a2, voffA);
            PG8_BAR; PG8_WAIT_L(0); PG8_MMA(1, 0, At, B0); PG8_BAR; PG8_SCHED;
            PG8_STAGE(PG8_SB(0, 1), b2 + hstepB, voffB);
            PG8_WAIT_V(6); PG8_BAR; PG8_MMA(1, 1, At, B1); PG8_BAR;
            PG8_LDB(B0, 1, 0); PG8_SCHED; PG8_LDA(At, 1, 0); PG8_STAGE(PG8_SA(0, 1), a2 + hstepA, voffA);
            PG8_WAIT_L(8); PG8_BAR; PG8_WAIT_L(0); PG8_MMA(0, 0, At, B0); PG8_BAR; PG8_SCHED;
            PG8_LDB(B1, 1, 1); PG8_STAGE(PG8_SB(1, 0), b3, voffB);
            PG8_BAR; PG8_WAIT_L(0); PG8_MMA(0, 1, At, B1); PG8_BAR;
            PG8_LDA(At, 1, 1); PG8_STAGE(PG8_SA(1, 0), a3, voffA);
            PG8_BAR; PG8_WAIT_L(0); PG8_MMA(1, 0, At, B0); PG8_BAR; PG8_SCHED;
            PG8_STAGE(PG8_SB(1, 1), b3 + hstepB, voffB);
            PG8_WAIT_V(6); PG8_BAR; PG8_MMA(1, 1, At, B1); PG8_BAR;
            }
        }
        if constexpr (ALIGN_EPI) { if (wr == 0) PG8_BAR; }
        if constexpr (!Epi::AFTER_DRAIN) { E(acc, cur, wr, wc, fr, fq); S.done(cur); }
        if (!has_next) break;
        if (!Epi::keep(cur)) {
        float zf2 = 0.f; asm volatile("" : "+v"(zf2));
#pragma unroll
        for (int a = 0; a < 2; ++a)
#pragma unroll
            for (int b = 0; b < 2; ++b)
#pragma unroll
                for (int m = 0; m < 4; ++m)
#pragma unroll
                    for (int n = 0; n < 2; ++n) acc[a][b][m][n] = (f32x4){zf2, zf2, zf2, zf2};
        }
        cur = nxt; cA = nA; cB = nB; ++ui;
        if constexpr (ALIGN_EPI) { if (wr == 1) PG8_BAR; }
    }
    PG8_WAIT_V(0);
    if constexpr (!ALIGN_EPI) { if (wr == 0) PG8_BAR; }
    PG8_BAR;
    if constexpr (Epi::AFTER_DRAIN) { E.fused(acc, cur, wr, wc, fr, fq, lds, wid, lane); S.done(cur); }
#undef PG8_SA
#undef PG8_SB
#undef PG8_STAGE
#undef PG8_LDA
#undef PG8_LDB
#undef PG8_MMA
#undef PG8_WAIT_V
#undef PG8_WAIT_L
#undef PG8_BAR
#undef PG8_SCHED
}
}

#define GAS __attribute__((address_space(1)))
#define LAS __attribute__((address_space(3)))
typedef unsigned short bf16;
typedef unsigned v4u __attribute__((ext_vector_type(4)));
typedef float f32x4 __attribute__((ext_vector_type(4)));
typedef short bf16x8 __attribute__((ext_vector_type(8)));
typedef GAS unsigned gu32;
typedef GAS unsigned long long gu64;
#define RLX_AGENT __ATOMIC_RELAXED, __HIP_MEMORY_SCOPE_AGENT
#define LDS_WAIT() asm volatile("s_waitcnt lgkmcnt(0)" ::: "memory")
#define VM_WAIT() asm volatile("s_waitcnt vmcnt(0)" ::: "memory")
__device__ __forceinline__ unsigned long long rt() { return __builtin_amdgcn_s_memrealtime(); }
__device__ __forceinline__ unsigned f2bf(float f) { unsigned u = __builtin_bit_cast(unsigned, f); return (u + 0x7fffu + ((u >> 16) & 1u)) >> 16; }
__device__ __forceinline__ unsigned pk2(float lo, float hi) { return f2bf(lo) | (f2bf(hi) << 16); }

#define XB_TMO      128
#define XB_XCNT(j)  (256  + 64 * (j))
#define XB_XSUB(j)  (1280 + 64 * (j))
#define XB_XGEN(j)  (2304 + 64 * (j))
#define XB_TOP      3328
#define XB_TOPGEN   3392
#define XCD_BAR_WORDS 3456
#define XB_SPIN_CAP (1u << 18)

__device__ __forceinline__ unsigned xb_ld(unsigned* p)              { return __hip_atomic_load(p, __ATOMIC_RELAXED, __HIP_MEMORY_SCOPE_AGENT); }
__device__ __forceinline__ unsigned xb_add(unsigned* p, unsigned v) { return __hip_atomic_fetch_add(p, v, __ATOMIC_RELAXED, __HIP_MEMORY_SCOPE_AGENT); }
__device__ __forceinline__ unsigned xb_xcc_id() { return (unsigned)__builtin_amdgcn_s_getreg((3 << 11) | 20) & 0xFu; }
#define XB_SPIN(cond, bar) do { unsigned _sp = 0; while (cond) { __builtin_amdgcn_s_sleep(1); \
    if ((++_sp & 255u) == 0u) { if (xb_ld(&(bar)[XB_TMO])) break; if (_sp > XB_SPIN_CAP) { atomicAdd(&(bar)[XB_TMO], 1u); break; } } } } while (0)

struct XcdBarrier {
    unsigned* bar; unsigned x;
    volatile LAS unsigned* st;
};

__device__ __forceinline__ XcdBarrier xcd_barrier_post(unsigned* bar, volatile LAS unsigned* st) {
    XcdBarrier b; b.bar = bar; b.x = xb_xcc_id(); b.st = st;
    if (threadIdx.x == 0) (void)xb_add(&bar[XB_XCNT(b.x)], 1u);
    return b;
}
__device__ __forceinline__ void xcd_barrier_complete(unsigned* bar, unsigned x, unsigned& nloc, unsigned& nx) {
    const unsigned G = gridDim.x * gridDim.y * gridDim.z;
    unsigned sum, cnt, mine, sp = 0u;
    for (;;) {
        sum = 0u; cnt = 0u; mine = 0u;
#pragma unroll
        for (unsigned j = 0; j < 16; ++j) { const unsigned c = xb_ld(&bar[XB_XCNT(j)]); sum += c; cnt += (c > 0u) ? 1u : 0u; mine = (j == x) ? c : mine; }
        if (sum == G) break;
        __builtin_amdgcn_s_sleep(1);
        if ((++sp & 255u) == 0u) { if (xb_ld(&bar[XB_TMO])) break; if (sp > XB_SPIN_CAP) { atomicAdd(&bar[XB_TMO], 1u); break; } }
    }
    nloc = mine > 0u ? mine : 1u; nx = cnt > 0u ? cnt : 1u;
}

__device__ __forceinline__ void xcd_barrier(const XcdBarrier& b) {
    asm volatile("s_waitcnt vmcnt(0)" ::: "memory");
    __syncthreads();
    if (threadIdx.x == 0) {
        unsigned* bar = b.bar;
        __builtin_amdgcn_s_waitcnt(0);
        unsigned nloc = b.st[0], nx = b.st[1];
        if (nloc == 0u) { xcd_barrier_complete(bar, b.x, nloc, nx); b.st[0] = nloc; b.st[1] = nx; }
        const unsigned old = xb_add(&bar[XB_XSUB(b.x)], 1u);
        const unsigned gen = old / nloc;
        if (old + 1u == (gen + 1u) * nloc) {
            __builtin_amdgcn_fence(__ATOMIC_RELEASE, "agent");
            asm volatile("s_waitcnt vmcnt(0)" ::: "memory");
            const unsigned og = xb_add(&bar[XB_TOP], 1u);
            const unsigned tg = og / nx;
            if (og + 1u == (tg + 1u) * nx) xb_add(&bar[XB_TOPGEN], 1u);
            else XB_SPIN(xb_ld(&bar[XB_TOPGEN]) == tg, bar);
            __builtin_amdgcn_fence(__ATOMIC_ACQUIRE, "agent");
            xb_add(&bar[XB_XGEN(b.x)], 1u);
            asm volatile("s_waitcnt vmcnt(0)" ::: "memory");
        } else {
            XB_SPIN(xb_ld(&bar[XB_XGEN(b.x)]) == gen, bar);
            __builtin_amdgcn_fence(__ATOMIC_ACQUIRE, "agent");
            asm volatile("s_waitcnt vmcnt(0)" ::: "memory");
        }
    }
    __syncthreads();
}

constexpr int D = 2048, SEQ = 16384, M = 32768, DEPTH = 2;
constexpr int NCH = 256;
constexpr int NSEG = 16, CPS = NCH / NSEG;
constexpr int DIN = 8224;
constexpr float RMS_EPS = 1e-6f;
constexpr int NWAVES = 8;
constexpr int NPH = 15;

constexpr size_t MiB = 1u << 20;
constexpr size_t WS_CTL = 0, CTL_ZERO_BYTES = 1 * MiB;
constexpr size_t WS_WIN = 1 * MiB;
constexpr size_t WS_WUPG = 34 * MiB;
constexpr size_t WS_WUPP = 38 * MiB;
constexpr size_t WS_WOUT = 42 * MiB;
constexpr size_t WS_WQ = 50 * MiB;
constexpr size_t WS_POOLW = 58 * MiB;
constexpr size_t WS_SUBK = 58 * MiB + 512 * 1024;
constexpr size_t WS_USC = 59 * MiB, WS_VSC = 59 * MiB + 512 * 1024;
constexpr size_t WS_UTAB = 60 * MiB, WS_VTAB = 124 * MiB;
constexpr size_t WS_H = 188 * MiB;
constexpr size_t WS_POOLED = WS_H, WS_POOLMIX = WS_H + 64 * MiB, WS_SEGL = WS_H + 64 * MiB, WS_SIN = WS_H + 96 * MiB;
constexpr size_t WS_QK = 316 * MiB;
constexpr size_t WS_P = 380 * MiB;
constexpr size_t WS_VT = 444 * MiB;
constexpr size_t WS_R = 508 * MiB;
constexpr size_t WS_MERGED = WS_VT;
constexpr size_t WS_G = 572 * MiB;
constexpr size_t WS_PQ = WS_G, WS_IDX = 700 * MiB, WS_GATE = 716 * MiB;
constexpr size_t WS_AFB = 828 * MiB;
constexpr size_t WS_QE = 832 * MiB;
constexpr size_t WS_GLAOUT = WS_QE;
constexpr size_t WS_KDT = 896 * MiB;
constexpr size_t WS_ATTN = 960 * MiB;
constexpr size_t WS_DEC = 992 * MiB;
constexpr size_t WS_SSP1 = 994 * MiB, WS_SSP2 = 998 * MiB;
constexpr size_t WS_END = 1000 * MiB;
constexpr int CW_BAR = 4096;

constexpr int RING_BYTES = 131072;
constexpr int LDSCTL_OFF = RING_BYTES, MISC_OFF = LDSCTL_OFF + 320;
constexpr int LDS_BYTES = 147456;

typedef unsigned v2u __attribute__((ext_vector_type(2)));
typedef float f32x2 __attribute__((ext_vector_type(2)));
typedef float f32x16 __attribute__((ext_vector_type(16)));
using pg8::pkbf; using pg8::bflo; using pg8::bfhi;
__device__ __forceinline__ float bf2f(bf16 h) { return __builtin_bit_cast(float, (unsigned)h << 16); }
__device__ __forceinline__ bf16 f2bf1(float f) { return (bf16)(pkbf(f, 0.f) & 0xffffu); }
__device__ __forceinline__ float wave_sum(float v) {
#pragma unroll
    for (int o = 1; o < 64; o <<= 1) v += __shfl_xor(v, o);
    return v;
}
__device__ __forceinline__ float wave_max(float v) {
#pragma unroll
    for (int o = 1; o < 64; o <<= 1) v = fmaxf(v, __shfl_xor(v, o));
    return v;
}
__device__ __forceinline__ f32x16 mfma32(bf16x8 a, bf16x8 b, f32x16 c) { return __builtin_amdgcn_mfma_f32_32x32x16_bf16(a, b, c, 0, 0, 0); }
__device__ __forceinline__ bf16x8 mk8(unsigned a, unsigned b, unsigned c, unsigned d) { v4u t = {a, b, c, d}; return __builtin_bit_cast(bf16x8, t); }

#define LDS_BAR() do { asm volatile("s_waitcnt lgkmcnt(0)" ::: "memory"); __builtin_amdgcn_s_barrier(); asm volatile("" ::: "memory"); } while (0)
__device__ __forceinline__ void transpose_item(const float* __restrict__ W, int N, bf16* WT, int ldt, int dst_row0, int k0, int n0, LAS float* scr, int lane, const float* __restrict__ gk = nullptr) {
#pragma unroll
    for (int i = 0; i < 8; ++i) { const int kk = 8 * i + (lane >> 3), c4 = 4 * (lane & 7); f32x4 v = *(const f32x4*)(W + (size_t)(k0 + kk) * N + n0 + c4);
        if (gk) v = v * gk[k0 + kk];
        LAS float* d = scr + kk * 33 + c4; d[0] = v.x; d[1] = v.y; d[2] = v.z; d[3] = v.w; }
    LDS_WAIT(); asm volatile("" ::: "memory");
    const int c = lane & 7;
#pragma unroll
    for (int j = 0; j < 4; ++j) { const int n = (lane >> 3) + 8 * j; const LAS float* s = scr + (8 * c) * 33 + n;
        v4u o; o.x = pkbf(s[0 * 33], s[1 * 33]); o.y = pkbf(s[2 * 33], s[3 * 33]); o.z = pkbf(s[4 * 33], s[5 * 33]); o.w = pkbf(s[6 * 33], s[7 * 33]);
        *(GAS v4u*)(WT + (size_t)(dst_row0 + n) * ldt + k0 + 8 * c) = o; }
    LDS_WAIT(); asm volatile("" ::: "memory");
}
__device__ __forceinline__ void transpose_matrix(const float* W, int K, int N, bf16* WT, LAS float* scr, int lane, int gw, int NGW) {
    const int nblk = N / 32, items = (K / 64) * nblk;
    for (int it = gw; it < items; it += NGW) { const int kb = it / nblk, nb = it % nblk; transpose_item(W, N, WT, K, nb * 32, kb * 64, nb * 32, scr, lane); }
}
__device__ __forceinline__ void table_rows_fp8(const float* __restrict__ T, unsigned* __restrict__ O, float* __restrict__ inv, int rowA, int rowB, int lane, const float* __restrict__ gc = nullptr) {
    const f32x4* sa = (const f32x4*)(T + (size_t)rowA * 2048) + lane; const f32x4* sb = (const f32x4*)(T + (size_t)rowB * 2048) + lane;
    f32x4 va[8], vb[8]; float ama = 0.f, amb = 0.f;
#pragma unroll
    for (int j = 0; j < 8; ++j) { va[j] = sa[64 * j]; vb[j] = sb[64 * j]; }
    if (gc) {
#pragma unroll
        for (int j = 0; j < 8; ++j) { const f32x4 gq = ((const f32x4*)gc)[64 * j + lane]; va[j] = va[j] * gq; vb[j] = vb[j] * gq; } }
#pragma unroll
    for (int j = 0; j < 8; ++j) { ama = fmaxf(ama, fmaxf(fmaxf(fabsf(va[j].x), fabsf(va[j].y)), fmaxf(fabsf(va[j].z), fabsf(va[j].w)))); amb = fmaxf(amb, fmaxf(fmaxf(fabsf(vb[j].x), fabsf(vb[j].y)), fmaxf(fabsf(vb[j].z), fabsf(vb[j].w)))); }
#pragma unroll
    for (int o = 1; o < 64; o <<= 1) { ama = fmaxf(ama, __shfl_xor(ama, o)); amb = fmaxf(amb, __shfl_xor(amb, o)); }
    float ea = (ama > 1e-30f) ? floorf(__log2f(224.f / ama)) : 0.f; ea = fminf(fmaxf(ea, -60.f), 60.f);
    float eb = (amb > 1e-30f) ? floorf(__log2f(224.f / amb)) : 0.f; eb = fminf(fmaxf(eb, -60.f), 60.f);
    const float sca = exp2f(ea), scb = exp2f(eb);
#pragma unroll
    for (int j = 0; j < 8; ++j) { const int dw = 64 * j + lane; int w = 0;
        w = __builtin_amdgcn_cvt_pk_fp8_f32(va[j].x * sca, va[j].y * sca, w, false); w = __builtin_amdgcn_cvt_pk_fp8_f32(va[j].z * sca, va[j].w * sca, w, true);
        O[((size_t)(dw >> 5) * 16384 + rowA) * 32 + (dw & 31)] = (unsigned)w; w = 0;
        w = __builtin_amdgcn_cvt_pk_fp8_f32(vb[j].x * scb, vb[j].y * scb, w, false); w = __builtin_amdgcn_cvt_pk_fp8_f32(vb[j].z * scb, vb[j].w * scb, w, true);
        O[((size_t)(dw >> 5) * 16384 + rowB) * 32 + (dw & 31)] = (unsigned)w; }
    if (lane == 0) { inv[rowA] = exp2f(-ea); inv[rowB] = exp2f(-eb); }
}
__device__ __forceinline__ void rmsnorm_row(const float* xrow, const float* __restrict__ g, bf16* orow, int lane) {
    const f32x4* xr = (const f32x4*)xrow + lane; const f32x4* gr = (const f32x4*)g + lane;
    f32x4 v[8]; float s = 0.f;
#pragma unroll
    for (int j = 0; j < 8; ++j) { v[j] = xr[64 * j]; s += (v[j].x * v[j].x + v[j].y * v[j].y) + (v[j].z * v[j].z + v[j].w * v[j].w); }
    const float rs = rsqrtf(wave_sum(s) * (1.f / 2048.f) + RMS_EPS);
    v2u* o8 = (v2u*)orow + lane;
#pragma unroll
    for (int j = 0; j < 8; ++j) { const f32x4 gg = gr[64 * j]; v2u o; o.x = pkbf(v[j].x * rs * gg.x, v[j].y * rs * gg.y); o.y = pkbf(v[j].z * rs * gg.z, v[j].w * rs * gg.w); o8[64 * j] = o; }
}

constexpr int PA_A = 0, PA_QT = 4096, PA_Q = 8192, PA_K = PA_Q + 17408, PA_KE = PA_K + 17408, PA_BYTES = PA_KE + 17408;
static_assert(2 * PA_BYTES <= RING_BYTES, "prep LDS");
struct PrepIn { f32x4 a; unsigned q[8], k[8]; float wg[2][16]; float bias[2]; };
__device__ __forceinline__ void gla_prep_load(PrepIn& in, int uid, const bf16* __restrict__ QK, const float* __restrict__ AFB, const float* __restrict__ Wgf, const float* __restrict__ Bgf,
                                              const float* __restrict__ Wgb, const float* __restrict__ Bgb, int tid) {
    const int dir = uid & 1, h = (uid >> 1) & 3, bn = uid >> 3; const size_t row0 = (size_t)bn * 64;
    const float* Wg = dir ? Wgb : Wgf; const float* Bg = dir ? Bgb : Bgf;
    { const int t = (tid & 255) >> 2, q4 = tid & 3; in.a = *(const f32x4*)(AFB + (row0 + t) * 32 + dir * 16 + 4 * q4); }
    const int c2 = tid & 63, tq = tid >> 6;
#pragma unroll
    for (int j = 0; j < 8; ++j) { const bf16* src = QK + (row0 + tq * 8 + j) * 1024 + h * 128 + 2 * c2; in.q[j] = *(const unsigned*)src; in.k[j] = *(const unsigned*)(src + 512); }
#pragma unroll
    for (int r = 0; r < 16; ++r) { const f32x2 w2 = *(const f32x2*)(Wg + r * 512 + h * 128 + 2 * c2); in.wg[0][r] = w2.x; in.wg[1][r] = w2.y; }
    { const f32x2 b2 = *(const f32x2*)(Bg + h * 128 + 2 * c2); in.bias[0] = b2.x; in.bias[1] = b2.y; }
}
__device__ __forceinline__ void gla_prep_unit(int uid, int uid_next, PrepIn& in, LAS unsigned char* lds, const bf16* __restrict__ QK, const float* __restrict__ AFB, const float* __restrict__ Wgf, const float* __restrict__ Bgf,
                                              const float* __restrict__ Wgb, const float* __restrict__ Bgb, bf16* QE, bf16* KDT, bf16* ATTN, float* DEC, int tid, int wave, int lane) {
    const int dir = uid & 1;
    LAS float* aS = (LAS float*)(lds + PA_A); LAS float* qtot = (LAS float*)(lds + PA_QT);
    LAS bf16* qS = (LAS bf16*)(lds + PA_Q); LAS bf16* kS = (LAS bf16*)(lds + PA_K); LAS bf16* keS = (LAS bf16*)(lds + PA_KE);
    if (tid < 256) { const int t = tid >> 2, q4 = tid & 3; *(LAS f32x4*)(aS + t * 16 + 4 * q4) = in.a; }
    const int c2 = tid & 63, tq = tid >> 6;
    unsigned qv[8], kv[8]; float wg0[16], wg1[16];
#pragma unroll
    for (int j = 0; j < 8; ++j) { qv[j] = in.q[j]; kv[j] = in.k[j]; }
#pragma unroll
    for (int r = 0; r < 16; ++r) { wg0[r] = in.wg[0][r]; wg1[r] = in.wg[1][r]; }
    const float bias0 = in.bias[0], bias1 = in.bias[1];
    gla_prep_load(in, uid_next, QK, AFB, Wgf, Bgf, Wgb, Bgb, tid);
    LDS_BAR();
    float lg0[8], lg1[8], P0[8], P1[8]; float run0 = 0.f, run1 = 0.f;
#pragma unroll
    for (int j = 0; j < 8; ++j) { const int t = tq * 8 + j;
        const f32x4 a0 = *(const LAS f32x4*)(aS + t * 16), a1 = *(const LAS f32x4*)(aS + t * 16 + 4), a2 = *(const LAS f32x4*)(aS + t * 16 + 8), a3 = *(const LAS f32x4*)(aS + t * 16 + 12);
        f32x2 z2 = {bias0, bias1};
        const float av[16] = {a0.x, a0.y, a0.z, a0.w, a1.x, a1.y, a1.z, a1.w, a2.x, a2.y, a2.z, a2.w, a3.x, a3.y, a3.z, a3.w};
#pragma unroll
        for (int r2 = 0; r2 < 16; ++r2) z2 = __builtin_elementwise_fma((f32x2){av[r2], av[r2]}, (f32x2){wg0[r2], wg1[r2]}, z2);
        const float z0 = z2.x, z1 = z2.y;
        lg0[j] = (fminf(z0, 0.f) - __logf(1.f + __expf(-fabsf(z0)))) * (1.f / 16.f); lg1[j] = (fminf(z1, 0.f) - __logf(1.f + __expf(-fabsf(z1)))) * (1.f / 16.f);
        run0 += lg0[j]; run1 += lg1[j]; P0[j] = run0; P1[j] = run1; }
    *(LAS f32x2*)(qtot + tq * 128 + 2 * c2) = (f32x2){run0, run1};
    LDS_BAR();
    float btot0 = 0.f, btot1 = 0.f, off0 = 0.f, off1 = 0.f;
#pragma unroll
    for (int g8 = 0; g8 < 8; ++g8) { const f32x2 v = *(const LAS f32x2*)(qtot + g8 * 128 + 2 * c2); btot0 += v.x; btot1 += v.y;
        const bool before = dir ? (g8 > tq) : (g8 < tq); off0 += before ? v.x : 0.f; off1 += before ? v.y : 0.f; }
    const float dt0 = __expf(btot0), dt1 = __expf(btot1);
    if (tq == 0) *(f32x2*)(DEC + (size_t)uid * 128 + 2 * c2) = (f32x2){dt0, dt1};
#pragma unroll
    for (int j = 0; j < 8; ++j) { const int t = tq * 8 + j;
        const float b0 = (dir ? (run0 - P0[j] + lg0[j]) : P0[j]) + off0, b1 = (dir ? (run1 - P1[j] + lg1[j]) : P1[j]) + off1;
        const float q0 = bflo(qv[j]), q1 = bfhi(qv[j]), k0 = bflo(kv[j]), k1 = bfhi(kv[j]);
        const float e0 = __expf(b0), e1 = __expf(b1), i0 = __builtin_amdgcn_rcpf(e0), i1 = __builtin_amdgcn_rcpf(e1);
        *(LAS unsigned*)(qS + t * 136 + 2 * c2) = pkbf(q0 * e0, q1 * e1);
        *(LAS unsigned*)(keS + t * 136 + 2 * c2) = pkbf(k0 * i0, k1 * i1);
        *(LAS unsigned*)(kS + t * 136 + 2 * c2) = pkbf(k0 * (dt0 * i0), k1 * (dt1 * i1)); }
    LDS_BAR();
    const int r = lane & 31, hh = lane >> 5;
    if (wave < 4) {
        const int jt = wave >> 1, it = wave & 1;
        f32x16 acc;
#pragma unroll
        for (int e = 0; e < 16; ++e) acc[e] = 0.f;
#pragma unroll
        for (int s = 0; s < 8; ++s) { const bf16x8 A = *(const LAS bf16x8*)(keS + (32 * jt + r) * 136 + 16 * s + 8 * hh); const bf16x8 B = *(const LAS bf16x8*)(qS + (32 * it + r) * 136 + 16 * s + 8 * hh); acc = mfma32(A, B, acc); }
        const int i = 32 * it + r; float v[16];
#pragma unroll
        for (int e = 0; e < 16; ++e) { const int j = 32 * jt + (e & 3) + 8 * (e >> 2) + 4 * hh; const bool keep = dir ? (j > i) : (j <= i); v[e] = keep ? acc[e] : 0.f; }
#pragma unroll
        for (int s2 = 0; s2 < 2; ++s2) { v4u o; o.x = pkbf(v[8 * s2 + 0], v[8 * s2 + 1]); o.y = pkbf(v[8 * s2 + 2], v[8 * s2 + 3]); o.z = pkbf(v[8 * s2 + 4], v[8 * s2 + 5]); o.w = pkbf(v[8 * s2 + 6], v[8 * s2 + 7]);
            *(v4u*)(ATTN + (size_t)uid * 4096 + (size_t)((it * 4 + 2 * jt + s2) * 64 + lane) * 8) = o; }
    }
#pragma unroll
    for (int e = 0; e < 2; ++e) { const int f = wave * 2 + e;
        {
            const int it = f >> 3, ks = f & 7, dt = ks >> 1, s2 = ks & 1;
            const LAS bf16* base = qS + (32 * it + r) * 136 + 32 * dt + 16 * s2 + 4 * hh;
            const v2u lo = *(const LAS v2u*)base, hi = *(const LAS v2u*)(base + 8);
            v4u o = {lo.x, lo.y, hi.x, hi.y};
            *(v4u*)(QE + (size_t)uid * 8192 + (size_t)(f * 64 + lane) * 8) = o; }
        {
            const int dt = f >> 2, ks = f & 3, dim = 32 * dt + r;
            unsigned w[4];
#pragma unroll
            for (int p2 = 0; p2 < 4; ++p2) { const int j0 = 2 * p2, j1 = 2 * p2 + 1;
                const int t0 = 16 * ks + 8 * (j0 >> 2) + 4 * hh + (j0 & 3), t1 = 16 * ks + 8 * (j1 >> 2) + 4 * hh + (j1 & 3);
                w[p2] = (unsigned)kS[t0 * 136 + dim] | ((unsigned)kS[t1 * 136 + dim] << 16); }
            v4u o = {w[0], w[1], w[2], w[3]};
            *(v4u*)(KDT + (size_t)uid * 8192 + (size_t)(f * 64 + lane) * 8) = o; }
    }
}

__device__ __forceinline__ void pool_item(int item, const bf16* __restrict__ P, bf16* __restrict__ PO) {
    const int oct = item & 127, run = item >> 7; const int m0 = run * 32, b = m0 >> 14, t0 = m0 & (SEQ - 1);
    const int g = oct >> 5, hw = 1 << g;
    const bf16* Pb = P + (size_t)b * SEQ * 1024 + oct * 8; bf16* Ob = PO + (size_t)b * SEQ * 1024 + oct * 8;
    float s[8];
#pragma unroll
    for (int e = 0; e < 8; ++e) s[e] = 0.f;
    const int lo0 = (t0 - hw > 0) ? t0 - hw : 0, hi0 = (t0 + hw < SEQ) ? t0 + hw : SEQ;
    for (int u = lo0; u < hi0; ++u) { const v4u w = *(const v4u*)(Pb + (size_t)u * 1024);
        s[0] += bflo(w.x); s[1] += bfhi(w.x); s[2] += bflo(w.y); s[3] += bfhi(w.y); s[4] += bflo(w.z); s[5] += bfhi(w.z); s[6] += bflo(w.w); s[7] += bfhi(w.w); }
    for (int t = t0; t < t0 + 32; ++t) {
        const int lo = (t - hw > 0) ? t - hw : 0, hi = (t + hw < SEQ) ? t + hw : SEQ; const float ic = 1.f / (float)(hi - lo);
        const v4u w = *(const v4u*)(Pb + (size_t)t * 1024);
        v4u o; o.x = pkbf(s[0] * ic - bflo(w.x), s[1] * ic - bfhi(w.x)); o.y = pkbf(s[2] * ic - bflo(w.y), s[3] * ic - bfhi(w.y));
        o.z = pkbf(s[4] * ic - bflo(w.z), s[5] * ic - bfhi(w.z)); o.w = pkbf(s[6] * ic - bflo(w.w), s[7] * ic - bfhi(w.w));
        *(v4u*)(Ob + (size_t)t * 1024) = o;
        if (t - hw >= 0) { const v4u x = *(const v4u*)(Pb + (size_t)(t - hw) * 1024);
            s[0] -= bflo(x.x); s[1] -= bfhi(x.x); s[2] -= bflo(x.y); s[3] -= bfhi(x.y); s[4] -= bflo(x.z); s[5] -= bfhi(x.z); s[6] -= bflo(x.w); s[7] -= bfhi(x.w); }
        if (t + hw < SEQ) { const v4u x = *(const v4u*)(Pb + (size_t)(t + hw) * 1024);
            s[0] += bflo(x.x); s[1] += bfhi(x.x); s[2] += bflo(x.y); s[3] += bfhi(x.y); s[4] += bflo(x.z); s[5] += bfhi(x.z); s[6] += bflo(x.w); s[7] += bfhi(x.w); }
    }
}

constexpr int SB_QE = 0, SB_AT = 16384, SB_KD = 24576, SB_DEC = 40960, SB_BYTES = 41472;
template <bool FULL> __device__ __forceinline__ void gla_scan_block(int su, LAS unsigned char* lds, const bf16* __restrict__ QE, const bf16* __restrict__ ATTN, const bf16* __restrict__ KDT,
                                                                    const float* __restrict__ DEC, const bf16* __restrict__ VT, float* SEGL, float* SEGD, bf16* OF, bf16* OB,
                                                                    int tid, int wave, int lane) {
    const int bhd = su / NSEG, seg = su % NSEG, dir = bhd & 1, h = (bhd >> 1) & 3, b = bhd >> 3;
    const int r = lane & 31, hh = lane >> 5, w = wave;
    f32x16 st[4];
    if (FULL) {
#pragma unroll
        for (int dt = 0; dt < 4; ++dt)
#pragma unroll
            for (int e = 0; e < 16; ++e) st[dt][e] = 0.f;
        for (int sp = 0; sp < seg; ++sp) { const int su2 = bhd * NSEG + sp;
#pragma unroll
            for (int dt = 0; dt < 4; ++dt) {
#pragma unroll
                for (int q = 0; q < 4; ++q) { const f32x4 d4 = *(const f32x4*)(SEGD + (size_t)su2 * 128 + 32 * dt + 8 * q + 4 * hh);
                    const size_t i0 = ((size_t)((su2 * 8 + w) * 4 + dt) * 16 + 4 * q) * 64 + lane;
                    st[dt][4 * q + 0] = d4.x * st[dt][4 * q + 0] + SEGL[i0]; st[dt][4 * q + 1] = d4.y * st[dt][4 * q + 1] + SEGL[i0 + 64];
                    st[dt][4 * q + 2] = d4.z * st[dt][4 * q + 2] + SEGL[i0 + 128]; st[dt][4 * q + 3] = d4.w * st[dt][4 * q + 3] + SEGL[i0 + 192]; } } }
    } else {
#pragma unroll
        for (int dt = 0; dt < 4; ++dt)
#pragma unroll
            for (int e = 0; e < 16; ++e) st[dt][e] = 0.f;
    }
    v4u sg[5]; v4u sdec; v2u vn[8]; bf16x8 vc[4];
#define SCAN_UID(i_) ({ const int sp_ = seg * CPS + (i_); const int n_ = dir ? (NCH - 1 - sp_) : sp_; (((b * NCH + n_) * 4 + h) * 2 + dir); })
#define SCAN_LOAD(i_) do { const int uid_ = SCAN_UID(i_); \
        if (FULL) { sg[0] = *(const v4u*)(QE + (size_t)uid_ * 8192 + (size_t)tid * 8); sg[1] = *(const v4u*)(QE + (size_t)uid_ * 8192 + (size_t)(tid + 512) * 8); \
                    sg[2] = *(const v4u*)(ATTN + (size_t)uid_ * 4096 + (size_t)tid * 8); } \
        sg[3] = *(const v4u*)(KDT + (size_t)uid_ * 8192 + (size_t)tid * 8); sg[4] = *(const v4u*)(KDT + (size_t)uid_ * 8192 + (size_t)(tid + 512) * 8); \
        if (tid < 32) sdec = *(const v4u*)(DEC + (size_t)uid_ * 128 + tid * 4); \
        const bf16* vb_ = VT + ((size_t)(uid_ >> 3) * 1024 + h * 256 + 32 * w + r) * 64 + 4 * hh; \
        _Pragma("unroll") for (int ks_ = 0; ks_ < 4; ++ks_) { vn[2 * ks_] = *(const v2u*)(vb_ + 16 * ks_); vn[2 * ks_ + 1] = *(const v2u*)(vb_ + 16 * ks_ + 8); } } while (0)
#define SCAN_STORE(buf_) do { LAS unsigned char* B_ = lds + (buf_) * SB_BYTES; \
        if (FULL) { *(LAS v4u*)(B_ + SB_QE + tid * 16) = sg[0]; *(LAS v4u*)(B_ + SB_QE + (tid + 512) * 16) = sg[1]; *(LAS v4u*)(B_ + SB_AT + tid * 16) = sg[2]; } \
        *(LAS v4u*)(B_ + SB_KD + tid * 16) = sg[3]; *(LAS v4u*)(B_ + SB_KD + (tid + 512) * 16) = sg[4]; \
        if (tid < 32) *(LAS v4u*)(B_ + SB_DEC + tid * 16) = sdec; \
        _Pragma("unroll") for (int ks_ = 0; ks_ < 4; ++ks_) vc[ks_] = mk8(vn[2 * ks_].x, vn[2 * ks_].y, vn[2 * ks_ + 1].x, vn[2 * ks_ + 1].y); } while (0)
    float dprod = 1.f;
    LDS_BAR();
    SCAN_LOAD(0); SCAN_STORE(0);
    LDS_BAR();
    for (int i = 0; i < CPS; ++i) {
        const bool more = (i + 1 < CPS);
        if (more) SCAN_LOAD(i + 1);
        const LAS unsigned char* B = lds + (i & 1) * SB_BYTES;
        if (FULL) {
            f32x16 o0, o1;
#pragma unroll
            for (int e = 0; e < 16; ++e) { o0[e] = 0.f; o1[e] = 0.f; }
#pragma unroll
            for (int dt = 0; dt < 4; ++dt)
#pragma unroll
                for (int s2 = 0; s2 < 2; ++s2) { const int ks = 2 * dt + s2;
                    const bf16x8 sf = mk8(pkbf(st[dt][8 * s2 + 0], st[dt][8 * s2 + 1]), pkbf(st[dt][8 * s2 + 2], st[dt][8 * s2 + 3]), pkbf(st[dt][8 * s2 + 4], st[dt][8 * s2 + 5]), pkbf(st[dt][8 * s2 + 6], st[dt][8 * s2 + 7]));
                    const bf16x8 a0 = *(const LAS bf16x8*)(B + SB_QE + ((0 * 8 + ks) * 64 + lane) * 16); const bf16x8 a1 = *(const LAS bf16x8*)(B + SB_QE + ((1 * 8 + ks) * 64 + lane) * 16);
                    o0 = mfma32(a0, sf, o0); o1 = mfma32(a1, sf, o1); }
#pragma unroll
            for (int ks = 0; ks < 4; ++ks) { const bf16x8 a0 = *(const LAS bf16x8*)(B + SB_AT + ((0 * 4 + ks) * 64 + lane) * 16); const bf16x8 a1 = *(const LAS bf16x8*)(B + SB_AT + ((1 * 4 + ks) * 64 + lane) * 16);
                o0 = mfma32(a0, vc[ks], o0); o1 = mfma32(a1, vc[ks], o1); }
            const int uid = SCAN_UID(i);
            bf16* Ob = (dir ? OB : OF) + (size_t)(uid >> 3) * 64 * 1024 + h * 256 + 32 * w + r;
#pragma unroll
            for (int e = 0; e < 16; ++e) { const int tk = (e & 3) + 8 * (e >> 2) + 4 * hh; Ob[(size_t)tk * 1024] = f2bf1(o0[e]); Ob[(size_t)(32 + tk) * 1024] = f2bf1(o1[e]); }
        }
#pragma unroll
        for (int dt = 0; dt < 4; ++dt) {
#pragma unroll
            for (int q = 0; q < 4; ++q) { const f32x4 d4 = *(const LAS f32x4*)(B + SB_DEC + (32 * dt + 8 * q + 4 * hh) * 4);
                st[dt][4 * q + 0] *= d4.x; st[dt][4 * q + 1] *= d4.y; st[dt][4 * q + 2] *= d4.z; st[dt][4 * q + 3] *= d4.w; }
#pragma unroll
            for (int ks = 0; ks < 4; ++ks) { const bf16x8 a = *(const LAS bf16x8*)(B + SB_KD + ((dt * 4 + ks) * 64 + lane) * 16); st[dt] = mfma32(a, vc[ks], st[dt]); }
        }
        if (!FULL && tid < 128) dprod *= *(const LAS float*)(B + SB_DEC + tid * 4);
        if (more) SCAN_STORE((i + 1) & 1);
        LDS_BAR();
    }
    if (!FULL) {
#pragma unroll
        for (int dt = 0; dt < 4; ++dt)
#pragma unroll
            for (int e = 0; e < 16; ++e) SEGL[((size_t)((su * 8 + w) * 4 + dt) * 16 + e) * 64 + lane] = st[dt][e];
        if (tid < 128) SEGD[(size_t)su * 128 + tid] = dprod;
    }
#undef SCAN_UID
#undef SCAN_LOAD
#undef SCAN_STORE
}
struct FinIn { v4u f0, f1, b0, b1, r0, r1; };
__device__ __forceinline__ void gla_fin_load(FinIn& in, int m, const bf16* __restrict__ OF, const bf16* __restrict__ OB, const bf16* __restrict__ R, int lane) {
    const size_t p = (size_t)m * 1024 + 16 * lane;
    in.f0 = *(const v4u*)(OF + p); in.f1 = *(const v4u*)(OF + p + 8); in.b0 = *(const v4u*)(OB + p); in.b1 = *(const v4u*)(OB + p + 8); in.r0 = *(const v4u*)(R + p); in.r1 = *(const v4u*)(R + p + 8);
}
__device__ __forceinline__ void gla_fin_row(const FinIn& in, int m, const float (&gg)[16], bf16* GO, int lane) {
    const size_t p = (size_t)m * 1024 + 16 * lane;
    const v4u f0 = in.f0, f1 = in.f1, b0 = in.b0, b1 = in.b1, r0 = in.r0, r1 = in.r1;
    float o[16], rr[16];
#define UNP(dst, w0, w1) do { dst[0] = bflo(w0.x); dst[1] = bfhi(w0.x); dst[2] = bflo(w0.y); dst[3] = bfhi(w0.y); dst[4] = bflo(w0.z); dst[5] = bfhi(w0.z); dst[6] = bflo(w0.w); dst[7] = bfhi(w0.w); \
        dst[8] = bflo(w1.x); dst[9] = bfhi(w1.x); dst[10] = bflo(w1.y); dst[11] = bfhi(w1.y); dst[12] = bflo(w1.z); dst[13] = bfhi(w1.z); dst[14] = bflo(w1.w); dst[15] = bfhi(w1.w); } while (0)
    float t[16]; UNP(o, f0, f1); UNP(t, b0, b1); UNP(rr, r0, r1);
#undef UNP
    float ss = 0.f;
#pragma unroll
    for (int e = 0; e < 16; ++e) { o[e] += t[e]; ss += o[e] * o[e]; }
    ss += __shfl_xor(ss, 1); ss += __shfl_xor(ss, 2); ss += __shfl_xor(ss, 4); ss += __shfl_xor(ss, 8);
    const float rs = rsqrtf(ss * (1.f / 256.f) + RMS_EPS);
    unsigned w[8];
#pragma unroll
    for (int e = 0; e < 8; ++e) w[e] = pkbf(o[2 * e] * rs * gg[2 * e] * rr[2 * e], o[2 * e + 1] * rs * gg[2 * e + 1] * rr[2 * e + 1]);
    v4u o0 = {w[0], w[1], w[2], w[3]}, o1 = {w[4], w[5], w[6], w[7]};
    *(v4u*)(GO + p) = o0; *(v4u*)(GO + p + 8) = o1;
}
__device__ __forceinline__ unsigned sortable(float f) { const unsigned b = __builtin_bit_cast(unsigned, f); return b ^ ((unsigned)((int)b >> 31) | 0x80000000u); }
__device__ __forceinline__ float unsortable(unsigned u) { const unsigned b = (u & 0x80000000u) ? (u ^ 0x80000000u) : ~u; return __builtin_bit_cast(float, b); }
__device__ __forceinline__ unsigned umax3(unsigned a, unsigned b, unsigned c) { return max(max(a, b), c); }
__device__ __forceinline__ void ce_desc(unsigned& a, unsigned& b) { const unsigned hi = max(a, b), lo = min(a, b); a = hi; b = lo; }
__device__ __forceinline__ void bitonic_sort16_desc(unsigned (&x)[16]) {
#pragma unroll
    for (int k = 2; k <= 16; k <<= 1)
#pragma unroll
        for (int j = k >> 1; j > 0; j >>= 1)
#pragma unroll
            for (int i = 0; i < 16; ++i) { const int l = i ^ j; if (l > i) { if ((i & k) == 0) ce_desc(x[i], x[l]); else ce_desc(x[l], x[i]); } }
}
__device__ __forceinline__ void bitonic_merge16_desc(unsigned (&x)[16]) {
#pragma unroll
    for (int j = 8; j > 0; j >>= 1)
#pragma unroll
        for (int i = 0; i < 16; ++i) { const int l = i ^ j; if (l > i) ce_desc(x[i], x[l]); }
}
__device__ __forceinline__ void topmerge16(unsigned (&a)[16], const unsigned (&b)[16]) {
#pragma unroll
    for (int i = 0; i < 16; ++i) a[i] = max(a[i], b[15 - i]);
    bitonic_merge16_desc(a);
}
__device__ __forceinline__ void peer_half_topk(int p, int h, const LAS unsigned char* sk, const bf16* __restrict__ PQ, size_t tok, int lane, unsigned (&Lp)[16]) {
    const int hh = lane >> 5;
    const bf16* qp = PQ + tok * 2048 + h * 256 + p * 128 + 8 * hh;
    bf16x8 bq[8];
#pragma unroll
    for (int s = 0; s < 8; ++s) bq[s] = *(const bf16x8*)(qp + 16 * s);
    unsigned key[64];
#pragma unroll
    for (int nt = 0; nt < 4; ++nt) { f32x16 sc;
#pragma unroll
        for (int e = 0; e < 16; ++e) sc[e] = 0.f;
#pragma unroll
        for (int s = 0; s < 8; ++s) { const bf16x8 a = *(const LAS bf16x8*)(sk + (((p * 4 + nt) * 8 + s) * 64 + lane) * 16); sc = mfma32(a, bq[s], sc); }
#pragma unroll
        for (int e = 0; e < 16; ++e) { const int n = 32 * nt + (e & 3) + 8 * (e >> 2) + 4 * hh; key[nt * 16 + e] = (sortable(sc[e]) & ~127u) | (unsigned)(127 - n); } }
    unsigned g0[16], g1[16], g2[16], g3[16];
#pragma unroll
    for (int e = 0; e < 16; ++e) { g0[e] = key[e]; g1[e] = key[16 + e]; g2[e] = key[32 + e]; g3[e] = key[48 + e]; }
    bitonic_sort16_desc(g0); bitonic_sort16_desc(g1); bitonic_sort16_desc(g2); bitonic_sort16_desc(g3);
    topmerge16(g0, g1); topmerge16(g2, g3); topmerge16(g0, g2);
#pragma unroll
    for (int e = 0; e < 16; ++e) g1[e] = (unsigned)__shfl_xor((int)g0[e], 32);
    topmerge16(g0, g1);
#pragma unroll
    for (int e = 0; e < 16; ++e) Lp[e] = g0[e];
}
__device__ __forceinline__ void peer_topk_item(int tile, int h, const LAS unsigned char* sk  , const bf16* __restrict__ PQ, unsigned short* IDX, float* GATE, int lane) {
    const int r = lane & 31, hh = lane >> 5; const size_t tok = (size_t)tile * 32 + r;
    unsigned L[2][16];
    peer_half_topk(0, h, sk, PQ, tok, lane, L[0]);
    __builtin_amdgcn_sched_barrier(0);
#pragma unroll
    for (int a = 0; a < 16; ++a) asm volatile("" : "+v"(L[0][a]));
    peer_half_topk(1, h, sk, PQ, tok, lane, L[1]);
    __builtin_amdgcn_sched_barrier(0);
#pragma unroll
    for (int a = 0; a < 16; ++a) asm volatile("" : "+v"(L[1][a]));
    float v0[16], v1[16];
#pragma unroll
    for (int a = 0; a < 16; ++a) { v0[a] = unsortable(L[0][a] & ~127u); v1[a] = unsortable(L[1][a] & ~127u); }
#define CKEY(a_, b_) ((sortable(v0[a_] + v1[b_]) & ~255u) | (unsigned)(255 - ((a_) * 16 + (b_))))
    unsigned R[16], T[16];
#pragma unroll
    for (int b2 = 0; b2 < 16; ++b2) R[b2] = CKEY(0, b2);
#define ROWMERGE(a_, n_) do { _Pragma("unroll") for (int b2 = 0; b2 < 16; ++b2) T[b2] = (b2 < (n_)) ? CKEY(a_, (b2 < (n_) ? b2 : 0)) : 0u; topmerge16(R, T); } while (0)
    ROWMERGE(1, 8); ROWMERGE(2, 5); ROWMERGE(3, 4); ROWMERGE(4, 3); ROWMERGE(5, 2); ROWMERGE(6, 2); ROWMERGE(7, 2);
#pragma unroll
    for (int b2 = 0; b2 < 16; ++b2) T[b2] = (b2 < 8) ? CKEY((b2 < 8 ? 8 + b2 : 8), 0) : 0u;
    topmerge16(R, T);
#undef ROWMERGE
#undef CKEY
    unsigned bk[16];
#pragma unroll
    for (int rd = 0; rd < 16; ++rd) bk[rd] = R[rd];
    float gs[16]; unsigned ex[16]; float Z = 0.f; const float s0 = unsortable(bk[0] & ~255u);
#pragma unroll
    for (int k = 0; k < 16; ++k) { const unsigned flat = 255u - (bk[k] & 255u), a = flat >> 4, b2 = flat & 15u;
        unsigned k1 = 0u, k2 = 0u;
#pragma unroll
        for (int a2 = 0; a2 < 16; ++a2) { k1 = (a == (unsigned)a2) ? L[0][a2] : k1; k2 = (b2 == (unsigned)a2) ? L[1][a2] : k2; }
        ex[k] = (127u - (k1 & 127u)) * 128u + (127u - (k2 & 127u));
        gs[k] = __expf(unsortable(bk[k] & ~255u) - s0); Z += gs[k]; }
    const float iz = 1.f / Z;
    if (hh == 0) {
        unsigned short* ip = IDX + (tok * 8 + h) * 16; float* gp = GATE + (tok * 8 + h) * 16;
        v4u i0 = {ex[0] | (ex[1] << 16), ex[2] | (ex[3] << 16), ex[4] | (ex[5] << 16), ex[6] | (ex[7] << 16)}, i1 = {ex[8] | (ex[9] << 16), ex[10] | (ex[11] << 16), ex[12] | (ex[13] << 16), ex[14] | (ex[15] << 16)};
        *(v4u*)ip = i0; *(v4u*)(ip + 8) = i1;
#pragma unroll
        for (int q = 0; q < 4; ++q) { f32x4 o = {gs[4 * q] * iz, gs[4 * q + 1] * iz, gs[4 * q + 2] * iz, gs[4 * q + 3] * iz}; *(f32x4*)(gp + 4 * q) = o; }
    }
}

__device__ __forceinline__ f32x2 dot16_fp8(const v4u w, const f32x2* hv2, f32x2 s) {
#pragma unroll
    for (int d = 0; d < 4; ++d) { const f32x2 lo = __builtin_amdgcn_cvt_pk_f32_fp8((int)w[d], false), hi = __builtin_amdgcn_cvt_pk_f32_fp8((int)w[d], true);
        s = __builtin_elementwise_fma(lo, hv2[2 * d], s); s = __builtin_elementwise_fma(hi, hv2[2 * d + 1], s); }
    return s;
}
__device__ __forceinline__ float dot16_fp8_bf(const v4u w, const v4u h0, const v4u h1) {
    const unsigned hx[8] = {h0.x, h0.y, h0.z, h0.w, h1.x, h1.y, h1.z, h1.w};
    float s = 0.f;
#pragma unroll
    for (int d = 0; d < 4; ++d) { const pg8::bf16x2_t lo = __builtin_amdgcn_cvt_scalef32_pk_bf16_fp8((int)w[d], 1.0f, false), hi = __builtin_amdgcn_cvt_scalef32_pk_bf16_fp8((int)w[d], 1.0f, true);
        s = __builtin_amdgcn_fdot2_f32_bf16(lo, __builtin_bit_cast(pg8::bf16x2_t, hx[2 * d]), s, false); s = __builtin_amdgcn_fdot2_f32_bf16(hi, __builtin_bit_cast(pg8::bf16x2_t, hx[2 * d + 1]), s, false); }
    return s;
}
__device__ __forceinline__ void axpy16_fp8(const v4u w, const f32x2 a2, f32x2* acc2) {
#pragma unroll
    for (int d = 0; d < 4; ++d) { const f32x2 lo = __builtin_amdgcn_cvt_pk_f32_fp8((int)w[d], false), hi = __builtin_amdgcn_cvt_pk_f32_fp8((int)w[d], true);
        acc2[2 * d] = __builtin_elementwise_fma(lo, a2, acc2[2 * d]); acc2[2 * d + 1] = __builtin_elementwise_fma(hi, a2, acc2[2 * d + 1]); }
}
__device__ __forceinline__ float gelu_erf(float x) { return 0.5f * x * (1.f + erff(x * 0.70710678118654752f)); }
template <int CTRL> __device__ __forceinline__ float dppf(float v) { return __builtin_bit_cast(float, __builtin_amdgcn_update_dpp(0, __builtin_bit_cast(int, v), CTRL, 0xF, 0xF, true)); }
__device__ __forceinline__ void swap32(float& a, float& b) { asm("s_nop 1\n\tv_permlane32_swap_b32 %0, %1" : "+v"(a), "+v"(b)); }
__device__ __forceinline__ void swap16(float& a, float& b) { asm("s_nop 1\n\tv_permlane16_swap_b32 %0, %1" : "+v"(a), "+v"(b)); }
__device__ __forceinline__ float wave_sum_valu(float v) {
    v += dppf<0xB1>(v); v += dppf<0x4E>(v); v += dppf<0x141>(v); v += dppf<0x140>(v);
    float a = v, b = v; swap16(a, b); v = a + b; a = v; b = v; swap32(a, b); return a + b;
}
__device__ __forceinline__ float sum8(float v) { v += dppf<0xB1>(v); v += dppf<0x4E>(v); v += dppf<0x141>(v); return v; }
struct PMeta { v4u ia, ib, o0, o1, o2, o3; f32x2 x1; };
__device__ __forceinline__ void peer_meta(PMeta& m, size_t tok, const unsigned short* __restrict__ IDX, int g) {
    m.ia = *(const v4u*)(IDX + tok * 128 + g * 16); m.ib = *(const v4u*)(IDX + tok * 128 + g * 16 + 8);
}
template <bool VP> __device__ __forceinline__ void peer_issue(PMeta& m, v4u (&w)[16], const unsigned char* __restrict__ tb, size_t tok, int sl, const bf16* __restrict__ XB, const float* __restrict__ ACT, const float* X, int g, int i, int c) {
    const unsigned iw[8] = {m.ia.x, m.ia.y, m.ia.z, m.ia.w, m.ib.x, m.ib.y, m.ib.z, m.ib.w}; const unsigned o16 = 16u * (unsigned)i;
#pragma unroll
    for (int q = 0; q < 16; ++q) { const unsigned e = (iw[q >> 1] >> (16 * (q & 1))) & 0xffffu; w[q] = *(const v4u*)(tb + ((e << 7) | o16)); }
    if (VP) { const v4u* ap = (const v4u*)(ACT + tok * 128 + g * 16); m.o0 = ap[0]; m.o1 = ap[1]; m.o2 = ap[2]; m.o3 = ap[3]; m.x1 = *(const f32x2*)(X + tok * 2048 + c); }
    else { const bf16* hp = XB + tok * 2048 + sl * 128 + 16 * i; m.o0 = *(const v4u*)hp; m.o1 = *(const v4u*)(hp + 8); }
}
__device__ __forceinline__ void peer_u_compute(const PMeta& m, const v4u (&w)[16], size_t tok, int label, int sub, float* PART, int g, int i) {
    const v4u h0 = m.o0, h1 = m.o1;
    float v[16];
#pragma unroll
    for (int q = 0; q < 16; ++q) v[q] = dot16_fp8_bf(w[q], h0, h1);
    const bool up1 = (i & 4) != 0, up2 = (i & 2) != 0, up3 = (i & 1) != 0;
    float a[8], b[4], c[2];
#pragma unroll
    for (int k = 0; k < 8; ++k) { const float send = up1 ? v[k] : v[k + 8], keep = up1 ? v[k + 8] : v[k]; a[k] = keep + dppf<0x141>(send); }
#pragma unroll
    for (int k = 0; k < 4; ++k) { const float send = up2 ? a[k] : a[k + 4], keep = up2 ? a[k + 4] : a[k]; b[k] = keep + dppf<0x4E>(send); }
#pragma unroll
    for (int k = 0; k < 2; ++k) { const float send = up3 ? b[k] : b[k + 2], keep = up3 ? b[k + 2] : b[k]; c[k] = keep + dppf<0xB1>(send); }
    *(unsigned*)((bf16*)PART + ((size_t)(2 * label + sub) * M + tok) * 128 + g * 16 + 2 * i) = pkbf(c[0], c[1]);
}
template <bool VP> __device__ __forceinline__ void peer_slice_loop(int sl, int label, int sub, int tok0, int tstep, const bf16* __restrict__ XB, const float* __restrict__ ACT, const unsigned short* __restrict__ IDX,
                                                                   const unsigned char* __restrict__ TAB, float* PART, float* X, bf16* XBn, const float* __restrict__ gn, float* ssn, int lane) {
    const int g = lane >> 3, i = lane & 7;
    const int j = ((lane >> 5) & 1) * 4 + ((lane >> 4) & 1) * 2 + ((lane >> 3) & 1), c = sl * 128 + 16 * i + 2 * j;
    const unsigned char* tb = TAB + (size_t)sl * (16384 * 128);
    f32x2 gg = {0.f, 0.f}; if (VP) gg = *(const f32x2*)(gn + c);
    if (tok0 >= M) return;
    const int NT = (M - tok0 + tstep - 1) / tstep;
#define PS_TOK(k_) ((size_t)(tok0 + ((k_) < NT ? (k_) : NT - 1) * tstep))
    PMeta mA, mB, mN; v4u wA[16], wB[16];
    peer_meta(mA, PS_TOK(0), IDX, g); peer_meta(mB, PS_TOK(1), IDX, g);
    asm volatile("" : "+v"(mB.ia), "+v"(mB.ib));
    peer_issue<VP>(mA, wA, tb, PS_TOK(0), sl, XB, ACT, X, g, i, c);
    int k = 0;
    for (; k + 1 < NT; k += 2) {
        peer_meta(mN, PS_TOK(k + 2), IDX, g);
        asm volatile("" ::: "memory");
        peer_issue<VP>(mB, wB, tb, PS_TOK(k + 1), sl, XB, ACT, X, g, i, c);
        asm volatile("" ::: "memory");
        peer_u_compute(mA, wA, PS_TOK(k), label, sub, PART, g, i);
        asm volatile("" ::: "memory");
        mA.ia = mN.ia; mA.ib = mN.ib;
        peer_meta(mN, PS_TOK(k + 3), IDX, g);
        asm volatile("" ::: "memory");
        peer_issue<VP>(mA, wA, tb, PS_TOK(k + 2), sl, XB, ACT, X, g, i, c);
        asm volatile("" ::: "memory");
        peer_u_compute(mB, wB, PS_TOK(k + 1), label, sub, PART, g, i);
        asm volatile("" ::: "memory");
        mB.ia = mN.ia; mB.ib = mN.ib;
    }
    if (k < NT) { peer_u_compute(mA, wA, PS_TOK(k), label, sub, PART, g, i); }
#undef PS_TOK
}
__device__ __forceinline__ void peer_combine_row(size_t tok, const float* __restrict__ PART, const unsigned short* __restrict__ IDX, const float* __restrict__ GATE, const float* __restrict__ USC, const float* __restrict__ VSC,
                                                 const float* __restrict__ ss, float* ACT, int lane) {
    float sv = ss[(tok + (lane >> 5)) * 32 + (lane & 31)];
    sv += __shfl_xor(sv, 1); sv += __shfl_xor(sv, 2); sv += __shfl_xor(sv, 4); sv += __shfl_xor(sv, 8); sv += __shfl_xor(sv, 16);
    const float rsv = rsqrtf(sv * (1.f / 2048.f) + RMS_EPS);
    const float rs[2] = {__shfl(rsv, 0), __shfl(rsv, 32)};
    f32x2 sum[2]; unsigned ew[2]; f32x2 gt[2]; unsigned pv[2][16];
#pragma unroll
    for (int t = 0; t < 2; ++t) { const size_t p = (tok + t) * 128 + 2 * lane;
        ew[t] = *(const unsigned*)(IDX + p); gt[t] = *(const f32x2*)(GATE + p);
#pragma unroll
        for (int lab = 0; lab < 16; ++lab) pv[t][lab] = *(const unsigned*)((const bf16*)PART + (size_t)lab * M * 128 + p); }
#pragma unroll
    for (int t = 0; t < 2; ++t) { sum[t] = (f32x2){0.f, 0.f};
#pragma unroll
        for (int lab = 0; lab < 16; ++lab) sum[t] = sum[t] + (f32x2){bflo(pv[t][lab]), bfhi(pv[t][lab])}; }
#pragma unroll
    for (int t = 0; t < 2; ++t) { const size_t p = (tok + t) * 128 + 2 * lane; const int e0 = ew[t] & 0xffff, e1 = ew[t] >> 16;
        *(unsigned*)((bf16*)ACT + p) = pkbf(gelu_erf(sum[t].x * rs[t] * USC[e0]) * gt[t].x * VSC[e0], gelu_erf(sum[t].y * rs[t] * USC[e1]) * gt[t].y * VSC[e1]); }
}
struct VMeta { v4u ia, ib; v4u a0, a1; f32x2 x1; };
__device__ __forceinline__ void peer_v_idx(VMeta& m, size_t tok, const unsigned short* __restrict__ IDX, int g) { m.ia = *(const v4u*)(IDX + tok * 128 + g * 16); m.ib = *(const v4u*)(IDX + tok * 128 + g * 16 + 8); }
__device__ __forceinline__ void peer_v_issue(VMeta& m, v4u (&w)[16], const unsigned char* __restrict__ vb, size_t tok, const float* __restrict__ ACT, const bf16* XB1, int g, int c) {
    const unsigned iw[8] = {m.ia.x, m.ia.y, m.ia.z, m.ia.w, m.ib.x, m.ib.y, m.ib.z, m.ib.w};
#pragma unroll
    for (int q = 0; q < 16; ++q) { const unsigned e = (iw[q >> 1] >> (16 * (q & 1))) & 0xffffu; w[q] = *(const v4u*)(vb + (size_t)e * 128); }
    const v4u* ap = (const v4u*)((const bf16*)ACT + tok * 128 + g * 16); m.a0 = ap[0]; m.a1 = ap[1];
    { const unsigned xw = *(const unsigned*)(XB1 + tok * 2048 + c); m.x1 = (f32x2){bflo(xw), bfhi(xw)}; }
}
template <bool WB> __device__ __forceinline__ void peer_v_fin(const VMeta& m, const v4u (&w)[16], size_t tok, int sl, bf16* XR, bf16* XBn, const f32x2 gg, float* ssn, int lane, int c) {
    const v4u a0 = m.a0, a1 = m.a1;
    const float av[16] = {bflo(a0.x), bfhi(a0.x), bflo(a0.y), bfhi(a0.y), bflo(a0.z), bfhi(a0.z), bflo(a0.w), bfhi(a0.w), bflo(a1.x), bfhi(a1.x), bflo(a1.y), bfhi(a1.y), bflo(a1.z), bfhi(a1.z), bflo(a1.w), bfhi(a1.w)};
    f32x2 acc2[8];
#pragma unroll
    for (int k = 0; k < 8; ++k) acc2[k] = (f32x2){0.f, 0.f};
#pragma unroll
    for (int q = 0; q < 16; ++q) { const f32x2 a2v = {av[q], av[q]}; axpy16_fp8(w[q], a2v, acc2); }
#pragma unroll
    for (int k = 0; k < 4; ++k) { float x0 = acc2[k].x, y0 = acc2[k + 4].x, x1 = acc2[k].y, y1 = acc2[k + 4].y; swap32(x0, y0); swap32(x1, y1); acc2[k] = (f32x2){x0 + y0, x1 + y1}; }
#pragma unroll
    for (int k = 0; k < 2; ++k) { float x0 = acc2[k].x, y0 = acc2[k + 2].x, x1 = acc2[k].y, y1 = acc2[k + 2].y; swap16(x0, y0); swap16(x1, y1); acc2[k] = (f32x2){x0 + y0, x1 + y1}; }
    { const bool up = (lane & 8) != 0; const f32x2 send = up ? acc2[0] : acc2[1], keep = up ? acc2[1] : acc2[0];
        acc2[0] = (f32x2){keep.x + dppf<0x128>(send.x), keep.y + dppf<0x128>(send.y)}; }
    const f32x2 x2 = {m.x1.x + acc2[0].x, m.x1.y + acc2[0].y};
    if (WB) { *(unsigned*)(XR + tok * 2048 + c) = pkbf(x2.x, x2.y); *(unsigned*)(XBn + tok * 2048 + c) = pkbf(x2.x * gg.x, x2.y * gg.y); }
    else *(unsigned*)(XBn + tok * 2048 + c) = pkbf(x2.x, x2.y);
    const float sq = wave_sum_valu(x2.x * x2.x + x2.y * x2.y);
    ssn[tok * 16 + sl] = sq;
}
template <bool WB> __device__ __forceinline__ void peer_v_loop(int sl, int tok0, int tstep, const float* __restrict__ ACT, const unsigned short* __restrict__ IDX, const unsigned char* __restrict__ V8, bf16* X, bf16* XBn, const float* __restrict__ gn, float* ssn, int lane) {
    const int g = lane >> 3, i = lane & 7;
    const int j = ((lane >> 5) & 1) * 4 + ((lane >> 4) & 1) * 2 + ((lane >> 3) & 1), c = sl * 128 + 16 * i + 2 * j;
    const unsigned char* vb = V8 + (size_t)sl * (16384 * 128) + 16 * i;
    const f32x2 gg = *(const f32x2*)(gn + c);
    if (tok0 >= M) return;
    const int NT = (M - tok0 + tstep - 1) / tstep;
#define PS_TOK(k_) ((size_t)(tok0 + ((k_) < NT ? (k_) : NT - 1) * tstep))
    VMeta mA, mB, mN; v4u wA[16], wB[16];
    peer_v_idx(mA, PS_TOK(0), IDX, g); peer_v_idx(mB, PS_TOK(1), IDX, g);
    asm volatile("" : "+v"(mB.ia), "+v"(mB.ib));
    peer_v_issue(mA, wA, vb, PS_TOK(0), ACT, XBn, g, c);
    int k = 0;
    for (; k + 1 < NT; k += 2) {
        peer_v_idx(mN, PS_TOK(k + 2), IDX, g);
        asm volatile("" ::: "memory");
        peer_v_issue(mB, wB, vb, PS_TOK(k + 1), ACT, XBn, g, c);
        asm volatile("" ::: "memory");
        peer_v_fin<WB>(mA, wA, PS_TOK(k), sl, X, XBn, gg, ssn, lane, c);
        asm volatile("" ::: "memory");
        mA.ia = mN.ia; mA.ib = mN.ib;
        peer_v_idx(mN, PS_TOK(k + 3), IDX, g);
        asm volatile("" ::: "memory");
        peer_v_issue(mA, wA, vb, PS_TOK(k + 2), ACT, XBn, g, c);
        asm volatile("" ::: "memory");
        peer_v_fin<WB>(mB, wB, PS_TOK(k + 1), sl, X, XBn, gg, ssn, lane, c);
        asm volatile("" ::: "memory");
        mB.ia = mN.ia; mB.ib = mN.ib;
    }
    if (k < NT) peer_v_fin<WB>(mA, wA, PS_TOK(k), sl, X, XBn, gg, ssn, lane, c);
#undef PS_TOK
}
__device__ __forceinline__ void final_norm_row(const bf16* __restrict__ xrow, float* orow, const float* __restrict__ g, const float* __restrict__ ssp, int lane) {
    const float rs = rsqrtf(wave_sum(lane < 16 ? ssp[lane] : 0.f) * (1.f / 2048.f) + RMS_EPS);
    const v4u* xr = (const v4u*)xrow + lane; const f32x4* gr = (const f32x4*)g + 2 * lane; f32x4* orw = (f32x4*)orow + 2 * lane;
    v4u v[4]; f32x4 g0[4], g1[4];
#pragma unroll
    for (int jj = 0; jj < 4; ++jj) { v[jj] = xr[64 * jj]; g0[jj] = gr[128 * jj]; g1[jj] = gr[128 * jj + 1]; }
#pragma unroll
    for (int jj = 0; jj < 4; ++jj) { orw[128 * jj] = (f32x4){bflo(v[jj].x) * rs * g0[jj].x, bfhi(v[jj].x) * rs * g0[jj].y, bflo(v[jj].y) * rs * g0[jj].z, bfhi(v[jj].y) * rs * g0[jj].w};
                                     orw[128 * jj + 1] = (f32x4){bflo(v[jj].z) * rs * g1[jj].x, bfhi(v[jj].z) * rs * g1[jj].y, bflo(v[jj].w) * rs * g1[jj].z, bfhi(v[jj].w) * rs * g1[jj].w}; }
}

__device__ __forceinline__ void afb_unit(int unit, const bf16* __restrict__ H, const bf16* __restrict__ Waf, float* AFBo, const float* __restrict__ ss, int lane) {
    const int fr = lane & 15, kq = lane >> 4, row0 = unit * 16;
    const bf16* ap = H + (size_t)(row0 + fr) * 2048 + 8 * kq; const bf16* bp = Waf + (size_t)fr * 2048 + 8 * kq;
    f32x4 c0 = {0.f, 0.f, 0.f, 0.f}, c1 = {0.f, 0.f, 0.f, 0.f};
#pragma unroll 1
    for (int s0 = 0; s0 < 64; s0 += 8) {
        bf16x8 Av[8], Bv[8], Cv[8];
#pragma unroll
        for (int q = 0; q < 8; ++q) { Av[q] = *(const bf16x8*)(ap + 32 * (s0 + q)); Bv[q] = *(const bf16x8*)(bp + 32 * (s0 + q)); Cv[q] = *(const bf16x8*)(bp + 16 * 2048 + 32 * (s0 + q)); }
        asm volatile("" : "+v"(Av[0]), "+v"(Bv[0]), "+v"(Cv[0]), "+v"(Av[7]), "+v"(Bv[7]), "+v"(Cv[7]));
#pragma unroll
        for (int q = 0; q < 8; ++q) { c0 = __builtin_amdgcn_mfma_f32_16x16x32_bf16(Av[q], Bv[q], c0, 0, 0, 0); c1 = __builtin_amdgcn_mfma_f32_16x16x32_bf16(Av[q], Cv[q], c1, 0, 0, 0); }
    }
    const float mine = ss ? pg8::row_rs<16>(ss, row0 + fr) : 1.f;
#pragma unroll
    for (int e = 0; e < 4; ++e) { const int rr = 4 * kq + e; const float sc = __shfl(mine, rr); float* o = AFBo + (size_t)(row0 + rr) * 32 + fr; o[0] = c0[e] * sc; o[16] = c1[e] * sc; }
}
__device__ __forceinline__ const float* gin(const float* p) { const GAS float* g = (const GAS float*)p; asm volatile("" : "+s"(g)); return (const float*)g; }
#ifndef MK_MULTI
#define MK_MULTI 0
#endif
struct Args { const float* in[19]; float* out; unsigned char* ws; int ph_lo, ph_hi, l_lo, l_hi; };
__global__ void __launch_bounds__(NWAVES * 64, 2) fwd_kernel(Args args) {
    extern __shared__ __attribute__((aligned(16))) unsigned char lds[];
    LAS unsigned char* ldsL = (LAS unsigned char*)lds;
    volatile LAS unsigned* MISC = (volatile LAS unsigned*)(ldsL + MISC_OFF);
    const int tid0 = threadIdx.x, wave = __builtin_amdgcn_readfirstlane(tid0 >> 6);
#define PHASE_IDS() int tid = threadIdx.x; asm volatile("" : "+v"(tid)); const int lane = tid & 63; (void)lane; GAS unsigned char* wsp0 = (GAS unsigned char*)args.ws; asm volatile("" : "+s"(wsp0)); unsigned char* wsp = (unsigned char*)wsp0; GAS float* outp0 = (GAS float*)args.out; asm volatile("" : "+s"(outp0)); float* outp = (float*)outp0; int lp = l; asm volatile("" : "+s"(lp)); (void)wsp; (void)outp; (void)lp
    const int G = gridDim.x; const int bx = blockIdx.x; const int vcu = (G % 8 == 0) ? (bx % 8) * (G / 8) + bx / 8 : bx;
    const int gw = vcu * NWAVES + wave, NGW = G * NWAVES;
    unsigned char* ws = args.ws;
    gu32* ctl = (gu32*)(ws + WS_CTL);
    for (int u = tid0; u < (LDS_BYTES - LDSCTL_OFF) / 4; u += NWAVES * 64) ((LAS unsigned*)(ldsL + LDSCTL_OFF))[u] = 0u;
    __syncthreads();
    XcdBarrier bar; bar.bar = (unsigned*)(ctl + CW_BAR); bar.x = 0; bar.st = nullptr;
    if (!MK_MULTI) bar = xcd_barrier_post((unsigned*)(ctl + CW_BAR), MISC + 8);
#define GRID_BAR() do { if (!MK_MULTI) xcd_barrier(bar); } while (0)
    const int lo = args.ph_lo, hi = args.ph_hi;
#ifdef PH_ONLY
#define IN(k) ((k) == PH_ONLY && lo <= (k) && (k) < hi)
#else
#define IN(k) (lo <= (k) && (k) < hi)
#endif
#define BOTH(k) (IN(k) && IN((k) + 1))
#ifndef DUP_MASK
#define DUP_MASK 0
#endif
#define NREP(k) ((((DUP_MASK) >> (k)) & 1) && l == 0 ? 2 : 1)

#define WIN ((bf16*)(wsp + WS_WIN))
#define WUPG ((bf16*)(wsp + WS_WUPG))
#define WUPP ((bf16*)(wsp + WS_WUPP))
#define WOUT ((bf16*)(wsp + WS_WOUT))
#define WQ ((bf16*)(wsp + WS_WQ))
#define POOLW ((bf16*)(wsp + WS_POOLW))
#define SUBK ((bf16*)(wsp + WS_SUBK))
#define Hb ((bf16*)(wsp + WS_H))
#define POOLED ((bf16*)(wsp + WS_POOLED))
#define POOLMIX ((bf16*)(wsp + WS_POOLMIX))
#define QK ((bf16*)(wsp + WS_QK))
#define Pb ((bf16*)(wsp + WS_P))
#define OFb ((bf16*)(wsp + WS_QK))
#define OBb ((bf16*)(wsp + WS_P))
#define VT ((bf16*)(wsp + WS_VT))
#define Rb ((bf16*)(wsp + WS_R))
#define MERGED ((bf16*)(wsp + WS_MERGED))
#define Gb ((bf16*)(wsp + WS_G))
#define PQ ((bf16*)(wsp + WS_PQ))
#define QE ((bf16*)(wsp + WS_QE))
#define GLAOUT ((bf16*)(wsp + WS_GLAOUT))
#define KDT ((bf16*)(wsp + WS_KDT))
#define ATTN ((bf16*)(wsp + WS_ATTN))
#define USC ((float*)(wsp + WS_USC))
#define VSC ((float*)(wsp + WS_VSC))
#define UTAB (wsp + WS_UTAB)
#define VTAB (wsp + WS_VTAB)
#define SEGL ((float*)(wsp + WS_SEGL))
#define SIN ((float*)(wsp + WS_SIN))
#define IDX ((unsigned short*)(wsp + WS_IDX))
#define GATE ((float*)(wsp + WS_GATE))
#define AFB ((float*)(wsp + WS_AFB))
#define DEC ((float*)(wsp + WS_DEC))
#define SSP1 ((float*)(wsp + WS_SSP1))
#define SSP2 ((float*)(wsp + WS_SSP2))
#define PART ((float*)(wsp + WS_QK))
#define ACT ((float*)(wsp + WS_QE))
#define GIN(k_) gin(args.in[k_])
#define x_in GIN(0)
#define XRES ((bf16*)outp)
#define w_in (GIN(2) + (size_t)lp * D * DIN)
#define ssin ((lp == 0) ? (const float*)nullptr : (const float*)SSP2)
#define ss1 SSP1
#define ss2 SSP2
    for (int l = args.l_lo; l < args.l_hi; ++l) {
        if (IN(0)) { PHASE_IDS(); for (int rep = 0; rep < NREP(0); ++rep) {
            LAS float* scr = (LAS float*)(ldsL + wave * 16384);
            { const float* sk = GIN(15) + (size_t)lp * 262144;
              const float* w_upg = GIN(8) + (size_t)lp * 1024 * 2048; const float* w_upp = GIN(11) + (size_t)lp * 1024 * 2048; const float* w_o = GIN(12) + (size_t)lp * 2048 * 2048; const float* w_q = GIN(14) + (size_t)lp * 2048 * 2048;
              const float* w_pool = GIN(9) + (size_t)lp * 4 * 65536;
              constexpr int I_IN = 32 * 257, I_UP = 16 * 64, I_SQ = 32 * 64, I_PL = 4 * 32, I_SK = 512;
              constexpr int E_IN = I_IN, E_UPG = E_IN + I_UP, E_UPP = E_UPG + I_UP, E_O = E_UPP + I_SQ, E_Q = E_O + I_SQ, E_PL = E_Q + I_PL, E_ALL = E_PL + I_SK;
              for (int it0 = gw; it0 < E_ALL; it0 += NGW) { int it = it0;
                if (it < E_IN) { const int kb = it / 257, nb = it % 257, n0 = nb * 32;
                    int d; if (n0 < 1024) d = n0; else if (n0 < 2048) d = n0 + 6400; else if (n0 < 3072) d = n0 - 1024; else if (n0 == 3072) d = 7168; else d = n0 - 1056;
                    transpose_item(w_in, DIN, WIN, 2048, d, kb * 64, n0, scr, lane); }
                else if (it < E_UPG) { it -= E_IN;  transpose_item(w_upg, 2048, WUPG, 1024, (it % 64) * 32, (it / 64) * 64, (it % 64) * 32, scr, lane); }
                else if (it < E_UPP) { it -= E_UPG; transpose_item(w_upp, 2048, WUPP, 1024, (it % 64) * 32, (it / 64) * 64, (it % 64) * 32, scr, lane); }
                else if (it < E_O)   { it -= E_UPP; transpose_item(w_o, 2048, WOUT, 2048, (it % 64) * 32, (it / 64) * 64, (it % 64) * 32, scr, lane); }
                else if (it < E_Q)   { it -= E_O;   transpose_item(w_q, 2048, WQ, 2048, (it % 64) * 32, (it / 64) * 64, (it % 64) * 32, scr, lane, GIN(13) + (size_t)lp * D); }
                else if (it < E_PL)  { it -= E_Q; const int g = it >> 5, r5 = it & 31; transpose_item(w_pool + (size_t)g * 65536, 256, POOLW + (size_t)g * 65536, 256, (r5 % 8) * 32, (r5 / 8) * 64, (r5 % 8) * 32, scr, lane); }
                else { const int f = it - E_PL; const int hp = f >> 5, nt = (f >> 3) & 3, s5 = f & 7, r = lane & 31, hh = lane >> 5;
                    const float* src = sk + ((size_t)hp * 128 + 32 * nt + r) * 128 + 16 * s5 + 8 * hh; const f32x4 a = *(const f32x4*)src, b = *(const f32x4*)(src + 4);
                    v4u o = {pkbf(a.x, a.y), pkbf(a.z, a.w), pkbf(b.x, b.y), pkbf(b.z, b.w)}; *(v4u*)(SUBK + ((size_t)f * 64 + lane) * 8) = o; } } }
            { const float* ut = GIN(16) + (size_t)lp * 16384 * 2048; const float* vt = GIN(17) + (size_t)lp * 16384 * 2048;
              for (int row = gw; row < 16384; row += NGW) { if (row < 8192)
                table_rows_fp8(ut, (unsigned*)UTAB, USC, row, row + 8192, lane, GIN(13) + (size_t)lp * D); else table_rows_fp8(vt, (unsigned*)VTAB, VSC, row - 8192, row, lane); } }
            if (lp == 0) for (int m = gw; m < M; m += NGW) rmsnorm_row(x_in + (size_t)m * D, GIN(1), Hb + (size_t)m * D, lane);
            if (rep + 1 < NREP(0)) GRID_BAR(); }
            if (BOTH(0)) GRID_BAR();
        }
        if (IN(1)) { PHASE_IDS(); for (int rep = 0; rep < NREP(1); ++rep) {
            { pg8::Gemm g{Hb, WIN, M, 7168, 2048, 2048, 2048, 0, nullptr, nullptr}; pg8::StaticOrder S; S.init(M, 7168, G, bx);
              pg8::EpiProj E{QK, Rb, Pb, Gb, AFB, ssin};
              pg8::gemm_phase<pg8::EpiProj, pg8::StaticOrder, true, true>(ldsL, g, S, E); }
            { pg8::Gemm g{WIN + (size_t)7424 * 2048, Hb, 1024, M, 2048, 2048, 2048, 0, nullptr, nullptr}; pg8::StaticOrder S; S.init(1024, M, G, bx);
              pg8::EpiVT E{VT, ssin};
              pg8::gemm_phase<pg8::EpiVT, pg8::StaticOrder, true, true>(ldsL, g, S, E); }
            for (int unit = gw; unit < M / 16; unit += NGW) afb_unit(unit, Hb, WIN + (size_t)7168 * 2048, AFB, ssin, lane);
            if (rep + 1 < NREP(1)) GRID_BAR(); }
            if (BOTH(1)) GRID_BAR();
        }
        if (IN(2)) { PHASE_IDS(); for (int rep = 0; rep < NREP(2); ++rep) {
            if (vcu < 4096) { PrepIn pin; gla_prep_load(pin, vcu, QK, AFB, GIN(3) + (size_t)lp * 8192, GIN(4) + (size_t)lp * 512, GIN(5) + (size_t)lp * 8192, GIN(6) + (size_t)lp * 512, tid);
                __syncthreads();
                int pb = 0;
                for (int uid = vcu; uid < 4096; uid += G, pb ^= 1)
                    gla_prep_unit(uid, (uid + G < 4096) ? uid + G : uid, pin, ldsL + pb * PA_BYTES, QK, AFB, GIN(3) + (size_t)lp * 8192, GIN(4) + (size_t)lp * 512, GIN(5) + (size_t)lp * 8192, GIN(6) + (size_t)lp * 512, QE, KDT, ATTN, DEC, tid, wave, lane);
                __syncthreads(); }
            for (int item = vcu * 512 + tid; item < (M / 32) * 128; item += G * 512) pool_item(item, Pb, POOLED);
            if (rep + 1 < NREP(2)) GRID_BAR(); }
            if (BOTH(2)) GRID_BAR();
        }
        if (IN(3)) { PHASE_IDS(); for (int rep = 0; rep < NREP(3); ++rep) {
            for (int su = vcu; su < 16 * NSEG; su += G) gla_scan_block<false>(su, ldsL, QE, ATTN, KDT, DEC, VT, SEGL, SIN, OFb, OBb, tid, wave, lane);
            if (rep + 1 < NREP(3)) GRID_BAR(); }
            if (BOTH(3)) GRID_BAR();
        }
        if (IN(5)) { PHASE_IDS(); for (int rep = 0; rep < NREP(5); ++rep) {
            for (int su = vcu; su < 16 * NSEG; su += G) gla_scan_block<true>(su, ldsL, QE, ATTN, KDT, DEC, VT, SEGL, SIN, OFb, OBb, tid, wave, lane);
            if (rep + 1 < NREP(5)) GRID_BAR(); }
            if (BOTH(5)) GRID_BAR();
        }
        if (IN(6)) { PHASE_IDS(); for (int rep = 0; rep < NREP(6); ++rep) {
            { float gg[16]; { const f32x4* gp = (const f32x4*)(GIN(7) + (size_t)lp * 1024 + 16 * lane);
#pragma unroll
                for (int q = 0; q < 4; ++q) { const f32x4 x = gp[q]; gg[4 * q] = x.x; gg[4 * q + 1] = x.y; gg[4 * q + 2] = x.z; gg[4 * q + 3] = x.w; } }
              for (int m = gw; m < M; m += 2 * NGW) { const int m2 = (m + NGW < M) ? m + NGW : m;
                  FinIn ia, ib; gla_fin_load(ia, m, OFb, OBb, Rb, lane); gla_fin_load(ib, m2, OFb, OBb, Rb, lane);
                  gla_fin_row(ia, m, gg, GLAOUT, lane); if (m2 != m) gla_fin_row(ib, m2, gg, GLAOUT, lane); } }
            { pg8::Gemm g{POOLED, POOLW, M, 1024, 256, 1024, 256, 512, nullptr, nullptr}; pg8::StaticOrder S; S.init(M, 1024, G, bx);
              pg8::EpiScale<false> E{POOLMIX, 1024, GIN(10) + (size_t)lp * 1024, nullptr};
              pg8::gemm_phase<pg8::EpiScale<false>, pg8::StaticOrder, true, true>(ldsL, g, S, E); }
            if (rep + 1 < NREP(6)) GRID_BAR(); }
            if (BOTH(6)) GRID_BAR();
        }
        if (IN(7)) { PHASE_IDS(); for (int rep = 0; rep < NREP(7); ++rep) {
            { pg8::Gemm g{GLAOUT, WUPG, M, 2048, 1024, 1024, 1024, 0, POOLMIX, WUPP}; pg8::TwoPartOrder S; S.init(M, 2048, G, bx);
              pg8::EpiMerge E{MERGED, (const unsigned char*)Gb};
              pg8::gemm_phase<pg8::EpiMerge, pg8::TwoPartOrder, true, true>(ldsL, g, S, E); }
            if (rep + 1 < NREP(7)) GRID_BAR(); }
            if (BOTH(7)) GRID_BAR();
        }
        if (IN(8)) { PHASE_IDS(); for (int rep = 0; rep < NREP(8); ++rep) {
            { pg8::Gemm g{MERGED, WOUT, M, 2048, 2048, 2048, 2048, 0, nullptr, nullptr}; pg8::StaticOrder S; S.init(M, 2048, G, bx);
              if (lp == 0) { pg8::EpiResid<false> E{GIN(0), Hb, ss1}; pg8::gemm_phase<pg8::EpiResid<false>, pg8::StaticOrder, true, true>(ldsL, g, S, E); }
              else         { pg8::EpiResid<true> E{XRES, Hb, ss1};   pg8::gemm_phase<pg8::EpiResid<true>, pg8::StaticOrder, true, true>(ldsL, g, S, E); } }
            if (rep + 1 < NREP(8)) GRID_BAR(); }
            if (BOTH(8)) GRID_BAR();
        }
        if (IN(9)) { PHASE_IDS(); for (int rep = 0; rep < NREP(9); ++rep) {
            { pg8::Gemm g{Hb, WQ, M, 2048, 2048, 2048, 2048, 0, nullptr, nullptr}; pg8::StaticOrder S; S.init(M, 2048, G, bx);
              pg8::EpiScale<true> E{PQ, 2048, nullptr, ss1};
              pg8::gemm_phase<pg8::EpiScale<true>, pg8::StaticOrder, true, true>(ldsL, g, S, E); }
            if (rep + 1 < NREP(9)) GRID_BAR(); }
            if (BOTH(9)) GRID_BAR();
        }
        if (IN(10)) { PHASE_IDS(); for (int rep = 0; rep < NREP(10); ++rep) {
            for (int j = 0; j < 4; ++j) {
                __syncthreads();
                for (int i = tid; i < 8192; i += 512) *(LAS v4u*)(ldsL + i * 16) = *(const v4u*)((const unsigned char*)SUBK + (size_t)j * 131072 + (size_t)i * 16);
                __syncthreads();
                const int hsel = wave >> 2, h = 2 * j + hsel;
                for (int tile = vcu * 4 + (wave & 3); tile < M / 32; tile += G * 4) peer_topk_item(tile, h, ldsL + hsel * 65536, PQ, IDX, GATE, lane);
            }
            if (rep + 1 < NREP(10)) GRID_BAR(); }
            if (BOTH(10)) GRID_BAR();
        }
        if (IN(11)) { PHASE_IDS(); for (int rep = 0; rep < NREP(11); ++rep) {
            const int label = bx & 7, rank = bx >> 3, nrank = (G - label + 7) >> 3;
            for (int sub = 0; sub < 2; ++sub)
                peer_slice_loop<false>(2 * label + sub, label, sub, rank * NWAVES + wave, nrank * NWAVES, Hb, ACT, IDX, UTAB, PART, outp, Hb, nullptr, nullptr, lane);
            if (rep + 1 < NREP(11)) GRID_BAR(); }
            if (BOTH(11)) GRID_BAR();
        }
        if (IN(12)) { PHASE_IDS(); for (int rep = 0; rep < NREP(12); ++rep) {
            for (int tok = 2 * gw; tok < M; tok += 2 * NGW) peer_combine_row((size_t)tok, PART, IDX, GATE, USC, VSC, ss1, ACT, lane);
            if (rep + 1 < NREP(12)) GRID_BAR(); }
            if (BOTH(12)) GRID_BAR();
        }
        if (IN(13)) { PHASE_IDS();
            const int last = (lp == DEPTH - 1);
            const float* gn = last ? GIN(18) : GIN(1) + (size_t)(lp + 1) * D;
            const int label = bx & 7, rank = bx >> 3, nrank = (G - label + 7) >> 3;
            for (int sub = 0; sub < 2; ++sub)
                if (last) peer_v_loop<false>(2 * label + sub, rank * NWAVES + wave, nrank * NWAVES, ACT, IDX, VTAB, XRES, Hb, gn, ss2, lane);
                else      peer_v_loop<true>(2 * label + sub, rank * NWAVES + wave, nrank * NWAVES, ACT, IDX, VTAB, XRES, Hb, gn, ss2, lane);
            if ((BOTH(13) && last) || (lo == 0 && hi == NPH && l + 1 < args.l_hi)) GRID_BAR();
        }
        if (IN(14) && l == DEPTH - 1) { PHASE_IDS();
            for (int m = gw; m < M; m += NGW) final_norm_row(Hb + (size_t)m * D, outp + (size_t)m * D, GIN(18), ss2 + (size_t)m * 16, lane);
        }
    }
#undef IN
#undef BOTH
#undef GRID_BAR
}

#undef WIN
#undef WUPG
#undef WUPP
#undef WOUT
#undef WQ
#undef POOLW
#undef SUBK
#undef Hb
#undef POOLED
#undef POOLMIX
#undef QK
#undef Pb
#undef OFb
#undef OBb
#undef VT
#undef Rb
#undef MERGED
#undef Gb
#undef PQ
#undef QE
#undef GLAOUT
#undef KDT
#undef ATTN
#undef USC
#undef VSC
#undef UTAB
#undef VTAB
#undef SEGL
#undef SIN
#undef IDX
#undef GATE
#undef AFB
#undef DEC
#undef SSP1
#undef SSP2
#undef PART
#undef ACT
#undef GIN
#undef x_in
#undef XRES
#undef w_in
#undef ssin
#undef ss1
#undef ss2
extern "C" void kernel_launch(void* const* d_in, const int* in_sizes, int n_in, void* d_out, int out_size, void* d_ws, size_t ws_size, hipStream_t stream) {
    static int grid = 0;
    if (grid == 0) {
        if (n_in != 19 || in_sizes[0] != M * D || out_size != M * D || ws_size < WS_END) { fprintf(stderr, "kernel_launch: unexpected shapes / workspace (n_in %d, ws %zu, need %zu); nothing launched\n", n_in, ws_size, (size_t)WS_END); grid = -1; return; }
        int dev = 0, cus = 0, per_cu = 0;
        if (hipGetDevice(&dev) != hipSuccess || hipDeviceGetAttribute(&cus, hipDeviceAttributeMultiprocessorCount, dev) != hipSuccess) { grid = -1; return; }
        if (hipFuncSetAttribute((const void*)fwd_kernel, hipFuncAttributeMaxDynamicSharedMemorySize, LDS_BYTES) != hipSuccess) { fprintf(stderr, "kernel_launch: hipFuncSetAttribute failed\n"); grid = -1; return; }
        if (hipOccupancyMaxActiveBlocksPerMultiprocessor(&per_cu, (const void*)fwd_kernel, NWAVES * 64, LDS_BYTES) != hipSuccess || per_cu < 1) { fprintf(stderr, "kernel_launch: occupancy query reports %d blocks per CU\n", per_cu); }
        (void)hipGetLastError();
        grid = cus;
    }
    if (grid < 0) return;
    if (hipMemsetAsync((char*)d_ws + WS_CTL, 0, CTL_ZERO_BYTES, stream) != hipSuccess) return;
    Args a{};
    for (int i = 0; i < 19; ++i) a.in[i] = (const float*)d_in[i];
    a.out = (float*)d_out; a.ws = (unsigned char*)d_ws;
#if MK_MULTI
    for (int l = 0; l < DEPTH; ++l)
        for (int ph = 0; ph < NPH; ++ph) { a.ph_lo = ph; a.ph_hi = ph + 1; a.l_lo = l; a.l_hi = l + 1;
            hipLaunchKernelGGL(fwd_kernel, dim3(grid), dim3(NWAVES * 64), LDS_BYTES, stream, a); }
#else
    a.ph_lo = 0; a.ph_hi = NPH; a.l_lo = 0; a.l_hi = DEPTH;
    hipLaunchKernelGGL(fwd_kernel, dim3(grid), dim3(NWAVES * 64), LDS_BYTES, stream, a);
#endif
}
```
